# Optimizing an MI355X kernel written in HIP

```python
import math
import jax, jax.numpy as jnp
from jax import lax
import numpy as np

D_MODEL = 2048
BATCH = 4
SEQ = 8192
DEPTH = 1

RET_HEADS = 8
RET_QK_DIM = 256
RET_V_DIM = 512
RET_CHUNK = 128
ATT_GROUPS = ((128, 1), (512, 4), (2048, 16))
ATT_HEADS_PER_GROUP = 6
ATT_HEAD_DIM = 128
ATT_BLOCK = 128
ROPE_THETA = 10000.0
D_FF = 5632
CONV_WIDTH = 3
NORM_EPS = 1e-6

N_ATT_GROUPS = len(ATT_GROUPS)
RET_QK_W = RET_HEADS * RET_QK_DIM
RET_V_W = RET_HEADS * RET_V_DIM
ATT_HEADS = N_ATT_GROUPS * ATT_HEADS_PER_GROUP
ATT_W = ATT_HEADS * ATT_HEAD_DIM
IN_PROJ_SIZES = (RET_QK_W, RET_QK_W, RET_V_W, RET_V_W, ATT_W, ATT_W, ATT_W)
IN_PROJ_W = sum(IN_PROJ_SIZES)
N_BRANCHES = 2

kernel_name = "hybrid_retention_dilated_attn_convffn_block"


def rms_norm(x, gain):
    xf = x.astype(jnp.float32)
    y = xf * lax.rsqrt(jnp.mean(xf * xf, axis=-1, keepdims=True) + NORM_EPS)
    return (y * gain.astype(jnp.float32)).astype(x.dtype)


def modulate(h, shift, scale):
    return h * (1.0 + scale[:, None, :]) + shift[:, None, :]


def rotary(t, positions):
    d = t.shape[-1]
    inv_freq = ROPE_THETA ** (-jnp.arange(0, d, 2, dtype=jnp.float32) / d)
    ang = positions.astype(jnp.float32)[:, :, None] * inv_freq
    cos = jnp.cos(ang)[:, :, None, :]
    sin = jnp.sin(ang)[:, :, None, :]
    tf = t.astype(jnp.float32)
    t1, t2 = tf[..., : d // 2], tf[..., d // 2:]
    out = jnp.concatenate([t1 * cos - t2 * sin, t2 * cos + t1 * sin], axis=-1)
    return out.astype(t.dtype)


def in_projection(h, w_in):
    proj = h @ w_in
    return jnp.split(proj, list(np.cumsum(IN_PROJ_SIZES)[:-1]), axis=-1)


def retention_chunkwise(q, k, v):
    B, S, H, dk = q.shape
    dv = v.shape[-1]
    C = RET_CHUNK
    N = S // C
    qf = q.astype(jnp.float32)
    kf = k.astype(jnp.float32) * (dk ** -0.5)
    vf = v.astype(jnp.float32)
    log_gamma = jnp.log1p(-jnp.exp2(-5.0 - jnp.arange(H, dtype=jnp.float32)))
    idx = jnp.arange(C, dtype=jnp.float32)
    dist = idx[:, None] - idx[None, :]
    decay_mat = jnp.where(dist[None] >= 0,
                          jnp.exp(jnp.maximum(dist, 0.0)[None] * log_gamma[:, None, None]), 0.0)
    xi = jnp.exp((idx[None, :] + 1.0) * log_gamma[:, None])
    zeta = jnp.exp((C - 1.0 - idx[None, :]) * log_gamma[:, None])
    gamma_c = jnp.exp(C * log_gamma)

    def to_chunks(t):
        return t.reshape(B, N, C, H, t.shape[-1]).transpose(1, 0, 3, 2, 4)

    def step(state, inp):
        qc, kc, vc = inp
        scores = jnp.einsum('bhid,bhjd->bhij', qc, kc) * decay_mat
        inner = jnp.einsum('bhij,bhjv->bhiv', scores, vc)
        cross = jnp.einsum('bhid,bhdv->bhiv', qc, state) * xi[None, :, :, None]
        new_state = state * gamma_c[None, :, None, None] + jnp.einsum(
            'bhjd,bhjv->bhdv', kc, vc * zeta[None, :, :, None])
        return new_state, inner + cross

    state0 = jnp.zeros((B, H, dk, dv), jnp.float32)
    _, out = lax.scan(step, state0, (to_chunks(qf), to_chunks(kf), to_chunks(vf)))
    return out.transpose(1, 0, 3, 2, 4).reshape(B, S, H, dv)


def dilated_window_attention(q, k, v, window, dilation):
    B, S, H, dh = q.shape
    span = window // dilation
    L = ATT_BLOCK
    assert span <= L
    n = S // dilation
    nb = -(-n // L)
    n_pad = nb * L

    def to_classes(t):
        t = t.reshape(B, n, dilation, H, dh).transpose(0, 2, 3, 1, 4)
        t = jnp.pad(t, ((0, 0), (0, 0), (0, 0), (0, n_pad - n), (0, 0)))
        return t.reshape(B, dilation, H, nb, L, dh)

    def with_prev_block(t):
        prev = jnp.pad(t[:, :, :, :-1], ((0, 0), (0, 0), (0, 0), (1, 0), (0, 0), (0, 0)))
        return jnp.concatenate([prev, t], axis=4)

    qb = to_classes(q)
    kw = with_prev_block(to_classes(k))
    vw = with_prev_block(to_classes(v))
    s = jnp.einsum('brhnqd,brhnkd->brhnqk', qb, kw).astype(jnp.float32) * (dh ** -0.5)
    iq = jnp.arange(L)[:, None]
    ik = jnp.arange(2 * L)[None, :]
    blk = jnp.arange(nb)[:, None, None]
    dist = L + iq - ik
    kpos = blk * L - L + ik
    valid = (dist >= 0) & (dist <= span) & (kpos >= 0)
    s = jnp.where(valid, s, -jnp.inf)
    m = jnp.max(s, axis=-1, keepdims=True)
    p = jnp.exp(s - m)
    denom = jnp.sum(p, axis=-1, keepdims=True)
    o = jnp.einsum('brhnqk,brhnkd->brhnqd', p, vw.astype(jnp.float32)) / denom
    lse = (m + jnp.log(denom))[..., 0]
    o = o.reshape(B, dilation, H, n_pad, dh)[:, :, :, :n].transpose(0, 3, 1, 2, 4).reshape(B, S, H, dh)
    lse = lse.reshape(B, dilation, H, n_pad)[..., :n].transpose(0, 3, 1, 2).reshape(B, S, H)
    return o.astype(q.dtype), lse


def hybrid_mixer(h, positions, w_in, ret_norm_gain, w_ret_out, w_att_out,
                 w_branch_gate, b_branch_gate, w_mix_out):
    B, S, _ = h.shape
    rq, rk, rv, rg, aq, ak, av = in_projection(h, w_in)

    rq = rotary(rq.reshape(B, S, RET_HEADS, RET_QK_DIM), positions)
    rk = rotary(rk.reshape(B, S, RET_HEADS, RET_QK_DIM), positions)
    rv = rv.reshape(B, S, RET_HEADS, RET_V_DIM)
    ret = retention_chunkwise(rq, rk, rv)
    ret = ret * lax.rsqrt(jnp.mean(ret * ret, axis=-1, keepdims=True) + NORM_EPS)
    ret = (ret * ret_norm_gain.astype(jnp.float32)).astype(h.dtype).reshape(B, S, RET_V_W)
    y_ret = (jax.nn.silu(rg) * ret) @ w_ret_out

    aq = rotary(aq.reshape(B, S, ATT_HEADS, ATT_HEAD_DIM), positions)
    ak = rotary(ak.reshape(B, S, ATT_HEADS, ATT_HEAD_DIM), positions)
    av = av.reshape(B, S, ATT_HEADS, ATT_HEAD_DIM)
    outs, lses = [], []
    for g, (window, dilation) in enumerate(ATT_GROUPS):
        sl = slice(g * ATT_HEADS_PER_GROUP, (g + 1) * ATT_HEADS_PER_GROUP)
        o, lse = dilated_window_attention(aq[:, :, sl], ak[:, :, sl], av[:, :, sl], window, dilation)
        outs.append(o)
        lses.append(lse)
    alpha = jax.nn.softmax(jnp.stack(lses, axis=0), axis=0)
    att = jnp.concatenate([outs[g] * alpha[g][..., None].astype(h.dtype) for g in range(N_ATT_GROUPS)],
                          axis=2).reshape(B, S, ATT_W)
    y_att = att @ w_att_out

    gates = jax.nn.sigmoid(h @ w_branch_gate + b_branch_gate)
    g_ret, g_att = jnp.split(gates, N_BRANCHES, axis=-1)
    return (g_ret * y_ret + g_att * y_att) @ w_mix_out


def conv_ffn(h, w_ffn_up, conv_w, conv_b, w_ffn_down):
    S = h.shape[1]
    up = h @ w_ffn_up
    a, b = jnp.split(up, 2, axis=-1)
    a_pad = jnp.pad(a, ((0, 0), (CONV_WIDTH - 1, 0), (0, 0)))
    a_conv = conv_b
    for j in range(CONV_WIDTH):
        start = CONV_WIDTH - 1 - j
        a_conv = a_conv + conv_w[j] * a_pad[:, start:start + S]
    return (jax.nn.gelu(a_conv, approximate=True) * b) @ w_ffn_down


def setup_inputs(seed: int = 0) -> dict:
    key = jax.random.key(seed)
    ks = jax.random.split(key, 20)
    f32 = jnp.float32

    def nrm(k, shape, fan_in, mult=1.0):
        return jax.random.normal(k, shape, f32) * (mult * fan_in ** -0.5)

    def gain(k, shape):
        return 1.0 + 0.05 * jax.random.normal(k, shape, f32)

    return {
        "x": jax.random.normal(ks[0], (BATCH, SEQ, D_MODEL), f32),
        "c": jax.random.normal(ks[1], (BATCH, D_MODEL), f32),
        "positions": jnp.broadcast_to(jnp.arange(SEQ, dtype=jnp.int32)[None, :], (BATCH, SEQ)),
        "w_ada": nrm(ks[2], (DEPTH, D_MODEL, 6 * D_MODEL), D_MODEL, 0.5),
        "b_ada": 0.01 * jax.random.normal(ks[3], (DEPTH, 6 * D_MODEL), f32),
        "g_pre_mix": gain(ks[4], (DEPTH, D_MODEL)),
        "w_in": nrm(ks[5], (DEPTH, D_MODEL, IN_PROJ_W), D_MODEL),
        "ret_norm_gain": gain(ks[6], (DEPTH, RET_HEADS, RET_V_DIM)),
        "w_ret_out": nrm(ks[7], (DEPTH, RET_V_W, D_MODEL), RET_V_W),
        "w_att_out": nrm(ks[8], (DEPTH, ATT_W, D_MODEL), ATT_W),
        "w_branch_gate": nrm(ks[9], (DEPTH, D_MODEL, N_BRANCHES * D_MODEL), D_MODEL),
        "b_branch_gate": 0.01 * jax.random.normal(ks[10], (DEPTH, N_BRANCHES * D_MODEL), f32),
        "w_mix_out": nrm(ks[11], (DEPTH, D_MODEL, D_MODEL), D_MODEL),
        "g_post_mix": gain(ks[12], (DEPTH, D_MODEL)),
        "g_pre_ffn": gain(ks[13], (DEPTH, D_MODEL)),
        "w_ffn_up": nrm(ks[14], (DEPTH, D_MODEL, 2 * D_FF), D_MODEL),
        "conv_w": nrm(ks[15], (DEPTH, CONV_WIDTH, D_FF), CONV_WIDTH),
        "conv_b": 0.01 * jax.random.normal(ks[16], (DEPTH, D_FF), f32),
        "w_ffn_down": nrm(ks[17], (DEPTH, D_FF, D_MODEL), D_FF),
        "g_post_ffn": gain(ks[18], (DEPTH, D_MODEL)),
    }


def reference(x, c, positions, w_ada, b_ada, g_pre_mix, w_in, ret_norm_gain, w_ret_out, w_att_out,
              w_branch_gate, b_branch_gate, w_mix_out, g_post_mix, g_pre_ffn, w_ffn_up, conv_w,
              conv_b, w_ffn_down, g_post_ffn):
    cond = jax.nn.silu(c)
    for l in range(DEPTH):
        ada = cond @ w_ada[l] + b_ada[l]
        sh_m, sc_m, gt_m, sh_f, sc_f, gt_f = jnp.split(ada, 6, axis=-1)
        h = modulate(rms_norm(x, g_pre_mix[l]), sh_m, sc_m)
        y = hybrid_mixer(h, positions, w_in[l], ret_norm_gain[l], w_ret_out[l], w_att_out[l],
                         w_branch_gate[l], b_branch_gate[l], w_mix_out[l])
        x = x + gt_m[:, None, :] * rms_norm(y, g_post_mix[l])
        h = modulate(rms_norm(x, g_pre_ffn[l]), sh_f, sc_f)
        y = conv_ffn(h, w_ffn_up[l], conv_w[l], conv_b[l], w_ffn_down[l])
        x = x + gt_f[:, None, :] * rms_norm(y, g_post_ffn[l])
    return x
```

```cpp
#include <hip/hip_runtime.h>
#include <hip/hip_cooperative_groups.h>
#include <cstdio>
#include <cstdint>
namespace cg = cooperative_groups;

#define DI __device__ __forceinline__
#define LAS __attribute__((address_space(3)))
typedef unsigned short bf16_t;
typedef short bf16x8 __attribute__((ext_vector_type(8)));
typedef short s16x4 __attribute__((ext_vector_type(4)));
typedef float f32x4 __attribute__((ext_vector_type(4)));
typedef unsigned u32x4 __attribute__((ext_vector_type(4)));
typedef unsigned u32x2 __attribute__((ext_vector_type(2)));

#ifndef PHMASK
#define PHMASK 0xFFFF
#endif
#ifndef N_LAUNCH_PER_PHASE
#define N_LAUNCH_PER_PHASE 0
#endif

constexpr int T_TOK = 32768, DM = 2048, SEQ = 8192, NB = 4;
constexpr int FF = 5632;
constexpr int LDS_BYTES = 131072;
constexpr size_t MiB = 1u << 20;
constexpr size_t WS_ADA = 0;
constexpr size_t WS_LSE = 1 * MiB;
constexpr size_t WS_RETSS = 4 * MiB;
constexpr size_t WS_WUP = 12 * MiB;
constexpr size_t WS_WDOWN = 56 * MiB;
constexpr size_t WS_WIN = 78 * MiB;
constexpr size_t WS_WGATE = 153 * MiB;
constexpr size_t WS_WRET = 169 * MiB;
constexpr size_t WS_WATT = 185 * MiB;
constexpr size_t WS_WMIX = 194 * MiB;
constexpr size_t WS_H = 206 * MiB;
constexpr size_t WS_RQ = 334 * MiB;
constexpr size_t WS_RK = 462 * MiB;
constexpr size_t WS_AQ = 590 * MiB;
constexpr size_t WS_AK = 734 * MiB;
constexpr size_t WS_AV = 878 * MiB;
constexpr size_t WS_GATES = 334 * MiB;
constexpr size_t WS_U = 734 * MiB;
constexpr size_t WS_U2 = 206 * MiB;
constexpr size_t WS_Y = 334 * MiB;
constexpr size_t WS_H2 = 78 * MiB;
constexpr size_t WS_A = 206 * MiB;
constexpr size_t WS_ACT = 558 * MiB;
constexpr size_t WS_Y2 = 78 * MiB;
constexpr size_t WS_END = 1022 * MiB;

struct Params {
    const float *x, *c; const int* pos;
    const float *w_ada, *b_ada, *g_pre_mix, *w_in, *ret_gain, *w_ret_out, *w_att_out, *w_gate, *b_gate, *w_mix, *g_post_mix, *g_pre_ffn, *w_up, *conv_w, *conv_b, *w_down, *g_post_ffn;
    float* out; unsigned char* ws; int ph_lo, ph_hi;
};

typedef __bf16 bf16x2_t __attribute__((ext_vector_type(2)));
DI unsigned cvt_pk_bf16(float lo, float hi) { bf16x2_t v = {(__bf16)lo, (__bf16)hi}; return __builtin_bit_cast(unsigned, v); }
DI float bflo(unsigned w) { return __uint_as_float(w << 16); }
DI float bfhi(unsigned w) { return __uint_as_float(w & 0xffff0000u); }
DI float wave_sum(float v) {
#pragma unroll
    for (int o = 1; o < 64; o <<= 1) v += __shfl_xor(v, o);
    return v;
}
DI float sigmoidf_(float v) { return 1.0f / (1.0f + __expf(-v)); }
DI f32x4 mfma16(bf16x8 a, bf16x8 b, f32x4 c) { return __builtin_amdgcn_mfma_f32_16x16x32_bf16(a, b, c, 0, 0, 0); }
DI s16x4 tr_read(LAS unsigned char* p) { return __builtin_amdgcn_ds_read_tr16_b64_v4i16((LAS s16x4*)p); }
DI bf16x8 tr_read2(LAS unsigned char* p0, LAS unsigned char* p1) { s16x4 lo = tr_read(p0), hi = tr_read(p1); return __builtin_shufflevector(lo, hi, 0, 1, 2, 3, 4, 5, 6, 7); }

namespace pg8 {
constexpr int BM = 256, BK = 64, HALF = 128, HTB = HALF * BK * 2, STAGE_BYTES = 8 * HTB, NXCD = 8, WGM = 8;
DI int lds_byte(int r, int c) { const int st = (r >> 4) * 2 + (c >> 5), rr = r & 15, cc = c & 31, ob = rr * 64 + cc * 2; return st * 1024 + (ob ^ (((ob >> 9) & 1) << 5)); }
DI void stage_rc(int b, int& R, int& C) { const int st = b / 1024, sb = b % 1024, swz = sb ^ (((sb >> 9) & 1) << 5); R = (st >> 1) * 16 + swz / 64; C = (st & 1) * 32 + (swz % 64) / 2; }
struct Unit { int pm, pn; };
struct Gemm { const bf16_t* A; const bf16_t* Bt; int M, N, K; };
struct StaticOrder {
    int nM, nN, nwg, G, c, skip_lo, skip_n;
    DI void init(int M, int N, int G_, int c_, int slo = 1 << 30, int sn = 0) { nM = M / BM; nN = N / BM; nwg = nM * nN; G = G_; c = c_; skip_lo = slo; skip_n = sn; }
    DI bool next(int i, Unit& u) const {
        const long L = (long)i * G + c; if (L >= nwg) return false;
        int wgid = (int)L; { const int q = nwg / NXCD, r = nwg % NXCD, xcd = wgid % NXCD, off = wgid / NXCD; wgid = (xcd < r ? xcd * (q + 1) : r * (q + 1) + (xcd - r) * q) + off; }
        const int nig = WGM * nN, gid = wgid / nig, fm = gid * WGM, gsz = (nM - fm) < WGM ? (nM - fm) : WGM;
        u.pm = fm + ((wgid % nig) % gsz); u.pn = (wgid % nig) / gsz; if (u.pn >= skip_lo) u.pn += skip_n; return true;
    }
};

template <class Epi>
DI void gemm_phase(LAS unsigned char* lds, const Gemm g, const StaticOrder& S, const Epi& E) {
    const int tid = threadIdx.x, wid = __builtin_amdgcn_readfirstlane(tid >> 6), lane = tid & 63, wr = wid >> 2, wc = wid & 3, fr = lane & 15, fq = lane >> 4;
    const int K = g.K, nt = K / BK;
    unsigned voffA[2];
#pragma unroll
    for (int i = 0; i < 2; ++i) { int R, C; stage_rc(tid * 16 + i * 8192, R, C); voffA[i] = (unsigned)(R * K + C) * 2u; }
    const size_t kstep = (size_t)(BK * 2);
    const size_t hstep = (size_t)HALF * K * 2;
    const size_t tstep = 2 * hstep;
    const unsigned ldsw = (unsigned)wid * 1024u;
    const int aoff = lds_byte(wr * 64 + fr, fq * 8), boff = lds_byte(wc * 32 + fr, fq * 8);
#define PG8_SA(b, h) (((b) * 2 + (h)) * HTB)
#define PG8_SB(b, h) ((4 + (b) * 2 + (h)) * HTB)
#define PG8_STAGE(bufoff, gbase) do { _Pragma("unroll") for (int _i = 0; _i < 2; ++_i) \
        __builtin_amdgcn_global_load_lds((const unsigned*)((const char*)(gbase) + voffA[_i]), (LAS unsigned*)(lds + (bufoff) + ldsw + _i * 8192), 16, 0, 0); } while (0)
#define PG8_LDA(dst, b, h) do { _Pragma("unroll") for (int m = 0; m < 4; ++m) _Pragma("unroll") for (int k = 0; k < 2; ++k) dst[m][k] = *(const LAS bf16x8*)(lds + PG8_SA(b, h) + aoff + m * 2048 + k * 1024); } while (0)
#define PG8_LDB(dst, b, h) do { _Pragma("unroll") for (int n = 0; n < 2; ++n) _Pragma("unroll") for (int k = 0; k < 2; ++k) dst[n][k] = *(const LAS bf16x8*)(lds + PG8_SB(b, h) + boff + n * 2048 + k * 1024); } while (0)
#define PG8_MMA(ai, bj, At, Bt) do { __builtin_amdgcn_s_setprio(1); _Pragma("unroll") for (int m = 0; m < 4; ++m) _Pragma("unroll") for (int n = 0; n < 2; ++n) _Pragma("unroll") for (int k = 0; k < 2; ++k) \
        acc[ai][bj][m][n] = __builtin_amdgcn_mfma_f32_16x16x32_bf16(Bt[n][k], At[m][k], acc[ai][bj][m][n], 0, 0, 0); __builtin_amdgcn_s_setprio(0); } while (0)
#define PG8_WAIT_V(n) asm volatile("s_waitcnt vmcnt(" #n ")" ::: "memory")
#define PG8_WAIT_L(n) asm volatile("s_waitcnt lgkmcnt(" #n ")" ::: "memory")
#define PG8_BAR __builtin_amdgcn_s_barrier()
#define PG8_SCHED __builtin_amdgcn_sched_barrier(0)
    Unit cur, nxt; int ui = 0;
    if (!S.next(0, cur)) return;
    f32x4 acc[2][2][4][2];
#pragma unroll
    for (int a = 0; a < 2; ++a)
#pragma unroll
        for (int b = 0; b < 2; ++b)
#pragma unroll
            for (int m = 0; m < 4; ++m)
#pragma unroll
                for (int n = 0; n < 2; ++n) acc[a][b][m][n] = (f32x4){0.f, 0.f, 0.f, 0.f};
    bf16x8 At[4][2], B0[2][2], B1[2][2];
    const char* cA = (const char*)g.A + (size_t)cur.pm * tstep; const char* cB = (const char*)g.Bt + (size_t)cur.pn * tstep;
    PG8_STAGE(PG8_SB(0, 0), cB); PG8_STAGE(PG8_SA(0, 0), cA); PG8_STAGE(PG8_SB(0, 1), cB + hstep); PG8_STAGE(PG8_SA(0, 1), cA + hstep);
    if (wr == 1) PG8_BAR;
    PG8_WAIT_V(4); PG8_BAR;
    PG8_STAGE(PG8_SB(1, 0), cB + kstep); PG8_STAGE(PG8_SA(1, 0), cA + kstep); PG8_STAGE(PG8_SB(1, 1), cB + hstep + kstep);
    PG8_WAIT_V(6); PG8_BAR;
    for (;;) {
        const bool has_next = S.next(ui + 1, nxt);
        const char* nA = has_next ? (const char*)g.A + (size_t)nxt.pm * tstep : cA; const char* nB = has_next ? (const char*)g.Bt + (size_t)nxt.pn * tstep : cB;
        for (int t = 0; t < nt; t += 2) {
            const bool last = (t == nt - 2);
            const char* a1 = cA + (size_t)(t + 1) * kstep;
            const char* a2 = last ? nA : cA + (size_t)(t + 2) * kstep; const char* b2 = last ? nB : cB + (size_t)(t + 2) * kstep;
            const char* a3 = a2 + kstep; const char* b3 = b2 + kstep;
            PG8_LDB(B0, 0, 0); PG8_SCHED; PG8_LDA(At, 0, 0); PG8_STAGE(PG8_SA(1, 1), a1 + hstep);
            PG8_WAIT_L(8); PG8_BAR; PG8_WAIT_L(0); PG8_MMA(0, 0, At, B0); PG8_BAR; PG8_SCHED;
            PG8_LDB(B1, 0, 1); PG8_STAGE(PG8_SB(0, 0), b2);
            PG8_BAR; PG8_WAIT_L(0); PG8_MMA(0, 1, At, B1); PG8_BAR;
            PG8_LDA(At, 0, 1); PG8_STAGE(PG8_SA(0, 0), a2);
            PG8_BAR; PG8_WAIT_L(0); PG8_MMA(1, 0, At, B0); PG8_BAR; PG8_SCHED;
            PG8_STAGE(PG8_SB(0, 1), b2 + hstep);
            PG8_WAIT_V(6); PG8_BAR; PG8_MMA(1, 1, At, B1); PG8_BAR;
            PG8_LDB(B0, 1, 0); PG8_SCHED; PG8_LDA(At, 1, 0); PG8_STAGE(PG8_SA(0, 1), a2 + hstep);
            PG8_WAIT_L(8); PG8_BAR; PG8_WAIT_L(0); PG8_MMA(0, 0, At, B0); PG8_BAR; PG8_SCHED;
            PG8_LDB(B1, 1, 1); PG8_STAGE(PG8_SB(1, 0), b3);
            PG8_BAR; PG8_WAIT_L(0); PG8_MMA(0, 1, At, B1); PG8_BAR;
            PG8_LDA(At, 1, 1); PG8_STAGE(PG8_SA(1, 0), a3);
            PG8_BAR; PG8_WAIT_L(0); PG8_MMA(1, 0, At, B0); PG8_BAR; PG8_SCHED;
            PG8_STAGE(PG8_SB(1, 1), b3 + hstep);
            PG8_WAIT_V(6); PG8_BAR; PG8_MMA(1, 1, At, B1); PG8_BAR;
        }
        E(acc, cur, wr, wc, fr, fq);
        if (!has_next) break;
#pragma unroll
        for (int a = 0; a < 2; ++a)
#pragma unroll
            for (int b = 0; b < 2; ++b)
#pragma unroll
                for (int m = 0; m < 4; ++m)
#pragma unroll
                    for (int n = 0; n < 2; ++n) acc[a][b][m][n] = (f32x4){0.f, 0.f, 0.f, 0.f};
        cur = nxt; cA = nA; cB = nB; ++ui;
    }
    PG8_WAIT_V(0);
    if (wr == 0) PG8_BAR;
    PG8_BAR;
#undef PG8_SA
#undef PG8_SB
#undef PG8_STAGE
#undef PG8_LDA
#undef PG8_LDB
#undef PG8_MMA
#undef PG8_WAIT_V
#undef PG8_WAIT_L
#undef PG8_BAR
#undef PG8_SCHED
}
}
using pg8::Unit;
typedef f32x4 AccT[2][2][4][2];

DI u32x4 pack8(const f32x4& v0, const f32x4& v1) { u32x4 w; w.x = cvt_pk_bf16(v0[0], v0[1]); w.y = cvt_pk_bf16(v0[2], v0[3]); w.z = cvt_pk_bf16(v1[0], v1[1]); w.w = cvt_pk_bf16(v1[2], v1[3]); return w; }

struct EpiStoreBf16 {
    bf16_t* O; int ld;
    DI void operator()(const AccT& acc, const Unit& u, int wr, int wc, int fr, int fq) const {
        const int row0 = u.pm * 256 + wr * 64 + fr, col0 = u.pn * 256 + wc * 32 + 8 * fq;
#pragma unroll
        for (int ai = 0; ai < 2; ++ai)
#pragma unroll
            for (int m = 0; m < 4; ++m) { bf16_t* rowp = O + (size_t)(row0 + ai * 128 + m * 16) * ld + col0;
#pragma unroll
                for (int bj = 0; bj < 2; ++bj) *(u32x4*)(rowp + bj * 128) = pack8(acc[ai][bj][m][0], acc[ai][bj][m][1]); }
    }
};

template <int HD>
DI void rope_store(const AccT& acc, int rowbase, const int* pos, bf16_t* dst, int ld, int c1, int half, int ibase, float scale) {
    float invf[2][4];
#pragma unroll
    for (int n = 0; n < 2; ++n)
#pragma unroll
        for (int j = 0; j < 4; ++j) invf[n][j] = exp2f(-(float)(ibase + 4 * n + j) * (2.0f / HD) * 13.287712379549449f);
#pragma unroll
    for (int ai = 0; ai < 2; ++ai)
#pragma unroll
        for (int m = 0; m < 4; ++m) {
            const int row = rowbase + ai * 128 + m * 16; const float ps = (float)pos[row];
            f32x4 o1[2], o2[2];
#pragma unroll
            for (int n = 0; n < 2; ++n)
#pragma unroll
                for (int j = 0; j < 4; ++j) {
                    const float ang = ps * invf[n][j]; const float rev = __builtin_amdgcn_fractf(ang * 0.15915494309189535f);
                    const float sn = __builtin_amdgcn_sinf(rev), cs = __builtin_amdgcn_cosf(rev);
                    const float t1 = acc[ai][0][m][n][j], t2 = acc[ai][1][m][n][j];
                    o1[n][j] = (t1 * cs - t2 * sn) * scale; o2[n][j] = (t2 * cs + t1 * sn) * scale;
                }
            bf16_t* rowp = dst + (size_t)row * ld + c1;
            *(u32x4*)rowp = pack8(o1[0], o1[1]); *(u32x4*)(rowp + half) = pack8(o2[0], o2[1]);
        }
}

struct EpiInProj {
    bf16_t *rq, *rk, *rv, *aq, *ak, *av; const int* pos;
    DI void operator()(const AccT& acc, const Unit& u, int wr, int wc, int fr, int fq) const {
        const int pn = u.pn, rowbase = u.pm * 256 + wr * 64 + fr;
        if (pn < 16) {
            bf16_t* dst = pn < 8 ? rq : rk; const float scale = pn < 8 ? 1.0f : 0.0625f;
            rope_store<256>(acc, rowbase, pos, dst, 2048, 256 * (pn & 7) + 32 * wc + 8 * fq, 128, 32 * wc + 8 * fq, scale);
        } else if (pn < 32) {
            const int col0 = (pn - 16) * 256 + wc * 32 + 8 * fq;
#pragma unroll
            for (int ai = 0; ai < 2; ++ai)
#pragma unroll
                for (int m = 0; m < 4; ++m) { bf16_t* rowp = rv + (size_t)(rowbase + ai * 128 + m * 16) * 4096 + col0;
#pragma unroll
                    for (int bj = 0; bj < 2; ++bj) *(u32x4*)(rowp + bj * 128) = pack8(acc[ai][bj][m][0], acc[ai][bj][m][1]); }
        } else if (pn < 66) {
            const int q9 = pn - 48; bf16_t* dst = q9 < 9 ? aq : ak; const int t9 = q9 < 9 ? q9 : q9 - 9;
            const int head = 2 * t9 + (wc >> 1), ib = 32 * (wc & 1) + 8 * fq;
            rope_store<128>(acc, rowbase, pos, dst, 2304, head * 128 + ib, 64, ib, 1.0f);
        } else {
            const int col0 = (pn - 66) * 256 + wc * 32 + 8 * fq;
#pragma unroll
            for (int ai = 0; ai < 2; ++ai)
#pragma unroll
                for (int m = 0; m < 4; ++m) { bf16_t* rowp = av + (size_t)(rowbase + ai * 128 + m * 16) * 2304 + col0;
#pragma unroll
                    for (int bj = 0; bj < 2; ++bj) *(u32x4*)(rowp + bj * 128) = pack8(acc[ai][bj][m][0], acc[ai][bj][m][1]); }
        }
    }
};

struct EpiRetGate {
    bf16_t* ret; const float* retss; const float* gain;
    DI void operator()(const AccT& acc, const Unit& u, int wr, int wc, int fr, int fq) const {
        const int rowbase = u.pm * 256 + wr * 64 + fr, head = u.pn >> 1;
#pragma unroll
        for (int ai = 0; ai < 2; ++ai)
#pragma unroll
            for (int m = 0; m < 4; ++m) {
                const int row = rowbase + ai * 128 + m * 16;
                const f32x4 s0 = *(const f32x4*)(retss + ((size_t)row * 8 + head) * 8), s1 = *(const f32x4*)(retss + ((size_t)row * 8 + head) * 8 + 4);
                const float ss = ((s0[0] + s0[1]) + (s0[2] + s0[3])) + ((s1[0] + s1[1]) + (s1[2] + s1[3]));
                const float rs = 1.0f / sqrtf(ss * (1.0f / 512.0f) + 1e-6f);
#pragma unroll
                for (int bj = 0; bj < 2; ++bj) {
                    const int col = u.pn * 256 + bj * 128 + wc * 32 + 8 * fq;
                    bf16_t* pr = ret + (size_t)row * 4096 + col;
                    const u32x4 rr = *(const u32x4*)pr; const f32x4 g0 = *(const f32x4*)(gain + col), g1 = *(const f32x4*)(gain + col + 4);
                    const float rf[8] = {bflo(rr.x), bfhi(rr.x), bflo(rr.y), bfhi(rr.y), bflo(rr.z), bfhi(rr.z), bflo(rr.w), bfhi(rr.w)};
                    f32x4 o0, o1;
#pragma unroll
                    for (int j = 0; j < 4; ++j) {
                        const float a0 = acc[ai][bj][m][0][j], a1 = acc[ai][bj][m][1][j];
                        o0[j] = a0 * sigmoidf_(a0) * (rf[j] * rs * g0[j]); o1[j] = a1 * sigmoidf_(a1) * (rf[4 + j] * rs * g1[j]);
                    }
                    *(u32x4*)pr = pack8(o0, o1);
                }
            }
    }
};

struct EpiGates {
    bf16_t* O; const float* bias;
    DI void operator()(const AccT& acc, const Unit& u, int wr, int wc, int fr, int fq) const {
        const int rowbase = u.pm * 256 + wr * 64 + fr;
#pragma unroll
        for (int bj = 0; bj < 2; ++bj) {
            const int col = u.pn * 256 + bj * 128 + wc * 32 + 8 * fq;
            const f32x4 b0 = *(const f32x4*)(bias + col), b1 = *(const f32x4*)(bias + col + 4);
#pragma unroll
            for (int ai = 0; ai < 2; ++ai)
#pragma unroll
                for (int m = 0; m < 4; ++m) {
                    f32x4 o0, o1;
#pragma unroll
                    for (int j = 0; j < 4; ++j) { o0[j] = sigmoidf_(acc[ai][bj][m][0][j] + b0[j]); o1[j] = sigmoidf_(acc[ai][bj][m][1][j] + b1[j]); }
                    *(u32x4*)(O + (size_t)(rowbase + ai * 128 + m * 16) * 4096 + col) = pack8(o0, o1);
                }
        }
    }
};

struct EpiYRet {
    float* U; const bf16_t* gates;
    DI void operator()(const AccT& acc, const Unit& u, int wr, int wc, int fr, int fq) const {
        const int rowbase = u.pm * 256 + wr * 64 + fr;
#pragma unroll
        for (int ai = 0; ai < 2; ++ai)
#pragma unroll
            for (int m = 0; m < 4; ++m) {
                const int row = rowbase + ai * 128 + m * 16;
#pragma unroll
                for (int bj = 0; bj < 2; ++bj) {
                    const int col = u.pn * 256 + bj * 128 + wc * 32 + 8 * fq;
                    const u32x4 gg = *(const u32x4*)(gates + (size_t)row * 4096 + col);
                    f32x4 o0 = acc[ai][bj][m][0], o1 = acc[ai][bj][m][1];
                    o0[0] *= bflo(gg.x); o0[1] *= bfhi(gg.x); o0[2] *= bflo(gg.y); o0[3] *= bfhi(gg.y);
                    o1[0] *= bflo(gg.z); o1[1] *= bfhi(gg.z); o1[2] *= bflo(gg.w); o1[3] *= bfhi(gg.w);
                    float* pu = U + (size_t)row * 2048 + col; *(f32x4*)pu = o0; *(f32x4*)(pu + 4) = o1;
                }
            }
    }
};

struct EpiYAtt {
    const float* U; const bf16_t* gates; bf16_t* U2;
    DI void operator()(const AccT& acc, const Unit& u, int wr, int wc, int fr, int fq) const {
        const int rowbase = u.pm * 256 + wr * 64 + fr;
#pragma unroll
        for (int ai = 0; ai < 2; ++ai)
#pragma unroll
            for (int m = 0; m < 4; ++m) {
                const int row = rowbase + ai * 128 + m * 16;
#pragma unroll
                for (int bj = 0; bj < 2; ++bj) {
                    const int col = u.pn * 256 + bj * 128 + wc * 32 + 8 * fq;
                    const u32x4 gg = *(const u32x4*)(gates + (size_t)row * 4096 + 2048 + col);
                    const float* pu = U + (size_t)row * 2048 + col; const f32x4 u0 = *(const f32x4*)pu, u1 = *(const f32x4*)(pu + 4);
                    f32x4 o0 = acc[ai][bj][m][0], o1 = acc[ai][bj][m][1];
                    o0[0] = u0[0] + o0[0] * bflo(gg.x); o0[1] = u0[1] + o0[1] * bfhi(gg.x); o0[2] = u0[2] + o0[2] * bflo(gg.y); o0[3] = u0[3] + o0[3] * bfhi(gg.y);
                    o1[0] = u1[0] + o1[0] * bflo(gg.z); o1[1] = u1[1] + o1[1] * bfhi(gg.z); o1[2] = u1[2] + o1[2] * bflo(gg.w); o1[3] = u1[3] + o1[3] * bfhi(gg.w);
                    *(u32x4*)(U2 + (size_t)row * 2048 + col) = pack8(o0, o1);
                }
            }
    }
};

DI float gelu_tanh(float v) {
    const float uu = 0.7978845608028654f * (v + 0.044715f * v * v * v);
    const float e = __expf(2.0f * uu);
    const float th = 1.0f - 2.0f / (e + 1.0f);
    return 0.5f * v * (1.0f + th);
}
struct EpiConvAct {
    const bf16_t* A; bf16_t* ACT; const float* conv_w; const float* conv_b;
    DI void operator()(const AccT& acc, const Unit& u, int wr, int wc, int fr, int fq) const {
        const int rowbase = u.pm * 256 + wr * 64 + fr;
#pragma unroll
        for (int bj = 0; bj < 2; ++bj) {
            const int col = u.pn * 256 + bj * 128 + wc * 32 + 8 * fq;
            float w0[8], w1[8], w2[8], cb[8];
#pragma unroll
            for (int e = 0; e < 8; ++e) { w0[e] = conv_w[col + e]; w1[e] = conv_w[FF + col + e]; w2[e] = conv_w[2 * FF + col + e]; cb[e] = conv_b[col + e]; }
#pragma unroll
            for (int ai = 0; ai < 2; ++ai)
#pragma unroll
                for (int m = 0; m < 4; ++m) {
                    const int row = rowbase + ai * 128 + m * 16; const int s = row & (SEQ - 1);
                    const bf16_t* pa = A + (size_t)row * FF + col;
                    const u32x4 z = {0u, 0u, 0u, 0u};
                    const u32x4 a0 = *(const u32x4*)pa;
                    const u32x4 a1 = s >= 1 ? *(const u32x4*)(pa - FF) : z;
                    const u32x4 a2 = s >= 2 ? *(const u32x4*)(pa - 2 * FF) : z;
                    const float f0[8] = {bflo(a0.x), bfhi(a0.x), bflo(a0.y), bfhi(a0.y), bflo(a0.z), bfhi(a0.z), bflo(a0.w), bfhi(a0.w)};
                    const float f1[8] = {bflo(a1.x), bfhi(a1.x), bflo(a1.y), bfhi(a1.y), bflo(a1.z), bfhi(a1.z), bflo(a1.w), bfhi(a1.w)};
                    const float f2[8] = {bflo(a2.x), bfhi(a2.x), bflo(a2.y), bfhi(a2.y), bflo(a2.z), bfhi(a2.z), bflo(a2.w), bfhi(a2.w)};
                    f32x4 o0, o1;
#pragma unroll
                    for (int j = 0; j < 4; ++j) {
                        const float c0 = cb[j] + w0[j] * f0[j] + w1[j] * f1[j] + w2[j] * f2[j];
                        const float c1 = cb[4 + j] + w0[4 + j] * f0[4 + j] + w1[4 + j] * f1[4 + j] + w2[4 + j] * f2[4 + j];
                        o0[j] = gelu_tanh(c0) * acc[ai][bj][m][0][j]; o1[j] = gelu_tanh(c1) * acc[ai][bj][m][1][j];
                    }
                    *(u32x4*)(ACT + (size_t)row * FF + col) = pack8(o0, o1);
                }
        }
    }
};

DI int invperm32(int c) { return 16 * ((c >> 2) & 1) + 4 * (c >> 3) + (c & 3); }
DI int slot_std(int c) { return (c & ~31) | invperm32(c & 31); }
DI int slot_win(int c) {
    if (c >= 12288 && c < 16896) { const int tc = c & 255, hh = tc >> 7, bj = (tc >> 6) & 1, i64 = tc & 63, x = 64 * hh + i64; return (c & ~255) + 128 * bj + (x & ~31) + invperm32(x & 31); }
    return slot_std(c);
}
DI void transpose_item(const float* W, int K, int N, bf16_t* WT, int mode, LAS float* scr, int item, int lane) {
    const int nblk = N / 32, kb = item / nblk, nb = item % nblk, k0 = 64 * kb, n0 = 32 * nb;
#pragma unroll 8
    for (int i = 0; i < 32; ++i) { const int kk = 2 * i + (lane >> 5); scr[kk * 33 + (lane & 31)] = W[(size_t)(k0 + kk) * N + n0 + (lane & 31)]; }
    asm volatile("s_waitcnt lgkmcnt(0)" ::: "memory");
    const int c = lane & 7;
#pragma unroll
    for (int j = 0; j < 4; ++j) { const int n = (lane >> 3) + 8 * j; const LAS float* s = scr + (8 * c) * 33 + n;
        u32x4 o; o.x = cvt_pk_bf16(s[0 * 33], s[1 * 33]); o.y = cvt_pk_bf16(s[2 * 33], s[3 * 33]); o.z = cvt_pk_bf16(s[4 * 33], s[5 * 33]); o.w = cvt_pk_bf16(s[6 * 33], s[7 * 33]);
        const int drow = mode ? slot_win(n0 + n) : slot_std(n0 + n);
        *(u32x4*)(WT + (size_t)drow * K + k0 + 8 * c) = o; }
    asm volatile("s_waitcnt lgkmcnt(0)" ::: "memory");
}

DI void phase0(const Params& p, LAS unsigned char* lds) {
    const int tid = threadIdx.x, lane = tid & 63, wave = tid >> 6;
    LAS float* sc = (LAS float*)lds;
    LAS float* red = sc + 8192;
    float* ada = (float*)(p.ws + WS_ADA);
    for (int i = tid; i < 8192; i += 512) { const float v = p.c[i]; sc[i] = v / (1.0f + __expf(-v)); }
    __syncthreads();
    for (int cb = blockIdx.x; cb < 256; cb += gridDim.x) {
        if (lane < 48) {
            float a0 = 0.f, a1 = 0.f, a2 = 0.f, a3 = 0.f;
            const float* wp = p.w_ada + (size_t)(256 * wave) * 12288 + 48 * cb + lane;
#pragma unroll 8
            for (int k = 0; k < 256; ++k) { const float wv = wp[(size_t)k * 12288]; const int kk = 256 * wave + k;
                a0 += sc[kk] * wv; a1 += sc[2048 + kk] * wv; a2 += sc[4096 + kk] * wv; a3 += sc[6144 + kk] * wv; }
            red[(wave * 4 + 0) * 48 + lane] = a0; red[(wave * 4 + 1) * 48 + lane] = a1; red[(wave * 4 + 2) * 48 + lane] = a2; red[(wave * 4 + 3) * 48 + lane] = a3;
        }
        __syncthreads();
        if (tid < 192) { const int b = tid / 48, l = tid % 48; float s = 0.f;
#pragma unroll
            for (int w = 0; w < 8; ++w) s += red[(w * 4 + b) * 48 + l];
            ada[b * 12288 + 48 * cb + l] = s + p.b_ada[48 * cb + l]; }
        __syncthreads();
    }
    LAS float* scr = (LAS float*)(lds + 40960 + wave * 8448);
    const int gw = blockIdx.x * 8 + wave, NGW = gridDim.x * 8;
    constexpr int I_IN = (2048 / 64) * (19200 / 32), I_GATE = (2048 / 64) * (4096 / 32), I_RET = (4096 / 64) * (2048 / 32), I_ATT = (2304 / 64) * (2048 / 32),
                  I_MIX = (2048 / 64) * (2048 / 32), I_UP = (2048 / 64) * (11264 / 32), I_DOWN = (5632 / 64) * (2048 / 32);
    constexpr int NITEMS = I_IN + I_GATE + I_RET + I_ATT + I_MIX + I_UP + I_DOWN;
    for (int it = gw; it < NITEMS; it += NGW) {
        int r = it;
        if (r < I_IN) { transpose_item(p.w_in, 2048, 19200, (bf16_t*)(p.ws + WS_WIN), 1, scr, r, lane); continue; } r -= I_IN;
        if (r < I_GATE) { transpose_item(p.w_gate, 2048, 4096, (bf16_t*)(p.ws + WS_WGATE), 0, scr, r, lane); continue; } r -= I_GATE;
        if (r < I_RET) { transpose_item(p.w_ret_out, 4096, 2048, (bf16_t*)(p.ws + WS_WRET), 0, scr, r, lane); continue; } r -= I_RET;
        if (r < I_ATT) { transpose_item(p.w_att_out, 2304, 2048, (bf16_t*)(p.ws + WS_WATT), 0, scr, r, lane); continue; } r -= I_ATT;
        if (r < I_MIX) { transpose_item(p.w_mix, 2048, 2048, (bf16_t*)(p.ws + WS_WMIX), 0, scr, r, lane); continue; } r -= I_MIX;
        if (r < I_UP) { transpose_item(p.w_up, 2048, 11264, (bf16_t*)(p.ws + WS_WUP), 0, scr, r, lane); continue; } r -= I_UP;
        transpose_item(p.w_down, 5632, 2048, (bf16_t*)(p.ws + WS_WDOWN), 0, scr, r, lane);
    }
}

DI void phase_h(const Params& p) {
    const int lane = threadIdx.x & 63, wave = threadIdx.x >> 6;
    const float* ada = (const float*)(p.ws + WS_ADA); bf16_t* H = (bf16_t*)(p.ws + WS_H);
    for (int row = blockIdx.x * 8 + wave; row < T_TOK; row += gridDim.x * 8) {
        const float* xr = p.x + (size_t)row * DM; const int b = row / SEQ;
        f32x4 v[4][2]; float ss = 0.f;
#pragma unroll
        for (int it = 0; it < 4; ++it) { const int col = (it * 64 + lane) * 8; v[it][0] = *(const f32x4*)(xr + col); v[it][1] = *(const f32x4*)(xr + col + 4);
#pragma unroll
            for (int j = 0; j < 4; ++j) ss += v[it][0][j] * v[it][0][j] + v[it][1][j] * v[it][1][j]; }
        const float r = 1.0f / sqrtf(wave_sum(ss) * (1.0f / DM) + 1e-6f);
#pragma unroll
        for (int it = 0; it < 4; ++it) { const int col = (it * 64 + lane) * 8;
            f32x4 o[2];
#pragma unroll
            for (int hh = 0; hh < 2; ++hh) { const f32x4 g = *(const f32x4*)(p.g_pre_mix + col + 4 * hh), sh = *(const f32x4*)(ada + b * 12288 + col + 4 * hh), scl = *(const f32x4*)(ada + b * 12288 + 2048 + col + 4 * hh);
#pragma unroll
                for (int j = 0; j < 4; ++j) o[hh][j] = v[it][hh][j] * r * g[j] * (1.0f + scl[j]) + sh[j]; }
            *(u32x4*)(H + (size_t)row * DM + col) = pack8(o[0], o[1]); }
    }
}

DI void phase_postmix(const Params& p) {
    const int lane = threadIdx.x & 63, wave = threadIdx.x >> 6;
    const float* ada = (const float*)(p.ws + WS_ADA); const bf16_t* Y = (const bf16_t*)(p.ws + WS_Y); bf16_t* H2 = (bf16_t*)(p.ws + WS_H2);
    for (int row = blockIdx.x * 8 + wave; row < T_TOK; row += gridDim.x * 8) {
        const int b = row / SEQ; const float* ab = ada + b * 12288;
        f32x4 y[4][2]; float ss = 0.f;
#pragma unroll
        for (int it = 0; it < 4; ++it) { const int col = (it * 64 + lane) * 8; const u32x4 w = *(const u32x4*)(Y + (size_t)row * DM + col);
            y[it][0] = (f32x4){bflo(w.x), bfhi(w.x), bflo(w.y), bfhi(w.y)}; y[it][1] = (f32x4){bflo(w.z), bfhi(w.z), bflo(w.w), bfhi(w.w)};
#pragma unroll
            for (int j = 0; j < 4; ++j) ss += y[it][0][j] * y[it][0][j] + y[it][1][j] * y[it][1][j]; }
        const float ry = 1.0f / sqrtf(wave_sum(ss) * (1.0f / DM) + 1e-6f);
        float s1 = 0.f;
#pragma unroll
        for (int it = 0; it < 4; ++it) { const int col = (it * 64 + lane) * 8;
#pragma unroll
            for (int hh = 0; hh < 2; ++hh) { const f32x4 xv = *(const f32x4*)(p.x + (size_t)row * DM + col + 4 * hh), g = *(const f32x4*)(p.g_post_mix + col + 4 * hh), gt = *(const f32x4*)(ab + 4096 + col + 4 * hh);
                f32x4 o;
#pragma unroll
                for (int j = 0; j < 4; ++j) { o[j] = xv[j] + gt[j] * (y[it][hh][j] * ry * g[j]); s1 += o[j] * o[j]; }
                y[it][hh] = o; *(f32x4*)(p.out + (size_t)row * DM + col + 4 * hh) = o; } }
        const float r1 = 1.0f / sqrtf(wave_sum(s1) * (1.0f / DM) + 1e-6f);
#pragma unroll
        for (int it = 0; it < 4; ++it) { const int col = (it * 64 + lane) * 8; f32x4 o[2];
#pragma unroll
            for (int hh = 0; hh < 2; ++hh) { const f32x4 g = *(const f32x4*)(p.g_pre_ffn + col + 4 * hh), sh = *(const f32x4*)(ab + 6144 + col + 4 * hh), scl = *(const f32x4*)(ab + 8192 + col + 4 * hh);
#pragma unroll
                for (int j = 0; j < 4; ++j) o[hh][j] = y[it][hh][j] * r1 * g[j] * (1.0f + scl[j]) + sh[j]; }
            *(u32x4*)(H2 + (size_t)row * DM + col) = pack8(o[0], o[1]); }
    }
}

DI void phase_final(const Params& p) {
    const int lane = threadIdx.x & 63, wave = threadIdx.x >> 6;
    const float* ada = (const float*)(p.ws + WS_ADA); const bf16_t* Y = (const bf16_t*)(p.ws + WS_Y2);
    for (int row = blockIdx.x * 8 + wave; row < T_TOK; row += gridDim.x * 8) {
        const int b = row / SEQ; const float* ab = ada + b * 12288;
        f32x4 y[4][2]; float ss = 0.f;
#pragma unroll
        for (int it = 0; it < 4; ++it) { const int col = (it * 64 + lane) * 8; const u32x4 w = *(const u32x4*)(Y + (size_t)row * DM + col);
            y[it][0] = (f32x4){bflo(w.x), bfhi(w.x), bflo(w.y), bfhi(w.y)}; y[it][1] = (f32x4){bflo(w.z), bfhi(w.z), bflo(w.w), bfhi(w.w)};
#pragma unroll
            for (int j = 0; j < 4; ++j) ss += y[it][0][j] * y[it][0][j] + y[it][1][j] * y[it][1][j]; }
        const float ry = 1.0f / sqrtf(wave_sum(ss) * (1.0f / DM) + 1e-6f);
#pragma unroll
        for (int it = 0; it < 4; ++it) { const int col = (it * 64 + lane) * 8;
#pragma unroll
            for (int hh = 0; hh < 2; ++hh) { float* po = p.out + (size_t)row * DM + col + 4 * hh; const f32x4 xv = *(const f32x4*)po, g = *(const f32x4*)(p.g_post_ffn + col + 4 * hh), gt = *(const f32x4*)(ab + 10240 + col + 4 * hh);
                f32x4 o;
#pragma unroll
                for (int j = 0; j < 4; ++j) o[j] = xv[j] + gt[j] * (y[it][hh][j] * ry * g[j]);
                *(f32x4*)po = o; } }
    }
}

DI void phase_alpha(const Params& p) {
    bf16_t* att = (bf16_t*)(p.ws + WS_AQ); const float* lse = (const float*)(p.ws + WS_LSE);
    const size_t total = (size_t)T_TOK * 288, stride = (size_t)gridDim.x * 512;
    for (size_t idx = (size_t)blockIdx.x * 512 + threadIdx.x; idx < total; idx += stride) {
        const int t = (int)(idx / 288), ch = (int)(idx % 288), head = ch >> 4, g = head / 6, j = head - 6 * g;
        const float l0 = lse[(size_t)t * 18 + j], l1 = lse[(size_t)t * 18 + 6 + j], l2 = lse[(size_t)t * 18 + 12 + j];
        const float mm = fmaxf(l0, fmaxf(l1, l2)); const float e0 = __expf(l0 - mm), e1 = __expf(l1 - mm), e2 = __expf(l2 - mm);
        const float al = (g == 0 ? e0 : (g == 1 ? e1 : e2)) / (e0 + e1 + e2);
        u32x4* pa = (u32x4*)(att + (size_t)t * 2304 + ch * 8); const u32x4 w = *pa; u32x4 o;
        o.x = cvt_pk_bf16(bflo(w.x) * al, bfhi(w.x) * al); o.y = cvt_pk_bf16(bflo(w.y) * al, bfhi(w.y) * al);
        o.z = cvt_pk_bf16(bflo(w.z) * al, bfhi(w.z) * al); o.w = cvt_pk_bf16(bflo(w.w) * al, bfhi(w.w) * al);
        *pa = o;
    }
}

DI void phase_retention(const Params& p, LAS unsigned char* lds) {
    const int tid = threadIdx.x, lane = tid & 63, w = tid >> 6, fr = lane & 15, fq = lane >> 4;
    LAS unsigned char* Qs = lds; LAS unsigned char* Ks = lds + 33792; LAS unsigned char* Vs = lds + 67584; LAS unsigned char* St = lds + 76800; LAS unsigned char* Ps = lds + 110592;
    LAS float* red = (LAS float*)(lds + 119808);
    const bf16_t* rq = (const bf16_t*)(p.ws + WS_RQ); const bf16_t* rk = (const bf16_t*)(p.ws + WS_RK); bf16_t* rv = (bf16_t*)p.out; float* retss = (float*)(p.ws + WS_RETSS);
    for (int item = blockIdx.x; item < 256; item += gridDim.x) {
        const int q5 = item >> 3, bh = (item & 7) * 4 + (q5 & 3), slice = q5 >> 2, b = bh >> 3, h = bh & 7;
        const float lg = log1pf(-exp2f(-5.0f - (float)h));
        const float gamma_c = expf(64.0f * lg);
        float xq[4], xk[4];
#pragma unroll
        for (int i = 0; i < 4; ++i) { const int row = (tid + 512 * i) >> 5; xq[i] = expf(lg * (float)(row + 1)); xk[i] = expf(-lg * (float)(row + 1)); }
        const size_t tok0 = (size_t)b * SEQ;
        const bf16_t* qbase = rq + tok0 * 2048 + h * 256 + (tid & 31) * 8; const bf16_t* kbase = rk + tok0 * 2048 + h * 256 + (tid & 31) * 8;
        bf16_t* vbase = rv + tok0 * 4096 + h * 512 + slice * 64;
        u32x4 pq[4], pk[4], pv;
        f32x4 Sreg[2][4];
#pragma unroll
        for (int a = 0; a < 2; ++a)
#pragma unroll
            for (int bb = 0; bb < 4; ++bb) Sreg[a][bb] = (f32x4){0.f, 0.f, 0.f, 0.f};
        for (int i = tid; i < 33792 / 16; i += 512) ((LAS u32x4*)St)[i] = (u32x4){0u, 0u, 0u, 0u};
#define RET_LOAD(c) do { _Pragma("unroll") for (int i = 0; i < 4; ++i) { const int row = (tid + 512 * i) >> 5; \
            pq[i] = *(const u32x4*)(qbase + (size_t)(64 * (c) + row) * 2048); pk[i] = *(const u32x4*)(kbase + (size_t)(64 * (c) + row) * 2048); } \
            pv = *(const u32x4*)(vbase + (size_t)(64 * (c) + (tid >> 3)) * 4096 + (tid & 7) * 8); } while (0)
#define RET_STORE() do { _Pragma("unroll") for (int i = 0; i < 4; ++i) { const int e = tid + 512 * i, row = e >> 5, pc = e & 31; \
            u32x4 o; o.x = cvt_pk_bf16(bflo(pq[i].x) * xq[i], bfhi(pq[i].x) * xq[i]); o.y = cvt_pk_bf16(bflo(pq[i].y) * xq[i], bfhi(pq[i].y) * xq[i]); \
            o.z = cvt_pk_bf16(bflo(pq[i].z) * xq[i], bfhi(pq[i].z) * xq[i]); o.w = cvt_pk_bf16(bflo(pq[i].w) * xq[i], bfhi(pq[i].w) * xq[i]); \
            *(LAS u32x4*)(Qs + row * 528 + pc * 16) = o; \
            o.x = cvt_pk_bf16(bflo(pk[i].x) * xk[i], bfhi(pk[i].x) * xk[i]); o.y = cvt_pk_bf16(bflo(pk[i].y) * xk[i], bfhi(pk[i].y) * xk[i]); \
            o.z = cvt_pk_bf16(bflo(pk[i].z) * xk[i], bfhi(pk[i].z) * xk[i]); o.w = cvt_pk_bf16(bflo(pk[i].w) * xk[i], bfhi(pk[i].w) * xk[i]); \
            *(LAS u32x4*)(Ks + row * 528 + pc * 16) = o; } \
            *(LAS u32x4*)(Vs + (tid >> 3) * 144 + (tid & 7) * 16) = pv; } while (0)
        RET_LOAD(0); RET_STORE();
        __syncthreads();
        for (int c = 0; c < 128; ++c) {
            if (c + 1 < 128) RET_LOAD(c + 1);
            {
                const int jt = w >> 1, it0 = (w & 1) * 2;
                f32x4 sa[2] = {(f32x4){0.f, 0.f, 0.f, 0.f}, (f32x4){0.f, 0.f, 0.f, 0.f}};
#pragma unroll
                for (int ks = 0; ks < 8; ++ks) {
                    const bf16x8 kf = *(const LAS bf16x8*)(Ks + (16 * jt + fr) * 528 + (32 * ks + 8 * fq) * 2);
#pragma unroll
                    for (int t = 0; t < 2; ++t) { const bf16x8 qf = *(const LAS bf16x8*)(Qs + (16 * (it0 + t) + fr) * 528 + (32 * ks + 8 * fq) * 2); sa[t] = mfma16(kf, qf, sa[t]); }
                }
#pragma unroll
                for (int t = 0; t < 2; ++t) { const int iq = 16 * (it0 + t) + fr, jk0 = 16 * jt + 4 * fq;
                    u32x2 o; o.x = cvt_pk_bf16(jk0 + 0 <= iq ? sa[t][0] : 0.f, jk0 + 1 <= iq ? sa[t][1] : 0.f); o.y = cvt_pk_bf16(jk0 + 2 <= iq ? sa[t][2] : 0.f, jk0 + 3 <= iq ? sa[t][3] : 0.f);
                    *(LAS u32x2*)(Ps + iq * 144 + jk0 * 2) = o; }
            }
            {
#pragma unroll
                for (int ks = 0; ks < 2; ++ks) {
                    const int j0 = 32 * ks + 8 * fq + (fr >> 2);
                    bf16x8 kt[2], vf[4];
#pragma unroll
                    for (int dd = 0; dd < 2; ++dd) { LAS unsigned char* a0 = Ks + j0 * 528 + (16 * (2 * w + dd) + 4 * (fr & 3)) * 2; kt[dd] = tr_read2(a0, a0 + 4 * 528); }
#pragma unroll
                    for (int vt = 0; vt < 4; ++vt) { LAS unsigned char* a0 = Vs + j0 * 144 + (16 * vt + 4 * (fr & 3)) * 2; vf[vt] = tr_read2(a0, a0 + 4 * 144); }
#pragma unroll
                    for (int dd = 0; dd < 2; ++dd)
#pragma unroll
                        for (int vt = 0; vt < 4; ++vt) Sreg[dd][vt] = mfma16(kt[dd], vf[vt], Sreg[dd][vt]);
                }
#pragma unroll
                for (int dd = 0; dd < 2; ++dd)
#pragma unroll
                    for (int vt = 0; vt < 4; ++vt) Sreg[dd][vt] *= gamma_c;
            }
            __syncthreads();
            {
                const int vt = w >> 1, it0 = (w & 1) * 2;
                f32x4 oa[2] = {(f32x4){0.f, 0.f, 0.f, 0.f}, (f32x4){0.f, 0.f, 0.f, 0.f}};
#pragma unroll
                for (int ks = 0; ks < 8; ++ks) {
                    const bf16x8 sf = *(const LAS bf16x8*)(St + (16 * vt + fr) * 528 + (32 * ks + 8 * fq) * 2);
#pragma unroll
                    for (int t = 0; t < 2; ++t) { const bf16x8 qf = *(const LAS bf16x8*)(Qs + (16 * (it0 + t) + fr) * 528 + (32 * ks + 8 * fq) * 2); oa[t] = mfma16(sf, qf, oa[t]); }
                }
#pragma unroll
                for (int ks = 0; ks < 2; ++ks) {
                    const int j0 = 32 * ks + 8 * fq + (fr >> 2);
                    LAS unsigned char* a0 = Vs + j0 * 144 + (16 * vt + 4 * (fr & 3)) * 2; const bf16x8 vf = tr_read2(a0, a0 + 4 * 144);
#pragma unroll
                    for (int t = 0; t < 2; ++t) { const bf16x8 pf = *(const LAS bf16x8*)(Ps + (16 * (it0 + t) + fr) * 144 + (32 * ks + 8 * fq) * 2); oa[t] = mfma16(vf, pf, oa[t]); }
                }
#pragma unroll
                for (int t = 0; t < 2; ++t) { const int iq = 16 * (it0 + t) + fr;
                    u32x2 o; o.x = cvt_pk_bf16(oa[t][0], oa[t][1]); o.y = cvt_pk_bf16(oa[t][2], oa[t][3]);
                    *(u32x2*)(vbase + (size_t)(64 * c + iq) * 4096 + 16 * vt + 4 * fq) = o;
                    float ss = (oa[t][0] * oa[t][0] + oa[t][1] * oa[t][1]) + (oa[t][2] * oa[t][2] + oa[t][3] * oa[t][3]);
                    ss += __shfl_xor(ss, 16); ss += __shfl_xor(ss, 32);
                    if (fq == 0) red[iq * 4 + vt] = ss; }
            }
            __syncthreads();
#pragma unroll
            for (int dd = 0; dd < 2; ++dd)
#pragma unroll
                for (int vt = 0; vt < 4; ++vt) { u32x2 o; o.x = cvt_pk_bf16(Sreg[dd][vt][0], Sreg[dd][vt][1]); o.y = cvt_pk_bf16(Sreg[dd][vt][2], Sreg[dd][vt][3]);
                    *(LAS u32x2*)(St + (16 * vt + fr) * 528 + (16 * (2 * w + dd) + 4 * fq) * 2) = o; }
            if (c + 1 < 128) RET_STORE();
            if (tid < 64) retss[((tok0 + 64 * c + tid) * 8 + h) * 8 + slice] = (red[tid * 4 + 0] + red[tid * 4 + 1]) + (red[tid * 4 + 2] + red[tid * 4 + 3]);
            __syncthreads();
        }
#undef RET_LOAD
#undef RET_STORE
    }
}

DI void phase_attention(const Params& p, LAS unsigned char* lds) {
    const int tid = threadIdx.x, lane = tid & 63, w = tid >> 6, fr = lane & 15, fq = lane >> 4;
    LAS unsigned char* Ks = lds; LAS unsigned char* Vs = lds + 52224; LAS unsigned char* Ps = lds + 104448;
    LAS float* mx = (LAS float*)(lds + 130048); LAS float* sm = mx + 128;
    bf16_t* aq = (bf16_t*)(p.ws + WS_AQ); const bf16_t* ak = (const bf16_t*)(p.ws + WS_AK); const bf16_t* av = (const bf16_t*)(p.ws + WS_AV); float* lse = (float*)(p.ws + WS_LSE);
    for (int item = blockIdx.x; item < 9216; item += gridDim.x) {
        const int hf = item & 1; int rest = item >> 1; const int cbk = rest & 63; rest >>= 6; const int head = rest % 18, b = rest / 18;
        const int g = head / 6, rsh = 2 * g, r = 1 << rsh, cls = cbk & (r - 1), nb = cbk >> rsh;
        const int pq0 = nb * 128 + 64 * hf, pk0 = pq0 - 128;
        const size_t tokb = (size_t)b * SEQ;
#pragma unroll
        for (int i = 0; i < 6; ++i) { const int e = tid + 512 * i, row = e >> 4, pc = e & 15; const int pk = pk0 + row; const bool valid = pk >= 0;
            const size_t off = (tokb + (size_t)(valid ? pk : 0) * r + cls) * 2304 + head * 128 + pc * 8;
            u32x4 kv = *(const u32x4*)(ak + off), vv = *(const u32x4*)(av + off);
            if (!valid) { kv = (u32x4){0u, 0u, 0u, 0u}; vv = kv; }
            *(LAS u32x4*)(Ks + row * 272 + pc * 16) = kv; *(LAS u32x4*)(Vs + row * 272 + pc * 16) = vv; }
        const int qt = w & 3, kh = w >> 2, qq = 16 * qt + fr;
        bf16x8 qf[4];
        { const bf16_t* qp = aq + (tokb + (size_t)(pq0 + qq) * r + cls) * 2304 + head * 128 + 8 * fq;
#pragma unroll
          for (int ks = 0; ks < 4; ++ks) qf[ks] = *(const bf16x8*)(qp + 32 * ks); }
        __syncthreads();
        f32x4 sa[6];
#pragma unroll
        for (int kt = 0; kt < 6; ++kt) { sa[kt] = (f32x4){0.f, 0.f, 0.f, 0.f};
#pragma unroll
            for (int ks = 0; ks < 4; ++ks) { const bf16x8 kf = *(const LAS bf16x8*)(Ks + (96 * kh + 16 * kt + fr) * 272 + (32 * ks + 8 * fq) * 2); sa[kt] = mfma16(kf, qf[ks], sa[kt]); } }
        const float sc2 = 0.08838834764831845f * 1.4426950408889634f;
        float mloc = -INFINITY;
#pragma unroll
        for (int kt = 0; kt < 6; ++kt)
#pragma unroll
            for (int j = 0; j < 4; ++j) { const int kk = 96 * kh + 16 * kt + 4 * fq + j; const bool valid = (kk >= qq) && (kk <= qq + 128) && (pk0 + kk >= 0);
                const float s = valid ? sa[kt][j] * sc2 : -INFINITY; sa[kt][j] = s; mloc = fmaxf(mloc, s); }
        mloc = fmaxf(mloc, __shfl_xor(mloc, 16)); mloc = fmaxf(mloc, __shfl_xor(mloc, 32));
        if (fq == 0) mx[kh * 64 + qq] = mloc;
        __syncthreads();
        const float mrow = fmaxf(mx[qq], mx[64 + qq]);
        float lsum = 0.f;
#pragma unroll
        for (int kt = 0; kt < 6; ++kt) { f32x4 pv;
#pragma unroll
            for (int j = 0; j < 4; ++j) { pv[j] = __builtin_amdgcn_exp2f(sa[kt][j] - mrow); lsum += pv[j]; }
            u32x2 o; o.x = cvt_pk_bf16(pv[0], pv[1]); o.y = cvt_pk_bf16(pv[2], pv[3]);
            *(LAS u32x2*)(Ps + qq * 400 + (96 * kh + 16 * kt + 4 * fq) * 2) = o; }
        lsum += __shfl_xor(lsum, 16); lsum += __shfl_xor(lsum, 32);
        if (fq == 0) sm[kh * 64 + qq] = lsum;
        __syncthreads();
        f32x4 oa[4];
#pragma unroll
        for (int t = 0; t < 4; ++t) oa[t] = (f32x4){0.f, 0.f, 0.f, 0.f};
#pragma unroll
        for (int ks = 0; ks < 6; ++ks) {
            const int j0 = 32 * ks + 8 * fq + (fr >> 2);
            LAS unsigned char* a0 = Vs + j0 * 272 + (16 * w + 4 * (fr & 3)) * 2; const bf16x8 vf = tr_read2(a0, a0 + 4 * 272);
#pragma unroll
            for (int t = 0; t < 4; ++t) { const bf16x8 pf = *(const LAS bf16x8*)(Ps + (16 * t + fr) * 400 + (32 * ks + 8 * fq) * 2); oa[t] = mfma16(vf, pf, oa[t]); }
        }
#pragma unroll
        for (int t = 0; t < 4; ++t) { const int q2 = 16 * t + fr; const float l = sm[q2] + sm[64 + q2], inv = 1.0f / l;
            const size_t tok = tokb + (size_t)(pq0 + q2) * r + cls;
            u32x2 o; o.x = cvt_pk_bf16(oa[t][0] * inv, oa[t][1] * inv); o.y = cvt_pk_bf16(oa[t][2] * inv, oa[t][3] * inv);
            *(u32x2*)(aq + tok * 2304 + head * 128 + 16 * w + 4 * fq) = o;
            if (w == 0 && fq == 0) lse[tok * 18 + head] = fmaxf(mx[q2], mx[64 + q2]) * 0.6931471805599453f + logf(l); }
        __syncthreads();
    }
}

constexpr int N_PHASES = 13;
__global__ void __launch_bounds__(512, 2) mega(Params p) {
    extern __shared__ __attribute__((aligned(16))) unsigned char shm[];
    LAS unsigned char* lds = (LAS unsigned char*)shm;
    unsigned char* ws = p.ws;
    const int G = gridDim.x, c = blockIdx.x;
    if (p.ph_lo <= 0 && 0 < p.ph_hi) {
        if (0 > p.ph_lo) cg::this_grid().sync();

#if (PHMASK >> 0) & 1
            phase0(p, lds);
#endif
    }
    if (p.ph_lo <= 1 && 1 < p.ph_hi) {
        if (1 > p.ph_lo) cg::this_grid().sync();

#if (PHMASK >> 1) & 1
            phase_h(p);
#endif
    }
    if (p.ph_lo <= 2 && 2 < p.ph_hi) {
        if (2 > p.ph_lo) cg::this_grid().sync();

#if (PHMASK >> 2) & 1
            pg8::Gemm g{(const bf16_t*)(ws + WS_H), (const bf16_t*)(ws + WS_WIN), T_TOK, 59 * 256, 2048}; pg8::StaticOrder S; S.init(T_TOK, 59 * 256, G, c, 32, 16);
            EpiInProj E{(bf16_t*)(ws + WS_RQ), (bf16_t*)(ws + WS_RK), (bf16_t*)p.out, (bf16_t*)(ws + WS_AQ), (bf16_t*)(ws + WS_AK), (bf16_t*)(ws + WS_AV), p.pos};
            pg8::gemm_phase(lds, g, S, E);
#endif
    }
    if (p.ph_lo <= 3 && 3 < p.ph_hi) {
        if (3 > p.ph_lo) cg::this_grid().sync();

#if (PHMASK >> 3) & 1
            phase_retention(p, lds); __syncthreads();
#endif
#if (PHMASK >> 13) & 1
            phase_attention(p, lds);
#endif
    }
    if (p.ph_lo <= 4 && 4 < p.ph_hi) {
        if (4 > p.ph_lo) cg::this_grid().sync();

#if (PHMASK >> 4) & 1
            { pg8::Gemm g{(const bf16_t*)(ws + WS_H), (const bf16_t*)(ws + WS_WIN) + (size_t)8192 * 2048, T_TOK, 4096, 2048}; pg8::StaticOrder S; S.init(T_TOK, 4096, G, c);
              EpiRetGate E{(bf16_t*)p.out, (const float*)(ws + WS_RETSS), p.ret_gain}; pg8::gemm_phase(lds, g, S, E); }
#endif
#if (PHMASK >> 14) & 1
            { pg8::Gemm g{(const bf16_t*)(ws + WS_H), (const bf16_t*)(ws + WS_WGATE), T_TOK, 4096, 2048}; pg8::StaticOrder S; S.init(T_TOK, 4096, G, c);
              EpiGates E{(bf16_t*)(ws + WS_GATES), p.b_gate}; pg8::gemm_phase(lds, g, S, E); }
#endif
#if (PHMASK >> 15) & 1
            phase_alpha(p);
#endif
    }
    if (p.ph_lo <= 5 && 5 < p.ph_hi) {
        if (5 > p.ph_lo) cg::this_grid().sync();

#if (PHMASK >> 5) & 1
            pg8::Gemm g{(const bf16_t*)p.out, (const bf16_t*)(ws + WS_WRET), T_TOK, 2048, 4096}; pg8::StaticOrder S; S.init(T_TOK, 2048, G, c);
            EpiYRet E{(float*)(ws + WS_U), (const bf16_t*)(ws + WS_GATES)}; pg8::gemm_phase(lds, g, S, E);
#endif
    }
    if (p.ph_lo <= 6 && 6 < p.ph_hi) {
        if (6 > p.ph_lo) cg::this_grid().sync();

#if (PHMASK >> 6) & 1
            pg8::Gemm g{(const bf16_t*)(ws + WS_AQ), (const bf16_t*)(ws + WS_WATT), T_TOK, 2048, 2304}; pg8::StaticOrder S; S.init(T_TOK, 2048, G, c);
            EpiYAtt E{(const float*)(ws + WS_U), (const bf16_t*)(ws + WS_GATES), (bf16_t*)(ws + WS_U2)}; pg8::gemm_phase(lds, g, S, E);
#endif
    }
    if (p.ph_lo <= 7 && 7 < p.ph_hi) {
        if (7 > p.ph_lo) cg::this_grid().sync();

#if (PHMASK >> 7) & 1
            pg8::Gemm g{(const bf16_t*)(ws + WS_U2), (const bf16_t*)(ws + WS_WMIX), T_TOK, 2048, 2048}; pg8::StaticOrder S; S.init(T_TOK, 2048, G, c);
            EpiStoreBf16 E{(bf16_t*)(ws + WS_Y), 2048}; pg8::gemm_phase(lds, g, S, E);
#endif
    }
    if (p.ph_lo <= 8 && 8 < p.ph_hi) {
        if (8 > p.ph_lo) cg::this_grid().sync();

#if (PHMASK >> 8) & 1
            phase_postmix(p);
#endif
    }
    if (p.ph_lo <= 9 && 9 < p.ph_hi) {
        if (9 > p.ph_lo) cg::this_grid().sync();

#if (PHMASK >> 9) & 1
            pg8::Gemm g{(const bf16_t*)(ws + WS_H2), (const bf16_t*)(ws + WS_WUP), T_TOK, FF, 2048}; pg8::StaticOrder S; S.init(T_TOK, FF, G, c);
            EpiStoreBf16 E{(bf16_t*)(ws + WS_A), FF}; pg8::gemm_phase(lds, g, S, E);
#endif
    }
    if (p.ph_lo <= 10 && 10 < p.ph_hi) {
        if (10 > p.ph_lo) cg::this_grid().sync();

#if (PHMASK >> 10) & 1
            pg8::Gemm g{(const bf16_t*)(ws + WS_H2), (const bf16_t*)(ws + WS_WUP) + (size_t)FF * 2048, T_TOK, FF, 2048}; pg8::StaticOrder S; S.init(T_TOK, FF, G, c);
            EpiConvAct E{(const bf16_t*)(ws + WS_A), (bf16_t*)(ws + WS_ACT), p.conv_w, p.conv_b}; pg8::gemm_phase(lds, g, S, E);
#endif
    }
    if (p.ph_lo <= 11 && 11 < p.ph_hi) {
        if (11 > p.ph_lo) cg::this_grid().sync();

#if (PHMASK >> 11) & 1
            pg8::Gemm g{(const bf16_t*)(ws + WS_ACT), (const bf16_t*)(ws + WS_WDOWN), T_TOK, 2048, FF}; pg8::StaticOrder S; S.init(T_TOK, 2048, G, c);
            EpiStoreBf16 E{(bf16_t*)(ws + WS_Y2), 2048}; pg8::gemm_phase(lds, g, S, E);
#endif
    }
    if (p.ph_lo <= 12 && 12 < p.ph_hi) {
        if (12 > p.ph_lo) cg::this_grid().sync();

#if (PHMASK >> 12) & 1
            phase_final(p);
#endif
    }
}

extern "C" void kernel_launch(void* const* d_in, const int* in_sizes, int n_in, void* d_out, int out_size, void* d_ws, size_t ws_size, hipStream_t stream) {
    static int grid = 0;
    if (grid == 0) {
        if (n_in != 20 || ws_size < WS_END) { fprintf(stderr, "kernel_launch: unexpected n_in %d or ws_size %zu (need %zu)\n", n_in, ws_size, (size_t)WS_END); grid = -1; return; }
        int dev = 0, cus = 0, per_cu = 0;
        hipGetDevice(&dev); hipDeviceGetAttribute(&cus, hipDeviceAttributeMultiprocessorCount, dev);
        if (hipFuncSetAttribute((const void*)mega, hipFuncAttributeMaxDynamicSharedMemorySize, LDS_BYTES) != hipSuccess) { fprintf(stderr, "kernel_launch: hipFuncSetAttribute failed\n"); grid = -1; return; }
        if (hipOccupancyMaxActiveBlocksPerMultiprocessor(&per_cu, (const void*)mega, 512, LDS_BYTES) != hipSuccess || per_cu < 1) { fprintf(stderr, "kernel_launch: occupancy query says %d\n", per_cu); per_cu = 1; }
        (void)hipGetLastError();
        grid = cus * 1;
    }
    if (grid < 0) return;
    Params p{};
    p.x = (const float*)d_in[0]; p.c = (const float*)d_in[1]; p.pos = (const int*)d_in[2]; p.w_ada = (const float*)d_in[3]; p.b_ada = (const float*)d_in[4]; p.g_pre_mix = (const float*)d_in[5];
    p.w_in = (const float*)d_in[6]; p.ret_gain = (const float*)d_in[7]; p.w_ret_out = (const float*)d_in[8]; p.w_att_out = (const float*)d_in[9]; p.w_gate = (const float*)d_in[10]; p.b_gate = (const float*)d_in[11];
    p.w_mix = (const float*)d_in[12]; p.g_post_mix = (const float*)d_in[13]; p.g_pre_ffn = (const float*)d_in[14]; p.w_up = (const float*)d_in[15]; p.conv_w = (const float*)d_in[16]; p.conv_b = (const float*)d_in[17];
    p.w_down = (const float*)d_in[18]; p.g_post_ffn = (const float*)d_in[19];
    p.out = (float*)d_out; p.ws = (unsigned char*)d_ws;
#if N_LAUNCH_PER_PHASE
    for (int ph = 0; ph < N_PHASES; ++ph) { p.ph_lo = ph; p.ph_hi = ph + 1; hipLaunchKernelGGL(mega, dim3(grid), dim3(512), LDS_BYTES, stream, p); }
#else
    p.ph_lo = 0; p.ph_hi = N_PHASES;
    void* args[] = {&p};
    hipError_t e = hipLaunchCooperativeKernel((const void*)mega, dim3(grid), dim3(512), args, LDS_BYTES, stream);
    if (e != hipSuccess) fprintf(stderr, "cooperative launch failed: %s (grid %d)\n", hipGetErrorString(e), grid);
#endif
}
```

```cpp
#include <hip/hip_runtime.h>
#include <hip/hip_cooperative_groups.h>
#include <cstdio>
#include <cstdint>
namespace cg = cooperative_groups;

#define DI __device__ __forceinline__
#define LAS __attribute__((address_space(3)))
typedef unsigned short bf16_t;
typedef short bf16x8 __attribute__((ext_vector_type(8)));
typedef short s16x4 __attribute__((ext_vector_type(4)));
typedef float f32x4 __attribute__((ext_vector_type(4)));
typedef unsigned u32x4 __attribute__((ext_vector_type(4)));
typedef unsigned u32x2 __attribute__((ext_vector_type(2)));

#ifndef PHMASK
#define PHMASK 0xFFFF
#endif
#ifndef N_LAUNCH_PER_PHASE
#define N_LAUNCH_PER_PHASE 0
#endif

constexpr int T_TOK = 32768, DM = 2048, SEQ = 8192, NB = 4;
constexpr int FF = 5632;
constexpr int LDS_BYTES = 131072;
constexpr size_t MiB = 1u << 20;
constexpr size_t WS_ADA = 0;
constexpr size_t WS_LSE = 1 * MiB;
constexpr size_t WS_RETSS = 4 * MiB;
constexpr size_t WS_WUP = 12 * MiB;
constexpr size_t WS_WDOWN = 56 * MiB;
constexpr size_t WS_WIN = 78 * MiB;
constexpr size_t WS_WGATE = 153 * MiB;
constexpr size_t WS_WRET = 169 * MiB;
constexpr size_t WS_WATT = 185 * MiB;
constexpr size_t WS_WMIX = 194 * MiB;
constexpr size_t WS_H = 206 * MiB;
constexpr size_t WS_RQ = 334 * MiB;
constexpr size_t WS_RK = 462 * MiB;
constexpr size_t WS_AQ = 590 * MiB;
constexpr size_t WS_AK = 734 * MiB;
constexpr size_t WS_AV = 878 * MiB;
constexpr size_t WS_GATES = 334 * MiB;
constexpr size_t WS_U = 734 * MiB;
constexpr size_t WS_U2 = 206 * MiB;
constexpr size_t WS_Y = 334 * MiB;
constexpr size_t WS_H2 = 78 * MiB;
constexpr size_t WS_A = 206 * MiB;
constexpr size_t WS_ACT = 558 * MiB;
constexpr size_t WS_Y2 = 78 * MiB;
constexpr size_t WS_END = 1022 * MiB;

struct Params {
    const float *x, *c; const int* pos;
    const float *w_ada, *b_ada, *g_pre_mix, *w_in, *ret_gain, *w_ret_out, *w_att_out, *w_gate, *b_gate, *w_mix, *g_post_mix, *g_pre_ffn, *w_up, *conv_w, *conv_b, *w_down, *g_post_ffn;
    float* out; unsigned char* ws; int ph_lo, ph_hi;
};

typedef __bf16 bf16x2_t __attribute__((ext_vector_type(2)));
DI unsigned cvt_pk_bf16(float lo, float hi) { bf16x2_t v = {(__bf16)lo, (__bf16)hi}; return __builtin_bit_cast(unsigned, v); }
DI float bflo(unsigned w) { return __uint_as_float(w << 16); }
DI float bfhi(unsigned w) { return __uint_as_float(w & 0xffff0000u); }
DI float wave_sum(float v) {
#pragma unroll
    for (int o = 1; o < 64; o <<= 1) v += __shfl_xor(v, o);
    return v;
}
DI float sigmoidf_(float v) { return __builtin_amdgcn_rcpf(1.0f + __builtin_amdgcn_exp2f(-1.4426950408889634f * v)); }
DI f32x4 mfma16(bf16x8 a, bf16x8 b, f32x4 c) { return __builtin_amdgcn_mfma_f32_16x16x32_bf16(a, b, c, 0, 0, 0); }
DI s16x4 tr_read(LAS unsigned char* p) { return __builtin_amdgcn_ds_read_tr16_b64_v4i16((LAS s16x4*)p); }
DI bf16x8 tr_read2(LAS unsigned char* p0, LAS unsigned char* p1) { s16x4 lo = tr_read(p0), hi = tr_read(p1); return __builtin_shufflevector(lo, hi, 0, 1, 2, 3, 4, 5, 6, 7); }

namespace pg8 {
constexpr int BM = 256, BK = 64, HALF = 128, HTB = HALF * BK * 2, STAGE_BYTES = 8 * HTB, NXCD = 8, WGM = 8;
DI int lds_byte(int r, int c) { const int st = (r >> 4) * 2 + (c >> 5), rr = r & 15, cc = c & 31, ob = rr * 64 + cc * 2; return st * 1024 + (ob ^ (((ob >> 9) & 1) << 5)); }
DI void stage_rc(int b, int& R, int& C) { const int st = b / 1024, sb = b % 1024, swz = sb ^ (((sb >> 9) & 1) << 5); R = (st >> 1) * 16 + swz / 64; C = (st & 1) * 32 + (swz % 64) / 2; }
struct Unit { int pm, pn; };
struct Gemm { const bf16_t* A; const bf16_t* Bt; int M, N, K; const bf16_t* A1; const bf16_t* Bt1; int K1; };
struct StaticOrder {
    int nM, nN, nwg, G, c, skip_lo, skip_n;
    DI void init(int M, int N, int G_, int c_, int slo = 1 << 30, int sn = 0) { nM = M / BM; nN = N / BM; nwg = nM * nN; G = G_; c = c_; skip_lo = slo; skip_n = sn; }
    DI bool next(int i, Unit& u) const {
        const long L = (long)i * G + c; if (L >= nwg) return false;
        int wgid = (int)L; { const int q = nwg / NXCD, r = nwg % NXCD, xcd = wgid % NXCD, off = wgid / NXCD; wgid = (xcd < r ? xcd * (q + 1) : r * (q + 1) + (xcd - r) * q) + off; }
        const int nig = WGM * nN, gid = wgid / nig, fm = gid * WGM, gsz = (nM - fm) < WGM ? (nM - fm) : WGM;
        u.pm = fm + ((wgid % nig) % gsz); u.pn = (wgid % nig) / gsz; if (u.pn >= skip_lo) u.pn += skip_n; return true;
    }
};

template <int NSEG, class Epi>
DI void gemm_phase(LAS unsigned char* lds, const Gemm g, const StaticOrder& S, const Epi& E) {
    const int tid = threadIdx.x, wid = __builtin_amdgcn_readfirstlane(tid >> 6), lane = tid & 63, wr = wid >> 2, wc = wid & 3, fr = lane & 15, fq = lane >> 4;
    int Rr[2], Cc[2];
#pragma unroll
    for (int i = 0; i < 2; ++i) stage_rc(tid * 16 + i * 8192, Rr[i], Cc[i]);
    const size_t kstep = (size_t)(BK * 2);
    const unsigned ldsw = (unsigned)wid * 1024u;
    const int aoff = lds_byte(wr * 64 + fr, fq * 8), boff = lds_byte(wc * 32 + fr, fq * 8);
#define PG8_SA(b, h) (((b) * 2 + (h)) * HTB)
#define PG8_SB(b, h) ((4 + (b) * 2 + (h)) * HTB)
#define PG8_STAGE(bufoff, gbase, VO) do { _Pragma("unroll") for (int _i = 0; _i < 2; ++_i) \
        __builtin_amdgcn_global_load_lds((const unsigned*)((const char*)(gbase) + VO[_i]), (LAS unsigned*)(lds + (bufoff) + ldsw + _i * 8192), 16, 0, 0); } while (0)
#define PG8_LDA(dst, b, h) do { _Pragma("unroll") for (int m = 0; m < 4; ++m) _Pragma("unroll") for (int k = 0; k < 2; ++k) dst[m][k] = *(const LAS bf16x8*)(lds + PG8_SA(b, h) + aoff + m * 2048 + k * 1024); } while (0)
#define PG8_LDB(dst, b, h) do { _Pragma("unroll") for (int n = 0; n < 2; ++n) _Pragma("unroll") for (int k = 0; k < 2; ++k) dst[n][k] = *(const LAS bf16x8*)(lds + PG8_SB(b, h) + boff + n * 2048 + k * 1024); } while (0)
#define PG8_MMA(ai, bj, At, Bt) do { __builtin_amdgcn_s_setprio(1); _Pragma("unroll") for (int m = 0; m < 4; ++m) _Pragma("unroll") for (int n = 0; n < 2; ++n) _Pragma("unroll") for (int k = 0; k < 2; ++k) \
        acc[ai][bj][m][n] = __builtin_amdgcn_mfma_f32_16x16x32_bf16(Bt[n][k], At[m][k], acc[ai][bj][m][n], 0, 0, 0); __builtin_amdgcn_s_setprio(0); } while (0)
#define PG8_WAIT_V(n) asm volatile("s_waitcnt vmcnt(" #n ")" ::: "memory")
#define PG8_WAIT_L(n) asm volatile("s_waitcnt lgkmcnt(" #n ")" ::: "memory")
#define PG8_BAR __builtin_amdgcn_s_barrier()
#define PG8_SCHED __builtin_amdgcn_sched_barrier(0)
    Unit cur, nxt; int ti = 0, seg = 0;
    if (!S.next(0, cur)) return;
    f32x4 acc[2][2][4][2];
#pragma unroll
    for (int a = 0; a < 2; ++a)
#pragma unroll
        for (int b = 0; b < 2; ++b)
#pragma unroll
            for (int m = 0; m < 4; ++m)
#pragma unroll
                for (int n = 0; n < 2; ++n) acc[a][b][m][n] = (f32x4){0.f, 0.f, 0.f, 0.f};
    bf16x8 At[4][2], B0[2][2], B1[2][2];
    int Kc = g.K;
    unsigned voffC[2];
#pragma unroll
    for (int i = 0; i < 2; ++i) voffC[i] = (unsigned)(Rr[i] * Kc + Cc[i]) * 2u;
    size_t hstepC = (size_t)HALF * Kc * 2;
    const char* cA = (const char*)g.A + (size_t)cur.pm * 2 * hstepC; const char* cB = (const char*)g.Bt + (size_t)cur.pn * 2 * hstepC;
    PG8_STAGE(PG8_SB(0, 0), cB, voffC); PG8_STAGE(PG8_SA(0, 0), cA, voffC); PG8_STAGE(PG8_SB(0, 1), cB + hstepC, voffC); PG8_STAGE(PG8_SA(0, 1), cA + hstepC, voffC);
    if (wr == 1) PG8_BAR;
    PG8_WAIT_V(4); PG8_BAR;
    PG8_STAGE(PG8_SB(1, 0), cB + kstep, voffC); PG8_STAGE(PG8_SA(1, 0), cA + kstep, voffC); PG8_STAGE(PG8_SB(1, 1), cB + hstepC + kstep, voffC);
    PG8_WAIT_V(6); PG8_BAR;
    for (;;) {
        bool has_next; int nseg = 0;
        if (NSEG > 1 && seg + 1 < NSEG) { has_next = true; nxt = cur; nseg = seg + 1; }
        else has_next = S.next(ti + 1, nxt);
        int Kn = Kc; const char* nA = cA; const char* nB = cB;
        if (has_next) { Kn = (NSEG > 1 && nseg == 1) ? g.K1 : g.K;
            nA = (const char*)((NSEG > 1 && nseg == 1) ? g.A1 : g.A) + (size_t)nxt.pm * 256 * Kn * 2; nB = (const char*)((NSEG > 1 && nseg == 1) ? g.Bt1 : g.Bt) + (size_t)nxt.pn * 256 * Kn * 2; }
        unsigned voffN[2];
#pragma unroll
        for (int i = 0; i < 2; ++i) voffN[i] = (NSEG > 1) ? (unsigned)(Rr[i] * Kn + Cc[i]) * 2u : voffC[i];
        const size_t hstepN = (NSEG > 1) ? (size_t)HALF * Kn * 2 : hstepC;
        const int nt = Kc / BK;
        for (int t = 0; t < nt; t += 2) {
            const bool last = (t == nt - 2);
            const char* a1 = cA + (size_t)(t + 1) * kstep;
            const char* a2 = last ? nA : cA + (size_t)(t + 2) * kstep; const char* b2 = last ? nB : cB + (size_t)(t + 2) * kstep;
            const char* a3 = a2 + kstep; const char* b3 = b2 + kstep;
            unsigned v2[2]; v2[0] = (NSEG > 1 && last) ? voffN[0] : voffC[0]; v2[1] = (NSEG > 1 && last) ? voffN[1] : voffC[1];
            const size_t h2 = (NSEG > 1 && last) ? hstepN : hstepC;
            PG8_LDB(B0, 0, 0); PG8_SCHED; PG8_LDA(At, 0, 0); PG8_STAGE(PG8_SA(1, 1), a1 + hstepC, voffC);
            PG8_WAIT_L(8); PG8_BAR; PG8_WAIT_L(0); PG8_MMA(0, 0, At, B0); PG8_BAR; PG8_SCHED;
            PG8_LDB(B1, 0, 1); PG8_STAGE(PG8_SB(0, 0), b2, v2);
            PG8_BAR; PG8_WAIT_L(0); PG8_MMA(0, 1, At, B1); PG8_BAR;
            PG8_LDA(At, 0, 1); PG8_STAGE(PG8_SA(0, 0), a2, v2);
            PG8_BAR; PG8_WAIT_L(0); PG8_MMA(1, 0, At, B0); PG8_BAR; PG8_SCHED;
            PG8_STAGE(PG8_SB(0, 1), b2 + h2, v2);
            PG8_WAIT_V(6); PG8_BAR; PG8_MMA(1, 1, At, B1); PG8_BAR;
            PG8_LDB(B0, 1, 0); PG8_SCHED; PG8_LDA(At, 1, 0); PG8_STAGE(PG8_SA(0, 1), a2 + h2, v2);
            PG8_WAIT_L(8); PG8_BAR; PG8_WAIT_L(0); PG8_MMA(0, 0, At, B0); PG8_BAR; PG8_SCHED;
            PG8_LDB(B1, 1, 1); PG8_STAGE(PG8_SB(1, 0), b3, v2);
            PG8_BAR; PG8_WAIT_L(0); PG8_MMA(0, 1, At, B1); PG8_BAR;
            PG8_LDA(At, 1, 1); PG8_STAGE(PG8_SA(1, 0), a3, v2);
            PG8_BAR; PG8_WAIT_L(0); PG8_MMA(1, 0, At, B0); PG8_BAR; PG8_SCHED;
            PG8_STAGE(PG8_SB(1, 1), b3 + h2, v2);
            PG8_WAIT_V(6); PG8_BAR; PG8_MMA(1, 1, At, B1); PG8_BAR;
        }
        if constexpr (NSEG > 1) { if (seg + 1 < NSEG) E.mid(acc, cur, wr, wc, fr, fq); else E(acc, cur, wr, wc, fr, fq); }
        else E(acc, cur, wr, wc, fr, fq);
        if (!has_next) break;
        if (NSEG == 1 || nseg == 0) {
#pragma unroll
            for (int a = 0; a < 2; ++a)
#pragma unroll
                for (int b = 0; b < 2; ++b)
#pragma unroll
                    for (int m = 0; m < 4; ++m)
#pragma unroll
                        for (int n = 0; n < 2; ++n) acc[a][b][m][n] = (f32x4){0.f, 0.f, 0.f, 0.f};
            ++ti;
        }
        cur = nxt; cA = nA; cB = nB; seg = nseg;
        if (NSEG > 1) { Kc = Kn; voffC[0] = voffN[0]; voffC[1] = voffN[1]; hstepC = hstepN; }
    }
    PG8_WAIT_V(0);
    if (wr == 0) PG8_BAR;
    PG8_BAR;
#undef PG8_SA
#undef PG8_SB
#undef PG8_STAGE
#undef PG8_LDA
#undef PG8_LDB
#undef PG8_MMA
#undef PG8_WAIT_V
#undef PG8_WAIT_L
#undef PG8_BAR
#undef PG8_SCHED
}
}
using pg8::Unit;
typedef f32x4 AccT[2][2][4][2];

DI u32x4 pack8(const f32x4& v0, const f32x4& v1) { u32x4 w; w.x = cvt_pk_bf16(v0[0], v0[1]); w.y = cvt_pk_bf16(v0[2], v0[3]); w.z = cvt_pk_bf16(v1[0], v1[1]); w.w = cvt_pk_bf16(v1[2], v1[3]); return w; }

struct EpiStoreBf16 {
    bf16_t* O; int ld;
    DI void operator()(const AccT& acc, const Unit& u, int wr, int wc, int fr, int fq) const {
        const int row0 = u.pm * 256 + wr * 64 + fr, col0 = u.pn * 256 + wc * 32 + 8 * fq;
#pragma unroll
        for (int ai = 0; ai < 2; ++ai)
#pragma unroll
            for (int m = 0; m < 4; ++m) { bf16_t* rowp = O + (size_t)(row0 + ai * 128 + m * 16) * ld + col0;
#pragma unroll
                for (int bj = 0; bj < 2; ++bj) *(u32x4*)(rowp + bj * 128) = pack8(acc[ai][bj][m][0], acc[ai][bj][m][1]); }
    }
};

template <int HD>
DI void rope_store(const AccT& acc, int rowbase, const int* pos, bf16_t* dst, int ld, int c1, int half, int ibase, float scale) {
    float invf[2][4];
#pragma unroll
    for (int n = 0; n < 2; ++n)
#pragma unroll
        for (int j = 0; j < 4; ++j) invf[n][j] = exp2f(-(float)(ibase + 4 * n + j) * (2.0f / HD) * 13.287712379549449f);
#pragma unroll
    for (int ai = 0; ai < 2; ++ai)
#pragma unroll
        for (int m = 0; m < 4; ++m) {
            const int row = rowbase + ai * 128 + m * 16; const float ps = (float)pos[row];
            f32x4 o1[2], o2[2];
#pragma unroll
            for (int n = 0; n < 2; ++n)
#pragma unroll
                for (int j = 0; j < 4; ++j) {
                    const float ang = ps * invf[n][j]; const float rev = __builtin_amdgcn_fractf(ang * 0.15915494309189535f);
                    const float sn = __builtin_amdgcn_sinf(rev), cs = __builtin_amdgcn_cosf(rev);
                    const float t1 = acc[ai][0][m][n][j], t2 = acc[ai][1][m][n][j];
                    o1[n][j] = (t1 * cs - t2 * sn) * scale; o2[n][j] = (t2 * cs + t1 * sn) * scale;
                }
            bf16_t* rowp = dst + (size_t)row * ld + c1;
            *(u32x4*)rowp = pack8(o1[0], o1[1]); *(u32x4*)(rowp + half) = pack8(o2[0], o2[1]);
        }
}

struct EpiInProj {
    bf16_t *rq, *rk, *rv, *aq, *ak, *av; const int* pos;
    DI void operator()(const AccT& acc, const Unit& u, int wr, int wc, int fr, int fq) const {
        const int pn = u.pn, rowbase = u.pm * 256 + wr * 64 + fr;
        if (pn < 16) {
            bf16_t* dst = pn < 8 ? rq : rk; const float scale = pn < 8 ? 1.0f : 0.0625f;
            rope_store<256>(acc, rowbase, pos, dst, 2048, 256 * (pn & 7) + 32 * wc + 8 * fq, 128, 32 * wc + 8 * fq, scale);
        } else if (pn < 32) {
            const int col0 = (pn - 16) * 256 + wc * 32 + 8 * fq;
#pragma unroll
            for (int ai = 0; ai < 2; ++ai)
#pragma unroll
                for (int m = 0; m < 4; ++m) { bf16_t* rowp = rv + (size_t)(rowbase + ai * 128 + m * 16) * 4096 + col0;
#pragma unroll
                    for (int bj = 0; bj < 2; ++bj) *(u32x4*)(rowp + bj * 128) = pack8(acc[ai][bj][m][0], acc[ai][bj][m][1]); }
        } else if (pn < 66) {
            const int q9 = pn - 48; bf16_t* dst = q9 < 9 ? aq : ak; const int t9 = q9 < 9 ? q9 : q9 - 9;
            const int head = 2 * t9 + (wc >> 1), ib = 32 * (wc & 1) + 8 * fq;
            rope_store<128>(acc, rowbase, pos, dst, 2304, head * 128 + ib, 64, ib, 1.0f);
        } else {
            const int col0 = (pn - 66) * 256 + wc * 32 + 8 * fq;
#pragma unroll
            for (int ai = 0; ai < 2; ++ai)
#pragma unroll
                for (int m = 0; m < 4; ++m) { bf16_t* rowp = av + (size_t)(rowbase + ai * 128 + m * 16) * 2304 + col0;
#pragma unroll
                    for (int bj = 0; bj < 2; ++bj) *(u32x4*)(rowp + bj * 128) = pack8(acc[ai][bj][m][0], acc[ai][bj][m][1]); }
        }
    }
};

struct EpiRetGate {
    bf16_t* ret; const float* retss; const float* gain;
    DI void operator()(const AccT& acc, const Unit& u, int wr, int wc, int fr, int fq) const {
        const int rowbase = u.pm * 256 + wr * 64 + fr, head = u.pn >> 1;
#pragma unroll
        for (int ai = 0; ai < 2; ++ai)
#pragma unroll
            for (int m = 0; m < 4; ++m) {
                const int row = rowbase + ai * 128 + m * 16;
                const f32x4 s0 = *(const f32x4*)(retss + ((size_t)row * 8 + head) * 8), s1 = *(const f32x4*)(retss + ((size_t)row * 8 + head) * 8 + 4);
                const float ss = ((s0[0] + s0[1]) + (s0[2] + s0[3])) + ((s1[0] + s1[1]) + (s1[2] + s1[3]));
                const float rs = __builtin_amdgcn_rsqf(ss * (1.0f / 512.0f) + 1e-6f);
#pragma unroll
                for (int bj = 0; bj < 2; ++bj) {
                    const int col = u.pn * 256 + bj * 128 + wc * 32 + 8 * fq;
                    bf16_t* pr = ret + (size_t)row * 4096 + col;
                    const u32x4 rr = *(const u32x4*)pr; const f32x4 g0 = *(const f32x4*)(gain + col), g1 = *(const f32x4*)(gain + col + 4);
                    const float rf[8] = {bflo(rr.x), bfhi(rr.x), bflo(rr.y), bfhi(rr.y), bflo(rr.z), bfhi(rr.z), bflo(rr.w), bfhi(rr.w)};
                    f32x4 o0, o1;
#pragma unroll
                    for (int j = 0; j < 4; ++j) {
                        const float a0 = acc[ai][bj][m][0][j], a1 = acc[ai][bj][m][1][j];
                        o0[j] = a0 * sigmoidf_(a0) * (rf[j] * rs * g0[j]); o1[j] = a1 * sigmoidf_(a1) * (rf[4 + j] * rs * g1[j]);
                    }
                    *(u32x4*)pr = pack8(o0, o1);
                }
            }
    }
};

struct EpiGates {
    bf16_t* O; const float* bias;
    DI void operator()(const AccT& acc, const Unit& u, int wr, int wc, int fr, int fq) const {
        const int rowbase = u.pm * 256 + wr * 64 + fr;
#pragma unroll
        for (int bj = 0; bj < 2; ++bj) {
            const int col = u.pn * 256 + bj * 128 + wc * 32 + 8 * fq;
            const f32x4 b0 = *(const f32x4*)(bias + col), b1 = *(const f32x4*)(bias + col + 4);
#pragma unroll
            for (int ai = 0; ai < 2; ++ai)
#pragma unroll
                for (int m = 0; m < 4; ++m) {
                    f32x4 o0, o1;
#pragma unroll
                    for (int j = 0; j < 4; ++j) { o0[j] = sigmoidf_(acc[ai][bj][m][0][j] + b0[j]); o1[j] = sigmoidf_(acc[ai][bj][m][1][j] + b1[j]); }
                    *(u32x4*)(O + (size_t)(rowbase + ai * 128 + m * 16) * 4096 + col) = pack8(o0, o1);
                }
        }
    }
};

struct EpiYMerge {
    const bf16_t* gates; bf16_t* U2;
    DI void mid(AccT& acc, const Unit& u, int wr, int wc, int fr, int fq) const {
        const int rowbase = u.pm * 256 + wr * 64 + fr;
#pragma unroll
        for (int ai = 0; ai < 2; ++ai)
#pragma unroll
            for (int m = 0; m < 4; ++m) {
                const int row = rowbase + ai * 128 + m * 16;
#pragma unroll
                for (int bj = 0; bj < 2; ++bj) {
                    const int col = u.pn * 256 + bj * 128 + wc * 32 + 8 * fq;
                    const u32x4 gr = *(const u32x4*)(gates + (size_t)row * 4096 + col), ga = *(const u32x4*)(gates + (size_t)row * 4096 + 2048 + col);
                    const float r[8] = {bflo(gr.x), bfhi(gr.x), bflo(gr.y), bfhi(gr.y), bflo(gr.z), bfhi(gr.z), bflo(gr.w), bfhi(gr.w)};
                    const float a[8] = {bflo(ga.x), bfhi(ga.x), bflo(ga.y), bfhi(ga.y), bflo(ga.z), bfhi(ga.z), bflo(ga.w), bfhi(ga.w)};
#pragma unroll
                    for (int j = 0; j < 4; ++j) { acc[ai][bj][m][0][j] *= r[j] * __builtin_amdgcn_rcpf(fmaxf(a[j], 1e-30f)); acc[ai][bj][m][1][j] *= r[4 + j] * __builtin_amdgcn_rcpf(fmaxf(a[4 + j], 1e-30f)); }
                }
            }
    }
    DI void operator()(const AccT& acc, const Unit& u, int wr, int wc, int fr, int fq) const {
        const int rowbase = u.pm * 256 + wr * 64 + fr;
#pragma unroll
        for (int ai = 0; ai < 2; ++ai)
#pragma unroll
            for (int m = 0; m < 4; ++m) {
                const int row = rowbase + ai * 128 + m * 16;
#pragma unroll
                for (int bj = 0; bj < 2; ++bj) {
                    const int col = u.pn * 256 + bj * 128 + wc * 32 + 8 * fq;
                    const u32x4 gg = *(const u32x4*)(gates + (size_t)row * 4096 + 2048 + col);
                    f32x4 o0 = acc[ai][bj][m][0], o1 = acc[ai][bj][m][1];
                    o0[0] *= bflo(gg.x); o0[1] *= bfhi(gg.x); o0[2] *= bflo(gg.y); o0[3] *= bfhi(gg.y);
                    o1[0] *= bflo(gg.z); o1[1] *= bfhi(gg.z); o1[2] *= bflo(gg.w); o1[3] *= bfhi(gg.w);
                    *(u32x4*)(U2 + (size_t)row * 2048 + col) = pack8(o0, o1);
                }
            }
    }
};

DI float gelu_tanh(float v) {
    const float uu = 0.7978845608028654f * (v + 0.044715f * v * v * v);
    const float e = __builtin_amdgcn_exp2f(2.8853900817779268f * uu);
    return v - v * __builtin_amdgcn_rcpf(e + 1.0f);
}
struct EpiConvAct {
    const bf16_t* A; bf16_t* ACT; const float* conv_w; const float* conv_b;
    DI void operator()(const AccT& acc, const Unit& u, int wr, int wc, int fr, int fq) const {
        const int rowbase = u.pm * 256 + wr * 64 + fr;
#pragma unroll
        for (int bj = 0; bj < 2; ++bj) {
            const int col = u.pn * 256 + bj * 128 + wc * 32 + 8 * fq;
            float w0[8], w1[8], w2[8], cb[8];
#pragma unroll
            for (int e = 0; e < 8; ++e) { w0[e] = conv_w[col + e]; w1[e] = conv_w[FF + col + e]; w2[e] = conv_w[2 * FF + col + e]; cb[e] = conv_b[col + e]; }
#pragma unroll
            for (int ai = 0; ai < 2; ++ai)
#pragma unroll
                for (int m = 0; m < 4; ++m) {
                    const int row = rowbase + ai * 128 + m * 16; const int s = row & (SEQ - 1);
                    const bf16_t* pa = A + (size_t)row * FF + col;
                    const u32x4 z = {0u, 0u, 0u, 0u};
                    const u32x4 a0 = *(const u32x4*)pa;
                    const u32x4 a1 = s >= 1 ? *(const u32x4*)(pa - FF) : z;
                    const u32x4 a2 = s >= 2 ? *(const u32x4*)(pa - 2 * FF) : z;
                    const float f0[8] = {bflo(a0.x), bfhi(a0.x), bflo(a0.y), bfhi(a0.y), bflo(a0.z), bfhi(a0.z), bflo(a0.w), bfhi(a0.w)};
                    const float f1[8] = {bflo(a1.x), bfhi(a1.x), bflo(a1.y), bfhi(a1.y), bflo(a1.z), bfhi(a1.z), bflo(a1.w), bfhi(a1.w)};
                    const float f2[8] = {bflo(a2.x), bfhi(a2.x), bflo(a2.y), bfhi(a2.y), bflo(a2.z), bfhi(a2.z), bflo(a2.w), bfhi(a2.w)};
                    f32x4 o0, o1;
#pragma unroll
                    for (int j = 0; j < 4; ++j) {
                        const float c0 = cb[j] + w0[j] * f0[j] + w1[j] * f1[j] + w2[j] * f2[j];
                        const float c1 = cb[4 + j] + w0[4 + j] * f0[4 + j] + w1[4 + j] * f1[4 + j] + w2[4 + j] * f2[4 + j];
                        o0[j] = gelu_tanh(c0) * acc[ai][bj][m][0][j]; o1[j] = gelu_tanh(c1) * acc[ai][bj][m][1][j];
                    }
                    *(u32x4*)(ACT + (size_t)row * FF + col) = pack8(o0, o1);
                }
        }
    }
};

DI int invperm32(int c) { return 16 * ((c >> 2) & 1) + 4 * (c >> 3) + (c & 3); }
DI int slot_std(int c) { return (c & ~31) | invperm32(c & 31); }
DI int slot_win(int c) {
    if (c >= 12288 && c < 16896) { const int tc = c & 255, hh = tc >> 7, bj = (tc >> 6) & 1, i64 = tc & 63, x = 64 * hh + i64; return (c & ~255) + 128 * bj + (x & ~31) + invperm32(x & 31); }
    return slot_std(c);
}
DI void transpose_item(const float* W, int K, int N, bf16_t* WT, int mode, LAS float* scr, int item, int lane) {
    const int nblk = N / 32, kb = item / nblk, nb = item % nblk, k0 = 64 * kb, n0 = 32 * nb;
#pragma unroll 8
    for (int i = 0; i < 32; ++i) { const int kk = 2 * i + (lane >> 5); scr[kk * 33 + (lane & 31)] = W[(size_t)(k0 + kk) * N + n0 + (lane & 31)]; }
    asm volatile("s_waitcnt lgkmcnt(0)" ::: "memory");
    const int c = lane & 7;
#pragma unroll
    for (int j = 0; j < 4; ++j) { const int n = (lane >> 3) + 8 * j; const LAS float* s = scr + (8 * c) * 33 + n;
        u32x4 o; o.x = cvt_pk_bf16(s[0 * 33], s[1 * 33]); o.y = cvt_pk_bf16(s[2 * 33], s[3 * 33]); o.z = cvt_pk_bf16(s[4 * 33], s[5 * 33]); o.w = cvt_pk_bf16(s[6 * 33], s[7 * 33]);
        const int drow = mode ? slot_win(n0 + n) : slot_std(n0 + n);
        *(u32x4*)(WT + (size_t)drow * K + k0 + 8 * c) = o; }
    asm volatile("s_waitcnt lgkmcnt(0)" ::: "memory");
}

DI void phase0(const Params& p, LAS unsigned char* lds) {
    const int tid = threadIdx.x, lane = tid & 63, wave = tid >> 6;
    LAS float* sc = (LAS float*)lds;
    LAS float* red = sc + 8192;
    float* ada = (float*)(p.ws + WS_ADA);
    for (int i = tid; i < 8192; i += 512) { const float v = p.c[i]; sc[i] = v / (1.0f + __expf(-v)); }
    __syncthreads();
    for (int cb = blockIdx.x; cb < 256; cb += gridDim.x) {
        if (lane < 48) {
            float a0 = 0.f, a1 = 0.f, a2 = 0.f, a3 = 0.f;
            const float* wp = p.w_ada + (size_t)(256 * wave) * 12288 + 48 * cb + lane;
#pragma unroll 8
            for (int k = 0; k < 256; ++k) { const float wv = wp[(size_t)k * 12288]; const int kk = 256 * wave + k;
                a0 += sc[kk] * wv; a1 += sc[2048 + kk] * wv; a2 += sc[4096 + kk] * wv; a3 += sc[6144 + kk] * wv; }
            red[(wave * 4 + 0) * 48 + lane] = a0; red[(wave * 4 + 1) * 48 + lane] = a1; red[(wave * 4 + 2) * 48 + lane] = a2; red[(wave * 4 + 3) * 48 + lane] = a3;
        }
        __syncthreads();
        if (tid < 192) { const int b = tid / 48, l = tid % 48; float s = 0.f;
#pragma unroll
            for (int w = 0; w < 8; ++w) s += red[(w * 4 + b) * 48 + l];
            ada[b * 12288 + 48 * cb + l] = s + p.b_ada[48 * cb + l]; }
        __syncthreads();
    }
    LAS float* scr = (LAS float*)(lds + 40960 + wave * 8448);
    const int gw = blockIdx.x * 8 + wave, NGW = gridDim.x * 8;
    constexpr int I_IN = (2048 / 64) * (19200 / 32), I_GATE = (2048 / 64) * (4096 / 32), I_RET = (4096 / 64) * (2048 / 32), I_ATT = (2304 / 64) * (2048 / 32),
                  I_MIX = (2048 / 64) * (2048 / 32), I_UP = (2048 / 64) * (11264 / 32), I_DOWN = (5632 / 64) * (2048 / 32);
    constexpr int NITEMS = I_IN + I_GATE + I_RET + I_ATT + I_MIX + I_UP + I_DOWN;
    for (int it = gw; it < NITEMS; it += NGW) {
        int r = it;
        if (r < I_IN) { transpose_item(p.w_in, 2048, 19200, (bf16_t*)(p.ws + WS_WIN), 1, scr, r, lane); continue; } r -= I_IN;
        if (r < I_GATE) { transpose_item(p.w_gate, 2048, 4096, (bf16_t*)(p.ws + WS_WGATE), 0, scr, r, lane); continue; } r -= I_GATE;
        if (r < I_RET) { transpose_item(p.w_ret_out, 4096, 2048, (bf16_t*)(p.ws + WS_WRET), 0, scr, r, lane); continue; } r -= I_RET;
        if (r < I_ATT) { transpose_item(p.w_att_out, 2304, 2048, (bf16_t*)(p.ws + WS_WATT), 0, scr, r, lane); continue; } r -= I_ATT;
        if (r < I_MIX) { transpose_item(p.w_mix, 2048, 2048, (bf16_t*)(p.ws + WS_WMIX), 0, scr, r, lane); continue; } r -= I_MIX;
        if (r < I_UP) { transpose_item(p.w_up, 2048, 11264, (bf16_t*)(p.ws + WS_WUP), 0, scr, r, lane); continue; } r -= I_UP;
        transpose_item(p.w_down, 5632, 2048, (bf16_t*)(p.ws + WS_WDOWN), 0, scr, r, lane);
    }
}

DI void phase_h(const Params& p) {
    const int lane = threadIdx.x & 63, wave = threadIdx.x >> 6;
    const float* ada = (const float*)(p.ws + WS_ADA); bf16_t* H = (bf16_t*)(p.ws + WS_H);
    for (int row = blockIdx.x * 8 + wave; row < T_TOK; row += gridDim.x * 8) {
        const float* xr = p.x + (size_t)row * DM; const int b = row / SEQ;
        f32x4 v[4][2]; float ss = 0.f;
#pragma unroll
        for (int it = 0; it < 4; ++it) { const int col = (it * 64 + lane) * 8; v[it][0] = *(const f32x4*)(xr + col); v[it][1] = *(const f32x4*)(xr + col + 4);
#pragma unroll
            for (int j = 0; j < 4; ++j) ss += v[it][0][j] * v[it][0][j] + v[it][1][j] * v[it][1][j]; }
        const float r = 1.0f / sqrtf(wave_sum(ss) * (1.0f / DM) + 1e-6f);
#pragma unroll
        for (int it = 0; it < 4; ++it) { const int col = (it * 64 + lane) * 8;
            f32x4 o[2];
#pragma unroll
            for (int hh = 0; hh < 2; ++hh) { const f32x4 g = *(const f32x4*)(p.g_pre_mix + col + 4 * hh), sh = *(const f32x4*)(ada + b * 12288 + col + 4 * hh), scl = *(const f32x4*)(ada + b * 12288 + 2048 + col + 4 * hh);
#pragma unroll
                for (int j = 0; j < 4; ++j) o[hh][j] = v[it][hh][j] * r * g[j] * (1.0f + scl[j]) + sh[j]; }
            *(u32x4*)(H + (size_t)row * DM + col) = pack8(o[0], o[1]); }
    }
}

DI void phase_postmix(const Params& p) {
    const int lane = threadIdx.x & 63, wave = threadIdx.x >> 6;
    const float* ada = (const float*)(p.ws + WS_ADA); const bf16_t* Y = (const bf16_t*)(p.ws + WS_Y); bf16_t* H2 = (bf16_t*)(p.ws + WS_H2);
    for (int row = blockIdx.x * 8 + wave; row < T_TOK; row += gridDim.x * 8) {
        const int b = row / SEQ; const float* ab = ada + b * 12288;
        f32x4 y[4][2]; float ss = 0.f;
#pragma unroll
        for (int it = 0; it < 4; ++it) { const int col = (it * 64 + lane) * 8; const u32x4 w = *(const u32x4*)(Y + (size_t)row * DM + col);
            y[it][0] = (f32x4){bflo(w.x), bfhi(w.x), bflo(w.y), bfhi(w.y)}; y[it][1] = (f32x4){bflo(w.z), bfhi(w.z), bflo(w.w), bfhi(w.w)};
#pragma unroll
            for (int j = 0; j < 4; ++j) ss += y[it][0][j] * y[it][0][j] + y[it][1][j] * y[it][1][j]; }
        const float ry = 1.0f / sqrtf(wave_sum(ss) * (1.0f / DM) + 1e-6f);
        float s1 = 0.f;
#pragma unroll
        for (int it = 0; it < 4; ++it) { const int col = (it * 64 + lane) * 8;
#pragma unroll
            for (int hh = 0; hh < 2; ++hh) { const f32x4 xv = *(const f32x4*)(p.x + (size_t)row * DM + col + 4 * hh), g = *(const f32x4*)(p.g_post_mix + col + 4 * hh), gt = *(const f32x4*)(ab + 4096 + col + 4 * hh);
                f32x4 o;
#pragma unroll
                for (int j = 0; j < 4; ++j) { o[j] = xv[j] + gt[j] * (y[it][hh][j] * ry * g[j]); s1 += o[j] * o[j]; }
                y[it][hh] = o; *(f32x4*)(p.out + (size_t)row * DM + col + 4 * hh) = o; } }
        const float r1 = 1.0f / sqrtf(wave_sum(s1) * (1.0f / DM) + 1e-6f);
#pragma unroll
        for (int it = 0; it < 4; ++it) { const int col = (it * 64 + lane) * 8; f32x4 o[2];
#pragma unroll
            for (int hh = 0; hh < 2; ++hh) { const f32x4 g = *(const f32x4*)(p.g_pre_ffn + col + 4 * hh), sh = *(const f32x4*)(ab + 6144 + col + 4 * hh), scl = *(const f32x4*)(ab + 8192 + col + 4 * hh);
#pragma unroll
                for (int j = 0; j < 4; ++j) o[hh][j] = y[it][hh][j] * r1 * g[j] * (1.0f + scl[j]) + sh[j]; }
            *(u32x4*)(H2 + (size_t)row * DM + col) = pack8(o[0], o[1]); }
    }
}

DI void phase_final(const Params& p) {
    const int lane = threadIdx.x & 63, wave = threadIdx.x >> 6;
    const float* ada = (const float*)(p.ws + WS_ADA); const bf16_t* Y = (const bf16_t*)(p.ws + WS_Y2);
    for (int row = blockIdx.x * 8 + wave; row < T_TOK; row += gridDim.x * 8) {
        const int b = row / SEQ; const float* ab = ada + b * 12288;
        f32x4 y[4][2]; float ss = 0.f;
#pragma unroll
        for (int it = 0; it < 4; ++it) { const int col = (it * 64 + lane) * 8; const u32x4 w = *(const u32x4*)(Y + (size_t)row * DM + col);
            y[it][0] = (f32x4){bflo(w.x), bfhi(w.x), bflo(w.y), bfhi(w.y)}; y[it][1] = (f32x4){bflo(w.z), bfhi(w.z), bflo(w.w), bfhi(w.w)};
#pragma unroll
            for (int j = 0; j < 4; ++j) ss += y[it][0][j] * y[it][0][j] + y[it][1][j] * y[it][1][j]; }
        const float ry = 1.0f / sqrtf(wave_sum(ss) * (1.0f / DM) + 1e-6f);
#pragma unroll
        for (int it = 0; it < 4; ++it) { const int col = (it * 64 + lane) * 8;
#pragma unroll
            for (int hh = 0; hh < 2; ++hh) { float* po = p.out + (size_t)row * DM + col + 4 * hh; const f32x4 xv = *(const f32x4*)po, g = *(const f32x4*)(p.g_post_ffn + col + 4 * hh), gt = *(const f32x4*)(ab + 10240 + col + 4 * hh);
                f32x4 o;
#pragma unroll
                for (int j = 0; j < 4; ++j) o[j] = xv[j] + gt[j] * (y[it][hh][j] * ry * g[j]);
                *(f32x4*)po = o; } }
    }
}

DI void phase_alpha(const Params& p) {
    bf16_t* att = (bf16_t*)(p.ws + WS_AQ); const float* lse = (const float*)(p.ws + WS_LSE);
    const int lane = threadIdx.x & 63, wave = threadIdx.x >> 6;
    for (int t = blockIdx.x * 8 + wave; t < T_TOK; t += gridDim.x * 8) {
        const float l = lse[(size_t)t * 18 + (lane < 18 ? lane : 0)];
        const int j = lane % 6;
        const float l0 = __shfl(l, j), l1 = __shfl(l, 6 + j), l2 = __shfl(l, 12 + j);
        const float mm = fmaxf(l0, fmaxf(l1, l2)); const float e0 = __expf(l0 - mm), e1 = __expf(l1 - mm), e2 = __expf(l2 - mm);
        const float al_lane = __expf(l - mm) / (e0 + e1 + e2);
        u32x4* row = (u32x4*)(att + (size_t)t * 2304);
        u32x4 w[5];
#pragma unroll
        for (int k = 0; k < 5; ++k) { const int ch = lane + 64 * k; if (ch < 288) w[k] = row[ch]; }
#pragma unroll
        for (int k = 0; k < 5; ++k) { const int ch = lane + 64 * k; const float al = __shfl(al_lane, (ch < 288 ? ch : 0) >> 4);
            if (ch < 288) { u32x4 o;
                o.x = cvt_pk_bf16(bflo(w[k].x) * al, bfhi(w[k].x) * al); o.y = cvt_pk_bf16(bflo(w[k].y) * al, bfhi(w[k].y) * al);
                o.z = cvt_pk_bf16(bflo(w[k].z) * al, bfhi(w[k].z) * al); o.w = cvt_pk_bf16(bflo(w[k].w) * al, bfhi(w[k].w) * al);
                row[ch] = o; } }
    }
}

DI void phase_retention(const Params& p, LAS unsigned char* lds) {
    const int tid = threadIdx.x, lane = tid & 63, w = tid >> 6, fr = lane & 15, fq = lane >> 4;
    LAS unsigned char* Qs = lds; LAS unsigned char* Ks = lds + 33792; LAS unsigned char* Vs = lds + 67584; LAS unsigned char* St = lds + 76800; LAS unsigned char* Ps = lds + 110592;
    LAS float* red = (LAS float*)(lds + 119808);
    const bf16_t* rq = (const bf16_t*)(p.ws + WS_RQ); const bf16_t* rk = (const bf16_t*)(p.ws + WS_RK); bf16_t* rv = (bf16_t*)p.out; float* retss = (float*)(p.ws + WS_RETSS);
    for (int item = blockIdx.x; item < 256; item += gridDim.x) {
        const int q5 = item >> 3, bh = (item & 7) * 4 + (q5 & 3), slice = q5 >> 2, b = bh >> 3, h = bh & 7;
        const float lg = log1pf(-exp2f(-5.0f - (float)h));
        const float gamma_c = expf(64.0f * lg);
        const float xv = expf(-lg * (float)((tid >> 3) + 1));
        const float xo0 = expf(lg * (float)(32 * (w & 1) + fr + 1)), xo1 = expf(lg * (float)(32 * (w & 1) + 16 + fr + 1));
        const size_t tok0 = (size_t)b * SEQ;
        const bf16_t* qbase = rq + tok0 * 2048 + h * 256 + (tid & 31) * 8; const bf16_t* kbase = rk + tok0 * 2048 + h * 256 + (tid & 31) * 8;
        bf16_t* vbase = rv + tok0 * 4096 + h * 512 + slice * 64;
        u32x4 pq[4], pk[4], pv;
        f32x4 Sreg[2][4];
#pragma unroll
        for (int a = 0; a < 2; ++a)
#pragma unroll
            for (int bb = 0; bb < 4; ++bb) Sreg[a][bb] = (f32x4){0.f, 0.f, 0.f, 0.f};
        for (int i = tid; i < 33792 / 16; i += 512) ((LAS u32x4*)St)[i] = (u32x4){0u, 0u, 0u, 0u};
#define RET_LOAD(c) do { _Pragma("unroll") for (int i = 0; i < 4; ++i) { const int row = (tid + 512 * i) >> 5; \
            pq[i] = *(const u32x4*)(qbase + (size_t)(64 * (c) + row) * 2048); pk[i] = *(const u32x4*)(kbase + (size_t)(64 * (c) + row) * 2048); } \
            pv = *(const u32x4*)(vbase + (size_t)(64 * (c) + (tid >> 3)) * 4096 + (tid & 7) * 8); } while (0)
#define RET_STORE() do { _Pragma("unroll") for (int i = 0; i < 4; ++i) { const int e = tid + 512 * i, row = e >> 5, pc = e & 31; \
            *(LAS u32x4*)(Qs + row * 528 + pc * 16) = pq[i]; *(LAS u32x4*)(Ks + row * 528 + pc * 16) = pk[i]; } \
            { u32x4 o; o.x = cvt_pk_bf16(bflo(pv.x) * xv, bfhi(pv.x) * xv); o.y = cvt_pk_bf16(bflo(pv.y) * xv, bfhi(pv.y) * xv); \
              o.z = cvt_pk_bf16(bflo(pv.z) * xv, bfhi(pv.z) * xv); o.w = cvt_pk_bf16(bflo(pv.w) * xv, bfhi(pv.w) * xv); \
              *(LAS u32x4*)(Vs + (tid >> 3) * 144 + (tid & 7) * 16) = o; } } while (0)
        RET_LOAD(0); RET_STORE();
        __syncthreads();
        for (int c = 0; c < 128; ++c) {
            if (c + 1 < 128) RET_LOAD(c + 1);
            {
                const int jt = w >> 1, it0 = (w & 1) * 2;
                f32x4 sa[2] = {(f32x4){0.f, 0.f, 0.f, 0.f}, (f32x4){0.f, 0.f, 0.f, 0.f}};
#pragma unroll
                for (int ks = 0; ks < 8; ++ks) {
                    const bf16x8 kf = *(const LAS bf16x8*)(Ks + (16 * jt + fr) * 528 + (32 * ks + 8 * fq) * 2);
#pragma unroll
                    for (int t = 0; t < 2; ++t) { const bf16x8 qf = *(const LAS bf16x8*)(Qs + (16 * (it0 + t) + fr) * 528 + (32 * ks + 8 * fq) * 2); sa[t] = mfma16(kf, qf, sa[t]); }
                }
#pragma unroll
                for (int t = 0; t < 2; ++t) { const int iq = 16 * (it0 + t) + fr, jk0 = 16 * jt + 4 * fq;
                    u32x2 o; o.x = cvt_pk_bf16(jk0 + 0 <= iq ? sa[t][0] : 0.f, jk0 + 1 <= iq ? sa[t][1] : 0.f); o.y = cvt_pk_bf16(jk0 + 2 <= iq ? sa[t][2] : 0.f, jk0 + 3 <= iq ? sa[t][3] : 0.f);
                    *(LAS u32x2*)(Ps + iq * 144 + jk0 * 2) = o; }
            }
            {
#pragma unroll
                for (int ks = 0; ks < 2; ++ks) {
                    const int j0 = 32 * ks + 8 * fq + (fr >> 2);
                    bf16x8 kt[2], vf[4];
#pragma unroll
                    for (int dd = 0; dd < 2; ++dd) { LAS unsigned char* a0 = Ks + j0 * 528 + (16 * (2 * w + dd) + 4 * (fr & 3)) * 2; kt[dd] = tr_read2(a0, a0 + 4 * 528); }
#pragma unroll
                    for (int vt = 0; vt < 4; ++vt) { LAS unsigned char* a0 = Vs + j0 * 144 + (16 * vt + 4 * (fr & 3)) * 2; vf[vt] = tr_read2(a0, a0 + 4 * 144); }
#pragma unroll
                    for (int dd = 0; dd < 2; ++dd)
#pragma unroll
                        for (int vt = 0; vt < 4; ++vt) Sreg[dd][vt] = mfma16(kt[dd], vf[vt], Sreg[dd][vt]);
                }
#pragma unroll
                for (int dd = 0; dd < 2; ++dd)
#pragma unroll
                    for (int vt = 0; vt < 4; ++vt) Sreg[dd][vt] *= gamma_c;
            }
            __syncthreads();
            {
                const int vt = w >> 1, it0 = (w & 1) * 2;
                f32x4 oa[2] = {(f32x4){0.f, 0.f, 0.f, 0.f}, (f32x4){0.f, 0.f, 0.f, 0.f}};
#pragma unroll
                for (int ks = 0; ks < 8; ++ks) {
                    const bf16x8 sf = *(const LAS bf16x8*)(St + (16 * vt + fr) * 528 + (32 * ks + 8 * fq) * 2);
#pragma unroll
                    for (int t = 0; t < 2; ++t) { const bf16x8 qf = *(const LAS bf16x8*)(Qs + (16 * (it0 + t) + fr) * 528 + (32 * ks + 8 * fq) * 2); oa[t] = mfma16(sf, qf, oa[t]); }
                }
#pragma unroll
                for (int ks = 0; ks < 2; ++ks) {
                    const int j0 = 32 * ks + 8 * fq + (fr >> 2);
                    LAS unsigned char* a0 = Vs + j0 * 144 + (16 * vt + 4 * (fr & 3)) * 2; const bf16x8 vf = tr_read2(a0, a0 + 4 * 144);
#pragma unroll
                    for (int t = 0; t < 2; ++t) { const bf16x8 pf = *(const LAS bf16x8*)(Ps + (16 * (it0 + t) + fr) * 144 + (32 * ks + 8 * fq) * 2); oa[t] = mfma16(vf, pf, oa[t]); }
                }
#pragma unroll
                for (int t = 0; t < 2; ++t) { const int iq = 16 * (it0 + t) + fr; oa[t] *= (t == 0 ? xo0 : xo1);
                    u32x2 o; o.x = cvt_pk_bf16(oa[t][0], oa[t][1]); o.y = cvt_pk_bf16(oa[t][2], oa[t][3]);
                    *(u32x2*)(vbase + (size_t)(64 * c + iq) * 4096 + 16 * vt + 4 * fq) = o;
                    float ss = (oa[t][0] * oa[t][0] + oa[t][1] * oa[t][1]) + (oa[t][2] * oa[t][2] + oa[t][3] * oa[t][3]);
                    ss += __shfl_xor(ss, 16); ss += __shfl_xor(ss, 32);
                    if (fq == 0) red[iq * 4 + vt] = ss; }
            }
            __syncthreads();
#pragma unroll
            for (int dd = 0; dd < 2; ++dd)
#pragma unroll
                for (int vt = 0; vt < 4; ++vt) { u32x2 o; o.x = cvt_pk_bf16(Sreg[dd][vt][0], Sreg[dd][vt][1]); o.y = cvt_pk_bf16(Sreg[dd][vt][2], Sreg[dd][vt][3]);
                    *(LAS u32x2*)(St + (16 * vt + fr) * 528 + (16 * (2 * w + dd) + 4 * fq) * 2) = o; }
            if (c + 1 < 128) RET_STORE();
            if (tid < 64) retss[((tok0 + 64 * c + tid) * 8 + h) * 8 + slice] = (red[tid * 4 + 0] + red[tid * 4 + 1]) + (red[tid * 4 + 2] + red[tid * 4 + 3]);
            __syncthreads();
        }
#undef RET_LOAD
#undef RET_STORE
    }
}

DI void phase_attention(const Params& p, LAS unsigned char* lds) {
    const int tid = threadIdx.x, lane = tid & 63, w = tid >> 6, fr = lane & 15, fq = lane >> 4;
    LAS unsigned char* Ks = lds; LAS unsigned char* Vs = lds + 52224; LAS unsigned char* Ps = lds + 104448;
    LAS float* mx = (LAS float*)(lds + 130048); LAS float* sm = mx + 128;
    bf16_t* aq = (bf16_t*)(p.ws + WS_AQ); const bf16_t* ak = (const bf16_t*)(p.ws + WS_AK); const bf16_t* av = (const bf16_t*)(p.ws + WS_AV); float* lse = (float*)(p.ws + WS_LSE);
    for (int item = blockIdx.x; item < 9216; item += gridDim.x) {
        const int hf = item & 1; int rest = item >> 1; const int cbk = rest & 63; rest >>= 6; const int head = rest % 18, b = rest / 18;
        const int g = head / 6, rsh = 2 * g, r = 1 << rsh, cls = cbk & (r - 1), nb = cbk >> rsh;
        const int pq0 = nb * 128 + 64 * hf, pk0 = pq0 - 128;
        const size_t tokb = (size_t)b * SEQ;
#pragma unroll
        for (int i = 0; i < 6; ++i) { const int e = tid + 512 * i, row = e >> 4, pc = e & 15; const int pk = pk0 + row; const bool valid = pk >= 0;
            const size_t off = (tokb + (size_t)(valid ? pk : 0) * r + cls) * 2304 + head * 128 + pc * 8;
            u32x4 kv = *(const u32x4*)(ak + off), vv = *(const u32x4*)(av + off);
            if (!valid) { kv = (u32x4){0u, 0u, 0u, 0u}; vv = kv; }
            *(LAS u32x4*)(Ks + row * 272 + pc * 16) = kv; *(LAS u32x4*)(Vs + row * 272 + pc * 16) = vv; }
        const int qt = w & 3, kh = w >> 2, qq = 16 * qt + fr;
        bf16x8 qf[4];
        { const bf16_t* qp = aq + (tokb + (size_t)(pq0 + qq) * r + cls) * 2304 + head * 128 + 8 * fq;
#pragma unroll
          for (int ks = 0; ks < 4; ++ks) qf[ks] = *(const bf16x8*)(qp + 32 * ks); }
        __syncthreads();
        f32x4 sa[6];
#pragma unroll
        for (int kt = 0; kt < 6; ++kt) { sa[kt] = (f32x4){0.f, 0.f, 0.f, 0.f};
#pragma unroll
            for (int ks = 0; ks < 4; ++ks) { const bf16x8 kf = *(const LAS bf16x8*)(Ks + (96 * kh + 16 * kt + fr) * 272 + (32 * ks + 8 * fq) * 2); sa[kt] = mfma16(kf, qf[ks], sa[kt]); } }
        const float sc2 = 0.08838834764831845f * 1.4426950408889634f;
        float mloc = -INFINITY;
#pragma unroll
        for (int kt = 0; kt < 6; ++kt)
#pragma unroll
            for (int j = 0; j < 4; ++j) { const int kk = 96 * kh + 16 * kt + 4 * fq + j; const bool valid = (kk >= qq) && (kk <= qq + 128) && (pk0 + kk >= 0);
                const float s = valid ? sa[kt][j] * sc2 : -INFINITY; sa[kt][j] = s; mloc = fmaxf(mloc, s); }
        mloc = fmaxf(mloc, __shfl_xor(mloc, 16)); mloc = fmaxf(mloc, __shfl_xor(mloc, 32));
        if (fq == 0) mx[kh * 64 + qq] = mloc;
        __syncthreads();
        const float mrow = fmaxf(mx[qq], mx[64 + qq]);
        float lsum = 0.f;
#pragma unroll
        for (int kt = 0; kt < 6; ++kt) { f32x4 pv;
#pragma unroll
            for (int j = 0; j < 4; ++j) { pv[j] = __builtin_amdgcn_exp2f(sa[kt][j] - mrow); lsum += pv[j]; }
            u32x2 o; o.x = cvt_pk_bf16(pv[0], pv[1]); o.y = cvt_pk_bf16(pv[2], pv[3]);
            *(LAS u32x2*)(Ps + qq * 400 + (96 * kh + 16 * kt + 4 * fq) * 2) = o; }
        lsum += __shfl_xor(lsum, 16); lsum += __shfl_xor(lsum, 32);
        if (fq == 0) sm[kh * 64 + qq] = lsum;
        __syncthreads();
        f32x4 oa[4];
#pragma unroll
        for (int t = 0; t < 4; ++t) oa[t] = (f32x4){0.f, 0.f, 0.f, 0.f};
#pragma unroll
        for (int ks = 0; ks < 6; ++ks) {
            const int j0 = 32 * ks + 8 * fq + (fr >> 2);
            LAS unsigned char* a0 = Vs + j0 * 272 + (16 * w + 4 * (fr & 3)) * 2; const bf16x8 vf = tr_read2(a0, a0 + 4 * 272);
#pragma unroll
            for (int t = 0; t < 4; ++t) { const bf16x8 pf = *(const LAS bf16x8*)(Ps + (16 * t + fr) * 400 + (32 * ks + 8 * fq) * 2); oa[t] = mfma16(vf, pf, oa[t]); }
        }
#pragma unroll
        for (int t = 0; t < 4; ++t) { const int q2 = 16 * t + fr; const float l = sm[q2] + sm[64 + q2], inv = 1.0f / l;
            const size_t tok = tokb + (size_t)(pq0 + q2) * r + cls;
            u32x2 o; o.x = cvt_pk_bf16(oa[t][0] * inv, oa[t][1] * inv); o.y = cvt_pk_bf16(oa[t][2] * inv, oa[t][3] * inv);
            *(u32x2*)(aq + tok * 2304 + head * 128 + 16 * w + 4 * fq) = o;
            if (w == 0 && fq == 0) lse[tok * 18 + head] = fmaxf(mx[q2], mx[64 + q2]) * 0.6931471805599453f + logf(l); }
        __syncthreads();
    }
}


constexpr size_t WS_BAR = 700000;
DI void grid_barrier(unsigned* bar, unsigned& nbar) {
    asm volatile("s_waitcnt vmcnt(0)" ::: "memory");
    __syncthreads();
    if (threadIdx.x == 0) {
        __builtin_amdgcn_fence(__ATOMIC_RELEASE, "agent");
        asm volatile("s_waitcnt vmcnt(0)" ::: "memory");
        const unsigned target = (nbar + 1u) * gridDim.x;
        __hip_atomic_fetch_add(bar, 1u, __ATOMIC_RELAXED, __HIP_MEMORY_SCOPE_AGENT);
        while (__hip_atomic_load(bar, __ATOMIC_RELAXED, __HIP_MEMORY_SCOPE_AGENT) < target) __builtin_amdgcn_s_sleep(1);
        __builtin_amdgcn_fence(__ATOMIC_ACQUIRE, "agent");
        asm volatile("s_waitcnt vmcnt(0)" ::: "memory");
    }
    __syncthreads();
    ++nbar;
}

constexpr int N_PHASES = 13;
__global__ void __launch_bounds__(512, 2) mega(Params p) {
    extern __shared__ __attribute__((aligned(16))) unsigned char shm[];
    LAS unsigned char* lds = (LAS unsigned char*)shm;
    unsigned char* ws = p.ws;
    const int G = gridDim.x, c = blockIdx.x;
    unsigned* bar = (unsigned*)(ws + WS_BAR); unsigned nbar = 0;
    if (p.ph_lo <= 0 && 0 < p.ph_hi) {
        if (0 > p.ph_lo) grid_barrier(bar, nbar);

#if (PHMASK >> 0) & 1
            phase0(p, lds);
#endif
    }
    if (p.ph_lo <= 1 && 1 < p.ph_hi) {
        if (1 > p.ph_lo) cg::this_grid().sync();

#if (PHMASK >> 1) & 1
            phase_h(p);
#endif
    }
    if (p.ph_lo <= 2 && 2 < p.ph_hi) {
        if (2 > p.ph_lo) grid_barrier(bar, nbar);

#if (PHMASK >> 2) & 1
            pg8::Gemm g{(const bf16_t*)(ws + WS_H), (const bf16_t*)(ws + WS_WIN), T_TOK, 59 * 256, 2048, nullptr, nullptr, 0}; pg8::StaticOrder S; S.init(T_TOK, 59 * 256, G, c, 32, 16);
            EpiInProj E{(bf16_t*)(ws + WS_RQ), (bf16_t*)(ws + WS_RK), (bf16_t*)p.out, (bf16_t*)(ws + WS_AQ), (bf16_t*)(ws + WS_AK), (bf16_t*)(ws + WS_AV), p.pos};
            pg8::gemm_phase<1>(lds, g, S, E);
#endif
    }
    if (p.ph_lo <= 3 && 3 < p.ph_hi) {
        if (3 > p.ph_lo) grid_barrier(bar, nbar);

#if (PHMASK >> 3) & 1
            phase_retention(p, lds); __syncthreads();
#endif
#if (PHMASK >> 13) & 1
            phase_attention(p, lds);
#endif
    }
    if (p.ph_lo <= 4 && 4 < p.ph_hi) {
        if (4 > p.ph_lo) grid_barrier(bar, nbar);

#if (PHMASK >> 4) & 1
            { pg8::Gemm g{(const bf16_t*)(ws + WS_H), (const bf16_t*)(ws + WS_WIN) + (size_t)8192 * 2048, T_TOK, 4096, 2048, nullptr, nullptr, 0}; pg8::StaticOrder S; S.init(T_TOK, 4096, G, c);
              EpiRetGate E{(bf16_t*)p.out, (const float*)(ws + WS_RETSS), p.ret_gain}; pg8::gemm_phase<1>(lds, g, S, E); }
#endif
#if (PHMASK >> 14) & 1
            { pg8::Gemm g{(const bf16_t*)(ws + WS_H), (const bf16_t*)(ws + WS_WGATE), T_TOK, 4096, 2048, nullptr, nullptr, 0}; pg8::StaticOrder S; S.init(T_TOK, 4096, G, c);
              EpiGates E{(bf16_t*)(ws + WS_GATES), p.b_gate}; pg8::gemm_phase<1>(lds, g, S, E); }
#endif
#if (PHMASK >> 15) & 1
            phase_alpha(p);
#endif
    }
    if (p.ph_lo <= 5 && 5 < p.ph_hi) {
        if (5 > p.ph_lo) grid_barrier(bar, nbar);

#if (PHMASK >> 5) & 1
            pg8::Gemm g{(const bf16_t*)p.out, (const bf16_t*)(ws + WS_WRET), T_TOK, 2048, 4096, (const bf16_t*)(ws + WS_AQ), (const bf16_t*)(ws + WS_WATT), 2304}; pg8::StaticOrder S; S.init(T_TOK, 2048, G, c);
            EpiYMerge E{(const bf16_t*)(ws + WS_GATES), (bf16_t*)(ws + WS_U2)}; pg8::gemm_phase<2>(lds, g, S, E);
#endif
    }
    if (p.ph_lo <= 7 && 7 < p.ph_hi) {
        if (7 > p.ph_lo) grid_barrier(bar, nbar);

#if (PHMASK >> 7) & 1
            pg8::Gemm g{(const bf16_t*)(ws + WS_U2), (const bf16_t*)(ws + WS_WMIX), T_TOK, 2048, 2048, nullptr, nullptr, 0}; pg8::StaticOrder S; S.init(T_TOK, 2048, G, c);
            EpiStoreBf16 E{(bf16_t*)(ws + WS_Y), 2048}; pg8::gemm_phase<1>(lds, g, S, E);
#endif
    }
    if (p.ph_lo <= 8 && 8 < p.ph_hi) {
        if (8 > p.ph_lo) grid_barrier(bar, nbar);

#if (PHMASK >> 8) & 1
            phase_postmix(p);
#endif
    }
    if (p.ph_lo <= 9 && 9 < p.ph_hi) {
        if (9 > p.ph_lo) grid_barrier(bar, nbar);

#if (PHMASK >> 9) & 1
            pg8::Gemm g{(const bf16_t*)(ws + WS_H2), (const bf16_t*)(ws + WS_WUP), T_TOK, FF, 2048, nullptr, nullptr, 0}; pg8::StaticOrder S; S.init(T_TOK, FF, G, c);
            EpiStoreBf16 E{(bf16_t*)(ws + WS_A), FF}; pg8::gemm_phase<1>(lds, g, S, E);
#endif
    }
    if (p.ph_lo <= 10 && 10 < p.ph_hi) {
        if (10 > p.ph_lo) grid_barrier(bar, nbar);

#if (PHMASK >> 10) & 1
            pg8::Gemm g{(const bf16_t*)(ws + WS_H2), (const bf16_t*)(ws + WS_WUP) + (size_t)FF * 2048, T_TOK, FF, 2048, nullptr, nullptr, 0}; pg8::StaticOrder S; S.init(T_TOK, FF, G, c);
            EpiConvAct E{(const bf16_t*)(ws + WS_A), (bf16_t*)(ws + WS_ACT), p.conv_w, p.conv_b}; pg8::gemm_phase<1>(lds, g, S, E);
#endif
    }
    if (p.ph_lo <= 11 && 11 < p.ph_hi) {
        if (11 > p.ph_lo) grid_barrier(bar, nbar);

#if (PHMASK >> 11) & 1
            pg8::Gemm g{(const bf16_t*)(ws + WS_ACT), (const bf16_t*)(ws + WS_WDOWN), T_TOK, 2048, FF, nullptr, nullptr, 0}; pg8::StaticOrder S; S.init(T_TOK, 2048, G, c);
            EpiStoreBf16 E{(bf16_t*)(ws + WS_Y2), 2048}; pg8::gemm_phase<1>(lds, g, S, E);
#endif
    }
    if (p.ph_lo <= 12 && 12 < p.ph_hi) {
        if (12 > p.ph_lo) grid_barrier(bar, nbar);

#if (PHMASK >> 12) & 1
            phase_final(p);
#endif
    }
}

extern "C" void kernel_launch(void* const* d_in, const int* in_sizes, int n_in, void* d_out, int out_size, void* d_ws, size_t ws_size, hipStream_t stream) {
    static int grid = 0;
    if (grid == 0) {
        if (n_in != 20 || ws_size < WS_END) { fprintf(stderr, "kernel_launch: unexpected n_in %d or ws_size %zu (need %zu)\n", n_in, ws_size, (size_t)WS_END); grid = -1; return; }
        int dev = 0, cus = 0, per_cu = 0;
        hipGetDevice(&dev); hipDeviceGetAttribute(&cus, hipDeviceAttributeMultiprocessorCount, dev);
        if (hipFuncSetAttribute((const void*)mega, hipFuncAttributeMaxDynamicSharedMemorySize, LDS_BYTES) != hipSuccess) { fprintf(stderr, "kernel_launch: hipFuncSetAttribute failed\n"); grid = -1; return; }
        if (hipOccupancyMaxActiveBlocksPerMultiprocessor(&per_cu, (const void*)mega, 512, LDS_BYTES) != hipSuccess || per_cu < 1) { fprintf(stderr, "kernel_launch: occupancy query says %d\n", per_cu); per_cu = 1; }
        (void)hipGetLastError();
        grid = cus * 1;
    }
    if (grid < 0) return;
    Params p{};
    p.x = (const float*)d_in[0]; p.c = (const float*)d_in[1]; p.pos = (const int*)d_in[2]; p.w_ada = (const float*)d_in[3]; p.b_ada = (const float*)d_in[4]; p.g_pre_mix = (const float*)d_in[5];
    p.w_in = (const float*)d_in[6]; p.ret_gain = (const float*)d_in[7]; p.w_ret_out = (const float*)d_in[8]; p.w_att_out = (const float*)d_in[9]; p.w_gate = (const float*)d_in[10]; p.b_gate = (const float*)d_in[11];
    p.w_mix = (const float*)d_in[12]; p.g_post_mix = (const float*)d_in[13]; p.g_pre_ffn = (const float*)d_in[14]; p.w_up = (const float*)d_in[15]; p.conv_w = (const float*)d_in[16]; p.conv_b = (const float*)d_in[17];
    p.w_down = (const float*)d_in[18]; p.g_post_ffn = (const float*)d_in[19];
    p.out = (float*)d_out; p.ws = (unsigned char*)d_ws;
    if (hipMemsetAsync((char*)d_ws + WS_BAR, 0, 256, stream) != hipSuccess) { fprintf(stderr, "kernel_launch: memset failed\n"); return; }
#if N_LAUNCH_PER_PHASE
    for (int ph = 0; ph < N_PHASES; ++ph) { p.ph_lo = ph; p.ph_hi = ph + 1; hipLaunchKernelGGL(mega, dim3(grid), dim3(512), LDS_BYTES, stream, p); }
#else
    p.ph_lo = 0; p.ph_hi = N_PHASES;
    void* args[] = {&p};
    hipError_t e = hipLaunchCooperativeKernel((const void*)mega, dim3(grid), dim3(512), args, LDS_BYTES, stream);
    if (e != hipSuccess) fprintf(stderr, "cooperative launch failed: %s (grid %d)\n", hipGetErrorString(e), grid);
#endif
}
```

```cpp
#include <hip/hip_runtime.h>
#include <hip/hip_cooperative_groups.h>
#include <cstdio>
#include <cstdint>
namespace cg = cooperative_groups;

#define DI __device__ __forceinline__
#define LAS __attribute__((address_space(3)))
typedef unsigned short bf16_t;
typedef short bf16x8 __attribute__((ext_vector_type(8)));
typedef short s16x4 __attribute__((ext_vector_type(4)));
typedef float f32x4 __attribute__((ext_vector_type(4)));
typedef unsigned u32x4 __attribute__((ext_vector_type(4)));
typedef unsigned u32x2 __attribute__((ext_vector_type(2)));

#ifndef PHMASK
#define PHMASK 0xFFFF
#endif
#ifndef N_LAUNCH_PER_PHASE
#define N_LAUNCH_PER_PHASE 0
#endif

constexpr int T_TOK = 32768, DM = 2048, SEQ = 8192, NB = 4;
constexpr int FF = 5632;
constexpr int LDS_BYTES = 139264;
constexpr size_t MiB = 1u << 20;
constexpr size_t WS_ADA = 0;
constexpr size_t WS_LSE = 1 * MiB;
constexpr size_t WS_RETSS = 4 * MiB;
constexpr size_t WS_WUP = 12 * MiB;
constexpr size_t WS_WDOWN = 56 * MiB;
constexpr size_t WS_WIN = 78 * MiB;
constexpr size_t WS_WGATE = 153 * MiB;
constexpr size_t WS_WRET = 169 * MiB;
constexpr size_t WS_WATT = 185 * MiB;
constexpr size_t WS_WMIX = 194 * MiB;
constexpr size_t WS_H = 206 * MiB;
constexpr size_t WS_RQ = 334 * MiB;
constexpr size_t WS_RK = 462 * MiB;
constexpr size_t WS_AQ = 590 * MiB;
constexpr size_t WS_AK = 734 * MiB;
constexpr size_t WS_AV = 878 * MiB;
constexpr size_t WS_GATES = 334 * MiB;
constexpr size_t WS_U = 734 * MiB;
constexpr size_t WS_U2 = 206 * MiB;
constexpr size_t WS_Y = 334 * MiB;
constexpr size_t WS_H2 = 78 * MiB;
constexpr size_t WS_A = 206 * MiB;
constexpr size_t WS_ACT = 558 * MiB;
constexpr size_t WS_Y2 = 78 * MiB;
constexpr size_t WS_END = 1022 * MiB;

struct Params {
    const float *x, *c; const int* pos;
    const float *w_ada, *b_ada, *g_pre_mix, *w_in, *ret_gain, *w_ret_out, *w_att_out, *w_gate, *b_gate, *w_mix, *g_post_mix, *g_pre_ffn, *w_up, *conv_w, *conv_b, *w_down, *g_post_ffn;
    float* out; unsigned char* ws; int ph_lo, ph_hi;
};

typedef __bf16 bf16x2_t __attribute__((ext_vector_type(2)));
DI unsigned cvt_pk_bf16(float lo, float hi) { bf16x2_t v = {(__bf16)lo, (__bf16)hi}; return __builtin_bit_cast(unsigned, v); }
DI float bflo(unsigned w) { return __uint_as_float(w << 16); }
DI float bfhi(unsigned w) { return __uint_as_float(w & 0xffff0000u); }
DI float wave_sum(float v) {
#pragma unroll
    for (int o = 1; o < 64; o <<= 1) v += __shfl_xor(v, o);
    return v;
}
DI float sigmoidf_(float v) { return __builtin_amdgcn_rcpf(1.0f + __builtin_amdgcn_exp2f(-1.4426950408889634f * v)); }
DI f32x4 mfma16(bf16x8 a, bf16x8 b, f32x4 c) { return __builtin_amdgcn_mfma_f32_16x16x32_bf16(a, b, c, 0, 0, 0); }
DI s16x4 tr_read(LAS unsigned char* p) { return __builtin_amdgcn_ds_read_tr16_b64_v4i16((LAS s16x4*)p); }
DI bf16x8 tr_read2(LAS unsigned char* p0, LAS unsigned char* p1) { s16x4 lo = tr_read(p0), hi = tr_read(p1); return __builtin_shufflevector(lo, hi, 0, 1, 2, 3, 4, 5, 6, 7); }

namespace pg8 {
constexpr int BM = 256, BK = 64, HALF = 128, HTB = HALF * BK * 2, STAGE_BYTES = 8 * HTB, NXCD = 8, WGM = 8;
DI int lds_byte(int r, int c) { const int st = (r >> 4) * 2 + (c >> 5), rr = r & 15, cc = c & 31, ob = rr * 64 + cc * 2; return st * 1024 + (ob ^ (((ob >> 9) & 1) << 5)); }
DI void stage_rc(int b, int& R, int& C) { const int st = b / 1024, sb = b % 1024, swz = sb ^ (((sb >> 9) & 1) << 5); R = (st >> 1) * 16 + swz / 64; C = (st & 1) * 32 + (swz % 64) / 2; }
struct Unit { int pm, pn; };
struct Gemm { const bf16_t* A; const bf16_t* Bt; int M, N, K; const bf16_t* A1; const bf16_t* Bt1; int K1; };
struct StaticOrder {
    int nM, nN, nwg, G, c, skip_lo, skip_n;
    DI void init(int M, int N, int G_, int c_, int slo = 1 << 30, int sn = 0) { nM = M / BM; nN = N / BM; nwg = nM * nN; G = G_; c = c_; skip_lo = slo; skip_n = sn; }
    DI bool next(int i, Unit& u) const {
        const long L = (long)i * G + c; if (L >= nwg) return false;
        int wgid = (int)L; { const int q = nwg / NXCD, r = nwg % NXCD, xcd = wgid % NXCD, off = wgid / NXCD; wgid = (xcd < r ? xcd * (q + 1) : r * (q + 1) + (xcd - r) * q) + off; }
        const int nig = WGM * nN, gid = wgid / nig, fm = gid * WGM, gsz = (nM - fm) < WGM ? (nM - fm) : WGM;
        u.pm = fm + ((wgid % nig) % gsz); u.pn = (wgid % nig) / gsz; if (u.pn >= skip_lo) u.pn += skip_n; return true;
    }
};

template <int NSEG, class Epi>
DI void gemm_phase(LAS unsigned char* lds, const Gemm g, const StaticOrder& S, const Epi& E) {
    const int tid = threadIdx.x, wid = __builtin_amdgcn_readfirstlane(tid >> 6), lane = tid & 63, wr = wid >> 2, wc = wid & 3, fr = lane & 15, fq = lane >> 4;
    int Rr[2], Cc[2];
#pragma unroll
    for (int i = 0; i < 2; ++i) stage_rc(tid * 16 + i * 8192, Rr[i], Cc[i]);
    const size_t kstep = (size_t)(BK * 2);
    const unsigned ldsw = (unsigned)wid * 1024u;
    const int aoff = lds_byte(wr * 64 + fr, fq * 8), boff = lds_byte(wc * 32 + fr, fq * 8);
#define PG8_SA(b, h) (((b) * 2 + (h)) * HTB)
#define PG8_SB(b, h) ((4 + (b) * 2 + (h)) * HTB)
#define PG8_STAGE(bufoff, gbase, VO) do { _Pragma("unroll") for (int _i = 0; _i < 2; ++_i) \
        __builtin_amdgcn_global_load_lds((const unsigned*)((const char*)(gbase) + VO[_i]), (LAS unsigned*)(lds + (bufoff) + ldsw + _i * 8192), 16, 0, 0); } while (0)
#define PG8_LDA(dst, b, h) do { _Pragma("unroll") for (int m = 0; m < 4; ++m) _Pragma("unroll") for (int k = 0; k < 2; ++k) dst[m][k] = *(const LAS bf16x8*)(lds + PG8_SA(b, h) + aoff + m * 2048 + k * 1024); } while (0)
#define PG8_LDB(dst, b, h) do { _Pragma("unroll") for (int n = 0; n < 2; ++n) _Pragma("unroll") for (int k = 0; k < 2; ++k) dst[n][k] = *(const LAS bf16x8*)(lds + PG8_SB(b, h) + boff + n * 2048 + k * 1024); } while (0)
#define PG8_MMA(ai, bj, At, Bt) do { __builtin_amdgcn_s_setprio(1); _Pragma("unroll") for (int m = 0; m < 4; ++m) _Pragma("unroll") for (int n = 0; n < 2; ++n) _Pragma("unroll") for (int k = 0; k < 2; ++k) \
        acc[ai][bj][m][n] = __builtin_amdgcn_mfma_f32_16x16x32_bf16(Bt[n][k], At[m][k], acc[ai][bj][m][n], 0, 0, 0); __builtin_amdgcn_s_setprio(0); } while (0)
#define PG8_WAIT_V(n) asm volatile("s_waitcnt vmcnt(" #n ")" ::: "memory")
#define PG8_WAIT_L(n) asm volatile("s_waitcnt lgkmcnt(" #n ")" ::: "memory")
#define PG8_BAR __builtin_amdgcn_s_barrier()
#define PG8_SCHED __builtin_amdgcn_sched_barrier(0)
    Unit cur, nxt; int ti = 0, seg = 0;
    if (!S.next(0, cur)) return;
    f32x4 acc[2][2][4][2];
#pragma unroll
    for (int a = 0; a < 2; ++a)
#pragma unroll
        for (int b = 0; b < 2; ++b)
#pragma unroll
            for (int m = 0; m < 4; ++m)
#pragma unroll
                for (int n = 0; n < 2; ++n) acc[a][b][m][n] = (f32x4){0.f, 0.f, 0.f, 0.f};
    bf16x8 At[4][2], B0[2][2], B1[2][2];
    int Kc = g.K;
    unsigned voffC[2];
#pragma unroll
    for (int i = 0; i < 2; ++i) voffC[i] = (unsigned)(Rr[i] * Kc + Cc[i]) * 2u;
    size_t hstepC = (size_t)HALF * Kc * 2;
    const char* cA = (const char*)g.A + (size_t)cur.pm * 2 * hstepC; const char* cB = (const char*)g.Bt + (size_t)cur.pn * 2 * hstepC;
    PG8_STAGE(PG8_SB(0, 0), cB, voffC); PG8_STAGE(PG8_SA(0, 0), cA, voffC); PG8_STAGE(PG8_SB(0, 1), cB + hstepC, voffC); PG8_STAGE(PG8_SA(0, 1), cA + hstepC, voffC);
    if (wr == 1) PG8_BAR;
    PG8_WAIT_V(4); PG8_BAR;
    PG8_STAGE(PG8_SB(1, 0), cB + kstep, voffC); PG8_STAGE(PG8_SA(1, 0), cA + kstep, voffC); PG8_STAGE(PG8_SB(1, 1), cB + hstepC + kstep, voffC);
    PG8_WAIT_V(6); PG8_BAR;
    for (;;) {
        bool has_next; int nseg = 0;
        if (NSEG > 1 && seg + 1 < NSEG) { has_next = true; nxt = cur; nseg = seg + 1; }
        else has_next = S.next(ti + 1, nxt);
        int Kn = Kc; const char* nA = cA; const char* nB = cB;
        if (has_next) { Kn = (NSEG > 1 && nseg == 1) ? g.K1 : g.K;
            nA = (const char*)((NSEG > 1 && nseg == 1) ? g.A1 : g.A) + (size_t)nxt.pm * 256 * Kn * 2; nB = (const char*)((NSEG > 1 && nseg == 1) ? g.Bt1 : g.Bt) + (size_t)nxt.pn * 256 * Kn * 2; }
        unsigned voffN[2];
#pragma unroll
        for (int i = 0; i < 2; ++i) voffN[i] = (NSEG > 1) ? (unsigned)(Rr[i] * Kn + Cc[i]) * 2u : voffC[i];
        const size_t hstepN = (NSEG > 1) ? (size_t)HALF * Kn * 2 : hstepC;
        const int nt = Kc / BK;
        for (int t = 0; t < nt; t += 2) {
            const bool last = (t == nt - 2);
            const char* a1 = cA + (size_t)(t + 1) * kstep;
            const char* a2 = last ? nA : cA + (size_t)(t + 2) * kstep; const char* b2 = last ? nB : cB + (size_t)(t + 2) * kstep;
            const char* a3 = a2 + kstep; const char* b3 = b2 + kstep;
            unsigned v2[2]; v2[0] = (NSEG > 1 && last) ? voffN[0] : voffC[0]; v2[1] = (NSEG > 1 && last) ? voffN[1] : voffC[1];
            const size_t h2 = (NSEG > 1 && last) ? hstepN : hstepC;
            PG8_LDB(B0, 0, 0); PG8_SCHED; PG8_LDA(At, 0, 0); PG8_STAGE(PG8_SA(1, 1), a1 + hstepC, voffC);
            PG8_WAIT_L(8); PG8_BAR; PG8_WAIT_L(0); PG8_MMA(0, 0, At, B0); PG8_BAR; PG8_SCHED;
            PG8_LDB(B1, 0, 1); PG8_STAGE(PG8_SB(0, 0), b2, v2);
            PG8_BAR; PG8_WAIT_L(0); PG8_MMA(0, 1, At, B1); PG8_BAR;
            PG8_LDA(At, 0, 1); PG8_STAGE(PG8_SA(0, 0), a2, v2);
            PG8_BAR; PG8_WAIT_L(0); PG8_MMA(1, 0, At, B0); PG8_BAR; PG8_SCHED;
            PG8_STAGE(PG8_SB(0, 1), b2 + h2, v2);
            PG8_WAIT_V(6); PG8_BAR; PG8_MMA(1, 1, At, B1); PG8_BAR;
            PG8_LDB(B0, 1, 0); PG8_SCHED; PG8_LDA(At, 1, 0); PG8_STAGE(PG8_SA(0, 1), a2 + h2, v2);
            PG8_WAIT_L(8); PG8_BAR; PG8_WAIT_L(0); PG8_MMA(0, 0, At, B0); PG8_BAR; PG8_SCHED;
            PG8_LDB(B1, 1, 1); PG8_STAGE(PG8_SB(1, 0), b3, v2);
            PG8_BAR; PG8_WAIT_L(0); PG8_MMA(0, 1, At, B1); PG8_BAR;
            PG8_LDA(At, 1, 1); PG8_STAGE(PG8_SA(1, 0), a3, v2);
            PG8_BAR; PG8_WAIT_L(0); PG8_MMA(1, 0, At, B0); PG8_BAR; PG8_SCHED;
            PG8_STAGE(PG8_SB(1, 1), b3 + h2, v2);
            PG8_WAIT_V(6); PG8_BAR; PG8_MMA(1, 1, At, B1); PG8_BAR;
        }
        if constexpr (NSEG > 1) { if (seg + 1 < NSEG) E.mid(acc, cur, wr, wc, fr, fq); else E(acc, cur, wr, wc, fr, fq); }
        else E(acc, cur, wr, wc, fr, fq);
        if (!has_next) break;
        if (NSEG == 1 || nseg == 0) {
#pragma unroll
            for (int a = 0; a < 2; ++a)
#pragma unroll
                for (int b = 0; b < 2; ++b)
#pragma unroll
                    for (int m = 0; m < 4; ++m)
#pragma unroll
                        for (int n = 0; n < 2; ++n) acc[a][b][m][n] = (f32x4){0.f, 0.f, 0.f, 0.f};
            ++ti;
        }
        cur = nxt; cA = nA; cB = nB; seg = nseg;
        if (NSEG > 1) { Kc = Kn; voffC[0] = voffN[0]; voffC[1] = voffN[1]; hstepC = hstepN; }
    }
    PG8_WAIT_V(0);
    if (wr == 0) PG8_BAR;
    PG8_BAR;
#undef PG8_SA
#undef PG8_SB
#undef PG8_STAGE
#undef PG8_LDA
#undef PG8_LDB
#undef PG8_MMA
#undef PG8_WAIT_V
#undef PG8_WAIT_L
#undef PG8_BAR
#undef PG8_SCHED
}
}
using pg8::Unit;
typedef f32x4 AccT[2][2][4][2];

DI u32x4 pack8(const f32x4& v0, const f32x4& v1) { u32x4 w; w.x = cvt_pk_bf16(v0[0], v0[1]); w.y = cvt_pk_bf16(v0[2], v0[3]); w.z = cvt_pk_bf16(v1[0], v1[1]); w.w = cvt_pk_bf16(v1[2], v1[3]); return w; }

struct EpiStoreBf16 {
    bf16_t* O; int ld;
    DI void operator()(const AccT& acc, const Unit& u, int wr, int wc, int fr, int fq) const {
        const int row0 = u.pm * 256 + wr * 64 + fr, col0 = u.pn * 256 + wc * 32 + 8 * fq;
#pragma unroll
        for (int ai = 0; ai < 2; ++ai)
#pragma unroll
            for (int m = 0; m < 4; ++m) { bf16_t* rowp = O + (size_t)(row0 + ai * 128 + m * 16) * ld + col0;
#pragma unroll
                for (int bj = 0; bj < 2; ++bj) *(u32x4*)(rowp + bj * 128) = pack8(acc[ai][bj][m][0], acc[ai][bj][m][1]); }
    }
};

template <int HD>
DI void rope_store(const AccT& acc, int rowbase, const int* pos, bf16_t* dst, int ld, int c1, int half, int ibase, float scale) {
    int pi[2][4];
#pragma unroll
    for (int ai = 0; ai < 2; ++ai)
#pragma unroll
        for (int m = 0; m < 4; ++m) pi[ai][m] = pos[rowbase + ai * 128 + m * 16];
    float invf[2][4];
#pragma unroll
    for (int n = 0; n < 2; ++n)
#pragma unroll
        for (int j = 0; j < 4; ++j) invf[n][j] = exp2f(-(float)(ibase + 4 * n + j) * (2.0f / HD) * 13.287712379549449f);
#pragma unroll
    for (int ai = 0; ai < 2; ++ai)
#pragma unroll
        for (int m = 0; m < 4; ++m) {
            const int row = rowbase + ai * 128 + m * 16; const float ps = (float)pi[ai][m];
            f32x4 o1[2], o2[2];
#pragma unroll
            for (int n = 0; n < 2; ++n)
#pragma unroll
                for (int j = 0; j < 4; ++j) {
                    const float ang = ps * invf[n][j]; const float rev = __builtin_amdgcn_fractf(ang * 0.15915494309189535f);
                    const float sn = __builtin_amdgcn_sinf(rev), cs = __builtin_amdgcn_cosf(rev);
                    const float t1 = acc[ai][0][m][n][j], t2 = acc[ai][1][m][n][j];
                    o1[n][j] = (t1 * cs - t2 * sn) * scale; o2[n][j] = (t2 * cs + t1 * sn) * scale;
                }
            bf16_t* rowp = dst + (size_t)row * ld + c1;
            *(u32x4*)rowp = pack8(o1[0], o1[1]); *(u32x4*)(rowp + half) = pack8(o2[0], o2[1]);
        }
}

struct EpiInProj {
    bf16_t *rq, *rk, *rv, *aq, *ak, *av; const int* pos;
    DI void operator()(const AccT& acc, const Unit& u, int wr, int wc, int fr, int fq) const {
        const int pn = u.pn, rowbase = u.pm * 256 + wr * 64 + fr;
        if (pn < 16) {
            bf16_t* dst = pn < 8 ? rq : rk; const float scale = pn < 8 ? 1.0f : 0.0625f;
            rope_store<256>(acc, rowbase, pos, dst, 2048, 256 * (pn & 7) + 32 * wc + 8 * fq, 128, 32 * wc + 8 * fq, scale);
        } else if (pn < 32) {
            const int col0 = (pn - 16) * 256 + wc * 32 + 8 * fq;
#pragma unroll
            for (int ai = 0; ai < 2; ++ai)
#pragma unroll
                for (int m = 0; m < 4; ++m) { bf16_t* rowp = rv + (size_t)(rowbase + ai * 128 + m * 16) * 4096 + col0;
#pragma unroll
                    for (int bj = 0; bj < 2; ++bj) *(u32x4*)(rowp + bj * 128) = pack8(acc[ai][bj][m][0], acc[ai][bj][m][1]); }
        } else if (pn < 66) {
            const int q9 = pn - 48; bf16_t* dst = q9 < 9 ? aq : ak; const int t9 = q9 < 9 ? q9 : q9 - 9;
            const int head = 2 * t9 + (wc >> 1), ib = 32 * (wc & 1) + 8 * fq;
            rope_store<128>(acc, rowbase, pos, dst, 2304, head * 128 + ib, 64, ib, 1.0f);
        } else {
            const int col0 = (pn - 66) * 256 + wc * 32 + 8 * fq;
#pragma unroll
            for (int ai = 0; ai < 2; ++ai)
#pragma unroll
                for (int m = 0; m < 4; ++m) { bf16_t* rowp = av + (size_t)(rowbase + ai * 128 + m * 16) * 2304 + col0;
#pragma unroll
                    for (int bj = 0; bj < 2; ++bj) *(u32x4*)(rowp + bj * 128) = pack8(acc[ai][bj][m][0], acc[ai][bj][m][1]); }
        }
    }
};

struct EpiRetGate {
    bf16_t* ret; const float* retss; const float* gain;
    DI void operator()(const AccT& acc, const Unit& u, int wr, int wc, int fr, int fq) const {
        const int rowbase = u.pm * 256 + wr * 64 + fr, head = u.pn >> 1, colb = u.pn * 256 + wc * 32 + 8 * fq;
        f32x4 gn[2][2];
#pragma unroll
        for (int bj = 0; bj < 2; ++bj) { gn[bj][0] = *(const f32x4*)(gain + colb + bj * 128); gn[bj][1] = *(const f32x4*)(gain + colb + bj * 128 + 4); }
#pragma unroll
        for (int ai = 0; ai < 2; ++ai) {
            f32x4 sA[4], sB[4]; u32x4 rr[4][2];
#pragma unroll
            for (int m = 0; m < 4; ++m) { const float* ps = retss + ((size_t)(rowbase + ai * 128 + m * 16) * 8 + head) * 8; sA[m] = *(const f32x4*)ps; sB[m] = *(const f32x4*)(ps + 4); }
#pragma unroll
            for (int m = 0; m < 4; ++m)
#pragma unroll
                for (int bj = 0; bj < 2; ++bj) rr[m][bj] = *(const u32x4*)(ret + (size_t)(rowbase + ai * 128 + m * 16) * 4096 + colb + bj * 128);
#pragma unroll
            for (int m = 0; m < 4; ++m) {
                const f32x4 s0 = sA[m], s1 = sB[m];
                const float rsv = __builtin_amdgcn_rsqf((((s0[0] + s0[1]) + (s0[2] + s0[3])) + ((s1[0] + s1[1]) + (s1[2] + s1[3]))) * (1.0f / 512.0f) + 1e-6f);
#pragma unroll
                for (int bj = 0; bj < 2; ++bj) {
                    const u32x4 r4 = rr[m][bj];
                    const float rf[8] = {bflo(r4.x), bfhi(r4.x), bflo(r4.y), bfhi(r4.y), bflo(r4.z), bfhi(r4.z), bflo(r4.w), bfhi(r4.w)};
                    f32x4 o0, o1;
#pragma unroll
                    for (int j = 0; j < 4; ++j) {
                        const float a0 = acc[ai][bj][m][0][j], a1 = acc[ai][bj][m][1][j];
                        o0[j] = a0 * sigmoidf_(a0) * (rf[j] * rsv * gn[bj][0][j]); o1[j] = a1 * sigmoidf_(a1) * (rf[4 + j] * rsv * gn[bj][1][j]);
                    }
                    *(u32x4*)(ret + (size_t)(rowbase + ai * 128 + m * 16) * 4096 + colb + bj * 128) = pack8(o0, o1);
                }
            }
        }
    }
};

struct EpiGates {
    bf16_t* O; const float* bias;
    DI void operator()(const AccT& acc, const Unit& u, int wr, int wc, int fr, int fq) const {
        const int rowbase = u.pm * 256 + wr * 64 + fr;
#pragma unroll
        for (int bj = 0; bj < 2; ++bj) {
            const int col = u.pn * 256 + bj * 128 + wc * 32 + 8 * fq;
            const f32x4 b0 = *(const f32x4*)(bias + col), b1 = *(const f32x4*)(bias + col + 4);
#pragma unroll
            for (int ai = 0; ai < 2; ++ai)
#pragma unroll
                for (int m = 0; m < 4; ++m) {
                    f32x4 o0, o1;
#pragma unroll
                    for (int j = 0; j < 4; ++j) { o0[j] = sigmoidf_(acc[ai][bj][m][0][j] + b0[j]); o1[j] = sigmoidf_(acc[ai][bj][m][1][j] + b1[j]); }
                    *(u32x4*)(O + (size_t)(rowbase + ai * 128 + m * 16) * 4096 + col) = pack8(o0, o1);
                }
        }
    }
};

struct EpiYMerge {
    const bf16_t* gates; bf16_t* U2;
    DI void mid(AccT& acc, const Unit& u, int wr, int wc, int fr, int fq) const {
        const int rowbase = u.pm * 256 + wr * 64 + fr, colb = u.pn * 256 + wc * 32 + 8 * fq;
#pragma unroll
        for (int ai = 0; ai < 2; ++ai) {
            u32x4 gr[4][2], ga[4][2];
#pragma unroll
            for (int m = 0; m < 4; ++m)
#pragma unroll
                for (int bj = 0; bj < 2; ++bj) { const bf16_t* pg = gates + (size_t)(rowbase + ai * 128 + m * 16) * 4096 + colb + bj * 128; gr[m][bj] = *(const u32x4*)pg; ga[m][bj] = *(const u32x4*)(pg + 2048); }
#pragma unroll
            for (int m = 0; m < 4; ++m)
#pragma unroll
                for (int bj = 0; bj < 2; ++bj) {
                    const u32x4 g1 = gr[m][bj], g2 = ga[m][bj];
                    const float r[8] = {bflo(g1.x), bfhi(g1.x), bflo(g1.y), bfhi(g1.y), bflo(g1.z), bfhi(g1.z), bflo(g1.w), bfhi(g1.w)};
                    const float a[8] = {bflo(g2.x), bfhi(g2.x), bflo(g2.y), bfhi(g2.y), bflo(g2.z), bfhi(g2.z), bflo(g2.w), bfhi(g2.w)};
#pragma unroll
                    for (int j = 0; j < 4; ++j) { acc[ai][bj][m][0][j] *= r[j] * __builtin_amdgcn_rcpf(fmaxf(a[j], 1e-30f)); acc[ai][bj][m][1][j] *= r[4 + j] * __builtin_amdgcn_rcpf(fmaxf(a[4 + j], 1e-30f)); }
                }
        }
    }
    DI void operator()(const AccT& acc, const Unit& u, int wr, int wc, int fr, int fq) const {
        const int rowbase = u.pm * 256 + wr * 64 + fr, colb = u.pn * 256 + wc * 32 + 8 * fq;
        u32x4 gg[2][4][2];
#pragma unroll
        for (int ai = 0; ai < 2; ++ai)
#pragma unroll
            for (int m = 0; m < 4; ++m)
#pragma unroll
                for (int bj = 0; bj < 2; ++bj) gg[ai][m][bj] = *(const u32x4*)(gates + (size_t)(rowbase + ai * 128 + m * 16) * 4096 + 2048 + colb + bj * 128);
#pragma unroll
        for (int ai = 0; ai < 2; ++ai)
#pragma unroll
            for (int m = 0; m < 4; ++m)
#pragma unroll
                for (int bj = 0; bj < 2; ++bj) {
                    const u32x4 g4 = gg[ai][m][bj];
                    f32x4 o0 = acc[ai][bj][m][0], o1 = acc[ai][bj][m][1];
                    o0[0] *= bflo(g4.x); o0[1] *= bfhi(g4.x); o0[2] *= bflo(g4.y); o0[3] *= bfhi(g4.y);
                    o1[0] *= bflo(g4.z); o1[1] *= bfhi(g4.z); o1[2] *= bflo(g4.w); o1[3] *= bfhi(g4.w);
                    *(u32x4*)(U2 + (size_t)(rowbase + ai * 128 + m * 16) * 2048 + colb + bj * 128) = pack8(o0, o1);
                }
    }
};

DI float gelu_tanh(float v) {
    const float uu = 0.7978845608028654f * (v + 0.044715f * v * v * v);
    const float e = __builtin_amdgcn_exp2f(2.8853900817779268f * uu);
    return v - v * __builtin_amdgcn_rcpf(e + 1.0f);
}
struct EpiConvAct {
    const bf16_t* A; bf16_t* ACT; const float* conv_w; const float* conv_b;
    DI void operator()(const AccT& acc, const Unit& u, int wr, int wc, int fr, int fq) const {
        const int rowbase = u.pm * 256 + wr * 64 + fr;
#pragma unroll
        for (int bj = 0; bj < 2; ++bj) {
            const int col = u.pn * 256 + bj * 128 + wc * 32 + 8 * fq;
            f32x4 w0[2], w1[2], w2[2], cb[2];
#pragma unroll
            for (int hh = 0; hh < 2; ++hh) { w0[hh] = *(const f32x4*)(conv_w + col + 4 * hh); w1[hh] = *(const f32x4*)(conv_w + FF + col + 4 * hh); w2[hh] = *(const f32x4*)(conv_w + 2 * FF + col + 4 * hh); cb[hh] = *(const f32x4*)(conv_b + col + 4 * hh); }
#pragma unroll
            for (int aim = 0; aim < 4; ++aim) { const int ai = aim >> 1, mb = (aim & 1) * 2;
                u32x4 a0[4], a1[4], a2[4];
#pragma unroll
                for (int m = mb; m < mb + 2; ++m) {
                    const int row = rowbase + ai * 128 + m * 16; const int sq = row & (SEQ - 1);
                    const bf16_t* pa = A + (size_t)row * FF + col;
                    a0[m] = *(const u32x4*)pa;
                    a1[m] = *(const u32x4*)(pa - (sq >= 1 ? FF : 0));
                    a2[m] = *(const u32x4*)(pa - (sq >= 2 ? 2 * FF : 0));
                }
#pragma unroll
                for (int m = mb; m < mb + 2; ++m) {
                    const int row = rowbase + ai * 128 + m * 16; const int sq = row & (SEQ - 1);
                    const float k1 = sq >= 1 ? 1.0f : 0.0f, k2 = sq >= 2 ? 1.0f : 0.0f;
                    const u32x4 x0 = a0[m], x1 = a1[m], x2 = a2[m];
                    const float f0[8] = {bflo(x0.x), bfhi(x0.x), bflo(x0.y), bfhi(x0.y), bflo(x0.z), bfhi(x0.z), bflo(x0.w), bfhi(x0.w)};
                    const float f1[8] = {bflo(x1.x), bfhi(x1.x), bflo(x1.y), bfhi(x1.y), bflo(x1.z), bfhi(x1.z), bflo(x1.w), bfhi(x1.w)};
                    const float f2[8] = {bflo(x2.x), bfhi(x2.x), bflo(x2.y), bfhi(x2.y), bflo(x2.z), bfhi(x2.z), bflo(x2.w), bfhi(x2.w)};
                    f32x4 o0, o1;
#pragma unroll
                    for (int j = 0; j < 4; ++j) {
                        const float c0 = cb[0][j] + w0[0][j] * f0[j] + k1 * (w1[0][j] * f1[j]) + k2 * (w2[0][j] * f2[j]);
                        const float c1 = cb[1][j] + w0[1][j] * f0[4 + j] + k1 * (w1[1][j] * f1[4 + j]) + k2 * (w2[1][j] * f2[4 + j]);
                        o0[j] = gelu_tanh(c0) * acc[ai][bj][m][0][j]; o1[j] = gelu_tanh(c1) * acc[ai][bj][m][1][j];
                    }
                    *(u32x4*)(ACT + (size_t)row * FF + col) = pack8(o0, o1);
                }
            }
        }
    }
};

DI int invperm32(int c) { return 16 * ((c >> 2) & 1) + 4 * (c >> 3) + (c & 3); }
DI int slot_std(int c) { return (c & ~31) | invperm32(c & 31); }
DI int slot_win(int c) {
    if (c >= 12288 && c < 16896) { const int tc = c & 255, hh = tc >> 7, bj = (tc >> 6) & 1, i64 = tc & 63, x = 64 * hh + i64; return (c & ~255) + 128 * bj + (x & ~31) + invperm32(x & 31); }
    return slot_std(c);
}
DI void transpose_item(const float* W, int K, int N, bf16_t* WT, int mode, LAS float* scr, int item, int lane) {
    const int nblk = N / 32, kb = item / nblk, nb = item % nblk, k0 = 64 * kb, n0 = 32 * nb;
#pragma unroll 8
    for (int i = 0; i < 32; ++i) { const int kk = 2 * i + (lane >> 5); scr[kk * 33 + (lane & 31)] = W[(size_t)(k0 + kk) * N + n0 + (lane & 31)]; }
    asm volatile("s_waitcnt lgkmcnt(0)" ::: "memory");
    const int c = lane & 7;
#pragma unroll
    for (int j = 0; j < 4; ++j) { const int n = (lane >> 3) + 8 * j; const LAS float* s = scr + (8 * c) * 33 + n;
        u32x4 o; o.x = cvt_pk_bf16(s[0 * 33], s[1 * 33]); o.y = cvt_pk_bf16(s[2 * 33], s[3 * 33]); o.z = cvt_pk_bf16(s[4 * 33], s[5 * 33]); o.w = cvt_pk_bf16(s[6 * 33], s[7 * 33]);
        const int drow = mode ? slot_win(n0 + n) : slot_std(n0 + n);
        *(u32x4*)(WT + (size_t)drow * K + k0 + 8 * c) = o; }
    asm volatile("s_waitcnt lgkmcnt(0)" ::: "memory");
}

DI void phase0(const Params& p, LAS unsigned char* lds) {
    const int tid = threadIdx.x, lane = tid & 63, wave = tid >> 6;
    LAS float* sc = (LAS float*)lds;
    LAS float* red = sc + 8192;
    float* ada = (float*)(p.ws + WS_ADA);
    for (int i = tid; i < 8192; i += 512) { const float v = p.c[i]; sc[i] = v / (1.0f + __expf(-v)); }
    __syncthreads();
    for (int cb = blockIdx.x; cb < 256; cb += gridDim.x) {
        if (lane < 48) {
            float a0 = 0.f, a1 = 0.f, a2 = 0.f, a3 = 0.f;
            const float* wp = p.w_ada + (size_t)(256 * wave) * 12288 + 48 * cb + lane;
#pragma unroll 8
            for (int k = 0; k < 256; ++k) { const float wv = wp[(size_t)k * 12288]; const int kk = 256 * wave + k;
                a0 += sc[kk] * wv; a1 += sc[2048 + kk] * wv; a2 += sc[4096 + kk] * wv; a3 += sc[6144 + kk] * wv; }
            red[(wave * 4 + 0) * 48 + lane] = a0; red[(wave * 4 + 1) * 48 + lane] = a1; red[(wave * 4 + 2) * 48 + lane] = a2; red[(wave * 4 + 3) * 48 + lane] = a3;
        }
        __syncthreads();
        if (tid < 192) { const int b = tid / 48, l = tid % 48; float s = 0.f;
#pragma unroll
            for (int w = 0; w < 8; ++w) s += red[(w * 4 + b) * 48 + l];
            ada[b * 12288 + 48 * cb + l] = s + p.b_ada[48 * cb + l]; }
        __syncthreads();
    }
    LAS float* scr = (LAS float*)(lds + 40960 + wave * 8448);
    const int gw = blockIdx.x * 8 + wave, NGW = gridDim.x * 8;
    constexpr int I_IN = (2048 / 64) * (19200 / 32), I_GATE = (2048 / 64) * (4096 / 32), I_RET = (4096 / 64) * (2048 / 32), I_ATT = (2304 / 64) * (2048 / 32),
                  I_MIX = (2048 / 64) * (2048 / 32), I_UP = (2048 / 64) * (11264 / 32), I_DOWN = (5632 / 64) * (2048 / 32);
    constexpr int NITEMS = I_IN + I_GATE + I_RET + I_ATT + I_MIX + I_UP + I_DOWN;
    for (int it = gw; it < NITEMS; it += NGW) {
        int r = it;
        if (r < I_IN) { transpose_item(p.w_in, 2048, 19200, (bf16_t*)(p.ws + WS_WIN), 1, scr, r, lane); continue; } r -= I_IN;
        if (r < I_GATE) { transpose_item(p.w_gate, 2048, 4096, (bf16_t*)(p.ws + WS_WGATE), 0, scr, r, lane); continue; } r -= I_GATE;
        if (r < I_RET) { transpose_item(p.w_ret_out, 4096, 2048, (bf16_t*)(p.ws + WS_WRET), 0, scr, r, lane); continue; } r -= I_RET;
        if (r < I_ATT) { transpose_item(p.w_att_out, 2304, 2048, (bf16_t*)(p.ws + WS_WATT), 0, scr, r, lane); continue; } r -= I_ATT;
        if (r < I_MIX) { transpose_item(p.w_mix, 2048, 2048, (bf16_t*)(p.ws + WS_WMIX), 0, scr, r, lane); continue; } r -= I_MIX;
        if (r < I_UP) { transpose_item(p.w_up, 2048, 11264, (bf16_t*)(p.ws + WS_WUP), 0, scr, r, lane); continue; } r -= I_UP;
        transpose_item(p.w_down, 5632, 2048, (bf16_t*)(p.ws + WS_WDOWN), 0, scr, r, lane);
    }
}

DI void phase_h(const Params& p) {
    const int lane = threadIdx.x & 63, wave = threadIdx.x >> 6;
    const float* ada = (const float*)(p.ws + WS_ADA); bf16_t* H = (bf16_t*)(p.ws + WS_H);
    for (int row = blockIdx.x * 8 + wave; row < T_TOK; row += gridDim.x * 8) {
        const float* xr = p.x + (size_t)row * DM; const int b = row / SEQ;
        f32x4 v[4][2]; float ss = 0.f;
#pragma unroll
        for (int it = 0; it < 4; ++it) { const int col = (it * 64 + lane) * 8; v[it][0] = *(const f32x4*)(xr + col); v[it][1] = *(const f32x4*)(xr + col + 4);
#pragma unroll
            for (int j = 0; j < 4; ++j) ss += v[it][0][j] * v[it][0][j] + v[it][1][j] * v[it][1][j]; }
        const float r = 1.0f / sqrtf(wave_sum(ss) * (1.0f / DM) + 1e-6f);
#pragma unroll
        for (int it = 0; it < 4; ++it) { const int col = (it * 64 + lane) * 8;
            f32x4 o[2];
#pragma unroll
            for (int hh = 0; hh < 2; ++hh) { const f32x4 g = *(const f32x4*)(p.g_pre_mix + col + 4 * hh), sh = *(const f32x4*)(ada + b * 12288 + col + 4 * hh), scl = *(const f32x4*)(ada + b * 12288 + 2048 + col + 4 * hh);
#pragma unroll
                for (int j = 0; j < 4; ++j) o[hh][j] = v[it][hh][j] * r * g[j] * (1.0f + scl[j]) + sh[j]; }
            *(u32x4*)(H + (size_t)row * DM + col) = pack8(o[0], o[1]); }
    }
}

DI void phase_postmix(const Params& p) {
    const int lane = threadIdx.x & 63, wave = threadIdx.x >> 6;
    const float* ada = (const float*)(p.ws + WS_ADA); const bf16_t* Y = (const bf16_t*)(p.ws + WS_Y); bf16_t* H2 = (bf16_t*)(p.ws + WS_H2);
    for (int row = blockIdx.x * 8 + wave; row < T_TOK; row += gridDim.x * 8) {
        const int b = row / SEQ; const float* ab = ada + b * 12288;
        f32x4 y[4][2]; float ss = 0.f;
#pragma unroll
        for (int it = 0; it < 4; ++it) { const int col = (it * 64 + lane) * 8; const u32x4 w = *(const u32x4*)(Y + (size_t)row * DM + col);
            y[it][0] = (f32x4){bflo(w.x), bfhi(w.x), bflo(w.y), bfhi(w.y)}; y[it][1] = (f32x4){bflo(w.z), bfhi(w.z), bflo(w.w), bfhi(w.w)};
#pragma unroll
            for (int j = 0; j < 4; ++j) ss += y[it][0][j] * y[it][0][j] + y[it][1][j] * y[it][1][j]; }
        const float ry = 1.0f / sqrtf(wave_sum(ss) * (1.0f / DM) + 1e-6f);
        float s1 = 0.f;
#pragma unroll
        for (int it = 0; it < 4; ++it) { const int col = (it * 64 + lane) * 8;
#pragma unroll
            for (int hh = 0; hh < 2; ++hh) { const f32x4 xv = *(const f32x4*)(p.x + (size_t)row * DM + col + 4 * hh), g = *(const f32x4*)(p.g_post_mix + col + 4 * hh), gt = *(const f32x4*)(ab + 4096 + col + 4 * hh);
                f32x4 o;
#pragma unroll
                for (int j = 0; j < 4; ++j) { o[j] = xv[j] + gt[j] * (y[it][hh][j] * ry * g[j]); s1 += o[j] * o[j]; }
                y[it][hh] = o; *(f32x4*)(p.out + (size_t)row * DM + col + 4 * hh) = o; } }
        const float r1 = 1.0f / sqrtf(wave_sum(s1) * (1.0f / DM) + 1e-6f);
#pragma unroll
        for (int it = 0; it < 4; ++it) { const int col = (it * 64 + lane) * 8; f32x4 o[2];
#pragma unroll
            for (int hh = 0; hh < 2; ++hh) { const f32x4 g = *(const f32x4*)(p.g_pre_ffn + col + 4 * hh), sh = *(const f32x4*)(ab + 6144 + col + 4 * hh), scl = *(const f32x4*)(ab + 8192 + col + 4 * hh);
#pragma unroll
                for (int j = 0; j < 4; ++j) o[hh][j] = y[it][hh][j] * r1 * g[j] * (1.0f + scl[j]) + sh[j]; }
            *(u32x4*)(H2 + (size_t)row * DM + col) = pack8(o[0], o[1]); }
    }
}

DI void phase_final(const Params& p) {
    const int lane = threadIdx.x & 63, wave = threadIdx.x >> 6;
    const float* ada = (const float*)(p.ws + WS_ADA); const bf16_t* Y = (const bf16_t*)(p.ws + WS_Y2);
    for (int row = blockIdx.x * 8 + wave; row < T_TOK; row += gridDim.x * 8) {
        const int b = row / SEQ; const float* ab = ada + b * 12288;
        f32x4 y[4][2]; float ss = 0.f;
#pragma unroll
        for (int it = 0; it < 4; ++it) { const int col = (it * 64 + lane) * 8; const u32x4 w = *(const u32x4*)(Y + (size_t)row * DM + col);
            y[it][0] = (f32x4){bflo(w.x), bfhi(w.x), bflo(w.y), bfhi(w.y)}; y[it][1] = (f32x4){bflo(w.z), bfhi(w.z), bflo(w.w), bfhi(w.w)};
#pragma unroll
            for (int j = 0; j < 4; ++j) ss += y[it][0][j] * y[it][0][j] + y[it][1][j] * y[it][1][j]; }
        const float ry = 1.0f / sqrtf(wave_sum(ss) * (1.0f / DM) + 1e-6f);
#pragma unroll
        for (int it = 0; it < 4; ++it) { const int col = (it * 64 + lane) * 8;
#pragma unroll
            for (int hh = 0; hh < 2; ++hh) { float* po = p.out + (size_t)row * DM + col + 4 * hh; const f32x4 xv = *(const f32x4*)po, g = *(const f32x4*)(p.g_post_ffn + col + 4 * hh), gt = *(const f32x4*)(ab + 10240 + col + 4 * hh);
                f32x4 o;
#pragma unroll
                for (int j = 0; j < 4; ++j) o[j] = xv[j] + gt[j] * (y[it][hh][j] * ry * g[j]);
                *(f32x4*)po = o; } }
    }
}

DI void phase_alpha(const Params& p) {
    bf16_t* att = (bf16_t*)(p.ws + WS_AQ); const float* lse = (const float*)(p.ws + WS_LSE);
    const int lane = threadIdx.x & 63, wave = threadIdx.x >> 6;
    for (int t = blockIdx.x * 8 + wave; t < T_TOK; t += gridDim.x * 8) {
        const float l = lse[(size_t)t * 18 + (lane < 18 ? lane : 0)];
        const int j = lane % 6;
        const float l0 = __shfl(l, j), l1 = __shfl(l, 6 + j), l2 = __shfl(l, 12 + j);
        const float mm = fmaxf(l0, fmaxf(l1, l2)); const float e0 = __expf(l0 - mm), e1 = __expf(l1 - mm), e2 = __expf(l2 - mm);
        const float al_lane = __expf(l - mm) / (e0 + e1 + e2);
        u32x4* row = (u32x4*)(att + (size_t)t * 2304);
        u32x4 w[5];
#pragma unroll
        for (int k = 0; k < 5; ++k) { const int ch = lane + 64 * k; if (ch < 288) w[k] = row[ch]; }
#pragma unroll
        for (int k = 0; k < 5; ++k) { const int ch = lane + 64 * k; const float al = __shfl(al_lane, (ch < 288 ? ch : 0) >> 4);
            if (ch < 288) { u32x4 o;
                o.x = cvt_pk_bf16(bflo(w[k].x) * al, bfhi(w[k].x) * al); o.y = cvt_pk_bf16(bflo(w[k].y) * al, bfhi(w[k].y) * al);
                o.z = cvt_pk_bf16(bflo(w[k].z) * al, bfhi(w[k].z) * al); o.w = cvt_pk_bf16(bflo(w[k].w) * al, bfhi(w[k].w) * al);
                row[ch] = o; } }
    }
}

DI void phase_retention(const Params& p, LAS unsigned char* lds, int cblk) {
    const int tid = threadIdx.x, lane = tid & 63, w = tid >> 6, fr = lane & 15, fq = lane >> 4;
    LAS unsigned char* Qs = lds; LAS unsigned char* Ks = lds + 33792; LAS unsigned char* Vs = lds + 67584; LAS unsigned char* St = lds + 76800; LAS unsigned char* Ps = lds + 110592;
    LAS float* red = (LAS float*)(lds + 119808);
    const bf16_t* rq = (const bf16_t*)(p.ws + WS_RQ); const bf16_t* rk = (const bf16_t*)(p.ws + WS_RK); bf16_t* rv = (bf16_t*)p.out; float* retss = (float*)(p.ws + WS_RETSS);
    for (int item = cblk; item < 256; item += gridDim.x) {
        const int q5 = item >> 3, bh = (item & 7) * 4 + (q5 & 3), slice = q5 >> 2, b = bh >> 3, h = bh & 7;
        const float lg = log1pf(-exp2f(-5.0f - (float)h));
        const float gamma_c = expf(64.0f * lg);
        const float xv = expf(-lg * (float)((tid >> 3) + 1));
        const float xo0 = expf(lg * (float)(32 * (w & 1) + fr + 1)), xo1 = expf(lg * (float)(32 * (w & 1) + 16 + fr + 1));
        const size_t tok0 = (size_t)b * SEQ;
        const bf16_t* qbase = rq + tok0 * 2048 + h * 256 + (tid & 31) * 8; const bf16_t* kbase = rk + tok0 * 2048 + h * 256 + (tid & 31) * 8;
        bf16_t* vbase = rv + tok0 * 4096 + h * 512 + slice * 64;
        u32x4 pq[4], pk[4], pv;
        f32x4 Sreg[2][4];
#pragma unroll
        for (int a = 0; a < 2; ++a)
#pragma unroll
            for (int bb = 0; bb < 4; ++bb) Sreg[a][bb] = (f32x4){0.f, 0.f, 0.f, 0.f};
        for (int i = tid; i < 33792 / 16; i += 512) ((LAS u32x4*)St)[i] = (u32x4){0u, 0u, 0u, 0u};
#define RET_LOAD(c) do { _Pragma("unroll") for (int i = 0; i < 4; ++i) { const int row = (tid + 512 * i) >> 5; \
            pq[i] = *(const u32x4*)(qbase + (size_t)(64 * (c) + row) * 2048); pk[i] = *(const u32x4*)(kbase + (size_t)(64 * (c) + row) * 2048); } \
            pv = *(const u32x4*)(vbase + (size_t)(64 * (c) + (tid >> 3)) * 4096 + (tid & 7) * 8); } while (0)
#define RET_STORE() do { _Pragma("unroll") for (int i = 0; i < 4; ++i) { const int e = tid + 512 * i, row = e >> 5, pc = e & 31; \
            *(LAS u32x4*)(Qs + row * 528 + pc * 16) = pq[i]; *(LAS u32x4*)(Ks + row * 528 + pc * 16) = pk[i]; } \
            { u32x4 o; o.x = cvt_pk_bf16(bflo(pv.x) * xv, bfhi(pv.x) * xv); o.y = cvt_pk_bf16(bflo(pv.y) * xv, bfhi(pv.y) * xv); \
              o.z = cvt_pk_bf16(bflo(pv.z) * xv, bfhi(pv.z) * xv); o.w = cvt_pk_bf16(bflo(pv.w) * xv, bfhi(pv.w) * xv); \
              *(LAS u32x4*)(Vs + (tid >> 3) * 144 + (tid & 7) * 16) = o; } } while (0)
        RET_LOAD(0); RET_STORE();
        __syncthreads();
        for (int c = 0; c < 128; ++c) {
            if (c + 1 < 128) RET_LOAD(c + 1);
            {
                const int jt = w >> 1, it0 = (w & 1) * 2;
                f32x4 sa[2] = {(f32x4){0.f, 0.f, 0.f, 0.f}, (f32x4){0.f, 0.f, 0.f, 0.f}};
#pragma unroll
                for (int ks = 0; ks < 8; ++ks) {
                    const bf16x8 kf = *(const LAS bf16x8*)(Ks + (16 * jt + fr) * 528 + (32 * ks + 8 * fq) * 2);
#pragma unroll
                    for (int t = 0; t < 2; ++t) { const bf16x8 qf = *(const LAS bf16x8*)(Qs + (16 * (it0 + t) + fr) * 528 + (32 * ks + 8 * fq) * 2); sa[t] = mfma16(kf, qf, sa[t]); }
                }
#pragma unroll
                for (int t = 0; t < 2; ++t) { const int iq = 16 * (it0 + t) + fr, jk0 = 16 * jt + 4 * fq;
                    u32x2 o; o.x = cvt_pk_bf16(jk0 + 0 <= iq ? sa[t][0] : 0.f, jk0 + 1 <= iq ? sa[t][1] : 0.f); o.y = cvt_pk_bf16(jk0 + 2 <= iq ? sa[t][2] : 0.f, jk0 + 3 <= iq ? sa[t][3] : 0.f);
                    *(LAS u32x2*)(Ps + iq * 144 + jk0 * 2) = o; }
            }
            {
#pragma unroll
                for (int ks = 0; ks < 2; ++ks) {
                    const int j0 = 32 * ks + 8 * fq + (fr >> 2);
                    bf16x8 kt[2], vf[4];
#pragma unroll
                    for (int dd = 0; dd < 2; ++dd) { LAS unsigned char* a0 = Ks + j0 * 528 + (16 * (2 * w + dd) + 4 * (fr & 3)) * 2; kt[dd] = tr_read2(a0, a0 + 4 * 528); }
#pragma unroll
                    for (int vt = 0; vt < 4; ++vt) { LAS unsigned char* a0 = Vs + j0 * 144 + (16 * vt + 4 * (fr & 3)) * 2; vf[vt] = tr_read2(a0, a0 + 4 * 144); }
#pragma unroll
                    for (int dd = 0; dd < 2; ++dd)
#pragma unroll
                        for (int vt = 0; vt < 4; ++vt) Sreg[dd][vt] = mfma16(kt[dd], vf[vt], Sreg[dd][vt]);
                }
#pragma unroll
                for (int dd = 0; dd < 2; ++dd)
#pragma unroll
                    for (int vt = 0; vt < 4; ++vt) Sreg[dd][vt] *= gamma_c;
            }
            __syncthreads();
            {
                const int vt = w >> 1, it0 = (w & 1) * 2;
                f32x4 oa[2] = {(f32x4){0.f, 0.f, 0.f, 0.f}, (f32x4){0.f, 0.f, 0.f, 0.f}};
#pragma unroll
                for (int ks = 0; ks < 8; ++ks) {
                    const bf16x8 sf = *(const LAS bf16x8*)(St + (16 * vt + fr) * 528 + (32 * ks + 8 * fq) * 2);
#pragma unroll
                    for (int t = 0; t < 2; ++t) { const bf16x8 qf = *(const LAS bf16x8*)(Qs + (16 * (it0 + t) + fr) * 528 + (32 * ks + 8 * fq) * 2); oa[t] = mfma16(sf, qf, oa[t]); }
                }
#pragma unroll
                for (int ks = 0; ks < 2; ++ks) {
                    const int j0 = 32 * ks + 8 * fq + (fr >> 2);
                    LAS unsigned char* a0 = Vs + j0 * 144 + (16 * vt + 4 * (fr & 3)) * 2; const bf16x8 vf = tr_read2(a0, a0 + 4 * 144);
#pragma unroll
                    for (int t = 0; t < 2; ++t) { const bf16x8 pf = *(const LAS bf16x8*)(Ps + (16 * (it0 + t) + fr) * 144 + (32 * ks + 8 * fq) * 2); oa[t] = mfma16(vf, pf, oa[t]); }
                }
#pragma unroll
                for (int t = 0; t < 2; ++t) { const int iq = 16 * (it0 + t) + fr; oa[t] *= (t == 0 ? xo0 : xo1);
                    u32x2 o; o.x = cvt_pk_bf16(oa[t][0], oa[t][1]); o.y = cvt_pk_bf16(oa[t][2], oa[t][3]);
                    *(u32x2*)(vbase + (size_t)(64 * c + iq) * 4096 + 16 * vt + 4 * fq) = o;
                    float ss = (oa[t][0] * oa[t][0] + oa[t][1] * oa[t][1]) + (oa[t][2] * oa[t][2] + oa[t][3] * oa[t][3]);
                    ss += __shfl_xor(ss, 16); ss += __shfl_xor(ss, 32);
                    if (fq == 0) red[iq * 4 + vt] = ss; }
            }
            __syncthreads();
#pragma unroll
            for (int dd = 0; dd < 2; ++dd)
#pragma unroll
                for (int vt = 0; vt < 4; ++vt) { u32x2 o; o.x = cvt_pk_bf16(Sreg[dd][vt][0], Sreg[dd][vt][1]); o.y = cvt_pk_bf16(Sreg[dd][vt][2], Sreg[dd][vt][3]);
                    *(LAS u32x2*)(St + (16 * vt + fr) * 528 + (16 * (2 * w + dd) + 4 * fq) * 2) = o; }
            if (c + 1 < 128) RET_STORE();
            if (tid < 64) retss[((tok0 + 64 * c + tid) * 8 + h) * 8 + slice] = (red[tid * 4 + 0] + red[tid * 4 + 1]) + (red[tid * 4 + 2] + red[tid * 4 + 3]);
            __syncthreads();
        }
#undef RET_LOAD
#undef RET_STORE
    }
}

DI void phase_attention(const Params& p, LAS unsigned char* lds) {
    const int tid = threadIdx.x, lane = tid & 63, w = tid >> 6, fr = lane & 15, fq = lane >> 4;
    LAS unsigned char* Ks = lds; LAS unsigned char* Vs = lds + 69632;
    bf16_t* aq = (bf16_t*)(p.ws + WS_AQ); const bf16_t* ak = (const bf16_t*)(p.ws + WS_AK); const bf16_t* av = (const bf16_t*)(p.ws + WS_AV); float* lse = (float*)(p.ws + WS_LSE);
    for (int item = blockIdx.x; item < 4608; item += gridDim.x) {
        int rest = item; const int cbk = rest & 63; rest >>= 6; const int head = rest % 18, b = rest / 18;
        const int g = head / 6, rsh = 2 * g, r = 1 << rsh, cls = cbk & (r - 1), nb = cbk >> rsh;
        const int pq0 = nb * 128, pk0 = pq0 - 128;
        const size_t tokb = (size_t)b * SEQ;
#pragma unroll
        for (int i = 0; i < 8; ++i) { const int e = tid + 512 * i, row = e >> 4, pc = e & 15; const int pk = pk0 + row; const bool valid = pk >= 0;
            const size_t off = (tokb + (size_t)(valid ? pk : 0) * r + cls) * 2304 + head * 128 + pc * 8;
            u32x4 kv = *(const u32x4*)(ak + off), vv = *(const u32x4*)(av + off);
            if (!valid) { kv = (u32x4){0u, 0u, 0u, 0u}; vv = kv; }
            *(LAS u32x4*)(Ks + row * 272 + pc * 16) = kv; *(LAS u32x4*)(Vs + row * 272 + pc * 16) = vv; }
        const int qq = 16 * w + fr;
        const size_t tokq = tokb + (size_t)(pq0 + qq) * r + cls;
        bf16x8 qf[4];
        { const bf16_t* qp = aq + tokq * 2304 + head * 128 + 8 * fq;
#pragma unroll
          for (int ks = 0; ks < 4; ++ks) qf[ks] = *(const bf16x8*)(qp + 32 * ks); }
        __syncthreads();
        f32x4 sa[10];
#pragma unroll
        for (int kt = 0; kt < 10; ++kt) { sa[kt] = (f32x4){0.f, 0.f, 0.f, 0.f};
            const int krow = (w + kt < 16 ? 16 * (w + kt) : 240) + fr;
#pragma unroll
            for (int ks = 0; ks < 4; ++ks) { const bf16x8 kf = *(const LAS bf16x8*)(Ks + krow * 272 + (32 * ks + 8 * fq) * 2); sa[kt] = mfma16(kf, qf[ks], sa[kt]); } }
        const float sc2 = 0.08838834764831845f * 1.4426950408889634f;
        float mrow = -INFINITY;
#pragma unroll
        for (int kt = 0; kt < 10; ++kt)
#pragma unroll
            for (int j = 0; j < 4; ++j) { const int kk = 16 * (w + kt) + 4 * fq + j; const bool valid = (kk >= qq) && (kk <= qq + 128) && (pk0 + kk >= 0);
                const float sv = valid ? sa[kt][j] * sc2 : -INFINITY; sa[kt][j] = sv; mrow = fmaxf(mrow, sv); }
        mrow = fmaxf(mrow, __shfl_xor(mrow, 16)); mrow = fmaxf(mrow, __shfl_xor(mrow, 32));
        float lsum = 0.f;
        bf16x8 pf[5];
#pragma unroll
        for (int t = 0; t < 5; ++t) { f32x4 p0, p1;
#pragma unroll
            for (int j = 0; j < 4; ++j) { p0[j] = __builtin_amdgcn_exp2f(sa[2 * t][j] - mrow); p1[j] = __builtin_amdgcn_exp2f(sa[2 * t + 1][j] - mrow); lsum += p0[j] + p1[j]; }
            const u32x4 pk4 = pack8(p0, p1); pf[t] = __builtin_bit_cast(bf16x8, pk4); }
        lsum += __shfl_xor(lsum, 16); lsum += __shfl_xor(lsum, 32);
        f32x4 oa[8];
#pragma unroll
        for (int dt = 0; dt < 8; ++dt) oa[dt] = (f32x4){0.f, 0.f, 0.f, 0.f};
#pragma unroll
        for (int t = 0; t < 5; ++t) {
            const int k0 = 16 * (w + 2 * t) + 4 * fq + (fr >> 2); const int k1 = (w + 2 * t + 1 < 16) ? k0 + 16 : k0;
            LAS unsigned char* a0 = Vs + k0 * 272 + (4 * (fr & 3)) * 2; LAS unsigned char* a1 = Vs + k1 * 272 + (4 * (fr & 3)) * 2;
#pragma unroll
            for (int dt = 0; dt < 8; ++dt) { const bf16x8 vf = tr_read2(a0 + 32 * dt, a1 + 32 * dt); oa[dt] = mfma16(vf, pf[t], oa[dt]); }
        }
        const float inv = __builtin_amdgcn_rcpf(lsum);
        bf16_t* po = aq + tokq * 2304 + head * 128 + 4 * fq;
#pragma unroll
        for (int dt = 0; dt < 8; ++dt) { u32x2 o; o.x = cvt_pk_bf16(oa[dt][0] * inv, oa[dt][1] * inv); o.y = cvt_pk_bf16(oa[dt][2] * inv, oa[dt][3] * inv); *(u32x2*)(po + 16 * dt) = o; }
        if (fq == 0) lse[tokq * 18 + head] = mrow * 0.6931471805599453f + __logf(lsum);
        __syncthreads();
    }
}

constexpr size_t WS_BAR = 700000;
DI void grid_barrier(unsigned* bar, unsigned& nbar) {
    asm volatile("s_waitcnt vmcnt(0)" ::: "memory");
    __syncthreads();
    if (threadIdx.x == 0) {
        __builtin_amdgcn_fence(__ATOMIC_RELEASE, "agent");
        asm volatile("s_waitcnt vmcnt(0)" ::: "memory");
        const unsigned target = (nbar + 1u) * gridDim.x;
        __hip_atomic_fetch_add(bar, 1u, __ATOMIC_RELAXED, __HIP_MEMORY_SCOPE_AGENT);
        while (__hip_atomic_load(bar, __ATOMIC_RELAXED, __HIP_MEMORY_SCOPE_AGENT) < target) __builtin_amdgcn_s_sleep(1);
        __builtin_amdgcn_fence(__ATOMIC_ACQUIRE, "agent");
        asm volatile("s_waitcnt vmcnt(0)" ::: "memory");
    }
    __syncthreads();
    ++nbar;
}

constexpr int N_PHASES = 13;
__global__ void __launch_bounds__(512, 2) mega(Params p) {
    extern __shared__ __attribute__((aligned(16))) unsigned char shm[];
    LAS unsigned char* lds = (LAS unsigned char*)shm;
    unsigned char* ws = p.ws;
    const int G = gridDim.x, c = blockIdx.x;
    unsigned* bar = (unsigned*)(ws + WS_BAR); unsigned nbar = 0;
    int c_eff = c; unsigned my_xcd = 0, my_idx = 0;
    if (p.ph_hi - p.ph_lo > 1) {
        my_xcd = (unsigned)__builtin_amdgcn_s_getreg((3 << 11) | 20) & 0xFu;
        if (threadIdx.x == 0) my_idx = __hip_atomic_fetch_add(bar + 64 + 16 * (my_xcd & 7u), 1u, __ATOMIC_RELAXED, __HIP_MEMORY_SCOPE_AGENT);
        my_idx = (unsigned)__builtin_amdgcn_readfirstlane((int)my_idx);
    }
    if (p.ph_lo <= 0 && 0 < p.ph_hi) {
        if (0 > p.ph_lo) grid_barrier(bar, nbar);

#if (PHMASK >> 0) & 1
            phase0(p, lds);
#endif
    }
    if (p.ph_lo <= 1 && 1 < p.ph_hi) {
        if (1 > p.ph_lo) cg::this_grid().sync();
        if (p.ph_hi - p.ph_lo > 1) {
            LAS unsigned* cw = (LAS unsigned*)lds;
            if (threadIdx.x == 0) {
                bool ok = (G % 8) == 0 && my_xcd < 8u;
                for (int x = 0; x < 8; ++x) ok = ok && (__hip_atomic_load(bar + 64 + 16 * x, __ATOMIC_RELAXED, __HIP_MEMORY_SCOPE_AGENT) == (unsigned)(G / 8));
                cw[0] = ok ? (my_idx * 8u + my_xcd) : (unsigned)c;
            }
            __syncthreads();
            c_eff = __builtin_amdgcn_readfirstlane((int)cw[0]);
            __syncthreads();
        }

#if (PHMASK >> 1) & 1
            phase_h(p);
#endif
    }
    if (p.ph_lo <= 2 && 2 < p.ph_hi) {
        if (2 > p.ph_lo) grid_barrier(bar, nbar);

#if (PHMASK >> 2) & 1
            pg8::Gemm g{(const bf16_t*)(ws + WS_H), (const bf16_t*)(ws + WS_WIN), T_TOK, 59 * 256, 2048, nullptr, nullptr, 0}; pg8::StaticOrder S; S.init(T_TOK, 59 * 256, G, c_eff, 32, 16);
            EpiInProj E{(bf16_t*)(ws + WS_RQ), (bf16_t*)(ws + WS_RK), (bf16_t*)p.out, (bf16_t*)(ws + WS_AQ), (bf16_t*)(ws + WS_AK), (bf16_t*)(ws + WS_AV), p.pos};
            pg8::gemm_phase<1>(lds, g, S, E);
#endif
    }
    if (p.ph_lo <= 3 && 3 < p.ph_hi) {
        if (3 > p.ph_lo) grid_barrier(bar, nbar);

#if (PHMASK >> 3) & 1
            phase_retention(p, lds, c_eff); __syncthreads();
#endif
#if (PHMASK >> 13) & 1
            phase_attention(p, lds);
#endif
    }
    if (p.ph_lo <= 4 && 4 < p.ph_hi) {
        if (4 > p.ph_lo) grid_barrier(bar, nbar);

#if (PHMASK >> 4) & 1
            { pg8::Gemm g{(const bf16_t*)(ws + WS_H), (const bf16_t*)(ws + WS_WIN) + (size_t)8192 * 2048, T_TOK, 4096, 2048, nullptr, nullptr, 0}; pg8::StaticOrder S; S.init(T_TOK, 4096, G, c_eff);
              EpiRetGate E{(bf16_t*)p.out, (const float*)(ws + WS_RETSS), p.ret_gain}; pg8::gemm_phase<1>(lds, g, S, E); }
#endif
#if (PHMASK >> 14) & 1
            { pg8::Gemm g{(const bf16_t*)(ws + WS_H), (const bf16_t*)(ws + WS_WGATE), T_TOK, 4096, 2048, nullptr, nullptr, 0}; pg8::StaticOrder S; S.init(T_TOK, 4096, G, c_eff);
              EpiGates E{(bf16_t*)(ws + WS_GATES), p.b_gate}; pg8::gemm_phase<1>(lds, g, S, E); }
#endif
#if (PHMASK >> 15) & 1
            phase_alpha(p);
#endif
    }
    if (p.ph_lo <= 5 && 5 < p.ph_hi) {
        if (5 > p.ph_lo) grid_barrier(bar, nbar);

#if (PHMASK >> 5) & 1
            pg8::Gemm g{(const bf16_t*)p.out, (const bf16_t*)(ws + WS_WRET), T_TOK, 2048, 4096, (const bf16_t*)(ws + WS_AQ), (const bf16_t*)(ws + WS_WATT), 2304}; pg8::StaticOrder S; S.init(T_TOK, 2048, G, c_eff);
            EpiYMerge E{(const bf16_t*)(ws + WS_GATES), (bf16_t*)(ws + WS_U2)}; pg8::gemm_phase<2>(lds, g, S, E);
#endif
    }
    if (p.ph_lo <= 7 && 7 < p.ph_hi) {
        if (7 > p.ph_lo) grid_barrier(bar, nbar);

#if (PHMASK >> 7) & 1
            pg8::Gemm g{(const bf16_t*)(ws + WS_U2), (const bf16_t*)(ws + WS_WMIX), T_TOK, 2048, 2048, nullptr, nullptr, 0}; pg8::StaticOrder S; S.init(T_TOK, 2048, G, c_eff);
            EpiStoreBf16 E{(bf16_t*)(ws + WS_Y), 2048}; pg8::gemm_phase<1>(lds, g, S, E);
#endif
    }
    if (p.ph_lo <= 8 && 8 < p.ph_hi) {
        if (8 > p.ph_lo) grid_barrier(bar, nbar);

#if (PHMASK >> 8) & 1
            phase_postmix(p);
#endif
    }
    if (p.ph_lo <= 9 && 9 < p.ph_hi) {
        if (9 > p.ph_lo) grid_barrier(bar, nbar);

#if (PHMASK >> 9) & 1
            pg8::Gemm g{(const bf16_t*)(ws + WS_H2), (const bf16_t*)(ws + WS_WUP), T_TOK, FF, 2048, nullptr, nullptr, 0}; pg8::StaticOrder S; S.init(T_TOK, FF, G, c_eff);
            EpiStoreBf16 E{(bf16_t*)(ws + WS_A), FF}; pg8::gemm_phase<1>(lds, g, S, E);
#endif
    }
    if (p.ph_lo <= 10 && 10 < p.ph_hi) {
        if (10 > p.ph_lo) grid_barrier(bar, nbar);

#if (PHMASK >> 10) & 1
            pg8::Gemm g{(const bf16_t*)(ws + WS_H2), (const bf16_t*)(ws + WS_WUP) + (size_t)FF * 2048, T_TOK, FF, 2048, nullptr, nullptr, 0}; pg8::StaticOrder S; S.init(T_TOK, FF, G, c_eff);
            EpiConvAct E{(const bf16_t*)(ws + WS_A), (bf16_t*)(ws + WS_ACT), p.conv_w, p.conv_b}; pg8::gemm_phase<1>(lds, g, S, E);
#endif
    }
    if (p.ph_lo <= 11 && 11 < p.ph_hi) {
        if (11 > p.ph_lo) grid_barrier(bar, nbar);

#if (PHMASK >> 11) & 1
            pg8::Gemm g{(const bf16_t*)(ws + WS_ACT), (const bf16_t*)(ws + WS_WDOWN), T_TOK, 2048, FF, nullptr, nullptr, 0}; pg8::StaticOrder S; S.init(T_TOK, 2048, G, c_eff);
            EpiStoreBf16 E{(bf16_t*)(ws + WS_Y2), 2048}; pg8::gemm_phase<1>(lds, g, S, E);
#endif
    }
    if (p.ph_lo <= 12 && 12 < p.ph_hi) {
        if (12 > p.ph_lo) grid_barrier(bar, nbar);

#if (PHMASK >> 12) & 1
            phase_final(p);
#endif
    }
}

extern "C" void kernel_launch(void* const* d_in, const int* in_sizes, int n_in, void* d_out, int out_size, void* d_ws, size_t ws_size, hipStream_t stream) {
    static int grid = 0;
    if (grid == 0) {
        if (n_in != 20 || ws_size < WS_END) { fprintf(stderr, "kernel_launch: unexpected n_in %d or ws_size %zu (need %zu)\n", n_in, ws_size, (size_t)WS_END); grid = -1; return; }
        int dev = 0, cus = 0, per_cu = 0;
        hipGetDevice(&dev); hipDeviceGetAttribute(&cus, hipDeviceAttributeMultiprocessorCount, dev);
        if (hipFuncSetAttribute((const void*)mega, hipFuncAttributeMaxDynamicSharedMemorySize, LDS_BYTES) != hipSuccess) { fprintf(stderr, "kernel_launch: hipFuncSetAttribute failed\n"); grid = -1; return; }
        if (hipOccupancyMaxActiveBlocksPerMultiprocessor(&per_cu, (const void*)mega, 512, LDS_BYTES) != hipSuccess || per_cu < 1) { fprintf(stderr, "kernel_launch: occupancy query says %d\n", per_cu); per_cu = 1; }
        (void)hipGetLastError();
        grid = cus * 1;
    }
    if (grid < 0) return;
    Params p{};
    p.x = (const float*)d_in[0]; p.c = (const float*)d_in[1]; p.pos = (const int*)d_in[2]; p.w_ada = (const float*)d_in[3]; p.b_ada = (const float*)d_in[4]; p.g_pre_mix = (const float*)d_in[5];
    p.w_in = (const float*)d_in[6]; p.ret_gain = (const float*)d_in[7]; p.w_ret_out = (const float*)d_in[8]; p.w_att_out = (const float*)d_in[9]; p.w_gate = (const float*)d_in[10]; p.b_gate = (const float*)d_in[11];
    p.w_mix = (const float*)d_in[12]; p.g_post_mix = (const float*)d_in[13]; p.g_pre_ffn = (const float*)d_in[14]; p.w_up = (const float*)d_in[15]; p.conv_w = (const float*)d_in[16]; p.conv_b = (const float*)d_in[17];
    p.w_down = (const float*)d_in[18]; p.g_post_ffn = (const float*)d_in[19];
    p.out = (float*)d_out; p.ws = (unsigned char*)d_ws;
    if (hipMemsetAsync((char*)d_ws + WS_BAR, 0, 1024, stream) != hipSuccess) { fprintf(stderr, "kernel_launch: memset failed\n"); return; }
#if N_LAUNCH_PER_PHASE
    for (int ph = 0; ph < N_PHASES; ++ph) { p.ph_lo = ph; p.ph_hi = ph + 1; hipLaunchKernelGGL(mega, dim3(grid), dim3(512), LDS_BYTES, stream, p); }
#else
    p.ph_lo = 0; p.ph_hi = N_PHASES;
    void* args[] = {&p};
    hipError_t e = hipLaunchCooperativeKernel((const void*)mega, dim3(grid), dim3(512), args, LDS_BYTES, stream);
    if (e != hipSuccess) fprintf(stderr, "cooperative launch failed: %s (grid %d)\n", hipGetErrorString(e), grid);
#endif
}
```

```cpp
#include <hip/hip_runtime.h>
#include <hip/hip_cooperative_groups.h>
#include <cstdio>
#include <cstdint>
namespace cg = cooperative_groups;

#define DI __device__ __forceinline__
#define LAS __attribute__((address_space(3)))
typedef unsigned short bf16_t;
typedef short bf16x8 __attribute__((ext_vector_type(8)));
typedef short s16x4 __attribute__((ext_vector_type(4)));
typedef float f32x4 __attribute__((ext_vector_type(4)));
typedef unsigned u32x4 __attribute__((ext_vector_type(4)));
typedef unsigned u32x2 __attribute__((ext_vector_type(2)));

#ifndef PHMASK
#define PHMASK 0xFFFF
#endif
#ifndef N_LAUNCH_PER_PHASE
#define N_LAUNCH_PER_PHASE 0
#endif

constexpr int T_TOK = 32768, DM = 2048, SEQ = 8192, NB = 4;
constexpr int FF = 5632;
constexpr int LDS_BYTES = 139264;
constexpr size_t MiB = 1u << 20;
constexpr size_t WS_ADA = 0;
constexpr size_t WS_LSE = 1 * MiB;
constexpr size_t WS_RETSS = 4 * MiB;
constexpr size_t WS_WUP = 12 * MiB;
constexpr size_t WS_WDOWN = 56 * MiB;
constexpr size_t WS_WIN = 78 * MiB;
constexpr size_t WS_WGATE = 153 * MiB;
constexpr size_t WS_WRET = 169 * MiB;
constexpr size_t WS_WATT = 185 * MiB;
constexpr size_t WS_WMIX = 194 * MiB;
constexpr size_t WS_H = 206 * MiB;
constexpr size_t WS_RQ = 334 * MiB;
constexpr size_t WS_RK = 462 * MiB;
constexpr size_t WS_AQ = 590 * MiB;
constexpr size_t WS_AK = 734 * MiB;
constexpr size_t WS_AV = 878 * MiB;
constexpr size_t WS_GATES = 334 * MiB;
constexpr size_t WS_U = 734 * MiB;
constexpr size_t WS_U2 = 206 * MiB;
constexpr size_t WS_Y = 334 * MiB;
constexpr size_t WS_H2 = 78 * MiB;
constexpr size_t WS_A = 206 * MiB;
constexpr size_t WS_ACT = 558 * MiB;
constexpr size_t WS_Y2 = 78 * MiB;
constexpr size_t WS_END = 1022 * MiB;

struct Params {
    const float *x, *c; const int* pos;
    const float *w_ada, *b_ada, *g_pre_mix, *w_in, *ret_gain, *w_ret_out, *w_att_out, *w_gate, *b_gate, *w_mix, *g_post_mix, *g_pre_ffn, *w_up, *conv_w, *conv_b, *w_down, *g_post_ffn;
    float* out; unsigned char* ws; int ph_lo, ph_hi;
};

typedef __bf16 bf16x2_t __attribute__((ext_vector_type(2)));
DI unsigned cvt_pk_bf16(float lo, float hi) { bf16x2_t v = {(__bf16)lo, (__bf16)hi}; return __builtin_bit_cast(unsigned, v); }
DI float bflo(unsigned w) { return __uint_as_float(w << 16); }
DI float bfhi(unsigned w) { return __uint_as_float(w & 0xffff0000u); }
DI float wave_sum(float v) {
#pragma unroll
    for (int o = 1; o < 64; o <<= 1) v += __shfl_xor(v, o);
    return v;
}
DI float sigmoidf_(float v) { return __builtin_amdgcn_rcpf(1.0f + __builtin_amdgcn_exp2f(-1.4426950408889634f * v)); }
DI f32x4 mfma16(bf16x8 a, bf16x8 b, f32x4 c) { return __builtin_amdgcn_mfma_f32_16x16x32_bf16(a, b, c, 0, 0, 0); }
DI s16x4 tr_read(LAS unsigned char* p) { return __builtin_amdgcn_ds_read_tr16_b64_v4i16((LAS s16x4*)p); }
DI bf16x8 tr_read2(LAS unsigned char* p0, LAS unsigned char* p1) { s16x4 lo = tr_read(p0), hi = tr_read(p1); return __builtin_shufflevector(lo, hi, 0, 1, 2, 3, 4, 5, 6, 7); }

namespace pg8 {
constexpr int BM = 256, BK = 64, HALF = 128, HTB = HALF * BK * 2, STAGE_BYTES = 8 * HTB, NXCD = 8, WGM = 8;
DI int lds_byte(int r, int c) { const int st = (r >> 4) * 2 + (c >> 5), rr = r & 15, cc = c & 31, ob = rr * 64 + cc * 2; return st * 1024 + (ob ^ (((ob >> 9) & 1) << 5)); }
DI void stage_rc(int b, int& R, int& C) { const int st = b / 1024, sb = b % 1024, swz = sb ^ (((sb >> 9) & 1) << 5); R = (st >> 1) * 16 + swz / 64; C = (st & 1) * 32 + (swz % 64) / 2; }
struct Unit { int pm, pn; };
struct Gemm { const bf16_t* A; const bf16_t* Bt; int M, N, K; const bf16_t* A1; const bf16_t* Bt1; int K1; };
struct StaticOrder {
    int nM, nN, nwg, G, c, skip_lo, skip_n;
    DI void init(int M, int N, int G_, int c_, int slo = 1 << 30, int sn = 0) { nM = M / BM; nN = N / BM; nwg = nM * nN; G = G_; c = c_; skip_lo = slo; skip_n = sn; }
    DI bool next(int i, Unit& u) const {
        const long L = (long)i * G + c; if (L >= nwg) return false;
        int wgid = (int)L; { const int q = nwg / NXCD, r = nwg % NXCD, xcd = wgid % NXCD, off = wgid / NXCD; wgid = (xcd < r ? xcd * (q + 1) : r * (q + 1) + (xcd - r) * q) + off; }
        const int nig = WGM * nN, gid = wgid / nig, fm = gid * WGM, gsz = (nM - fm) < WGM ? (nM - fm) : WGM;
        u.pm = fm + ((wgid % nig) % gsz); u.pn = (wgid % nig) / gsz; if (u.pn >= skip_lo) u.pn += skip_n; return true;
    }
};

template <int NSEG, class Epi>
DI void gemm_phase(LAS unsigned char* lds, const Gemm g, const StaticOrder& S, const Epi& E) {
    const int tid = threadIdx.x, wid = __builtin_amdgcn_readfirstlane(tid >> 6), lane = tid & 63, wr = wid >> 2, wc = wid & 3, fr = lane & 15, fq = lane >> 4;
    int Rr[2], Cc[2];
#pragma unroll
    for (int i = 0; i < 2; ++i) stage_rc(tid * 16 + i * 8192, Rr[i], Cc[i]);
    const size_t kstep = (size_t)(BK * 2);
    const unsigned ldsw = (unsigned)wid * 1024u;
    const int aoff = lds_byte(wr * 64 + fr, fq * 8), boff = lds_byte(wc * 32 + fr, fq * 8);
#define PG8_SA(b, h) (((b) * 2 + (h)) * HTB)
#define PG8_SB(b, h) ((4 + (b) * 2 + (h)) * HTB)
#define PG8_STAGE(bufoff, gbase, VO) do { _Pragma("unroll") for (int _i = 0; _i < 2; ++_i) \
        __builtin_amdgcn_global_load_lds((const unsigned*)((const char*)(gbase) + VO[_i]), (LAS unsigned*)(lds + (bufoff) + ldsw + _i * 8192), 16, 0, 0); } while (0)
#define PG8_LDA(dst, b, h) do { _Pragma("unroll") for (int m = 0; m < 4; ++m) _Pragma("unroll") for (int k = 0; k < 2; ++k) dst[m][k] = *(const LAS bf16x8*)(lds + PG8_SA(b, h) + aoff + m * 2048 + k * 1024); } while (0)
#define PG8_LDB(dst, b, h) do { _Pragma("unroll") for (int n = 0; n < 2; ++n) _Pragma("unroll") for (int k = 0; k < 2; ++k) dst[n][k] = *(const LAS bf16x8*)(lds + PG8_SB(b, h) + boff + n * 2048 + k * 1024); } while (0)
#define PG8_MMA(ai, bj, At, Bt) do { __builtin_amdgcn_s_setprio(1); _Pragma("unroll") for (int m = 0; m < 4; ++m) _Pragma("unroll") for (int n = 0; n < 2; ++n) _Pragma("unroll") for (int k = 0; k < 2; ++k) \
        acc[ai][bj][m][n] = __builtin_amdgcn_mfma_f32_16x16x32_bf16(Bt[n][k], At[m][k], acc[ai][bj][m][n], 0, 0, 0); __builtin_amdgcn_s_setprio(0); } while (0)
#define PG8_WAIT_V(n) asm volatile("s_waitcnt vmcnt(" #n ")" ::: "memory")
#define PG8_WAIT_L(n) asm volatile("s_waitcnt lgkmcnt(" #n ")" ::: "memory")
#define PG8_BAR __builtin_amdgcn_s_barrier()
#define PG8_SCHED __builtin_amdgcn_sched_barrier(0)
    Unit cur, nxt; int ti = 0, seg = 0;
    if (!S.next(0, cur)) return;
    f32x4 acc[2][2][4][2];
#pragma unroll
    for (int a = 0; a < 2; ++a)
#pragma unroll
        for (int b = 0; b < 2; ++b)
#pragma unroll
            for (int m = 0; m < 4; ++m)
#pragma unroll
                for (int n = 0; n < 2; ++n) acc[a][b][m][n] = (f32x4){0.f, 0.f, 0.f, 0.f};
    bf16x8 At[4][2], B0[2][2], B1[2][2];
    int Kc = g.K;
    unsigned voffC[2];
#pragma unroll
    for (int i = 0; i < 2; ++i) voffC[i] = (unsigned)(Rr[i] * Kc + Cc[i]) * 2u;
    size_t hstepC = (size_t)HALF * Kc * 2;
    const char* cA = (const char*)g.A + (size_t)cur.pm * 2 * hstepC; const char* cB = (const char*)g.Bt + (size_t)cur.pn * 2 * hstepC;
    PG8_STAGE(PG8_SB(0, 0), cB, voffC); PG8_STAGE(PG8_SA(0, 0), cA, voffC); PG8_STAGE(PG8_SB(0, 1), cB + hstepC, voffC); PG8_STAGE(PG8_SA(0, 1), cA + hstepC, voffC);
    if (wr == 1) PG8_BAR;
    PG8_WAIT_V(4); PG8_BAR;
    PG8_STAGE(PG8_SB(1, 0), cB + kstep, voffC); PG8_STAGE(PG8_SA(1, 0), cA + kstep, voffC); PG8_STAGE(PG8_SB(1, 1), cB + hstepC + kstep, voffC);
    PG8_WAIT_V(6); PG8_BAR;
    for (;;) {
        bool has_next; int nseg = 0;
        if (NSEG > 1 && seg + 1 < NSEG) { has_next = true; nxt = cur; nseg = seg + 1; }
        else has_next = S.next(ti + 1, nxt);
        int Kn = Kc; const char* nA = cA; const char* nB = cB;
        if (has_next) { Kn = (NSEG > 1 && nseg == 1) ? g.K1 : g.K;
            nA = (const char*)((NSEG > 1 && nseg == 1) ? g.A1 : g.A) + (size_t)nxt.pm * 256 * Kn * 2; nB = (const char*)((NSEG > 1 && nseg == 1) ? g.Bt1 : g.Bt) + (size_t)nxt.pn * 256 * Kn * 2; }
        unsigned voffN[2];
#pragma unroll
        for (int i = 0; i < 2; ++i) voffN[i] = (NSEG > 1) ? (unsigned)(Rr[i] * Kn + Cc[i]) * 2u : voffC[i];
        const size_t hstepN = (NSEG > 1) ? (size_t)HALF * Kn * 2 : hstepC;
        const int nt = Kc / BK;
        for (int t = 0; t < nt; t += 2) {
            const bool last = (t == nt - 2);
            const char* a1 = cA + (size_t)(t + 1) * kstep;
            const char* a2 = last ? nA : cA + (size_t)(t + 2) * kstep; const char* b2 = last ? nB : cB + (size_t)(t + 2) * kstep;
            const char* a3 = a2 + kstep; const char* b3 = b2 + kstep;
            unsigned v2[2]; v2[0] = (NSEG > 1 && last) ? voffN[0] : voffC[0]; v2[1] = (NSEG > 1 && last) ? voffN[1] : voffC[1];
            const size_t h2 = (NSEG > 1 && last) ? hstepN : hstepC;
            PG8_LDB(B0, 0, 0); PG8_SCHED; PG8_LDA(At, 0, 0); PG8_STAGE(PG8_SA(1, 1), a1 + hstepC, voffC);
            PG8_WAIT_L(8); PG8_BAR; PG8_WAIT_L(0); PG8_MMA(0, 0, At, B0); PG8_BAR; PG8_SCHED;
            PG8_LDB(B1, 0, 1); PG8_STAGE(PG8_SB(0, 0), b2, v2);
            PG8_BAR; PG8_WAIT_L(0); PG8_MMA(0, 1, At, B1); PG8_BAR;
            PG8_LDA(At, 0, 1); PG8_STAGE(PG8_SA(0, 0), a2, v2);
            PG8_BAR; PG8_WAIT_L(0); PG8_MMA(1, 0, At, B0); PG8_BAR; PG8_SCHED;
            PG8_STAGE(PG8_SB(0, 1), b2 + h2, v2);
            PG8_WAIT_V(6); PG8_BAR; PG8_MMA(1, 1, At, B1); PG8_BAR;
            PG8_LDB(B0, 1, 0); PG8_SCHED; PG8_LDA(At, 1, 0); PG8_STAGE(PG8_SA(0, 1), a2 + h2, v2);
            PG8_WAIT_L(8); PG8_BAR; PG8_WAIT_L(0); PG8_MMA(0, 0, At, B0); PG8_BAR; PG8_SCHED;
            PG8_LDB(B1, 1, 1); PG8_STAGE(PG8_SB(1, 0), b3, v2);
            PG8_BAR; PG8_WAIT_L(0); PG8_MMA(0, 1, At, B1); PG8_BAR;
            PG8_LDA(At, 1, 1); PG8_STAGE(PG8_SA(1, 0), a3, v2);
            PG8_BAR; PG8_WAIT_L(0); PG8_MMA(1, 0, At, B0); PG8_BAR; PG8_SCHED;
            PG8_STAGE(PG8_SB(1, 1), b3 + h2, v2);
            PG8_WAIT_V(6); PG8_BAR; PG8_MMA(1, 1, At, B1); PG8_BAR;
        }
        if constexpr (NSEG > 1) { if (seg + 1 < NSEG) E.mid(acc, cur, wr, wc, fr, fq); else E(acc, cur, wr, wc, fr, fq); }
        else E(acc, cur, wr, wc, fr, fq);
        if (!has_next) break;
        if (NSEG == 1 || nseg == 0) {
#pragma unroll
            for (int a = 0; a < 2; ++a)
#pragma unroll
                for (int b = 0; b < 2; ++b)
#pragma unroll
                    for (int m = 0; m < 4; ++m)
#pragma unroll
                        for (int n = 0; n < 2; ++n) acc[a][b][m][n] = (f32x4){0.f, 0.f, 0.f, 0.f};
            ++ti;
        }
        cur = nxt; cA = nA; cB = nB; seg = nseg;
        if (NSEG > 1) { Kc = Kn; voffC[0] = voffN[0]; voffC[1] = voffN[1]; hstepC = hstepN; }
    }
    PG8_WAIT_V(0);
    if (wr == 0) PG8_BAR;
    PG8_BAR;
#undef PG8_SA
#undef PG8_SB
#undef PG8_STAGE
#undef PG8_LDA
#undef PG8_LDB
#undef PG8_MMA
#undef PG8_WAIT_V
#undef PG8_WAIT_L
#undef PG8_BAR
#undef PG8_SCHED
}
}
using pg8::Unit;
typedef f32x4 AccT[2][2][4][2];

DI u32x4 pack8(const f32x4& v0, const f32x4& v1) { u32x4 w; w.x = cvt_pk_bf16(v0[0], v0[1]); w.y = cvt_pk_bf16(v0[2], v0[3]); w.z = cvt_pk_bf16(v1[0], v1[1]); w.w = cvt_pk_bf16(v1[2], v1[3]); return w; }

struct EpiStoreBf16 {
    bf16_t* O; int ld;
    DI void operator()(const AccT& acc, const Unit& u, int wr, int wc, int fr, int fq) const {
        const int row0 = u.pm * 256 + wr * 64 + fr, col0 = u.pn * 256 + wc * 32 + 8 * fq;
#pragma unroll
        for (int ai = 0; ai < 2; ++ai)
#pragma unroll
            for (int m = 0; m < 4; ++m) { bf16_t* rowp = O + (size_t)(row0 + ai * 128 + m * 16) * ld + col0;
#pragma unroll
                for (int bj = 0; bj < 2; ++bj) *(u32x4*)(rowp + bj * 128) = pack8(acc[ai][bj][m][0], acc[ai][bj][m][1]); }
    }
};

template <int HD>
DI void rope_store(const AccT& acc, int rowbase, const int* pos, bf16_t* dst, int ld, int c1, int half, int ibase, float scale) {
    int pi[2][4];
#pragma unroll
    for (int ai = 0; ai < 2; ++ai)
#pragma unroll
        for (int m = 0; m < 4; ++m) pi[ai][m] = pos[rowbase + ai * 128 + m * 16];
    float invf[2][4];
#pragma unroll
    for (int n = 0; n < 2; ++n)
#pragma unroll
        for (int j = 0; j < 4; ++j) invf[n][j] = exp2f(-(float)(ibase + 4 * n + j) * (2.0f / HD) * 13.287712379549449f);
#pragma unroll
    for (int ai = 0; ai < 2; ++ai)
#pragma unroll
        for (int m = 0; m < 4; ++m) {
            const int row = rowbase + ai * 128 + m * 16; const float ps = (float)pi[ai][m];
            f32x4 o1[2], o2[2];
#pragma unroll
            for (int n = 0; n < 2; ++n)
#pragma unroll
                for (int j = 0; j < 4; ++j) {
                    const float ang = ps * invf[n][j]; const float rev = __builtin_amdgcn_fractf(ang * 0.15915494309189535f);
                    const float sn = __builtin_amdgcn_sinf(rev), cs = __builtin_amdgcn_cosf(rev);
                    const float t1 = acc[ai][0][m][n][j], t2 = acc[ai][1][m][n][j];
                    o1[n][j] = (t1 * cs - t2 * sn) * scale; o2[n][j] = (t2 * cs + t1 * sn) * scale;
                }
            bf16_t* rowp = dst + (size_t)row * ld + c1;
            *(u32x4*)rowp = pack8(o1[0], o1[1]); *(u32x4*)(rowp + half) = pack8(o2[0], o2[1]);
        }
}

struct EpiInProj {
    bf16_t *rq, *rk, *rv, *aq, *ak, *av; const int* pos;
    DI void operator()(const AccT& acc, const Unit& u, int wr, int wc, int fr, int fq) const {
        const int pn = u.pn, rowbase = u.pm * 256 + wr * 64 + fr;
        if (pn < 16) {
            bf16_t* dst = pn < 8 ? rq : rk; const float scale = pn < 8 ? 1.0f : 0.0625f;
            rope_store<256>(acc, rowbase, pos, dst, 2048, 256 * (pn & 7) + 32 * wc + 8 * fq, 128, 32 * wc + 8 * fq, scale);
        } else if (pn < 32) {
            const int col0 = (pn - 16) * 256 + wc * 32 + 8 * fq;
#pragma unroll
            for (int ai = 0; ai < 2; ++ai)
#pragma unroll
                for (int m = 0; m < 4; ++m) { bf16_t* rowp = rv + (size_t)(rowbase + ai * 128 + m * 16) * 4096 + col0;
#pragma unroll
                    for (int bj = 0; bj < 2; ++bj) *(u32x4*)(rowp + bj * 128) = pack8(acc[ai][bj][m][0], acc[ai][bj][m][1]); }
        } else if (pn < 66) {
            const int q9 = pn - 48; bf16_t* dst = q9 < 9 ? aq : ak; const int t9 = q9 < 9 ? q9 : q9 - 9;
            const int head = 2 * t9 + (wc >> 1), ib = 32 * (wc & 1) + 8 * fq;
            rope_store<128>(acc, rowbase, pos, dst, 2304, head * 128 + ib, 64, ib, 1.0f);
        } else {
            const int col0 = (pn - 66) * 256 + wc * 32 + 8 * fq;
#pragma unroll
            for (int ai = 0; ai < 2; ++ai)
#pragma unroll
                for (int m = 0; m < 4; ++m) { bf16_t* rowp = av + (size_t)(rowbase + ai * 128 + m * 16) * 2304 + col0;
#pragma unroll
                    for (int bj = 0; bj < 2; ++bj) *(u32x4*)(rowp + bj * 128) = pack8(acc[ai][bj][m][0], acc[ai][bj][m][1]); }
        }
    }
};

struct EpiRetGate {
    bf16_t* ret; const float* retss; const float* gain;
    DI void operator()(const AccT& acc, const Unit& u, int wr, int wc, int fr, int fq) const {
        const int rowbase = u.pm * 256 + wr * 64 + fr, head = u.pn >> 1, colb = u.pn * 256 + wc * 32 + 8 * fq;
        f32x4 gn[2][2];
#pragma unroll
        for (int bj = 0; bj < 2; ++bj) { gn[bj][0] = *(const f32x4*)(gain + colb + bj * 128); gn[bj][1] = *(const f32x4*)(gain + colb + bj * 128 + 4); }
#pragma unroll
        for (int ai = 0; ai < 2; ++ai) {
            f32x4 sA[4], sB[4]; u32x4 rr[4][2];
#pragma unroll
            for (int m = 0; m < 4; ++m) { const float* ps = retss + ((size_t)(rowbase + ai * 128 + m * 16) * 8 + head) * 8; sA[m] = *(const f32x4*)ps; sB[m] = *(const f32x4*)(ps + 4); }
#pragma unroll
            for (int m = 0; m < 4; ++m)
#pragma unroll
                for (int bj = 0; bj < 2; ++bj) rr[m][bj] = *(const u32x4*)(ret + (size_t)(rowbase + ai * 128 + m * 16) * 4096 + colb + bj * 128);
#pragma unroll
            for (int m = 0; m < 4; ++m) {
                const f32x4 s0 = sA[m], s1 = sB[m];
                const float rsv = __builtin_amdgcn_rsqf((((s0[0] + s0[1]) + (s0[2] + s0[3])) + ((s1[0] + s1[1]) + (s1[2] + s1[3]))) * (1.0f / 512.0f) + 1e-6f);
#pragma unroll
                for (int bj = 0; bj < 2; ++bj) {
                    const u32x4 r4 = rr[m][bj];
                    const float rf[8] = {bflo(r4.x), bfhi(r4.x), bflo(r4.y), bfhi(r4.y), bflo(r4.z), bfhi(r4.z), bflo(r4.w), bfhi(r4.w)};
                    f32x4 o0, o1;
#pragma unroll
                    for (int j = 0; j < 4; ++j) {
                        const float a0 = acc[ai][bj][m][0][j], a1 = acc[ai][bj][m][1][j];
                        o0[j] = a0 * sigmoidf_(a0) * (rf[j] * rsv * gn[bj][0][j]); o1[j] = a1 * sigmoidf_(a1) * (rf[4 + j] * rsv * gn[bj][1][j]);
                    }
                    *(u32x4*)(ret + (size_t)(rowbase + ai * 128 + m * 16) * 4096 + colb + bj * 128) = pack8(o0, o1);
                }
            }
        }
    }
};

struct EpiGates {
    bf16_t* O; const float* bias;
    DI void operator()(const AccT& acc, const Unit& u, int wr, int wc, int fr, int fq) const {
        const int rowbase = u.pm * 256 + wr * 64 + fr;
#pragma unroll
        for (int bj = 0; bj < 2; ++bj) {
            const int col = u.pn * 256 + bj * 128 + wc * 32 + 8 * fq;
            const f32x4 b0 = *(const f32x4*)(bias + col), b1 = *(const f32x4*)(bias + col + 4);
#pragma unroll
            for (int ai = 0; ai < 2; ++ai)
#pragma unroll
                for (int m = 0; m < 4; ++m) {
                    f32x4 o0, o1;
#pragma unroll
                    for (int j = 0; j < 4; ++j) { o0[j] = sigmoidf_(acc[ai][bj][m][0][j] + b0[j]); o1[j] = sigmoidf_(acc[ai][bj][m][1][j] + b1[j]); }
                    *(u32x4*)(O + (size_t)(rowbase + ai * 128 + m * 16) * 4096 + col) = pack8(o0, o1);
                }
        }
    }
};

struct EpiYMerge {
    const bf16_t* gates; bf16_t* U2;
    DI void mid(AccT& acc, const Unit& u, int wr, int wc, int fr, int fq) const {
        const int rowbase = u.pm * 256 + wr * 64 + fr, colb = u.pn * 256 + wc * 32 + 8 * fq;
#pragma unroll
        for (int ai = 0; ai < 2; ++ai) {
            u32x4 gr[4][2], ga[4][2];
#pragma unroll
            for (int m = 0; m < 4; ++m)
#pragma unroll
                for (int bj = 0; bj < 2; ++bj) { const bf16_t* pg = gates + (size_t)(rowbase + ai * 128 + m * 16) * 4096 + colb + bj * 128; gr[m][bj] = *(const u32x4*)pg; ga[m][bj] = *(const u32x4*)(pg + 2048); }
#pragma unroll
            for (int m = 0; m < 4; ++m)
#pragma unroll
                for (int bj = 0; bj < 2; ++bj) {
                    const u32x4 g1 = gr[m][bj], g2 = ga[m][bj];
                    const float r[8] = {bflo(g1.x), bfhi(g1.x), bflo(g1.y), bfhi(g1.y), bflo(g1.z), bfhi(g1.z), bflo(g1.w), bfhi(g1.w)};
                    const float a[8] = {bflo(g2.x), bfhi(g2.x), bflo(g2.y), bfhi(g2.y), bflo(g2.z), bfhi(g2.z), bflo(g2.w), bfhi(g2.w)};
#pragma unroll
                    for (int j = 0; j < 4; ++j) { acc[ai][bj][m][0][j] *= r[j] * __builtin_amdgcn_rcpf(fmaxf(a[j], 1e-30f)); acc[ai][bj][m][1][j] *= r[4 + j] * __builtin_amdgcn_rcpf(fmaxf(a[4 + j], 1e-30f)); }
                }
        }
    }
    DI void operator()(const AccT& acc, const Unit& u, int wr, int wc, int fr, int fq) const {
        const int rowbase = u.pm * 256 + wr * 64 + fr, colb = u.pn * 256 + wc * 32 + 8 * fq;
        u32x4 gg[2][4][2];
#pragma unroll
        for (int ai = 0; ai < 2; ++ai)
#pragma unroll
            for (int m = 0; m < 4; ++m)
#pragma unroll
                for (int bj = 0; bj < 2; ++bj) gg[ai][m][bj] = *(const u32x4*)(gates + (size_t)(rowbase + ai * 128 + m * 16) * 4096 + 2048 + colb + bj * 128);
#pragma unroll
        for (int ai = 0; ai < 2; ++ai)
#pragma unroll
            for (int m = 0; m < 4; ++m)
#pragma unroll
                for (int bj = 0; bj < 2; ++bj) {
                    const u32x4 g4 = gg[ai][m][bj];
                    f32x4 o0 = acc[ai][bj][m][0], o1 = acc[ai][bj][m][1];
                    o0[0] *= bflo(g4.x); o0[1] *= bfhi(g4.x); o0[2] *= bflo(g4.y); o0[3] *= bfhi(g4.y);
                    o1[0] *= bflo(g4.z); o1[1] *= bfhi(g4.z); o1[2] *= bflo(g4.w); o1[3] *= bfhi(g4.w);
                    *(u32x4*)(U2 + (size_t)(rowbase + ai * 128 + m * 16) * 2048 + colb + bj * 128) = pack8(o0, o1);
                }
    }
};

DI float gelu_tanh(float v) {
    const float uu = 0.7978845608028654f * (v + 0.044715f * v * v * v);
    const float e = __builtin_amdgcn_exp2f(2.8853900817779268f * uu);
    return v - v * __builtin_amdgcn_rcpf(e + 1.0f);
}
struct EpiConvAct {
    const bf16_t* A; bf16_t* ACT; const float* conv_w; const float* conv_b;
    DI void operator()(const AccT& acc, const Unit& u, int wr, int wc, int fr, int fq) const {
        const int rowbase = u.pm * 256 + wr * 64 + fr;
#pragma unroll
        for (int bj = 0; bj < 2; ++bj) {
            const int col = u.pn * 256 + bj * 128 + wc * 32 + 8 * fq;
            f32x4 w0[2], w1[2], w2[2], cb[2];
#pragma unroll
            for (int hh = 0; hh < 2; ++hh) { w0[hh] = *(const f32x4*)(conv_w + col + 4 * hh); w1[hh] = *(const f32x4*)(conv_w + FF + col + 4 * hh); w2[hh] = *(const f32x4*)(conv_w + 2 * FF + col + 4 * hh); cb[hh] = *(const f32x4*)(conv_b + col + 4 * hh); }
#pragma unroll
            for (int aim = 0; aim < 4; ++aim) { const int ai = aim >> 1, mb = (aim & 1) * 2;
                u32x4 a0[4], a1[4], a2[4];
#pragma unroll
                for (int m = mb; m < mb + 2; ++m) {
                    const int row = rowbase + ai * 128 + m * 16; const int sq = row & (SEQ - 1);
                    const bf16_t* pa = A + (size_t)row * FF + col;
                    a0[m] = *(const u32x4*)pa;
                    a1[m] = *(const u32x4*)(pa - (sq >= 1 ? FF : 0));
                    a2[m] = *(const u32x4*)(pa - (sq >= 2 ? 2 * FF : 0));
                }
#pragma unroll
                for (int m = mb; m < mb + 2; ++m) {
                    const int row = rowbase + ai * 128 + m * 16; const int sq = row & (SEQ - 1);
                    const float k1 = sq >= 1 ? 1.0f : 0.0f, k2 = sq >= 2 ? 1.0f : 0.0f;
                    const u32x4 x0 = a0[m], x1 = a1[m], x2 = a2[m];
                    const float f0[8] = {bflo(x0.x), bfhi(x0.x), bflo(x0.y), bfhi(x0.y), bflo(x0.z), bfhi(x0.z), bflo(x0.w), bfhi(x0.w)};
                    const float f1[8] = {bflo(x1.x), bfhi(x1.x), bflo(x1.y), bfhi(x1.y), bflo(x1.z), bfhi(x1.z), bflo(x1.w), bfhi(x1.w)};
                    const float f2[8] = {bflo(x2.x), bfhi(x2.x), bflo(x2.y), bfhi(x2.y), bflo(x2.z), bfhi(x2.z), bflo(x2.w), bfhi(x2.w)};
                    f32x4 o0, o1;
#pragma unroll
                    for (int j = 0; j < 4; ++j) {
                        const float c0 = cb[0][j] + w0[0][j] * f0[j] + k1 * (w1[0][j] * f1[j]) + k2 * (w2[0][j] * f2[j]);
                        const float c1 = cb[1][j] + w0[1][j] * f0[4 + j] + k1 * (w1[1][j] * f1[4 + j]) + k2 * (w2[1][j] * f2[4 + j]);
                        o0[j] = gelu_tanh(c0) * acc[ai][bj][m][0][j]; o1[j] = gelu_tanh(c1) * acc[ai][bj][m][1][j];
                    }
                    *(u32x4*)(ACT + (size_t)row * FF + col) = pack8(o0, o1);
                }
            }
        }
    }
};

DI int invperm32(int c) { return 16 * ((c >> 2) & 1) + 4 * (c >> 3) + (c & 3); }
DI int slot_std(int c) { return (c & ~31) | invperm32(c & 31); }
DI int slot_win(int c) {
    if (c >= 12288 && c < 16896) { const int tc = c & 255, hh = tc >> 7, bj = (tc >> 6) & 1, i64 = tc & 63, x = 64 * hh + i64; return (c & ~255) + 128 * bj + (x & ~31) + invperm32(x & 31); }
    return slot_std(c);
}
DI void transpose_item(const float* W, int K, int N, bf16_t* WT, int mode, LAS float* scr, int item, int lane) {
    const int nblk = N / 32, kb = item / nblk, nb = item % nblk, k0 = 64 * kb, n0 = 32 * nb;
#pragma unroll 16
    for (int i = 0; i < 32; ++i) { const int kk = 2 * i + (lane >> 5); scr[kk * 33 + (lane & 31)] = W[(size_t)(k0 + kk) * N + n0 + (lane & 31)]; }
    asm volatile("s_waitcnt lgkmcnt(0)" ::: "memory");
    const int c = lane & 7;
#pragma unroll
    for (int j = 0; j < 4; ++j) { const int n = (lane >> 3) + 8 * j; const LAS float* s = scr + (8 * c) * 33 + n;
        u32x4 o; o.x = cvt_pk_bf16(s[0 * 33], s[1 * 33]); o.y = cvt_pk_bf16(s[2 * 33], s[3 * 33]); o.z = cvt_pk_bf16(s[4 * 33], s[5 * 33]); o.w = cvt_pk_bf16(s[6 * 33], s[7 * 33]);
        const int drow = mode ? slot_win(n0 + n) : slot_std(n0 + n);
        *(u32x4*)(WT + (size_t)drow * K + k0 + 8 * c) = o; }
    asm volatile("s_waitcnt lgkmcnt(0)" ::: "memory");
}

DI void phase0(const Params& p, LAS unsigned char* lds) {
    const int tid = threadIdx.x, lane = tid & 63, wave = tid >> 6;
    LAS float* sc = (LAS float*)lds;
    LAS float* red = sc + 8192;
    float* ada = (float*)(p.ws + WS_ADA);
    for (int i = tid; i < 8192; i += 512) { const float v = p.c[i]; sc[i] = v / (1.0f + __expf(-v)); }
    __syncthreads();
    for (int cb = blockIdx.x; cb < 256; cb += gridDim.x) {
        {
            const int rg = lane / 12, cq = lane - 12 * rg;
            f32x4 a0 = {0.f, 0.f, 0.f, 0.f}, a1 = a0, a2 = a0, a3 = a0;
            if (rg < 5) {
                const float* wp = p.w_ada + 48 * cb + 4 * cq;
#pragma unroll 13
                for (int i = 0; i < 52; ++i) { const int kl = 5 * i + rg; if (kl < 256) { const int kk = 256 * wave + kl; const f32x4 wv = *(const f32x4*)(wp + (size_t)kk * 12288);
                    a0 += sc[kk] * wv; a1 += sc[2048 + kk] * wv; a2 += sc[4096 + kk] * wv; a3 += sc[6144 + kk] * wv; } }
                LAS float* rp = red + ((wave * 5 + rg) * 4) * 48 + 4 * cq;
                *(LAS f32x4*)(rp) = a0; *(LAS f32x4*)(rp + 48) = a1; *(LAS f32x4*)(rp + 96) = a2; *(LAS f32x4*)(rp + 144) = a3;
            }
        }
        __syncthreads();
        if (tid < 192) { const int b = tid / 48, l = tid % 48; float sacc = 0.f;
#pragma unroll 8
            for (int wg = 0; wg < 40; ++wg) sacc += red[(wg * 4 + b) * 48 + l];
            ada[b * 12288 + 48 * cb + l] = sacc + p.b_ada[48 * cb + l]; }
        __syncthreads();
    }
    LAS float* scr = (LAS float*)(lds + 40960 + wave * 8448);
    const int gw = blockIdx.x * 8 + wave, NGW = gridDim.x * 8;
    constexpr int I_IN = (2048 / 64) * (19200 / 32), I_GATE = (2048 / 64) * (4096 / 32), I_RET = (4096 / 64) * (2048 / 32), I_ATT = (2304 / 64) * (2048 / 32),
                  I_MIX = (2048 / 64) * (2048 / 32), I_UP = (2048 / 64) * (11264 / 32), I_DOWN = (5632 / 64) * (2048 / 32);
    constexpr int NITEMS = I_IN + I_GATE + I_RET + I_ATT + I_MIX + I_UP + I_DOWN;
    for (int it = gw; it < NITEMS; it += NGW) {
        int r = it;
        if (r < I_IN) { transpose_item(p.w_in, 2048, 19200, (bf16_t*)(p.ws + WS_WIN), 1, scr, r, lane); continue; } r -= I_IN;
        if (r < I_GATE) { transpose_item(p.w_gate, 2048, 4096, (bf16_t*)(p.ws + WS_WGATE), 0, scr, r, lane); continue; } r -= I_GATE;
        if (r < I_RET) { transpose_item(p.w_ret_out, 4096, 2048, (bf16_t*)(p.ws + WS_WRET), 0, scr, r, lane); continue; } r -= I_RET;
        if (r < I_ATT) { transpose_item(p.w_att_out, 2304, 2048, (bf16_t*)(p.ws + WS_WATT), 0, scr, r, lane); continue; } r -= I_ATT;
        if (r < I_MIX) { transpose_item(p.w_mix, 2048, 2048, (bf16_t*)(p.ws + WS_WMIX), 0, scr, r, lane); continue; } r -= I_MIX;
        if (r < I_UP) { transpose_item(p.w_up, 2048, 11264, (bf16_t*)(p.ws + WS_WUP), 0, scr, r, lane); continue; } r -= I_UP;
        transpose_item(p.w_down, 5632, 2048, (bf16_t*)(p.ws + WS_WDOWN), 0, scr, r, lane);
    }
}

constexpr int NR = 2;
DI void phase_h(const Params& p) {
    const int lane = threadIdx.x & 63, wave = threadIdx.x >> 6;
    const float* ada = (const float*)(p.ws + WS_ADA); bf16_t* H = (bf16_t*)(p.ws + WS_H);
    const int nw = gridDim.x * 8;
    for (int row0 = blockIdx.x * 8 + wave; row0 < T_TOK; row0 += nw * NR) {
        f32x4 v[NR][4][2]; float ss[NR];
#pragma unroll
        for (int q = 0; q < NR; ++q) { const float* xr = p.x + (size_t)(row0 + q * nw) * DM; ss[q] = 0.f;
#pragma unroll
            for (int it = 0; it < 4; ++it) { const int col = (it * 64 + lane) * 8; v[q][it][0] = *(const f32x4*)(xr + col); v[q][it][1] = *(const f32x4*)(xr + col + 4); } }
#pragma unroll
        for (int q = 0; q < NR; ++q) {
#pragma unroll
            for (int it = 0; it < 4; ++it)
#pragma unroll
                for (int j = 0; j < 4; ++j) ss[q] += v[q][it][0][j] * v[q][it][0][j] + v[q][it][1][j] * v[q][it][1][j];
            ss[q] = __builtin_amdgcn_rsqf(wave_sum(ss[q]) * (1.0f / DM) + 1e-6f); }
#pragma unroll
        for (int it = 0; it < 4; ++it) { const int col = (it * 64 + lane) * 8;
            f32x4 g[2], sh[NR][2], scl[NR][2];
#pragma unroll
            for (int hh = 0; hh < 2; ++hh) { g[hh] = *(const f32x4*)(p.g_pre_mix + col + 4 * hh);
#pragma unroll
                for (int q = 0; q < NR; ++q) { const int b = (row0 + q * nw) / SEQ; sh[q][hh] = *(const f32x4*)(ada + b * 12288 + col + 4 * hh); scl[q][hh] = *(const f32x4*)(ada + b * 12288 + 2048 + col + 4 * hh); } }
#pragma unroll
            for (int q = 0; q < NR; ++q) { f32x4 o[2];
#pragma unroll
                for (int hh = 0; hh < 2; ++hh)
#pragma unroll
                    for (int j = 0; j < 4; ++j) o[hh][j] = v[q][it][hh][j] * ss[q] * g[hh][j] * (1.0f + scl[q][hh][j]) + sh[q][hh][j];
                *(u32x4*)(H + (size_t)(row0 + q * nw) * DM + col) = pack8(o[0], o[1]); } }
    }
}

DI void phase_postmix(const Params& p) {
    const int lane = threadIdx.x & 63, wave = threadIdx.x >> 6;
    const float* ada = (const float*)(p.ws + WS_ADA); const bf16_t* Y = (const bf16_t*)(p.ws + WS_Y); bf16_t* H2 = (bf16_t*)(p.ws + WS_H2);
    const int nw = gridDim.x * 8;
    for (int row0 = blockIdx.x * 8 + wave; row0 < T_TOK; row0 += nw * NR) {
        f32x4 y[NR][4][2], xv[NR][4][2]; float ry[NR], r1[NR];
#pragma unroll
        for (int q = 0; q < NR; ++q) { const size_t ro = (size_t)(row0 + q * nw) * DM;
#pragma unroll
            for (int it = 0; it < 4; ++it) { const int col = (it * 64 + lane) * 8; const u32x4 w = *(const u32x4*)(Y + ro + col);
                y[q][it][0] = (f32x4){bflo(w.x), bfhi(w.x), bflo(w.y), bfhi(w.y)}; y[q][it][1] = (f32x4){bflo(w.z), bfhi(w.z), bflo(w.w), bfhi(w.w)};
                xv[q][it][0] = *(const f32x4*)(p.x + ro + col); xv[q][it][1] = *(const f32x4*)(p.x + ro + col + 4); } }
#pragma unroll
        for (int q = 0; q < NR; ++q) { float ss = 0.f;
#pragma unroll
            for (int it = 0; it < 4; ++it)
#pragma unroll
                for (int j = 0; j < 4; ++j) ss += y[q][it][0][j] * y[q][it][0][j] + y[q][it][1][j] * y[q][it][1][j];
            ry[q] = __builtin_amdgcn_rsqf(wave_sum(ss) * (1.0f / DM) + 1e-6f); }
#pragma unroll
        for (int q = 0; q < NR; ++q) { const int row = row0 + q * nw; const float* ab = ada + (row / SEQ) * 12288; float s1 = 0.f;
#pragma unroll
            for (int it = 0; it < 4; ++it) { const int col = (it * 64 + lane) * 8;
#pragma unroll
                for (int hh = 0; hh < 2; ++hh) { const f32x4 g = *(const f32x4*)(p.g_post_mix + col + 4 * hh), gt = *(const f32x4*)(ab + 4096 + col + 4 * hh);
                    f32x4 o;
#pragma unroll
                    for (int j = 0; j < 4; ++j) { o[j] = xv[q][it][hh][j] + gt[j] * (y[q][it][hh][j] * ry[q] * g[j]); s1 += o[j] * o[j]; }
                    y[q][it][hh] = o; *(f32x4*)(p.out + (size_t)row * DM + col + 4 * hh) = o; } }
            r1[q] = __builtin_amdgcn_rsqf(wave_sum(s1) * (1.0f / DM) + 1e-6f); }
#pragma unroll
        for (int q = 0; q < NR; ++q) { const int row = row0 + q * nw; const float* ab = ada + (row / SEQ) * 12288;
#pragma unroll
            for (int it = 0; it < 4; ++it) { const int col = (it * 64 + lane) * 8; f32x4 o[2];
#pragma unroll
                for (int hh = 0; hh < 2; ++hh) { const f32x4 g = *(const f32x4*)(p.g_pre_ffn + col + 4 * hh), sh = *(const f32x4*)(ab + 6144 + col + 4 * hh), scl = *(const f32x4*)(ab + 8192 + col + 4 * hh);
#pragma unroll
                    for (int j = 0; j < 4; ++j) o[hh][j] = y[q][it][hh][j] * r1[q] * g[j] * (1.0f + scl[j]) + sh[j]; }
                *(u32x4*)(H2 + (size_t)row * DM + col) = pack8(o[0], o[1]); } }
    }
}

DI void phase_final(const Params& p) {
    const int lane = threadIdx.x & 63, wave = threadIdx.x >> 6;
    const float* ada = (const float*)(p.ws + WS_ADA); const bf16_t* Y = (const bf16_t*)(p.ws + WS_Y2);
    const int nw = gridDim.x * 8;
    for (int row0 = blockIdx.x * 8 + wave; row0 < T_TOK; row0 += nw * NR) {
        f32x4 y[NR][4][2], xv[NR][4][2]; float ry[NR];
#pragma unroll
        for (int q = 0; q < NR; ++q) { const size_t ro = (size_t)(row0 + q * nw) * DM;
#pragma unroll
            for (int it = 0; it < 4; ++it) { const int col = (it * 64 + lane) * 8; const u32x4 w = *(const u32x4*)(Y + ro + col);
                y[q][it][0] = (f32x4){bflo(w.x), bfhi(w.x), bflo(w.y), bfhi(w.y)}; y[q][it][1] = (f32x4){bflo(w.z), bfhi(w.z), bflo(w.w), bfhi(w.w)};
                xv[q][it][0] = *(const f32x4*)(p.out + ro + col); xv[q][it][1] = *(const f32x4*)(p.out + ro + col + 4); } }
#pragma unroll
        for (int q = 0; q < NR; ++q) { float ss = 0.f;
#pragma unroll
            for (int it = 0; it < 4; ++it)
#pragma unroll
                for (int j = 0; j < 4; ++j) ss += y[q][it][0][j] * y[q][it][0][j] + y[q][it][1][j] * y[q][it][1][j];
            ry[q] = __builtin_amdgcn_rsqf(wave_sum(ss) * (1.0f / DM) + 1e-6f); }
#pragma unroll
        for (int q = 0; q < NR; ++q) { const int row = row0 + q * nw; const float* ab = ada + (row / SEQ) * 12288;
#pragma unroll
            for (int it = 0; it < 4; ++it) { const int col = (it * 64 + lane) * 8;
#pragma unroll
                for (int hh = 0; hh < 2; ++hh) { const f32x4 g = *(const f32x4*)(p.g_post_ffn + col + 4 * hh), gt = *(const f32x4*)(ab + 10240 + col + 4 * hh);
                    f32x4 o;
#pragma unroll
                    for (int j = 0; j < 4; ++j) o[j] = xv[q][it][hh][j] + gt[j] * (y[q][it][hh][j] * ry[q] * g[j]);
                    *(f32x4*)(p.out + (size_t)row * DM + col + 4 * hh) = o; } } }
    }
}

DI void phase_alpha(const Params& p) {
    bf16_t* att = (bf16_t*)(p.ws + WS_AQ); const float* lse = (const float*)(p.ws + WS_LSE);
    const int lane = threadIdx.x & 63, wave = threadIdx.x >> 6;
    for (int t = blockIdx.x * 8 + wave; t < T_TOK; t += gridDim.x * 8) {
        const float l = lse[(size_t)t * 18 + (lane < 18 ? lane : 0)];
        const int j = lane % 6;
        const float l0 = __shfl(l, j), l1 = __shfl(l, 6 + j), l2 = __shfl(l, 12 + j);
        const float mm = fmaxf(l0, fmaxf(l1, l2)); const float e0 = __expf(l0 - mm), e1 = __expf(l1 - mm), e2 = __expf(l2 - mm);
        const float al_lane = __expf(l - mm) / (e0 + e1 + e2);
        u32x4* row = (u32x4*)(att + (size_t)t * 2304);
        u32x4 w[5];
#pragma unroll
        for (int k = 0; k < 5; ++k) { const int ch = lane + 64 * k; if (ch < 288) w[k] = row[ch]; }
#pragma unroll
        for (int k = 0; k < 5; ++k) { const int ch = lane + 64 * k; const float al = __shfl(al_lane, (ch < 288 ? ch : 0) >> 4);
            if (ch < 288) { u32x4 o;
                o.x = cvt_pk_bf16(bflo(w[k].x) * al, bfhi(w[k].x) * al); o.y = cvt_pk_bf16(bflo(w[k].y) * al, bfhi(w[k].y) * al);
                o.z = cvt_pk_bf16(bflo(w[k].z) * al, bfhi(w[k].z) * al); o.w = cvt_pk_bf16(bflo(w[k].w) * al, bfhi(w[k].w) * al);
                row[ch] = o; } }
    }
}

DI void phase_retention(const Params& p, LAS unsigned char* lds, int cblk) {
    const int tid = threadIdx.x, lane = tid & 63, w = tid >> 6, fr = lane & 15, fq = lane >> 4;
    LAS unsigned char* Qs = lds; LAS unsigned char* Ks = lds + 33792; LAS unsigned char* Vs = lds + 67584; LAS unsigned char* St = lds + 76800; LAS unsigned char* Ps = lds + 110592;
    LAS float* red = (LAS float*)(lds + 119808);
    const bf16_t* rq = (const bf16_t*)(p.ws + WS_RQ); const bf16_t* rk = (const bf16_t*)(p.ws + WS_RK); bf16_t* rv = (bf16_t*)p.out; float* retss = (float*)(p.ws + WS_RETSS);
    for (int item = cblk; item < 256; item += gridDim.x) {
        const int q5 = item >> 3, bh = (item & 7) * 4 + (q5 & 3), slice = q5 >> 2, b = bh >> 3, h = bh & 7;
        const float lg = log1pf(-exp2f(-5.0f - (float)h));
        const float gamma_c = expf(64.0f * lg);
        const float xv = expf(-lg * (float)((tid >> 3) + 1));
        const float xo0 = expf(lg * (float)(32 * (w & 1) + fr + 1)), xo1 = expf(lg * (float)(32 * (w & 1) + 16 + fr + 1));
        const size_t tok0 = (size_t)b * SEQ;
        const bf16_t* qbase = rq + tok0 * 2048 + h * 256 + (tid & 31) * 8; const bf16_t* kbase = rk + tok0 * 2048 + h * 256 + (tid & 31) * 8;
        bf16_t* vbase = rv + tok0 * 4096 + h * 512 + slice * 64;
        u32x4 pq[4], pk[4], pv;
        f32x4 Sreg[2][4];
#pragma unroll
        for (int a = 0; a < 2; ++a)
#pragma unroll
            for (int bb = 0; bb < 4; ++bb) Sreg[a][bb] = (f32x4){0.f, 0.f, 0.f, 0.f};
        for (int i = tid; i < 33792 / 16; i += 512) ((LAS u32x4*)St)[i] = (u32x4){0u, 0u, 0u, 0u};
#define RET_LOAD(c) do { _Pragma("unroll") for (int i = 0; i < 4; ++i) { const int row = (tid + 512 * i) >> 5; \
            pq[i] = *(const u32x4*)(qbase + (size_t)(64 * (c) + row) * 2048); pk[i] = *(const u32x4*)(kbase + (size_t)(64 * (c) + row) * 2048); } \
            pv = *(const u32x4*)(vbase + (size_t)(64 * (c) + (tid >> 3)) * 4096 + (tid & 7) * 8); } while (0)
#define RET_STORE() do { _Pragma("unroll") for (int i = 0; i < 4; ++i) { const int e = tid + 512 * i, row = e >> 5, pc = e & 31; \
            *(LAS u32x4*)(Qs + row * 528 + pc * 16) = pq[i]; *(LAS u32x4*)(Ks + row * 528 + pc * 16) = pk[i]; } \
            { u32x4 o; o.x = cvt_pk_bf16(bflo(pv.x) * xv, bfhi(pv.x) * xv); o.y = cvt_pk_bf16(bflo(pv.y) * xv, bfhi(pv.y) * xv); \
              o.z = cvt_pk_bf16(bflo(pv.z) * xv, bfhi(pv.z) * xv); o.w = cvt_pk_bf16(bflo(pv.w) * xv, bfhi(pv.w) * xv); \
              *(LAS u32x4*)(Vs + (tid >> 3) * 144 + (tid & 7) * 16) = o; } } while (0)
        RET_LOAD(0); RET_STORE();
        __syncthreads();
        for (int c = 0; c < 128; ++c) {
            if (c + 1 < 128) RET_LOAD(c + 1);
            {
                const int jt = w >> 1, it0 = (w & 1) * 2;
                f32x4 sa[2] = {(f32x4){0.f, 0.f, 0.f, 0.f}, (f32x4){0.f, 0.f, 0.f, 0.f}};
#pragma unroll
                for (int ks = 0; ks < 8; ++ks) {
                    const bf16x8 kf = *(const LAS bf16x8*)(Ks + (16 * jt + fr) * 528 + (32 * ks + 8 * fq) * 2);
#pragma unroll
                    for (int t = 0; t < 2; ++t) { const bf16x8 qf = *(const LAS bf16x8*)(Qs + (16 * (it0 + t) + fr) * 528 + (32 * ks + 8 * fq) * 2); sa[t] = mfma16(kf, qf, sa[t]); }
                }
#pragma unroll
                for (int t = 0; t < 2; ++t) { const int iq = 16 * (it0 + t) + fr, jk0 = 16 * jt + 4 * fq;
                    u32x2 o; o.x = cvt_pk_bf16(jk0 + 0 <= iq ? sa[t][0] : 0.f, jk0 + 1 <= iq ? sa[t][1] : 0.f); o.y = cvt_pk_bf16(jk0 + 2 <= iq ? sa[t][2] : 0.f, jk0 + 3 <= iq ? sa[t][3] : 0.f);
                    *(LAS u32x2*)(Ps + iq * 144 + jk0 * 2) = o; }
            }
            {
#pragma unroll
                for (int ks = 0; ks < 2; ++ks) {
                    const int j0 = 32 * ks + 8 * fq + (fr >> 2);
                    bf16x8 kt[2], vf[4];
#pragma unroll
                    for (int dd = 0; dd < 2; ++dd) { LAS unsigned char* a0 = Ks + j0 * 528 + (16 * (2 * w + dd) + 4 * (fr & 3)) * 2; kt[dd] = tr_read2(a0, a0 + 4 * 528); }
#pragma unroll
                    for (int vt = 0; vt < 4; ++vt) { LAS unsigned char* a0 = Vs + j0 * 144 + (16 * vt + 4 * (fr & 3)) * 2; vf[vt] = tr_read2(a0, a0 + 4 * 144); }
#pragma unroll
                    for (int dd = 0; dd < 2; ++dd)
#pragma unroll
                        for (int vt = 0; vt < 4; ++vt) Sreg[dd][vt] = mfma16(kt[dd], vf[vt], Sreg[dd][vt]);
                }
#pragma unroll
                for (int dd = 0; dd < 2; ++dd)
#pragma unroll
                    for (int vt = 0; vt < 4; ++vt) Sreg[dd][vt] *= gamma_c;
            }
            __syncthreads();
            {
                const int vt = w >> 1, it0 = (w & 1) * 2;
                f32x4 oa[2] = {(f32x4){0.f, 0.f, 0.f, 0.f}, (f32x4){0.f, 0.f, 0.f, 0.f}};
#pragma unroll
                for (int ks = 0; ks < 8; ++ks) {
                    const bf16x8 sf = *(const LAS bf16x8*)(St + (16 * vt + fr) * 528 + (32 * ks + 8 * fq) * 2);
#pragma unroll
                    for (int t = 0; t < 2; ++t) { const bf16x8 qf = *(const LAS bf16x8*)(Qs + (16 * (it0 + t) + fr) * 528 + (32 * ks + 8 * fq) * 2); oa[t] = mfma16(sf, qf, oa[t]); }
                }
#pragma unroll
                for (int ks = 0; ks < 2; ++ks) {
                    const int j0 = 32 * ks + 8 * fq + (fr >> 2);
                    LAS unsigned char* a0 = Vs + j0 * 144 + (16 * vt + 4 * (fr & 3)) * 2; const bf16x8 vf = tr_read2(a0, a0 + 4 * 144);
#pragma unroll
                    for (int t = 0; t < 2; ++t) { const bf16x8 pf = *(const LAS bf16x8*)(Ps + (16 * (it0 + t) + fr) * 144 + (32 * ks + 8 * fq) * 2); oa[t] = mfma16(vf, pf, oa[t]); }
                }
#pragma unroll
                for (int t = 0; t < 2; ++t) { const int iq = 16 * (it0 + t) + fr; oa[t] *= (t == 0 ? xo0 : xo1);
                    u32x2 o; o.x = cvt_pk_bf16(oa[t][0], oa[t][1]); o.y = cvt_pk_bf16(oa[t][2], oa[t][3]);
                    *(u32x2*)(vbase + (size_t)(64 * c + iq) * 4096 + 16 * vt + 4 * fq) = o;
                    float ss = (oa[t][0] * oa[t][0] + oa[t][1] * oa[t][1]) + (oa[t][2] * oa[t][2] + oa[t][3] * oa[t][3]);
                    ss += __shfl_xor(ss, 16); ss += __shfl_xor(ss, 32);
                    if (fq == 0) red[iq * 4 + vt] = ss; }
            }
            __syncthreads();
#pragma unroll
            for (int dd = 0; dd < 2; ++dd)
#pragma unroll
                for (int vt = 0; vt < 4; ++vt) { u32x2 o; o.x = cvt_pk_bf16(Sreg[dd][vt][0], Sreg[dd][vt][1]); o.y = cvt_pk_bf16(Sreg[dd][vt][2], Sreg[dd][vt][3]);
                    *(LAS u32x2*)(St + (16 * vt + fr) * 528 + (16 * (2 * w + dd) + 4 * fq) * 2) = o; }
            if (c + 1 < 128) RET_STORE();
            if (tid < 64) retss[((tok0 + 64 * c + tid) * 8 + h) * 8 + slice] = (red[tid * 4 + 0] + red[tid * 4 + 1]) + (red[tid * 4 + 2] + red[tid * 4 + 3]);
            __syncthreads();
        }
#undef RET_LOAD
#undef RET_STORE
    }
}

DI void phase_attention(const Params& p, LAS unsigned char* lds) {
    const int tid = threadIdx.x, lane = tid & 63, w = tid >> 6, fr = lane & 15, fq = lane >> 4;
    LAS unsigned char* Ks = lds; LAS unsigned char* Vs = lds + 69632;
    bf16_t* aq = (bf16_t*)(p.ws + WS_AQ); const bf16_t* ak = (const bf16_t*)(p.ws + WS_AK); const bf16_t* av = (const bf16_t*)(p.ws + WS_AV); float* lse = (float*)(p.ws + WS_LSE);
    const int per = (4608 + (int)gridDim.x - 1) / (int)gridDim.x, it_lo = (int)blockIdx.x * per, it_hi = (it_lo + per < 4608) ? it_lo + per : 4608;
    int prev_key = -1;
    for (int item = it_lo, cnt = 0; item < it_hi; ++item, ++cnt) {
        const int bh = item >> 6, e64 = item & 63, head = bh % 18, b = bh / 18;
        const int g = head / 6, rsh = 2 * g, r = 1 << rsh, nbc = 64 >> rsh, cls = e64 / nbc, nb = e64 - cls * nbc;
        const int pq0 = nb * 128, pk0 = pq0 - 128;
        const size_t tokb = (size_t)b * SEQ;
        const int scur = cnt & 1, sprev = scur ^ 1;
        const bool reuse = (nb > 0) && (prev_key == item - 1);
#pragma unroll
        for (int i = 0; i < 4; ++i) { const int e = tid + 512 * i, row = e >> 4, pc = e & 15;
            const size_t off = (tokb + (size_t)(pq0 + row) * r + cls) * 2304 + head * 128 + pc * 8;
            const u32x4 kv = *(const u32x4*)(ak + off), vv = *(const u32x4*)(av + off);
            *(LAS u32x4*)(Ks + (scur * 128 + row) * 272 + pc * 16) = kv; *(LAS u32x4*)(Vs + (scur * 128 + row) * 272 + pc * 16) = vv; }
        if (!reuse) {
#pragma unroll
            for (int i = 0; i < 4; ++i) { const int e = tid + 512 * i, row = e >> 4, pc = e & 15;
                u32x4 kv = {0u, 0u, 0u, 0u}, vv = kv;
                if (nb > 0) { const size_t off = (tokb + (size_t)(pk0 + row) * r + cls) * 2304 + head * 128 + pc * 8; kv = *(const u32x4*)(ak + off); vv = *(const u32x4*)(av + off); }
                *(LAS u32x4*)(Ks + (sprev * 128 + row) * 272 + pc * 16) = kv; *(LAS u32x4*)(Vs + (sprev * 128 + row) * 272 + pc * 16) = vv; }
        }
        prev_key = item;
        const int qq = 16 * w + fr;
        const size_t tokq = tokb + (size_t)(pq0 + qq) * r + cls;
        bf16x8 qf[4];
        { const bf16_t* qp = aq + tokq * 2304 + head * 128 + 8 * fq;
#pragma unroll
          for (int ks = 0; ks < 4; ++ks) qf[ks] = *(const bf16x8*)(qp + 32 * ks); }
        __syncthreads();
        f32x4 sa[10];
#pragma unroll
        for (int kt = 0; kt < 10; ++kt) { sa[kt] = (f32x4){0.f, 0.f, 0.f, 0.f};
            const int T = (w + kt < 16) ? w + kt : 15;
            const int krow = ((T < 8) ? sprev : scur) * 128 + 16 * (T & 7) + fr;
#pragma unroll
            for (int ks = 0; ks < 4; ++ks) { const bf16x8 kf = *(const LAS bf16x8*)(Ks + krow * 272 + (32 * ks + 8 * fq) * 2); sa[kt] = mfma16(kf, qf[ks], sa[kt]); } }
        const float sc2 = 0.08838834764831845f * 1.4426950408889634f;
        float mrow = -INFINITY;
#pragma unroll
        for (int kt = 0; kt < 10; ++kt)
#pragma unroll
            for (int j = 0; j < 4; ++j) { const int kk = 16 * (w + kt) + 4 * fq + j; const bool valid = (kk >= qq) && (kk <= qq + 128) && (pk0 + kk >= 0);
                const float sv = valid ? sa[kt][j] * sc2 : -INFINITY; sa[kt][j] = sv; mrow = fmaxf(mrow, sv); }
        mrow = fmaxf(mrow, __shfl_xor(mrow, 16)); mrow = fmaxf(mrow, __shfl_xor(mrow, 32));
        float lsum = 0.f;
        bf16x8 pf[5];
#pragma unroll
        for (int t = 0; t < 5; ++t) { f32x4 p0, p1;
#pragma unroll
            for (int j = 0; j < 4; ++j) { p0[j] = __builtin_amdgcn_exp2f(sa[2 * t][j] - mrow); p1[j] = __builtin_amdgcn_exp2f(sa[2 * t + 1][j] - mrow); lsum += p0[j] + p1[j]; }
            const u32x4 pk4 = pack8(p0, p1); pf[t] = __builtin_bit_cast(bf16x8, pk4); }
        lsum += __shfl_xor(lsum, 16); lsum += __shfl_xor(lsum, 32);
        f32x4 oa[8];
#pragma unroll
        for (int dt = 0; dt < 8; ++dt) oa[dt] = (f32x4){0.f, 0.f, 0.f, 0.f};
#pragma unroll
        for (int t = 0; t < 5; ++t) {
            const int T0 = w + 2 * t, T1 = (T0 + 1 < 16) ? T0 + 1 : T0;
            const int r0 = ((T0 < 8) ? sprev : scur) * 128 + 16 * (T0 & 7) + 4 * fq + (fr >> 2), r1 = ((T1 < 8) ? sprev : scur) * 128 + 16 * (T1 & 7) + 4 * fq + (fr >> 2);
            LAS unsigned char* a0 = Vs + r0 * 272 + (4 * (fr & 3)) * 2; LAS unsigned char* a1 = Vs + r1 * 272 + (4 * (fr & 3)) * 2;
#pragma unroll
            for (int dt = 0; dt < 8; ++dt) { const bf16x8 vf = tr_read2(a0 + 32 * dt, a1 + 32 * dt); oa[dt] = mfma16(vf, pf[t], oa[dt]); }
        }
        const float inv = __builtin_amdgcn_rcpf(lsum);
        bf16_t* po = aq + tokq * 2304 + head * 128 + 4 * fq;
#pragma unroll
        for (int dt = 0; dt < 8; ++dt) { u32x2 o; o.x = cvt_pk_bf16(oa[dt][0] * inv, oa[dt][1] * inv); o.y = cvt_pk_bf16(oa[dt][2] * inv, oa[dt][3] * inv); *(u32x2*)(po + 16 * dt) = o; }
        if (fq == 0) lse[tokq * 18 + head] = mrow * 0.6931471805599453f + __logf(lsum);
        __syncthreads();
    }
}

constexpr size_t WS_BAR = 700000;
DI void grid_barrier(unsigned* bar, unsigned& nbar) {
    asm volatile("s_waitcnt vmcnt(0)" ::: "memory");
    __syncthreads();
    if (threadIdx.x == 0) {
        __builtin_amdgcn_fence(__ATOMIC_RELEASE, "agent");
        asm volatile("s_waitcnt vmcnt(0)" ::: "memory");
        const unsigned target = (nbar + 1u) * gridDim.x;
        __hip_atomic_fetch_add(bar, 1u, __ATOMIC_RELAXED, __HIP_MEMORY_SCOPE_AGENT);
        while (__hip_atomic_load(bar, __ATOMIC_RELAXED, __HIP_MEMORY_SCOPE_AGENT) < target) __builtin_amdgcn_s_sleep(1);
        __builtin_amdgcn_fence(__ATOMIC_ACQUIRE, "agent");
        asm volatile("s_waitcnt vmcnt(0)" ::: "memory");
    }
    __syncthreads();
    ++nbar;
}

constexpr int N_PHASES = 13;
__global__ void __launch_bounds__(512, 2) mega(Params p) {
    extern __shared__ __attribute__((aligned(16))) unsigned char shm[];
    LAS unsigned char* lds = (LAS unsigned char*)shm;
    unsigned char* ws = p.ws;
    const int G = gridDim.x, c = blockIdx.x;
    unsigned* bar = (unsigned*)(ws + WS_BAR); unsigned nbar = 0;
    int c_eff = c; unsigned my_xcd = 0, my_idx = 0;
    if (p.ph_hi - p.ph_lo > 1) {
        my_xcd = (unsigned)__builtin_amdgcn_s_getreg((3 << 11) | 20) & 0xFu;
        if (threadIdx.x == 0) my_idx = __hip_atomic_fetch_add(bar + 64 + 16 * (my_xcd & 7u), 1u, __ATOMIC_RELAXED, __HIP_MEMORY_SCOPE_AGENT);
        my_idx = (unsigned)__builtin_amdgcn_readfirstlane((int)my_idx);
    }
    if (p.ph_lo <= 0 && 0 < p.ph_hi) {
        if (0 > p.ph_lo) grid_barrier(bar, nbar);

#if (PHMASK >> 0) & 1
            phase0(p, lds);
#endif
    }
    if (p.ph_lo <= 1 && 1 < p.ph_hi) {
        if (1 > p.ph_lo) cg::this_grid().sync();
        if (p.ph_hi - p.ph_lo > 1) {
            LAS unsigned* cw = (LAS unsigned*)lds;
            if (threadIdx.x == 0) {
                bool ok = (G % 8) == 0 && my_xcd < 8u;
                for (int x = 0; x < 8; ++x) ok = ok && (__hip_atomic_load(bar + 64 + 16 * x, __ATOMIC_RELAXED, __HIP_MEMORY_SCOPE_AGENT) == (unsigned)(G / 8));
                cw[0] = ok ? (my_idx * 8u + my_xcd) : (unsigned)c;
            }
            __syncthreads();
            c_eff = __builtin_amdgcn_readfirstlane((int)cw[0]);
            __syncthreads();
        }

#if (PHMASK >> 1) & 1
            phase_h(p);
#endif
    }
    if (p.ph_lo <= 2 && 2 < p.ph_hi) {
        if (2 > p.ph_lo) grid_barrier(bar, nbar);

#if (PHMASK >> 2) & 1
            pg8::Gemm g{(const bf16_t*)(ws + WS_H), (const bf16_t*)(ws + WS_WIN), T_TOK, 59 * 256, 2048, nullptr, nullptr, 0}; pg8::StaticOrder S; S.init(T_TOK, 59 * 256, G, c_eff, 32, 16);
            EpiInProj E{(bf16_t*)(ws + WS_RQ), (bf16_t*)(ws + WS_RK), (bf16_t*)p.out, (bf16_t*)(ws + WS_AQ), (bf16_t*)(ws + WS_AK), (bf16_t*)(ws + WS_AV), p.pos};
            pg8::gemm_phase<1>(lds, g, S, E);
#endif
    }
    if (p.ph_lo <= 3 && 3 < p.ph_hi) {
        if (3 > p.ph_lo) grid_barrier(bar, nbar);

#if (PHMASK >> 3) & 1
            phase_retention(p, lds, c_eff); __syncthreads();
#endif
#if (PHMASK >> 13) & 1
            phase_attention(p, lds);
#endif
    }
    if (p.ph_lo <= 4 && 4 < p.ph_hi) {
        if (4 > p.ph_lo) grid_barrier(bar, nbar);

#if (PHMASK >> 4) & 1
            { pg8::Gemm g{(const bf16_t*)(ws + WS_H), (const bf16_t*)(ws + WS_WIN) + (size_t)8192 * 2048, T_TOK, 4096, 2048, nullptr, nullptr, 0}; pg8::StaticOrder S; S.init(T_TOK, 4096, G, c_eff);
              EpiRetGate E{(bf16_t*)p.out, (const float*)(ws + WS_RETSS), p.ret_gain}; pg8::gemm_phase<1>(lds, g, S, E); }
#endif
#if (PHMASK >> 14) & 1
            { pg8::Gemm g{(const bf16_t*)(ws + WS_H), (const bf16_t*)(ws + WS_WGATE), T_TOK, 4096, 2048, nullptr, nullptr, 0}; pg8::StaticOrder S; S.init(T_TOK, 4096, G, c_eff);
              EpiGates E{(bf16_t*)(ws + WS_GATES), p.b_gate}; pg8::gemm_phase<1>(lds, g, S, E); }
#endif
#if (PHMASK >> 15) & 1
            phase_alpha(p);
#endif
    }
    if (p.ph_lo <= 5 && 5 < p.ph_hi) {
        if (5 > p.ph_lo) grid_barrier(bar, nbar);

#if (PHMASK >> 5) & 1
            pg8::Gemm g{(const bf16_t*)p.out, (const bf16_t*)(ws + WS_WRET), T_TOK, 2048, 4096, (const bf16_t*)(ws + WS_AQ), (const bf16_t*)(ws + WS_WATT), 2304}; pg8::StaticOrder S; S.init(T_TOK, 2048, G, c_eff);
            EpiYMerge E{(const bf16_t*)(ws + WS_GATES), (bf16_t*)(ws + WS_U2)}; pg8::gemm_phase<2>(lds, g, S, E);
#endif
    }
    if (p.ph_lo <= 7 && 7 < p.ph_hi) {
        if (7 > p.ph_lo) grid_barrier(bar, nbar);

#if (PHMASK >> 7) & 1
            pg8::Gemm g{(const bf16_t*)(ws + WS_U2), (const bf16_t*)(ws + WS_WMIX), T_TOK, 2048, 2048, nullptr, nullptr, 0}; pg8::StaticOrder S; S.init(T_TOK, 2048, G, c_eff);
            EpiStoreBf16 E{(bf16_t*)(ws + WS_Y), 2048}; pg8::gemm_phase<1>(lds, g, S, E);
#endif
    }
    if (p.ph_lo <= 8 && 8 < p.ph_hi) {
        if (8 > p.ph_lo) grid_barrier(bar, nbar);

#if (PHMASK >> 8) & 1
            phase_postmix(p);
#endif
    }
    if (p.ph_lo <= 9 && 9 < p.ph_hi) {
        if (9 > p.ph_lo) grid_barrier(bar, nbar);

#if (PHMASK >> 9) & 1
            pg8::Gemm g{(const bf16_t*)(ws + WS_H2), (const bf16_t*)(ws + WS_WUP), T_TOK, FF, 2048, nullptr, nullptr, 0}; pg8::StaticOrder S; S.init(T_TOK, FF, G, c_eff);
            EpiStoreBf16 E{(bf16_t*)(ws + WS_A), FF}; pg8::gemm_phase<1>(lds, g, S, E);
#endif
    }
    if (p.ph_lo <= 10 && 10 < p.ph_hi) {
        if (10 > p.ph_lo) grid_barrier(bar, nbar);

#if (PHMASK >> 10) & 1
            pg8::Gemm g{(const bf16_t*)(ws + WS_H2), (const bf16_t*)(ws + WS_WUP) + (size_t)FF * 2048, T_TOK, FF, 2048, nullptr, nullptr, 0}; pg8::StaticOrder S; S.init(T_TOK, FF, G, c_eff);
            EpiConvAct E{(const bf16_t*)(ws + WS_A), (bf16_t*)(ws + WS_ACT), p.conv_w, p.conv_b}; pg8::gemm_phase<1>(lds, g, S, E);
#endif
    }
    if (p.ph_lo <= 11 && 11 < p.ph_hi) {
        if (11 > p.ph_lo) grid_barrier(bar, nbar);

#if (PHMASK >> 11) & 1
            pg8::Gemm g{(const bf16_t*)(ws + WS_ACT), (const bf16_t*)(ws + WS_WDOWN), T_TOK, 2048, FF, nullptr, nullptr, 0}; pg8::StaticOrder S; S.init(T_TOK, 2048, G, c_eff);
            EpiStoreBf16 E{(bf16_t*)(ws + WS_Y2), 2048}; pg8::gemm_phase<1>(lds, g, S, E);
#endif
    }
    if (p.ph_lo <= 12 && 12 < p.ph_hi) {
        if (12 > p.ph_lo) grid_barrier(bar, nbar);

#if (PHMASK >> 12) & 1
            phase_final(p);
#endif
    }
}

extern "C" void kernel_launch(void* const* d_in, const int* in_sizes, int n_in, void* d_out, int out_size, void* d_ws, size_t ws_size, hipStream_t stream) {
    static int grid = 0;
    if (grid == 0) {
        if (n_in != 20 || ws_size < WS_END) { fprintf(stderr, "kernel_launch: unexpected n_in %d or ws_size %zu (need %zu)\n", n_in, ws_size, (size_t)WS_END); grid = -1; return; }
        int dev = 0, cus = 0, per_cu = 0;
        hipGetDevice(&dev); hipDeviceGetAttribute(&cus, hipDeviceAttributeMultiprocessorCount, dev);
        if (hipFuncSetAttribute((const void*)mega, hipFuncAttributeMaxDynamicSharedMemorySize, LDS_BYTES) != hipSuccess) { fprintf(stderr, "kernel_launch: hipFuncSetAttribute failed\n"); grid = -1; return; }
        if (hipOccupancyMaxActiveBlocksPerMultiprocessor(&per_cu, (const void*)mega, 512, LDS_BYTES) != hipSuccess || per_cu < 1) { fprintf(stderr, "kernel_launch: occupancy query says %d\n", per_cu); per_cu = 1; }
        (void)hipGetLastError();
        grid = cus * 1;
    }
    if (grid < 0) return;
    Params p{};
    p.x = (const float*)d_in[0]; p.c = (const float*)d_in[1]; p.pos = (const int*)d_in[2]; p.w_ada = (const float*)d_in[3]; p.b_ada = (const float*)d_in[4]; p.g_pre_mix = (const float*)d_in[5];
    p.w_in = (const float*)d_in[6]; p.ret_gain = (const float*)d_in[7]; p.w_ret_out = (const float*)d_in[8]; p.w_att_out = (const float*)d_in[9]; p.w_gate = (const float*)d_in[10]; p.b_gate = (const float*)d_in[11];
    p.w_mix = (const float*)d_in[12]; p.g_post_mix = (const float*)d_in[13]; p.g_pre_ffn = (const float*)d_in[14]; p.w_up = (const float*)d_in[15]; p.conv_w = (const float*)d_in[16]; p.conv_b = (const float*)d_in[17];
    p.w_down = (const float*)d_in[18]; p.g_post_ffn = (const float*)d_in[19];
    p.out = (float*)d_out; p.ws = (unsigned char*)d_ws;
    if (hipMemsetAsync((char*)d_ws + WS_BAR, 0, 1024, stream) != hipSuccess) { fprintf(stderr, "kernel_launch: memset failed\n"); return; }
#if N_LAUNCH_PER_PHASE
    for (int ph = 0; ph < N_PHASES; ++ph) { p.ph_lo = ph; p.ph_hi = ph + 1; hipLaunchKernelGGL(mega, dim3(grid), dim3(512), LDS_BYTES, stream, p); }
#else
    p.ph_lo = 0; p.ph_hi = N_PHASES;
    void* args[] = {&p};
    hipError_t e = hipLaunchCooperativeKernel((const void*)mega, dim3(grid), dim3(512), args, LDS_BYTES, stream);
    if (e != hipSuccess) fprintf(stderr, "cooperative launch failed: %s (grid %d)\n", hipGetErrorString(e), grid);
#endif
}
```

```cpp
#include <hip/hip_runtime.h>
#include <hip/hip_cooperative_groups.h>
#include <cstdio>
#include <cstdint>
namespace cg = cooperative_groups;

#define DI __device__ __forceinline__
#define LAS __attribute__((address_space(3)))
typedef unsigned short bf16_t;
typedef short bf16x8 __attribute__((ext_vector_type(8)));
typedef short s16x4 __attribute__((ext_vector_type(4)));
typedef float f32x4 __attribute__((ext_vector_type(4)));
typedef unsigned u32x4 __attribute__((ext_vector_type(4)));
typedef unsigned u32x2 __attribute__((ext_vector_type(2)));

#ifndef PHMASK
#define PHMASK 0xFFFF
#endif
#ifndef N_LAUNCH_PER_PHASE
#define N_LAUNCH_PER_PHASE 0
#endif

constexpr int T_TOK = 32768, DM = 2048, SEQ = 8192, NB = 4;
constexpr int FF = 5632;
constexpr int LDS_BYTES = 139264;
constexpr size_t MiB = 1u << 20;
constexpr size_t WS_ADA = 0;
constexpr size_t WS_LSE = 1 * MiB;
constexpr size_t WS_RETSS = 4 * MiB;
constexpr size_t WS_WUP = 12 * MiB;
constexpr size_t WS_WDOWN = 56 * MiB;
constexpr size_t WS_WIN = 78 * MiB;
constexpr size_t WS_WGATE = 153 * MiB;
constexpr size_t WS_WRET = 169 * MiB;
constexpr size_t WS_WATT = 185 * MiB;
constexpr size_t WS_WMIX = 194 * MiB;
constexpr size_t WS_H = 206 * MiB;
constexpr size_t WS_RQ = 334 * MiB;
constexpr size_t WS_RK = 462 * MiB;
constexpr size_t WS_AQ = 590 * MiB;
constexpr size_t WS_AK = 734 * MiB;
constexpr size_t WS_AV = 878 * MiB;
constexpr size_t WS_GATES = 334 * MiB;
constexpr size_t WS_U = 734 * MiB;
constexpr size_t WS_U2 = 206 * MiB;
constexpr size_t WS_Y = 334 * MiB;
constexpr size_t WS_H2 = 78 * MiB;
constexpr size_t WS_A = 206 * MiB;
constexpr size_t WS_ACT = 558 * MiB;
constexpr size_t WS_Y2 = 78 * MiB;
constexpr size_t WS_END = 1022 * MiB;

struct Params {
    const float *x, *c; const int* pos;
    const float *w_ada, *b_ada, *g_pre_mix, *w_in, *ret_gain, *w_ret_out, *w_att_out, *w_gate, *b_gate, *w_mix, *g_post_mix, *g_pre_ffn, *w_up, *conv_w, *conv_b, *w_down, *g_post_ffn;
    float* out; unsigned char* ws; int ph_lo, ph_hi;
};

typedef __bf16 bf16x2_t __attribute__((ext_vector_type(2)));
DI unsigned cvt_pk_bf16(float lo, float hi) { bf16x2_t v = {(__bf16)lo, (__bf16)hi}; return __builtin_bit_cast(unsigned, v); }
DI float bflo(unsigned w) { return __uint_as_float(w << 16); }
DI float bfhi(unsigned w) { return __uint_as_float(w & 0xffff0000u); }
DI float wave_sum(float v) {
#pragma unroll
    for (int o = 1; o < 64; o <<= 1) v += __shfl_xor(v, o);
    return v;
}
DI float sigmoidf_(float v) { return __builtin_amdgcn_rcpf(1.0f + __builtin_amdgcn_exp2f(-1.4426950408889634f * v)); }
DI f32x4 mfma16(bf16x8 a, bf16x8 b, f32x4 c) { return __builtin_amdgcn_mfma_f32_16x16x32_bf16(a, b, c, 0, 0, 0); }
DI s16x4 tr_read(LAS unsigned char* p) { return __builtin_amdgcn_ds_read_tr16_b64_v4i16((LAS s16x4*)p); }
DI bf16x8 tr_read2(LAS unsigned char* p0, LAS unsigned char* p1) { s16x4 lo = tr_read(p0), hi = tr_read(p1); return __builtin_shufflevector(lo, hi, 0, 1, 2, 3, 4, 5, 6, 7); }

namespace pg8 {
constexpr int BM = 256, BK = 64, HALF = 128, HTB = HALF * BK * 2, STAGE_BYTES = 8 * HTB, NXCD = 8, WGM = 8;
DI int lds_byte(int r, int c) { const int st = (r >> 4) * 2 + (c >> 5), rr = r & 15, cc = c & 31, ob = rr * 64 + cc * 2; return st * 1024 + (ob ^ (((ob >> 9) & 1) << 5)); }
DI void stage_rc(int b, int& R, int& C) { const int st = b / 1024, sb = b % 1024, swz = sb ^ (((sb >> 9) & 1) << 5); R = (st >> 1) * 16 + swz / 64; C = (st & 1) * 32 + (swz % 64) / 2; }
struct Unit { int pm, pn; };
struct Gemm { const bf16_t* A; const bf16_t* Bt; int M, N, K; const bf16_t* A1; const bf16_t* Bt1; int K1; };
struct StaticOrder {
    int nM, nN, nwg, G, c, skip_lo, skip_n;
    DI void init(int M, int N, int G_, int c_, int slo = 1 << 30, int sn = 0) { nM = M / BM; nN = N / BM; nwg = nM * nN; G = G_; c = c_; skip_lo = slo; skip_n = sn; }
    DI bool next(int i, Unit& u) const {
        const long L = (long)i * G + c; if (L >= nwg) return false;
        int wgid = (int)L; { const int q = nwg / NXCD, r = nwg % NXCD, xcd = wgid % NXCD, off = wgid / NXCD; wgid = (xcd < r ? xcd * (q + 1) : r * (q + 1) + (xcd - r) * q) + off; }
        const int nig = WGM * nN, gid = wgid / nig, fm = gid * WGM, gsz = (nM - fm) < WGM ? (nM - fm) : WGM;
        u.pm = fm + ((wgid % nig) % gsz); u.pn = (wgid % nig) / gsz; if (u.pn >= skip_lo) u.pn += skip_n; return true;
    }
};

template <int NSEG, class Epi>
DI void gemm_phase(LAS unsigned char* lds, const Gemm g, const StaticOrder& S, const Epi& E) {
    const int tid = threadIdx.x, wid = __builtin_amdgcn_readfirstlane(tid >> 6), lane = tid & 63, wr = wid >> 2, wc = wid & 3, fr = lane & 15, fq = lane >> 4;
    int Rr[2], Cc[2];
#pragma unroll
    for (int i = 0; i < 2; ++i) stage_rc(tid * 16 + i * 8192, Rr[i], Cc[i]);
    const size_t kstep = (size_t)(BK * 2);
    const unsigned ldsw = (unsigned)wid * 1024u;
    const int aoff = lds_byte(wr * 64 + fr, fq * 8), boff = lds_byte(wc * 32 + fr, fq * 8);
#define PG8_SA(b, h) (((b) * 2 + (h)) * HTB)
#define PG8_SB(b, h) ((4 + (b) * 2 + (h)) * HTB)
#define PG8_STAGE(bufoff, gbase, VO) do { _Pragma("unroll") for (int _i = 0; _i < 2; ++_i) \
        __builtin_amdgcn_global_load_lds((const unsigned*)((const char*)(gbase) + VO[_i]), (LAS unsigned*)(lds + (bufoff) + ldsw + _i * 8192), 16, 0, 0); } while (0)
#define PG8_LDA(dst, b, h) do { _Pragma("unroll") for (int m = 0; m < 4; ++m) _Pragma("unroll") for (int k = 0; k < 2; ++k) dst[m][k] = *(const LAS bf16x8*)(lds + PG8_SA(b, h) + aoff + m * 2048 + k * 1024); } while (0)
#define PG8_LDB(dst, b, h) do { _Pragma("unroll") for (int n = 0; n < 2; ++n) _Pragma("unroll") for (int k = 0; k < 2; ++k) dst[n][k] = *(const LAS bf16x8*)(lds + PG8_SB(b, h) + boff + n * 2048 + k * 1024); } while (0)
#define PG8_MMA(ai, bj, At, Bt) do { __builtin_amdgcn_s_setprio(1); _Pragma("unroll") for (int m = 0; m < 4; ++m) _Pragma("unroll") for (int n = 0; n < 2; ++n) _Pragma("unroll") for (int k = 0; k < 2; ++k) \
        acc[ai][bj][m][n] = __builtin_amdgcn_mfma_f32_16x16x32_bf16(Bt[n][k], At[m][k], acc[ai][bj][m][n], 0, 0, 0); __builtin_amdgcn_s_setprio(0); } while (0)
#define PG8_WAIT_V(n) asm volatile("s_waitcnt vmcnt(" #n ")" ::: "memory")
#define PG8_WAIT_L(n) asm volatile("s_waitcnt lgkmcnt(" #n ")" ::: "memory")
#define PG8_BAR __builtin_amdgcn_s_barrier()
#define PG8_SCHED __builtin_amdgcn_sched_barrier(0)
    Unit cur, nxt; int ti = 0, seg = 0;
    if (!S.next(0, cur)) return;
    f32x4 acc[2][2][4][2];
#pragma unroll
    for (int a = 0; a < 2; ++a)
#pragma unroll
        for (int b = 0; b < 2; ++b)
#pragma unroll
            for (int m = 0; m < 4; ++m)
#pragma unroll
                for (int n = 0; n < 2; ++n) acc[a][b][m][n] = (f32x4){0.f, 0.f, 0.f, 0.f};
    bf16x8 At[4][2], B0[2][2], B1[2][2];
    int Kc = g.K;
    unsigned voffC[2];
#pragma unroll
    for (int i = 0; i < 2; ++i) voffC[i] = (unsigned)(Rr[i] * Kc + Cc[i]) * 2u;
    size_t hstepC = (size_t)HALF * Kc * 2;
    const char* cA = (const char*)g.A + (size_t)cur.pm * 2 * hstepC; const char* cB = (const char*)g.Bt + (size_t)cur.pn * 2 * hstepC;
    PG8_STAGE(PG8_SB(0, 0), cB, voffC); PG8_STAGE(PG8_SA(0, 0), cA, voffC); PG8_STAGE(PG8_SB(0, 1), cB + hstepC, voffC); PG8_STAGE(PG8_SA(0, 1), cA + hstepC, voffC);
    if (wr == 1) PG8_BAR;
    PG8_WAIT_V(4); PG8_BAR;
    PG8_STAGE(PG8_SB(1, 0), cB + kstep, voffC); PG8_STAGE(PG8_SA(1, 0), cA + kstep, voffC); PG8_STAGE(PG8_SB(1, 1), cB + hstepC + kstep, voffC);
    PG8_WAIT_V(6); PG8_BAR;
    for (;;) {
        bool has_next; int nseg = 0;
        if (NSEG > 1 && seg + 1 < NSEG) { has_next = true; nxt = cur; nseg = seg + 1; }
        else has_next = S.next(ti + 1, nxt);
        int Kn = Kc; const char* nA = cA; const char* nB = cB;
        if (has_next) { Kn = (NSEG > 1 && nseg == 1) ? g.K1 : g.K;
            nA = (const char*)((NSEG > 1 && nseg == 1) ? g.A1 : g.A) + (size_t)nxt.pm * 256 * Kn * 2; nB = (const char*)((NSEG > 1 && nseg == 1) ? g.Bt1 : g.Bt) + (size_t)nxt.pn * 256 * Kn * 2; }
        unsigned voffN[2];
#pragma unroll
        for (int i = 0; i < 2; ++i) voffN[i] = (NSEG > 1) ? (unsigned)(Rr[i] * Kn + Cc[i]) * 2u : voffC[i];
        const size_t hstepN = (NSEG > 1) ? (size_t)HALF * Kn * 2 : hstepC;
        const int nt = Kc / BK;
        for (int t = 0; t < nt; t += 2) {
            const bool last = (t == nt - 2);
            const char* a1 = cA + (size_t)(t + 1) * kstep;
            const char* a2 = last ? nA : cA + (size_t)(t + 2) * kstep; const char* b2 = last ? nB : cB + (size_t)(t + 2) * kstep;
            const char* a3 = a2 + kstep; const char* b3 = b2 + kstep;
            unsigned v2[2]; v2[0] = (NSEG > 1 && last) ? voffN[0] : voffC[0]; v2[1] = (NSEG > 1 && last) ? voffN[1] : voffC[1];
            const size_t h2 = (NSEG > 1 && last) ? hstepN : hstepC;
            PG8_LDB(B0, 0, 0); PG8_SCHED; PG8_LDA(At, 0, 0); PG8_STAGE(PG8_SA(1, 1), a1 + hstepC, voffC);
            PG8_WAIT_L(8); PG8_BAR; PG8_WAIT_L(0); PG8_MMA(0, 0, At, B0); PG8_BAR; PG8_SCHED;
            PG8_LDB(B1, 0, 1); PG8_STAGE(PG8_SB(0, 0), b2, v2);
            PG8_BAR; PG8_WAIT_L(0); PG8_MMA(0, 1, At, B1); PG8_BAR;
            PG8_LDA(At, 0, 1); PG8_STAGE(PG8_SA(0, 0), a2, v2);
            PG8_BAR; PG8_WAIT_L(0); PG8_MMA(1, 0, At, B0); PG8_BAR; PG8_SCHED;
            PG8_STAGE(PG8_SB(0, 1), b2 + h2, v2);
            PG8_WAIT_V(6); PG8_BAR; PG8_MMA(1, 1, At, B1); PG8_BAR;
            PG8_LDB(B0, 1, 0); PG8_SCHED; PG8_LDA(At, 1, 0); PG8_STAGE(PG8_SA(0, 1), a2 + h2, v2);
            PG8_WAIT_L(8); PG8_BAR; PG8_WAIT_L(0); PG8_MMA(0, 0, At, B0); PG8_BAR; PG8_SCHED;
            PG8_LDB(B1, 1, 1); PG8_STAGE(PG8_SB(1, 0), b3, v2);
            PG8_BAR; PG8_WAIT_L(0); PG8_MMA(0, 1, At, B1); PG8_BAR;
            PG8_LDA(At, 1, 1); PG8_STAGE(PG8_SA(1, 0), a3, v2);
            PG8_BAR; PG8_WAIT_L(0); PG8_MMA(1, 0, At, B0); PG8_BAR; PG8_SCHED;
            PG8_STAGE(PG8_SB(1, 1), b3 + h2, v2);
            PG8_WAIT_V(6); PG8_BAR; PG8_MMA(1, 1, At, B1); PG8_BAR;
        }
        if constexpr (NSEG > 1) { if (seg + 1 < NSEG) E.mid(acc, cur, wr, wc, fr, fq); else E(acc, cur, wr, wc, fr, fq); }
        else E(acc, cur, wr, wc, fr, fq);
        if (!has_next) break;
        if (NSEG == 1 || nseg == 0) {
#pragma unroll
            for (int a = 0; a < 2; ++a)
#pragma unroll
                for (int b = 0; b < 2; ++b)
#pragma unroll
                    for (int m = 0; m < 4; ++m)
#pragma unroll
                        for (int n = 0; n < 2; ++n) acc[a][b][m][n] = (f32x4){0.f, 0.f, 0.f, 0.f};
            ++ti;
        }
        cur = nxt; cA = nA; cB = nB; seg = nseg;
        if (NSEG > 1) { Kc = Kn; voffC[0] = voffN[0]; voffC[1] = voffN[1]; hstepC = hstepN; }
    }
    PG8_WAIT_V(0);
    if (wr == 0) PG8_BAR;
    PG8_BAR;
#undef PG8_SA
#undef PG8_SB
#undef PG8_STAGE
#undef PG8_LDA
#undef PG8_LDB
#undef PG8_MMA
#undef PG8_WAIT_V
#undef PG8_WAIT_L
#undef PG8_BAR
#undef PG8_SCHED
}
}
using pg8::Unit;
typedef f32x4 AccT[2][2][4][2];

DI u32x4 pack8(const f32x4& v0, const f32x4& v1) { u32x4 w; w.x = cvt_pk_bf16(v0[0], v0[1]); w.y = cvt_pk_bf16(v0[2], v0[3]); w.z = cvt_pk_bf16(v1[0], v1[1]); w.w = cvt_pk_bf16(v1[2], v1[3]); return w; }

struct EpiStoreBf16 {
    bf16_t* O; int ld;
    DI void operator()(const AccT& acc, const Unit& u, int wr, int wc, int fr, int fq) const {
        const int row0 = u.pm * 256 + wr * 64 + fr, col0 = u.pn * 256 + wc * 32 + 8 * fq;
#pragma unroll
        for (int ai = 0; ai < 2; ++ai)
#pragma unroll
            for (int m = 0; m < 4; ++m) { bf16_t* rowp = O + (size_t)(row0 + ai * 128 + m * 16) * ld + col0;
#pragma unroll
                for (int bj = 0; bj < 2; ++bj) *(u32x4*)(rowp + bj * 128) = pack8(acc[ai][bj][m][0], acc[ai][bj][m][1]); }
    }
};

template <int HD>
DI void rope_store(const AccT& acc, int rowbase, const int* pos, bf16_t* dst, int ld, int c1, int half, int ibase, float scale) {
    int pi[2][4];
#pragma unroll
    for (int ai = 0; ai < 2; ++ai)
#pragma unroll
        for (int m = 0; m < 4; ++m) pi[ai][m] = pos[rowbase + ai * 128 + m * 16];
    float invf[2][4];
#pragma unroll
    for (int n = 0; n < 2; ++n)
#pragma unroll
        for (int j = 0; j < 4; ++j) invf[n][j] = exp2f(-(float)(ibase + 4 * n + j) * (2.0f / HD) * 13.287712379549449f);
#pragma unroll
    for (int ai = 0; ai < 2; ++ai)
#pragma unroll
        for (int m = 0; m < 4; ++m) {
            const int row = rowbase + ai * 128 + m * 16; const float ps = (float)pi[ai][m];
            f32x4 o1[2], o2[2];
#pragma unroll
            for (int n = 0; n < 2; ++n)
#pragma unroll
                for (int j = 0; j < 4; ++j) {
                    const float ang = ps * invf[n][j]; const float rev = __builtin_amdgcn_fractf(ang * 0.15915494309189535f);
                    const float sn = __builtin_amdgcn_sinf(rev), cs = __builtin_amdgcn_cosf(rev);
                    const float t1 = acc[ai][0][m][n][j], t2 = acc[ai][1][m][n][j];
                    o1[n][j] = (t1 * cs - t2 * sn) * scale; o2[n][j] = (t2 * cs + t1 * sn) * scale;
                }
            bf16_t* rowp = dst + (size_t)row * ld + c1;
            *(u32x4*)rowp = pack8(o1[0], o1[1]); *(u32x4*)(rowp + half) = pack8(o2[0], o2[1]);
        }
}

struct EpiInProj {
    bf16_t *rq, *rk, *rv, *aq, *ak, *av; const int* pos;
    DI void operator()(const AccT& acc, const Unit& u, int wr, int wc, int fr, int fq) const {
        const int pn = u.pn, rowbase = u.pm * 256 + wr * 64 + fr;
        if (pn < 16) {
            bf16_t* dst = pn < 8 ? rq : rk; const float scale = pn < 8 ? 1.0f : 0.0625f;
            rope_store<256>(acc, rowbase, pos, dst, 2048, 256 * (pn & 7) + 32 * wc + 8 * fq, 128, 32 * wc + 8 * fq, scale);
        } else if (pn < 32) {
            const int col0 = (pn - 16) * 256 + wc * 32 + 8 * fq;
#pragma unroll
            for (int ai = 0; ai < 2; ++ai)
#pragma unroll
                for (int m = 0; m < 4; ++m) { bf16_t* rowp = rv + (size_t)(rowbase + ai * 128 + m * 16) * 4096 + col0;
#pragma unroll
                    for (int bj = 0; bj < 2; ++bj) *(u32x4*)(rowp + bj * 128) = pack8(acc[ai][bj][m][0], acc[ai][bj][m][1]); }
        } else if (pn < 66) {
            const int q9 = pn - 48; bf16_t* dst = q9 < 9 ? aq : ak; const int t9 = q9 < 9 ? q9 : q9 - 9;
            const int head = 2 * t9 + (wc >> 1), ib = 32 * (wc & 1) + 8 * fq;
            rope_store<128>(acc, rowbase, pos, dst, 2304, head * 128 + ib, 64, ib, 1.0f);
        } else {
            const int col0 = (pn - 66) * 256 + wc * 32 + 8 * fq;
#pragma unroll
            for (int ai = 0; ai < 2; ++ai)
#pragma unroll
                for (int m = 0; m < 4; ++m) { bf16_t* rowp = av + (size_t)(rowbase + ai * 128 + m * 16) * 2304 + col0;
#pragma unroll
                    for (int bj = 0; bj < 2; ++bj) *(u32x4*)(rowp + bj * 128) = pack8(acc[ai][bj][m][0], acc[ai][bj][m][1]); }
        }
    }
};

struct EpiRetGate {
    bf16_t* ret; const float* retss; const float* gain;
    DI void operator()(const AccT& acc, const Unit& u, int wr, int wc, int fr, int fq) const {
        const int rowbase = u.pm * 256 + wr * 64 + fr, head = u.pn >> 1, colb = u.pn * 256 + wc * 32 + 8 * fq;
        f32x4 gn[2][2];
#pragma unroll
        for (int bj = 0; bj < 2; ++bj) { gn[bj][0] = *(const f32x4*)(gain + colb + bj * 128); gn[bj][1] = *(const f32x4*)(gain + colb + bj * 128 + 4); }
#pragma unroll
        for (int ai = 0; ai < 2; ++ai) {
            f32x4 sA[4], sB[4]; u32x4 rr[4][2];
#pragma unroll
            for (int m = 0; m < 4; ++m) { const float* ps = retss + ((size_t)(rowbase + ai * 128 + m * 16) * 8 + head) * 8; sA[m] = *(const f32x4*)ps; sB[m] = *(const f32x4*)(ps + 4); }
#pragma unroll
            for (int m = 0; m < 4; ++m)
#pragma unroll
                for (int bj = 0; bj < 2; ++bj) rr[m][bj] = *(const u32x4*)(ret + (size_t)(rowbase + ai * 128 + m * 16) * 4096 + colb + bj * 128);
#pragma unroll
            for (int m = 0; m < 4; ++m) {
                const f32x4 s0 = sA[m], s1 = sB[m];
                const float rsv = __builtin_amdgcn_rsqf((((s0[0] + s0[1]) + (s0[2] + s0[3])) + ((s1[0] + s1[1]) + (s1[2] + s1[3]))) * (1.0f / 512.0f) + 1e-6f);
#pragma unroll
                for (int bj = 0; bj < 2; ++bj) {
                    const u32x4 r4 = rr[m][bj];
                    const float rf[8] = {bflo(r4.x), bfhi(r4.x), bflo(r4.y), bfhi(r4.y), bflo(r4.z), bfhi(r4.z), bflo(r4.w), bfhi(r4.w)};
                    f32x4 o0, o1;
#pragma unroll
                    for (int j = 0; j < 4; ++j) {
                        const float a0 = acc[ai][bj][m][0][j], a1 = acc[ai][bj][m][1][j];
                        o0[j] = a0 * sigmoidf_(a0) * (rf[j] * rsv * gn[bj][0][j]); o1[j] = a1 * sigmoidf_(a1) * (rf[4 + j] * rsv * gn[bj][1][j]);
                    }
                    *(u32x4*)(ret + (size_t)(rowbase + ai * 128 + m * 16) * 4096 + colb + bj * 128) = pack8(o0, o1);
                }
            }
        }
    }
};

struct EpiGates {
    bf16_t* O; const float* bias;
    DI void operator()(const AccT& acc, const Unit& u, int wr, int wc, int fr, int fq) const {
        const int rowbase = u.pm * 256 + wr * 64 + fr;
#pragma unroll
        for (int bj = 0; bj < 2; ++bj) {
            const int col = u.pn * 256 + bj * 128 + wc * 32 + 8 * fq;
            const f32x4 b0 = *(const f32x4*)(bias + col), b1 = *(const f32x4*)(bias + col + 4);
#pragma unroll
            for (int ai = 0; ai < 2; ++ai)
#pragma unroll
                for (int m = 0; m < 4; ++m) {
                    f32x4 o0, o1;
#pragma unroll
                    for (int j = 0; j < 4; ++j) { o0[j] = sigmoidf_(acc[ai][bj][m][0][j] + b0[j]); o1[j] = sigmoidf_(acc[ai][bj][m][1][j] + b1[j]); }
                    *(u32x4*)(O + (size_t)(rowbase + ai * 128 + m * 16) * 4096 + col) = pack8(o0, o1);
                }
        }
    }
};

struct EpiYMerge {
    const bf16_t* gates; bf16_t* U2;
    DI void mid(AccT& acc, const Unit& u, int wr, int wc, int fr, int fq) const {
        const int rowbase = u.pm * 256 + wr * 64 + fr, colb = u.pn * 256 + wc * 32 + 8 * fq;
#pragma unroll
        for (int ai = 0; ai < 2; ++ai) {
            u32x4 gr[4][2], ga[4][2];
#pragma unroll
            for (int m = 0; m < 4; ++m)
#pragma unroll
                for (int bj = 0; bj < 2; ++bj) { const bf16_t* pg = gates + (size_t)(rowbase + ai * 128 + m * 16) * 4096 + colb + bj * 128; gr[m][bj] = *(const u32x4*)pg; ga[m][bj] = *(const u32x4*)(pg + 2048); }
#pragma unroll
            for (int m = 0; m < 4; ++m)
#pragma unroll
                for (int bj = 0; bj < 2; ++bj) {
                    const u32x4 g1 = gr[m][bj], g2 = ga[m][bj];
                    const float r[8] = {bflo(g1.x), bfhi(g1.x), bflo(g1.y), bfhi(g1.y), bflo(g1.z), bfhi(g1.z), bflo(g1.w), bfhi(g1.w)};
                    const float a[8] = {bflo(g2.x), bfhi(g2.x), bflo(g2.y), bfhi(g2.y), bflo(g2.z), bfhi(g2.z), bflo(g2.w), bfhi(g2.w)};
#pragma unroll
                    for (int j = 0; j < 4; ++j) { acc[ai][bj][m][0][j] *= r[j] * __builtin_amdgcn_rcpf(fmaxf(a[j], 1e-30f)); acc[ai][bj][m][1][j] *= r[4 + j] * __builtin_amdgcn_rcpf(fmaxf(a[4 + j], 1e-30f)); }
                }
        }
    }
    DI void operator()(const AccT& acc, const Unit& u, int wr, int wc, int fr, int fq) const {
        const int rowbase = u.pm * 256 + wr * 64 + fr, colb = u.pn * 256 + wc * 32 + 8 * fq;
        u32x4 gg[2][4][2];
#pragma unroll
        for (int ai = 0; ai < 2; ++ai)
#pragma unroll
            for (int m = 0; m < 4; ++m)
#pragma unroll
                for (int bj = 0; bj < 2; ++bj) gg[ai][m][bj] = *(const u32x4*)(gates + (size_t)(rowbase + ai * 128 + m * 16) * 4096 + 2048 + colb + bj * 128);
#pragma unroll
        for (int ai = 0; ai < 2; ++ai)
#pragma unroll
            for (int m = 0; m < 4; ++m)
#pragma unroll
                for (int bj = 0; bj < 2; ++bj) {
                    const u32x4 g4 = gg[ai][m][bj];
                    f32x4 o0 = acc[ai][bj][m][0], o1 = acc[ai][bj][m][1];
                    o0[0] *= bflo(g4.x); o0[1] *= bfhi(g4.x); o0[2] *= bflo(g4.y); o0[3] *= bfhi(g4.y);
                    o1[0] *= bflo(g4.z); o1[1] *= bfhi(g4.z); o1[2] *= bflo(g4.w); o1[3] *= bfhi(g4.w);
                    *(u32x4*)(U2 + (size_t)(rowbase + ai * 128 + m * 16) * 2048 + colb + bj * 128) = pack8(o0, o1);
                }
    }
};

DI float gelu_tanh(float v) {
    const float uu = 0.7978845608028654f * (v + 0.044715f * v * v * v);
    const float e = __builtin_amdgcn_exp2f(2.8853900817779268f * uu);
    return v - v * __builtin_amdgcn_rcpf(e + 1.0f);
}
struct EpiConvAct {
    const bf16_t* A; bf16_t* ACT; const float* conv_w; const float* conv_b;
    DI void operator()(const AccT& acc, const Unit& u, int wr, int wc, int fr, int fq) const {
        const int rowbase = u.pm * 256 + wr * 64 + fr;
#pragma unroll
        for (int bj = 0; bj < 2; ++bj) {
            const int col = u.pn * 256 + bj * 128 + wc * 32 + 8 * fq;
            f32x4 w0[2], w1[2], w2[2], cb[2];
#pragma unroll
            for (int hh = 0; hh < 2; ++hh) { w0[hh] = *(const f32x4*)(conv_w + col + 4 * hh); w1[hh] = *(const f32x4*)(conv_w + FF + col + 4 * hh); w2[hh] = *(const f32x4*)(conv_w + 2 * FF + col + 4 * hh); cb[hh] = *(const f32x4*)(conv_b + col + 4 * hh); }
#pragma unroll
            for (int aim = 0; aim < 4; ++aim) { const int ai = aim >> 1, mb = (aim & 1) * 2;
                u32x4 a0[4], a1[4], a2[4];
#pragma unroll
                for (int m = mb; m < mb + 2; ++m) {
                    const int row = rowbase + ai * 128 + m * 16; const int sq = row & (SEQ - 1);
                    const bf16_t* pa = A + (size_t)row * FF + col;
                    a0[m] = *(const u32x4*)pa;
                    a1[m] = *(const u32x4*)(pa - (sq >= 1 ? FF : 0));
                    a2[m] = *(const u32x4*)(pa - (sq >= 2 ? 2 * FF : 0));
                }
#pragma unroll
                for (int m = mb; m < mb + 2; ++m) {
                    const int row = rowbase + ai * 128 + m * 16; const int sq = row & (SEQ - 1);
                    const float k1 = sq >= 1 ? 1.0f : 0.0f, k2 = sq >= 2 ? 1.0f : 0.0f;
                    const u32x4 x0 = a0[m], x1 = a1[m], x2 = a2[m];
                    const float f0[8] = {bflo(x0.x), bfhi(x0.x), bflo(x0.y), bfhi(x0.y), bflo(x0.z), bfhi(x0.z), bflo(x0.w), bfhi(x0.w)};
                    const float f1[8] = {bflo(x1.x), bfhi(x1.x), bflo(x1.y), bfhi(x1.y), bflo(x1.z), bfhi(x1.z), bflo(x1.w), bfhi(x1.w)};
                    const float f2[8] = {bflo(x2.x), bfhi(x2.x), bflo(x2.y), bfhi(x2.y), bflo(x2.z), bfhi(x2.z), bflo(x2.w), bfhi(x2.w)};
                    f32x4 o0, o1;
#pragma unroll
                    for (int j = 0; j < 4; ++j) {
                        const float c0 = cb[0][j] + w0[0][j] * f0[j] + k1 * (w1[0][j] * f1[j]) + k2 * (w2[0][j] * f2[j]);
                        const float c1 = cb[1][j] + w0[1][j] * f0[4 + j] + k1 * (w1[1][j] * f1[4 + j]) + k2 * (w2[1][j] * f2[4 + j]);
                        o0[j] = gelu_tanh(c0) * acc[ai][bj][m][0][j]; o1[j] = gelu_tanh(c1) * acc[ai][bj][m][1][j];
                    }
                    *(u32x4*)(ACT + (size_t)row * FF + col) = pack8(o0, o1);
                }
            }
        }
    }
};

DI int invperm32(int c) { return 16 * ((c >> 2) & 1) + 4 * (c >> 3) + (c & 3); }
DI int slot_std(int c) { return (c & ~31) | invperm32(c & 31); }
DI int slot_win(int c) {
    if (c >= 12288 && c < 16896) { const int tc = c & 255, hh = tc >> 7, bj = (tc >> 6) & 1, i64 = tc & 63, x = 64 * hh + i64; return (c & ~255) + 128 * bj + (x & ~31) + invperm32(x & 31); }
    return slot_std(c);
}
DI void transpose_item(const float* W, int K, int N, bf16_t* WT, int mode, LAS float* scr, int item, int lane) {
    const int nblk = N / 32, kb = item / nblk, nb = item % nblk, k0 = 64 * kb, n0 = 32 * nb;
#pragma unroll 16
    for (int i = 0; i < 32; ++i) { const int kk = 2 * i + (lane >> 5); scr[kk * 33 + (lane & 31)] = W[(size_t)(k0 + kk) * N + n0 + (lane & 31)]; }
    asm volatile("s_waitcnt lgkmcnt(0)" ::: "memory");
    const int c = lane & 7;
#pragma unroll
    for (int j = 0; j < 4; ++j) { const int n = (lane >> 3) + 8 * j; const LAS float* s = scr + (8 * c) * 33 + n;
        u32x4 o; o.x = cvt_pk_bf16(s[0 * 33], s[1 * 33]); o.y = cvt_pk_bf16(s[2 * 33], s[3 * 33]); o.z = cvt_pk_bf16(s[4 * 33], s[5 * 33]); o.w = cvt_pk_bf16(s[6 * 33], s[7 * 33]);
        const int drow = mode ? slot_win(n0 + n) : slot_std(n0 + n);
        *(u32x4*)(WT + (size_t)drow * K + k0 + 8 * c) = o; }
    asm volatile("s_waitcnt lgkmcnt(0)" ::: "memory");
}

DI void phase0(const Params& p, LAS unsigned char* lds) {
    const int tid = threadIdx.x, lane = tid & 63, wave = tid >> 6;
    LAS float* sc = (LAS float*)lds;
    LAS float* red = sc + 8192;
    float* ada = (float*)(p.ws + WS_ADA);
    for (int i = tid; i < 8192; i += 512) { const float v = p.c[i]; sc[i] = v / (1.0f + __expf(-v)); }
    __syncthreads();
    for (int cb = blockIdx.x; cb < 256; cb += gridDim.x) {
        {
            const int rg = lane / 12, cq = lane - 12 * rg;
            f32x4 a0 = {0.f, 0.f, 0.f, 0.f}, a1 = a0, a2 = a0, a3 = a0;
            if (rg < 5) {
                const float* wp = p.w_ada + 48 * cb + 4 * cq;
#pragma unroll 13
                for (int i = 0; i < 52; ++i) { const int kl = 5 * i + rg; if (kl < 256) { const int kk = 256 * wave + kl; const f32x4 wv = *(const f32x4*)(wp + (size_t)kk * 12288);
                    a0 += sc[kk] * wv; a1 += sc[2048 + kk] * wv; a2 += sc[4096 + kk] * wv; a3 += sc[6144 + kk] * wv; } }
                LAS float* rp = red + ((wave * 5 + rg) * 4) * 48 + 4 * cq;
                *(LAS f32x4*)(rp) = a0; *(LAS f32x4*)(rp + 48) = a1; *(LAS f32x4*)(rp + 96) = a2; *(LAS f32x4*)(rp + 144) = a3;
            }
        }
        __syncthreads();
        if (tid < 192) { const int b = tid / 48, l = tid % 48; float sacc = 0.f;
#pragma unroll 8
            for (int wg = 0; wg < 40; ++wg) sacc += red[(wg * 4 + b) * 48 + l];
            ada[b * 12288 + 48 * cb + l] = sacc + p.b_ada[48 * cb + l]; }
        __syncthreads();
    }
    LAS float* scr = (LAS float*)(lds + 40960 + wave * 8448);
    const int gw = blockIdx.x * 8 + wave, NGW = gridDim.x * 8;
    constexpr int I_IN = (2048 / 64) * (19200 / 32), I_GATE = (2048 / 64) * (4096 / 32), I_RET = (4096 / 64) * (2048 / 32), I_ATT = (2304 / 64) * (2048 / 32),
                  I_MIX = (2048 / 64) * (2048 / 32), I_UP = (2048 / 64) * (11264 / 32), I_DOWN = (5632 / 64) * (2048 / 32);
    constexpr int NITEMS = I_IN + I_GATE + I_RET + I_ATT + I_MIX + I_UP + I_DOWN;
    for (int it = gw; it < NITEMS; it += NGW) {
        int r = it;
        if (r < I_IN) { transpose_item(p.w_in, 2048, 19200, (bf16_t*)(p.ws + WS_WIN), 1, scr, r, lane); continue; } r -= I_IN;
        if (r < I_GATE) { transpose_item(p.w_gate, 2048, 4096, (bf16_t*)(p.ws + WS_WGATE), 0, scr, r, lane); continue; } r -= I_GATE;
        if (r < I_RET) { transpose_item(p.w_ret_out, 4096, 2048, (bf16_t*)(p.ws + WS_WRET), 0, scr, r, lane); continue; } r -= I_RET;
        if (r < I_ATT) { transpose_item(p.w_att_out, 2304, 2048, (bf16_t*)(p.ws + WS_WATT), 0, scr, r, lane); continue; } r -= I_ATT;
        if (r < I_MIX) { transpose_item(p.w_mix, 2048, 2048, (bf16_t*)(p.ws + WS_WMIX), 0, scr, r, lane); continue; } r -= I_MIX;
        if (r < I_UP) { transpose_item(p.w_up, 2048, 11264, (bf16_t*)(p.ws + WS_WUP), 0, scr, r, lane); continue; } r -= I_UP;
        transpose_item(p.w_down, 5632, 2048, (bf16_t*)(p.ws + WS_WDOWN), 0, scr, r, lane);
    }
}

constexpr int NR = 2;
DI void phase_h(const Params& p) {
    const int lane = threadIdx.x & 63, wave = threadIdx.x >> 6;
    const float* ada = (const float*)(p.ws + WS_ADA); bf16_t* H = (bf16_t*)(p.ws + WS_H);
    const int nw = gridDim.x * 8;
    for (int row0 = blockIdx.x * 8 + wave; row0 < T_TOK; row0 += nw * NR) {
        f32x4 v[NR][4][2]; float ss[NR];
#pragma unroll
        for (int q = 0; q < NR; ++q) { const float* xr = p.x + (size_t)(row0 + q * nw) * DM; ss[q] = 0.f;
#pragma unroll
            for (int it = 0; it < 4; ++it) { const int col = (it * 64 + lane) * 8; v[q][it][0] = *(const f32x4*)(xr + col); v[q][it][1] = *(const f32x4*)(xr + col + 4); } }
#pragma unroll
        for (int q = 0; q < NR; ++q) {
#pragma unroll
            for (int it = 0; it < 4; ++it)
#pragma unroll
                for (int j = 0; j < 4; ++j) ss[q] += v[q][it][0][j] * v[q][it][0][j] + v[q][it][1][j] * v[q][it][1][j];
            ss[q] = __builtin_amdgcn_rsqf(wave_sum(ss[q]) * (1.0f / DM) + 1e-6f); }
#pragma unroll
        for (int it = 0; it < 4; ++it) { const int col = (it * 64 + lane) * 8;
            f32x4 g[2], sh[NR][2], scl[NR][2];
#pragma unroll
            for (int hh = 0; hh < 2; ++hh) { g[hh] = *(const f32x4*)(p.g_pre_mix + col + 4 * hh);
#pragma unroll
                for (int q = 0; q < NR; ++q) { const int b = (row0 + q * nw) / SEQ; sh[q][hh] = *(const f32x4*)(ada + b * 12288 + col + 4 * hh); scl[q][hh] = *(const f32x4*)(ada + b * 12288 + 2048 + col + 4 * hh); } }
#pragma unroll
            for (int q = 0; q < NR; ++q) { f32x4 o[2];
#pragma unroll
                for (int hh = 0; hh < 2; ++hh)
#pragma unroll
                    for (int j = 0; j < 4; ++j) o[hh][j] = v[q][it][hh][j] * ss[q] * g[hh][j] * (1.0f + scl[q][hh][j]) + sh[q][hh][j];
                *(u32x4*)(H + (size_t)(row0 + q * nw) * DM + col) = pack8(o[0], o[1]); } }
    }
}

DI void phase_postmix(const Params& p) {
    const int lane = threadIdx.x & 63, wave = threadIdx.x >> 6;
    const float* ada = (const float*)(p.ws + WS_ADA); const bf16_t* Y = (const bf16_t*)(p.ws + WS_Y); bf16_t* H2 = (bf16_t*)(p.ws + WS_H2);
    const int nw = gridDim.x * 8;
    for (int row0 = blockIdx.x * 8 + wave; row0 < T_TOK; row0 += nw * NR) {
        f32x4 y[NR][4][2], xv[NR][4][2]; float ry[NR], r1[NR];
#pragma unroll
        for (int q = 0; q < NR; ++q) { const size_t ro = (size_t)(row0 + q * nw) * DM;
#pragma unroll
            for (int it = 0; it < 4; ++it) { const int col = (it * 64 + lane) * 8; const u32x4 w = *(const u32x4*)(Y + ro + col);
                y[q][it][0] = (f32x4){bflo(w.x), bfhi(w.x), bflo(w.y), bfhi(w.y)}; y[q][it][1] = (f32x4){bflo(w.z), bfhi(w.z), bflo(w.w), bfhi(w.w)};
                xv[q][it][0] = *(const f32x4*)(p.x + ro + col); xv[q][it][1] = *(const f32x4*)(p.x + ro + col + 4); } }
#pragma unroll
        for (int q = 0; q < NR; ++q) { float ss = 0.f;
#pragma unroll
            for (int it = 0; it < 4; ++it)
#pragma unroll
                for (int j = 0; j < 4; ++j) ss += y[q][it][0][j] * y[q][it][0][j] + y[q][it][1][j] * y[q][it][1][j];
            ry[q] = __builtin_amdgcn_rsqf(wave_sum(ss) * (1.0f / DM) + 1e-6f); }
#pragma unroll
        for (int q = 0; q < NR; ++q) { const int row = row0 + q * nw; const float* ab = ada + (row / SEQ) * 12288; float s1 = 0.f;
#pragma unroll
            for (int it = 0; it < 4; ++it) { const int col = (it * 64 + lane) * 8;
#pragma unroll
                for (int hh = 0; hh < 2; ++hh) { const f32x4 g = *(const f32x4*)(p.g_post_mix + col + 4 * hh), gt = *(const f32x4*)(ab + 4096 + col + 4 * hh);
                    f32x4 o;
#pragma unroll
                    for (int j = 0; j < 4; ++j) { o[j] = xv[q][it][hh][j] + gt[j] * (y[q][it][hh][j] * ry[q] * g[j]); s1 += o[j] * o[j]; }
                    y[q][it][hh] = o; *(f32x4*)(p.out + (size_t)row * DM + col + 4 * hh) = o; } }
            r1[q] = __builtin_amdgcn_rsqf(wave_sum(s1) * (1.0f / DM) + 1e-6f); }
#pragma unroll
        for (int q = 0; q < NR; ++q) { const int row = row0 + q * nw; const float* ab = ada + (row / SEQ) * 12288;
#pragma unroll
            for (int it = 0; it < 4; ++it) { const int col = (it * 64 + lane) * 8; f32x4 o[2];
#pragma unroll
                for (int hh = 0; hh < 2; ++hh) { const f32x4 g = *(const f32x4*)(p.g_pre_ffn + col + 4 * hh), sh = *(const f32x4*)(ab + 6144 + col + 4 * hh), scl = *(const f32x4*)(ab + 8192 + col + 4 * hh);
#pragma unroll
                    for (int j = 0; j < 4; ++j) o[hh][j] = y[q][it][hh][j] * r1[q] * g[j] * (1.0f + scl[j]) + sh[j]; }
                *(u32x4*)(H2 + (size_t)row * DM + col) = pack8(o[0], o[1]); } }
    }
}

DI void phase_final(const Params& p) {
    const int lane = threadIdx.x & 63, wave = threadIdx.x >> 6;
    const float* ada = (const float*)(p.ws + WS_ADA); const bf16_t* Y = (const bf16_t*)(p.ws + WS_Y2);
    const int nw = gridDim.x * 8;
    for (int row0 = blockIdx.x * 8 + wave; row0 < T_TOK; row0 += nw * NR) {
        f32x4 y[NR][4][2], xv[NR][4][2]; float ry[NR];
#pragma unroll
        for (int q = 0; q < NR; ++q) { const size_t ro = (size_t)(row0 + q * nw) * DM;
#pragma unroll
            for (int it = 0; it < 4; ++it) { const int col = (it * 64 + lane) * 8; const u32x4 w = *(const u32x4*)(Y + ro + col);
                y[q][it][0] = (f32x4){bflo(w.x), bfhi(w.x), bflo(w.y), bfhi(w.y)}; y[q][it][1] = (f32x4){bflo(w.z), bfhi(w.z), bflo(w.w), bfhi(w.w)};
                xv[q][it][0] = *(const f32x4*)(p.out + ro + col); xv[q][it][1] = *(const f32x4*)(p.out + ro + col + 4); } }
#pragma unroll
        for (int q = 0; q < NR; ++q) { float ss = 0.f;
#pragma unroll
            for (int it = 0; it < 4; ++it)
#pragma unroll
                for (int j = 0; j < 4; ++j) ss += y[q][it][0][j] * y[q][it][0][j] + y[q][it][1][j] * y[q][it][1][j];
            ry[q] = __builtin_amdgcn_rsqf(wave_sum(ss) * (1.0f / DM) + 1e-6f); }
#pragma unroll
        for (int q = 0; q < NR; ++q) { const int row = row0 + q * nw; const float* ab = ada + (row / SEQ) * 12288;
#pragma unroll
            for (int it = 0; it < 4; ++it) { const int col = (it * 64 + lane) * 8;
#pragma unroll
                for (int hh = 0; hh < 2; ++hh) { const f32x4 g = *(const f32x4*)(p.g_post_ffn + col + 4 * hh), gt = *(const f32x4*)(ab + 10240 + col + 4 * hh);
                    f32x4 o;
#pragma unroll
                    for (int j = 0; j < 4; ++j) o[j] = xv[q][it][hh][j] + gt[j] * (y[q][it][hh][j] * ry[q] * g[j]);
                    *(f32x4*)(p.out + (size_t)row * DM + col + 4 * hh) = o; } } }
    }
}

DI void phase_alpha(const Params& p) {
    bf16_t* att = (bf16_t*)(p.ws + WS_AQ); const float* lse = (const float*)(p.ws + WS_LSE);
    const int lane = threadIdx.x & 63, wave = threadIdx.x >> 6;
    for (int t = blockIdx.x * 8 + wave; t < T_TOK; t += gridDim.x * 8) {
        const float l = lse[(size_t)t * 18 + (lane < 18 ? lane : 0)];
        const int j = lane % 6;
        const float l0 = __shfl(l, j), l1 = __shfl(l, 6 + j), l2 = __shfl(l, 12 + j);
        const float mm = fmaxf(l0, fmaxf(l1, l2)); const float e0 = __expf(l0 - mm), e1 = __expf(l1 - mm), e2 = __expf(l2 - mm);
        const float al_lane = __expf(l - mm) / (e0 + e1 + e2);
        u32x4* row = (u32x4*)(att + (size_t)t * 2304);
        u32x4 w[5];
#pragma unroll
        for (int k = 0; k < 5; ++k) { const int ch = lane + 64 * k; if (ch < 288) w[k] = row[ch]; }
#pragma unroll
        for (int k = 0; k < 5; ++k) { const int ch = lane + 64 * k; const float al = __shfl(al_lane, (ch < 288 ? ch : 0) >> 4);
            if (ch < 288) { u32x4 o;
                o.x = cvt_pk_bf16(bflo(w[k].x) * al, bfhi(w[k].x) * al); o.y = cvt_pk_bf16(bflo(w[k].y) * al, bfhi(w[k].y) * al);
                o.z = cvt_pk_bf16(bflo(w[k].z) * al, bfhi(w[k].z) * al); o.w = cvt_pk_bf16(bflo(w[k].w) * al, bfhi(w[k].w) * al);
                row[ch] = o; } }
    }
}

DI void phase_retention(const Params& p, LAS unsigned char* lds, int cblk) {
    const int tid = threadIdx.x, lane = tid & 63, w = tid >> 6, fr = lane & 15, fq = lane >> 4;
    LAS unsigned char* Qs = lds; LAS unsigned char* Ks = lds + 33792; LAS unsigned char* Vs = lds + 67584; LAS unsigned char* St = lds + 76800; LAS unsigned char* Ps = lds + 110592;
    LAS float* red = (LAS float*)(lds + 119808);
    const bf16_t* rq = (const bf16_t*)(p.ws + WS_RQ); const bf16_t* rk = (const bf16_t*)(p.ws + WS_RK); bf16_t* rv = (bf16_t*)p.out; float* retss = (float*)(p.ws + WS_RETSS);
    for (int item = cblk; item < 256; item += gridDim.x) {
        const int q5 = item >> 3, bh = (item & 7) * 4 + (q5 & 3), slice = q5 >> 2, b = bh >> 3, h = bh & 7;
        const float lg = log1pf(-exp2f(-5.0f - (float)h));
        const float gamma_c = expf(64.0f * lg);
        const float xv = expf(-lg * (float)((tid >> 3) + 1));
        const float xo0 = expf(lg * (float)(32 * (w & 1) + fr + 1)), xo1 = expf(lg * (float)(32 * (w & 1) + 16 + fr + 1));
        const size_t tok0 = (size_t)b * SEQ;
        const bf16_t* qbase = rq + tok0 * 2048 + h * 256 + (tid & 31) * 8; const bf16_t* kbase = rk + tok0 * 2048 + h * 256 + (tid & 31) * 8;
        bf16_t* vbase = rv + tok0 * 4096 + h * 512 + slice * 64;
        u32x4 pq[4], pk[4], pv;
        f32x4 Sreg[2][4];
#pragma unroll
        for (int a = 0; a < 2; ++a)
#pragma unroll
            for (int bb = 0; bb < 4; ++bb) Sreg[a][bb] = (f32x4){0.f, 0.f, 0.f, 0.f};
        for (int i = tid; i < 33792 / 16; i += 512) ((LAS u32x4*)St)[i] = (u32x4){0u, 0u, 0u, 0u};
#define RET_LOAD(c) do { _Pragma("unroll") for (int i = 0; i < 4; ++i) { const int row = (tid + 512 * i) >> 5; \
            pq[i] = *(const u32x4*)(qbase + (size_t)(64 * (c) + row) * 2048); pk[i] = *(const u32x4*)(kbase + (size_t)(64 * (c) + row) * 2048); } \
            pv = *(const u32x4*)(vbase + (size_t)(64 * (c) + (tid >> 3)) * 4096 + (tid & 7) * 8); } while (0)
#define RET_STORE() do { _Pragma("unroll") for (int i = 0; i < 4; ++i) { const int e = tid + 512 * i, row = e >> 5, pc = e & 31; \
            *(LAS u32x4*)(Qs + row * 528 + pc * 16) = pq[i]; *(LAS u32x4*)(Ks + row * 528 + pc * 16) = pk[i]; } \
            { u32x4 o; o.x = cvt_pk_bf16(bflo(pv.x) * xv, bfhi(pv.x) * xv); o.y = cvt_pk_bf16(bflo(pv.y) * xv, bfhi(pv.y) * xv); \
              o.z = cvt_pk_bf16(bflo(pv.z) * xv, bfhi(pv.z) * xv); o.w = cvt_pk_bf16(bflo(pv.w) * xv, bfhi(pv.w) * xv); \
              *(LAS u32x4*)(Vs + (tid >> 3) * 144 + (tid & 7) * 16) = o; } } while (0)
        RET_LOAD(0); RET_STORE();
        __syncthreads();
        for (int c = 0; c < 128; ++c) {
            if (c + 1 < 128) RET_LOAD(c + 1);
            {
                const int jt = w >> 1, it0 = (w & 1) * 2;
                f32x4 sa[2] = {(f32x4){0.f, 0.f, 0.f, 0.f}, (f32x4){0.f, 0.f, 0.f, 0.f}};
#pragma unroll
                for (int ks = 0; ks < 8; ++ks) {
                    const bf16x8 kf = *(const LAS bf16x8*)(Ks + (16 * jt + fr) * 528 + (32 * ks + 8 * fq) * 2);
#pragma unroll
                    for (int t = 0; t < 2; ++t) { const bf16x8 qf = *(const LAS bf16x8*)(Qs + (16 * (it0 + t) + fr) * 528 + (32 * ks + 8 * fq) * 2); sa[t] = mfma16(kf, qf, sa[t]); }
                }
#pragma unroll
                for (int t = 0; t < 2; ++t) { const int iq = 16 * (it0 + t) + fr, jk0 = 16 * jt + 4 * fq;
                    u32x2 o; o.x = cvt_pk_bf16(jk0 + 0 <= iq ? sa[t][0] : 0.f, jk0 + 1 <= iq ? sa[t][1] : 0.f); o.y = cvt_pk_bf16(jk0 + 2 <= iq ? sa[t][2] : 0.f, jk0 + 3 <= iq ? sa[t][3] : 0.f);
                    *(LAS u32x2*)(Ps + iq * 144 + jk0 * 2) = o; }
            }
            {
#pragma unroll
                for (int ks = 0; ks < 2; ++ks) {
                    const int j0 = 32 * ks + 8 * fq + (fr >> 2);
                    bf16x8 kt[2], vf[4];
#pragma unroll
                    for (int dd = 0; dd < 2; ++dd) { LAS unsigned char* a0 = Ks + j0 * 528 + (16 * (2 * w + dd) + 4 * (fr & 3)) * 2; kt[dd] = tr_read2(a0, a0 + 4 * 528); }
#pragma unroll
                    for (int vt = 0; vt < 4; ++vt) { LAS unsigned char* a0 = Vs + j0 * 144 + (16 * vt + 4 * (fr & 3)) * 2; vf[vt] = tr_read2(a0, a0 + 4 * 144); }
#pragma unroll
                    for (int dd = 0; dd < 2; ++dd)
#pragma unroll
                        for (int vt = 0; vt < 4; ++vt) Sreg[dd][vt] = mfma16(kt[dd], vf[vt], Sreg[dd][vt]);
                }
#pragma unroll
                for (int dd = 0; dd < 2; ++dd)
#pragma unroll
                    for (int vt = 0; vt < 4; ++vt) Sreg[dd][vt] *= gamma_c;
            }
            __syncthreads();
            {
                const int vt = w >> 1, it0 = (w & 1) * 2;
                f32x4 oa[2] = {(f32x4){0.f, 0.f, 0.f, 0.f}, (f32x4){0.f, 0.f, 0.f, 0.f}};
#pragma unroll
                for (int ks = 0; ks < 8; ++ks) {
                    const bf16x8 sf = *(const LAS bf16x8*)(St + (16 * vt + fr) * 528 + (32 * ks + 8 * fq) * 2);
#pragma unroll
                    for (int t = 0; t < 2; ++t) { const bf16x8 qf = *(const LAS bf16x8*)(Qs + (16 * (it0 + t) + fr) * 528 + (32 * ks + 8 * fq) * 2); oa[t] = mfma16(sf, qf, oa[t]); }
                }
#pragma unroll
                for (int ks = 0; ks < 2; ++ks) {
                    const int j0 = 32 * ks + 8 * fq + (fr >> 2);
                    LAS unsigned char* a0 = Vs + j0 * 144 + (16 * vt + 4 * (fr & 3)) * 2; const bf16x8 vf = tr_read2(a0, a0 + 4 * 144);
#pragma unroll
                    for (int t = 0; t < 2; ++t) { const bf16x8 pf = *(const LAS bf16x8*)(Ps + (16 * (it0 + t) + fr) * 144 + (32 * ks + 8 * fq) * 2); oa[t] = mfma16(vf, pf, oa[t]); }
                }
#pragma unroll
                for (int t = 0; t < 2; ++t) { const int iq = 16 * (it0 + t) + fr; oa[t] *= (t == 0 ? xo0 : xo1);
                    u32x2 o; o.x = cvt_pk_bf16(oa[t][0], oa[t][1]); o.y = cvt_pk_bf16(oa[t][2], oa[t][3]);
                    *(u32x2*)(vbase + (size_t)(64 * c + iq) * 4096 + 16 * vt + 4 * fq) = o;
                    float ss = (oa[t][0] * oa[t][0] + oa[t][1] * oa[t][1]) + (oa[t][2] * oa[t][2] + oa[t][3] * oa[t][3]);
                    ss += __shfl_xor(ss, 16); ss += __shfl_xor(ss, 32);
                    if (fq == 0) red[iq * 4 + vt] = ss; }
            }
            __syncthreads();
#pragma unroll
            for (int dd = 0; dd < 2; ++dd)
#pragma unroll
                for (int vt = 0; vt < 4; ++vt) { u32x2 o; o.x = cvt_pk_bf16(Sreg[dd][vt][0], Sreg[dd][vt][1]); o.y = cvt_pk_bf16(Sreg[dd][vt][2], Sreg[dd][vt][3]);
                    *(LAS u32x2*)(St + (16 * vt + fr) * 528 + (16 * (2 * w + dd) + 4 * fq) * 2) = o; }
            if (c + 1 < 128) RET_STORE();
            if (tid < 64) retss[((tok0 + 64 * c + tid) * 8 + h) * 8 + slice] = (red[tid * 4 + 0] + red[tid * 4 + 1]) + (red[tid * 4 + 2] + red[tid * 4 + 3]);
            __syncthreads();
        }
#undef RET_LOAD
#undef RET_STORE
    }
}

DI void phase_attention(const Params& p, LAS unsigned char* lds) {
    const int tid = threadIdx.x, lane = tid & 63, w = tid >> 6, fr = lane & 15, fq = lane >> 4;
    LAS unsigned char* Ks = lds; LAS unsigned char* Vs = lds + 69632;
    bf16_t* aq = (bf16_t*)(p.ws + WS_AQ); const bf16_t* ak = (const bf16_t*)(p.ws + WS_AK); const bf16_t* av = (const bf16_t*)(p.ws + WS_AV); float* lse = (float*)(p.ws + WS_LSE);
    const int per = (4608 + (int)gridDim.x - 1) / (int)gridDim.x, it_lo = (int)blockIdx.x * per, it_hi = (it_lo + per < 4608) ? it_lo + per : 4608;
    int prev_key = -1;
    for (int item = it_lo, cnt = 0; item < it_hi; ++item, ++cnt) {
        const int bh = item >> 6, e64 = item & 63, head = bh % 18, b = bh / 18;
        const int g = head / 6, rsh = 2 * g, r = 1 << rsh, nbc = 64 >> rsh, cls = e64 / nbc, nb = e64 - cls * nbc;
        const int pq0 = nb * 128, pk0 = pq0 - 128;
        const size_t tokb = (size_t)b * SEQ;
        const int scur = cnt & 1, sprev = scur ^ 1;
        const bool reuse = (nb > 0) && (prev_key == item - 1);
#pragma unroll
        for (int i = 0; i < 4; ++i) { const int e = tid + 512 * i, row = e >> 4, pc = e & 15;
            const size_t off = (tokb + (size_t)(pq0 + row) * r + cls) * 2304 + head * 128 + pc * 8;
            const u32x4 kv = *(const u32x4*)(ak + off), vv = *(const u32x4*)(av + off);
            *(LAS u32x4*)(Ks + (scur * 128 + row) * 272 + pc * 16) = kv; *(LAS u32x4*)(Vs + (scur * 128 + row) * 272 + pc * 16) = vv; }
        if (!reuse) {
#pragma unroll
            for (int i = 0; i < 4; ++i) { const int e = tid + 512 * i, row = e >> 4, pc = e & 15;
                u32x4 kv = {0u, 0u, 0u, 0u}, vv = kv;
                if (nb > 0) { const size_t off = (tokb + (size_t)(pk0 + row) * r + cls) * 2304 + head * 128 + pc * 8; kv = *(const u32x4*)(ak + off); vv = *(const u32x4*)(av + off); }
                *(LAS u32x4*)(Ks + (sprev * 128 + row) * 272 + pc * 16) = kv; *(LAS u32x4*)(Vs + (sprev * 128 + row) * 272 + pc * 16) = vv; }
        }
        prev_key = item;
        const int qq = 16 * w + fr;
        const size_t tokq = tokb + (size_t)(pq0 + qq) * r + cls;
        bf16x8 qf[4];
        { const bf16_t* qp = aq + tokq * 2304 + head * 128 + 8 * fq;
#pragma unroll
          for (int ks = 0; ks < 4; ++ks) qf[ks] = *(const bf16x8*)(qp + 32 * ks); }
        __syncthreads();
        f32x4 sa[10];
#pragma unroll
        for (int kt = 0; kt < 10; ++kt) { sa[kt] = (f32x4){0.f, 0.f, 0.f, 0.f};
            const int T = (w + kt < 16) ? w + kt : 15;
            const int krow = ((T < 8) ? sprev : scur) * 128 + 16 * (T & 7) + fr;
#pragma unroll
            for (int ks = 0; ks < 4; ++ks) { const bf16x8 kf = *(const LAS bf16x8*)(Ks + krow * 272 + (32 * ks + 8 * fq) * 2); sa[kt] = mfma16(kf, qf[ks], sa[kt]); } }
        const float sc2 = 0.08838834764831845f * 1.4426950408889634f;
        float mrow = -INFINITY;
#pragma unroll
        for (int kt = 0; kt < 10; ++kt)
#pragma unroll
            for (int j = 0; j < 4; ++j) { const int kk = 16 * (w + kt) + 4 * fq + j; const bool valid = (kk >= qq) && (kk <= qq + 128) && (pk0 + kk >= 0);
                const float sv = valid ? sa[kt][j] * sc2 : -INFINITY; sa[kt][j] = sv; mrow = fmaxf(mrow, sv); }
        mrow = fmaxf(mrow, __shfl_xor(mrow, 16)); mrow = fmaxf(mrow, __shfl_xor(mrow, 32));
        float lsum = 0.f;
        bf16x8 pf[5];
#pragma unroll
        for (int t = 0; t < 5; ++t) { f32x4 p0, p1;
#pragma unroll
            for (int j = 0; j < 4; ++j) { p0[j] = __builtin_amdgcn_exp2f(sa[2 * t][j] - mrow); p1[j] = __builtin_amdgcn_exp2f(sa[2 * t + 1][j] - mrow); lsum += p0[j] + p1[j]; }
            const u32x4 pk4 = pack8(p0, p1); pf[t] = __builtin_bit_cast(bf16x8, pk4); }
        lsum += __shfl_xor(lsum, 16); lsum += __shfl_xor(lsum, 32);
        f32x4 oa[8];
#pragma unroll
        for (int dt = 0; dt < 8; ++dt) oa[dt] = (f32x4){0.f, 0.f, 0.f, 0.f};
#pragma unroll
        for (int t = 0; t < 5; ++t) {
            const int T0 = w + 2 * t, T1 = (T0 + 1 < 16) ? T0 + 1 : T0;
            const int r0 = ((T0 < 8) ? sprev : scur) * 128 + 16 * (T0 & 7) + 4 * fq + (fr >> 2), r1 = ((T1 < 8) ? sprev : scur) * 128 + 16 * (T1 & 7) + 4 * fq + (fr >> 2);
            LAS unsigned char* a0 = Vs + r0 * 272 + (4 * (fr & 3)) * 2; LAS unsigned char* a1 = Vs + r1 * 272 + (4 * (fr & 3)) * 2;
#pragma unroll
            for (int dt = 0; dt < 8; ++dt) { const bf16x8 vf = tr_read2(a0 + 32 * dt, a1 + 32 * dt); oa[dt] = mfma16(vf, pf[t], oa[dt]); }
        }
        const float inv = __builtin_amdgcn_rcpf(lsum);
        bf16_t* po = aq + tokq * 2304 + head * 128 + 4 * fq;
#pragma unroll
        for (int dt = 0; dt < 8; ++dt) { u32x2 o; o.x = cvt_pk_bf16(oa[dt][0] * inv, oa[dt][1] * inv); o.y = cvt_pk_bf16(oa[dt][2] * inv, oa[dt][3] * inv); *(u32x2*)(po + 16 * dt) = o; }
        if (fq == 0) lse[tokq * 18 + head] = mrow * 0.6931471805599453f + __logf(lsum);
        __syncthreads();
    }
}

constexpr size_t WS_BAR = 700000;
DI void grid_barrier(unsigned* bar, unsigned& nbar, const bool hier, const unsigned xcd, const unsigned per_xcd) {
    asm volatile("s_waitcnt vmcnt(0)" ::: "memory");
    __syncthreads();
    if (threadIdx.x == 0) {
        __builtin_amdgcn_fence(__ATOMIC_RELEASE, "agent");
        asm volatile("s_waitcnt vmcnt(0)" ::: "memory");
        const unsigned gen = nbar + 1u;
        if (hier) {
            unsigned* xc = bar + 256 + 64 * xcd; unsigned* top = bar + 1024;
            const unsigned old = __hip_atomic_fetch_add(xc, 1u, __ATOMIC_RELAXED, __HIP_MEMORY_SCOPE_AGENT);
            if (old + 1u == gen * per_xcd) __hip_atomic_fetch_add(top, 1u, __ATOMIC_RELAXED, __HIP_MEMORY_SCOPE_AGENT);
            while (__hip_atomic_load(top, __ATOMIC_RELAXED, __HIP_MEMORY_SCOPE_AGENT) < gen * 8u) __builtin_amdgcn_s_sleep(1);
        } else {
            const unsigned target = gen * gridDim.x;
            __hip_atomic_fetch_add(bar, 1u, __ATOMIC_RELAXED, __HIP_MEMORY_SCOPE_AGENT);
            while (__hip_atomic_load(bar, __ATOMIC_RELAXED, __HIP_MEMORY_SCOPE_AGENT) < target) __builtin_amdgcn_s_sleep(1);
        }
        __builtin_amdgcn_fence(__ATOMIC_ACQUIRE, "agent");
        asm volatile("s_waitcnt vmcnt(0)" ::: "memory");
    }
    __syncthreads();
    ++nbar;
}

constexpr int N_PHASES = 13;
__global__ void __launch_bounds__(512, 2) mega(Params p) {
    extern __shared__ __attribute__((aligned(16))) unsigned char shm[];
    LAS unsigned char* lds = (LAS unsigned char*)shm;
    unsigned char* ws = p.ws;
    const int G = gridDim.x, c = blockIdx.x;
    unsigned* bar = (unsigned*)(ws + WS_BAR); unsigned nbar = 0;
    int c_eff = c; unsigned my_xcd = 0, my_idx = 0; bool hier = false;
    if (p.ph_hi - p.ph_lo > 1) {
        my_xcd = (unsigned)__builtin_amdgcn_s_getreg((3 << 11) | 20) & 0xFu;
        if (threadIdx.x == 0) my_idx = __hip_atomic_fetch_add(bar + 64 + 16 * (my_xcd & 7u), 1u, __ATOMIC_RELAXED, __HIP_MEMORY_SCOPE_AGENT);
        my_idx = (unsigned)__builtin_amdgcn_readfirstlane((int)my_idx);
    }
    if (p.ph_lo <= 0 && 0 < p.ph_hi) {
        if (0 > p.ph_lo) grid_barrier(bar, nbar, hier, my_xcd, (unsigned)G / 8u);

#if (PHMASK >> 0) & 1
            phase0(p, lds);
#endif
    }
    if (p.ph_lo <= 1 && 1 < p.ph_hi) {
        if (1 > p.ph_lo) cg::this_grid().sync();
        if (p.ph_hi - p.ph_lo > 1) {
            LAS unsigned* cw = (LAS unsigned*)lds;
            if (threadIdx.x == 0) {
                bool ok = (G % 8) == 0 && my_xcd < 8u;
                for (int x = 0; x < 8; ++x) ok = ok && (__hip_atomic_load(bar + 64 + 16 * x, __ATOMIC_RELAXED, __HIP_MEMORY_SCOPE_AGENT) == (unsigned)(G / 8));
                cw[0] = ok ? (my_idx * 8u + my_xcd) : (unsigned)c; cw[1] = ok ? 1u : 0u;
            }
            __syncthreads();
            c_eff = __builtin_amdgcn_readfirstlane((int)cw[0]);
            hier = (cw[1] != 0u);
            __syncthreads();
        }

#if (PHMASK >> 1) & 1
            phase_h(p);
#endif
    }
    if (p.ph_lo <= 2 && 2 < p.ph_hi) {
        if (2 > p.ph_lo) grid_barrier(bar, nbar, hier, my_xcd, (unsigned)G / 8u);

#if (PHMASK >> 2) & 1
            pg8::Gemm g{(const bf16_t*)(ws + WS_H), (const bf16_t*)(ws + WS_WIN), T_TOK, 59 * 256, 2048, nullptr, nullptr, 0}; pg8::StaticOrder S; S.init(T_TOK, 59 * 256, G, c_eff, 32, 16);
            EpiInProj E{(bf16_t*)(ws + WS_RQ), (bf16_t*)(ws + WS_RK), (bf16_t*)p.out, (bf16_t*)(ws + WS_AQ), (bf16_t*)(ws + WS_AK), (bf16_t*)(ws + WS_AV), p.pos};
            pg8::gemm_phase<1>(lds, g, S, E);
#endif
    }
    if (p.ph_lo <= 3 && 3 < p.ph_hi) {
        if (3 > p.ph_lo) grid_barrier(bar, nbar, hier, my_xcd, (unsigned)G / 8u);

#if (PHMASK >> 3) & 1
            phase_retention(p, lds, c_eff); __syncthreads();
#endif
#if (PHMASK >> 13) & 1
            phase_attention(p, lds);
#endif
    }
    if (p.ph_lo <= 4 && 4 < p.ph_hi) {
        if (4 > p.ph_lo) grid_barrier(bar, nbar, hier, my_xcd, (unsigned)G / 8u);

#if (PHMASK >> 4) & 1
            { pg8::Gemm g{(const bf16_t*)(ws + WS_H), (const bf16_t*)(ws + WS_WIN) + (size_t)8192 * 2048, T_TOK, 4096, 2048, nullptr, nullptr, 0}; pg8::StaticOrder S; S.init(T_TOK, 4096, G, c_eff);
              EpiRetGate E{(bf16_t*)p.out, (const float*)(ws + WS_RETSS), p.ret_gain}; pg8::gemm_phase<1>(lds, g, S, E); }
#endif
#if (PHMASK >> 14) & 1
            { pg8::Gemm g{(const bf16_t*)(ws + WS_H), (const bf16_t*)(ws + WS_WGATE), T_TOK, 4096, 2048, nullptr, nullptr, 0}; pg8::StaticOrder S; S.init(T_TOK, 4096, G, c_eff);
              EpiGates E{(bf16_t*)(ws + WS_GATES), p.b_gate}; pg8::gemm_phase<1>(lds, g, S, E); }
#endif
#if (PHMASK >> 15) & 1
            phase_alpha(p);
#endif
    }
    if (p.ph_lo <= 5 && 5 < p.ph_hi) {
        if (5 > p.ph_lo) grid_barrier(bar, nbar, hier, my_xcd, (unsigned)G / 8u);

#if (PHMASK >> 5) & 1
            pg8::Gemm g{(const bf16_t*)p.out, (const bf16_t*)(ws + WS_WRET), T_TOK, 2048, 4096, (const bf16_t*)(ws + WS_AQ), (const bf16_t*)(ws + WS_WATT), 2304}; pg8::StaticOrder S; S.init(T_TOK, 2048, G, c_eff);
            EpiYMerge E{(const bf16_t*)(ws + WS_GATES), (bf16_t*)(ws + WS_U2)}; pg8::gemm_phase<2>(lds, g, S, E);
#endif
    }
    if (p.ph_lo <= 7 && 7 < p.ph_hi) {
        if (7 > p.ph_lo) grid_barrier(bar, nbar, hier, my_xcd, (unsigned)G / 8u);

#if (PHMASK >> 7) & 1
            pg8::Gemm g{(const bf16_t*)(ws + WS_U2), (const bf16_t*)(ws + WS_WMIX), T_TOK, 2048, 2048, nullptr, nullptr, 0}; pg8::StaticOrder S; S.init(T_TOK, 2048, G, c_eff);
            EpiStoreBf16 E{(bf16_t*)(ws + WS_Y), 2048}; pg8::gemm_phase<1>(lds, g, S, E);
#endif
    }
    if (p.ph_lo <= 8 && 8 < p.ph_hi) {
        if (8 > p.ph_lo) grid_barrier(bar, nbar, hier, my_xcd, (unsigned)G / 8u);

#if (PHMASK >> 8) & 1
            phase_postmix(p);
#endif
    }
    if (p.ph_lo <= 9 && 9 < p.ph_hi) {
        if (9 > p.ph_lo) grid_barrier(bar, nbar, hier, my_xcd, (unsigned)G / 8u);

#if (PHMASK >> 9) & 1
            pg8::Gemm g{(const bf16_t*)(ws + WS_H2), (const bf16_t*)(ws + WS_WUP), T_TOK, FF, 2048, nullptr, nullptr, 0}; pg8::StaticOrder S; S.init(T_TOK, FF, G, c_eff);
            EpiStoreBf16 E{(bf16_t*)(ws + WS_A), FF}; pg8::gemm_phase<1>(lds, g, S, E);
#endif
    }
    if (p.ph_lo <= 10 && 10 < p.ph_hi) {
        if (10 > p.ph_lo) grid_barrier(bar, nbar, hier, my_xcd, (unsigned)G / 8u);

#if (PHMASK >> 10) & 1
            pg8::Gemm g{(const bf16_t*)(ws + WS_H2), (const bf16_t*)(ws + WS_WUP) + (size_t)FF * 2048, T_TOK, FF, 2048, nullptr, nullptr, 0}; pg8::StaticOrder S; S.init(T_TOK, FF, G, c_eff);
            EpiConvAct E{(const bf16_t*)(ws + WS_A), (bf16_t*)(ws + WS_ACT), p.conv_w, p.conv_b}; pg8::gemm_phase<1>(lds, g, S, E);
#endif
    }
    if (p.ph_lo <= 11 && 11 < p.ph_hi) {
        if (11 > p.ph_lo) grid_barrier(bar, nbar, hier, my_xcd, (unsigned)G / 8u);

#if (PHMASK >> 11) & 1
            pg8::Gemm g{(const bf16_t*)(ws + WS_ACT), (const bf16_t*)(ws + WS_WDOWN), T_TOK, 2048, FF, nullptr, nullptr, 0}; pg8::StaticOrder S; S.init(T_TOK, 2048, G, c_eff);
            EpiStoreBf16 E{(bf16_t*)(ws + WS_Y2), 2048}; pg8::gemm_phase<1>(lds, g, S, E);
#endif
    }
    if (p.ph_lo <= 12 && 12 < p.ph_hi) {
        if (12 > p.ph_lo) grid_barrier(bar, nbar, hier, my_xcd, (unsigned)G / 8u);

#if (PHMASK >> 12) & 1
            phase_final(p);
#endif
    }
}

extern "C" void kernel_launch(void* const* d_in, const int* in_sizes, int n_in, void* d_out, int out_size, void* d_ws, size_t ws_size, hipStream_t stream) {
    static int grid = 0;
    if (grid == 0) {
        if (n_in != 20 || ws_size < WS_END) { fprintf(stderr, "kernel_launch: unexpected n_in %d or ws_size %zu (need %zu)\n", n_in, ws_size, (size_t)WS_END); grid = -1; return; }
        int dev = 0, cus = 0, per_cu = 0;
        hipGetDevice(&dev); hipDeviceGetAttribute(&cus, hipDeviceAttributeMultiprocessorCount, dev);
        if (hipFuncSetAttribute((const void*)mega, hipFuncAttributeMaxDynamicSharedMemorySize, LDS_BYTES) != hipSuccess) { fprintf(stderr, "kernel_launch: hipFuncSetAttribute failed\n"); grid = -1; return; }
        if (hipOccupancyMaxActiveBlocksPerMultiprocessor(&per_cu, (const void*)mega, 512, LDS_BYTES) != hipSuccess || per_cu < 1) { fprintf(stderr, "kernel_launch: occupancy query says %d\n", per_cu); per_cu = 1; }
        (void)hipGetLastError();
        grid = cus * 1;
    }
    if (grid < 0) return;
    Params p{};
    p.x = (const float*)d_in[0]; p.c = (const float*)d_in[1]; p.pos = (const int*)d_in[2]; p.w_ada = (const float*)d_in[3]; p.b_ada = (const float*)d_in[4]; p.g_pre_mix = (const float*)d_in[5];
    p.w_in = (const float*)d_in[6]; p.ret_gain = (const float*)d_in[7]; p.w_ret_out = (const float*)d_in[8]; p.w_att_out = (const float*)d_in[9]; p.w_gate = (const float*)d_in[10]; p.b_gate = (const float*)d_in[11];
    p.w_mix = (const float*)d_in[12]; p.g_post_mix = (const float*)d_in[13]; p.g_pre_ffn = (const float*)d_in[14]; p.w_up = (const float*)d_in[15]; p.conv_w = (const float*)d_in[16]; p.conv_b = (const float*)d_in[17];
    p.w_down = (const float*)d_in[18]; p.g_post_ffn = (const float*)d_in[19];
    p.out = (float*)d_out; p.ws = (unsigned char*)d_ws;
    if (hipMemsetAsync((char*)d_ws + WS_BAR, 0, 8192, stream) != hipSuccess) { fprintf(stderr, "kernel_launch: memset failed\n"); return; }
#if N_LAUNCH_PER_PHASE
    for (int ph = 0; ph < N_PHASES; ++ph) { p.ph_lo = ph; p.ph_hi = ph + 1; hipLaunchKernelGGL(mega, dim3(grid), dim3(512), LDS_BYTES, stream, p); }
#else
    p.ph_lo = 0; p.ph_hi = N_PHASES;
    void* args[] = {&p};
    hipError_t e = hipLaunchCooperativeKernel((const void*)mega, dim3(grid), dim3(512), args, LDS_BYTES, stream);
    if (e != hipSuccess) fprintf(stderr, "cooperative launch failed: %s (grid %d)\n", hipGetErrorString(e), grid);
#endif
}
```

```cpp
#include <hip/hip_runtime.h>
#include <hip/hip_cooperative_groups.h>
#include <cstdio>
#include <cstdint>
namespace cg = cooperative_groups;

#define DI __device__ __forceinline__
#define LAS __attribute__((address_space(3)))
typedef unsigned short bf16_t;
typedef short bf16x8 __attribute__((ext_vector_type(8)));
typedef short s16x4 __attribute__((ext_vector_type(4)));
typedef float f32x4 __attribute__((ext_vector_type(4)));
typedef unsigned u32x4 __attribute__((ext_vector_type(4)));
typedef unsigned u32x2 __attribute__((ext_vector_type(2)));

#ifndef PHMASK
#define PHMASK 0xFFFF
#endif
#ifndef N_LAUNCH_PER_PHASE
#define N_LAUNCH_PER_PHASE 0
#endif

constexpr int T_TOK = 32768, DM = 2048, SEQ = 8192, NB = 4;
constexpr int FF = 5632;
constexpr int LDS_BYTES = 143360;
constexpr size_t MiB = 1u << 20;
constexpr size_t WS_ADA = 0;
constexpr size_t WS_LSE = 1 * MiB;
constexpr size_t WS_RETSS = 4 * MiB;
constexpr size_t WS_WUP = 12 * MiB;
constexpr size_t WS_WDOWN = 56 * MiB;
constexpr size_t WS_WIN = 78 * MiB;
constexpr size_t WS_WGATE = 153 * MiB;
constexpr size_t WS_WRET = 169 * MiB;
constexpr size_t WS_WATT = 185 * MiB;
constexpr size_t WS_WMIX = 194 * MiB;
constexpr size_t WS_H = 206 * MiB;
constexpr size_t WS_RQ = 334 * MiB;
constexpr size_t WS_RK = 462 * MiB;
constexpr size_t WS_AQ = 590 * MiB;
constexpr size_t WS_AK = 734 * MiB;
constexpr size_t WS_AV = 878 * MiB;
constexpr size_t WS_GATES = 334 * MiB;
constexpr size_t WS_U = 734 * MiB;
constexpr size_t WS_U2 = 206 * MiB;
constexpr size_t WS_Y = 334 * MiB;
constexpr size_t WS_H2 = 78 * MiB;
constexpr size_t WS_A = 206 * MiB;
constexpr size_t WS_ACT = 558 * MiB;
constexpr size_t WS_Y2 = 78 * MiB;
constexpr size_t WS_END = 1022 * MiB;

struct Params {
    const float *x, *c; const int* pos;
    const float *w_ada, *b_ada, *g_pre_mix, *w_in, *ret_gain, *w_ret_out, *w_att_out, *w_gate, *b_gate, *w_mix, *g_post_mix, *g_pre_ffn, *w_up, *conv_w, *conv_b, *w_down, *g_post_ffn;
    float* out; unsigned char* ws; int ph_lo, ph_hi;
};

typedef __bf16 bf16x2_t __attribute__((ext_vector_type(2)));
DI unsigned cvt_pk_bf16(float lo, float hi) { bf16x2_t v = {(__bf16)lo, (__bf16)hi}; return __builtin_bit_cast(unsigned, v); }
DI float bflo(unsigned w) { return __uint_as_float(w << 16); }
DI float bfhi(unsigned w) { return __uint_as_float(w & 0xffff0000u); }
DI float wave_sum(float v) {
#pragma unroll
    for (int o = 1; o < 64; o <<= 1) v += __shfl_xor(v, o);
    return v;
}
DI float sigmoidf_(float v) { return __builtin_amdgcn_rcpf(1.0f + __builtin_amdgcn_exp2f(-1.4426950408889634f * v)); }
DI f32x4 mfma16(bf16x8 a, bf16x8 b, f32x4 c) { return __builtin_amdgcn_mfma_f32_16x16x32_bf16(a, b, c, 0, 0, 0); }
DI s16x4 tr_read(LAS unsigned char* p) { return __builtin_amdgcn_ds_read_tr16_b64_v4i16((LAS s16x4*)p); }
DI bf16x8 tr_read2(LAS unsigned char* p0, LAS unsigned char* p1) { s16x4 lo = tr_read(p0), hi = tr_read(p1); return __builtin_shufflevector(lo, hi, 0, 1, 2, 3, 4, 5, 6, 7); }

namespace pg8 {
constexpr int BM = 256, BK = 64, HALF = 128, HTB = HALF * BK * 2, STAGE_BYTES = 8 * HTB, NXCD = 8, WGM = 8;
DI int lds_byte(int r, int c) { const int st = (r >> 4) * 2 + (c >> 5), rr = r & 15, cc = c & 31, ob = rr * 64 + cc * 2; return st * 1024 + (ob ^ (((ob >> 9) & 1) << 5)); }
DI void stage_rc(int b, int& R, int& C) { const int st = b / 1024, sb = b % 1024, swz = sb ^ (((sb >> 9) & 1) << 5); R = (st >> 1) * 16 + swz / 64; C = (st & 1) * 32 + (swz % 64) / 2; }
struct Unit { int pm, pn; };
struct Gemm { const bf16_t* A; const bf16_t* Bt; int M, N, K; const bf16_t* A1; const bf16_t* Bt1; int K1; };
struct StaticOrder {
    int nM, nN, nwg, G, c, skip_lo, skip_n;
    DI void init(int M, int N, int G_, int c_, int slo = 1 << 30, int sn = 0) { nM = M / BM; nN = N / BM; nwg = nM * nN; G = G_; c = c_; skip_lo = slo; skip_n = sn; }
    DI bool next(int i, Unit& u) const {
        const long L = (long)i * G + c; if (L >= nwg) return false;
        int wgid = (int)L; { const int q = nwg / NXCD, r = nwg % NXCD, xcd = wgid % NXCD, off = wgid / NXCD; wgid = (xcd < r ? xcd * (q + 1) : r * (q + 1) + (xcd - r) * q) + off; }
        const int nig = WGM * nN, gid = wgid / nig, fm = gid * WGM, gsz = (nM - fm) < WGM ? (nM - fm) : WGM;
        u.pm = fm + ((wgid % nig) % gsz); u.pn = (wgid % nig) / gsz; if (u.pn >= skip_lo) u.pn += skip_n; return true;
    }
};

template <int NSEG, class Epi>
DI void gemm_phase(LAS unsigned char* lds, const Gemm g, const StaticOrder& S, const Epi& E) {
    const int tid = threadIdx.x, wid = __builtin_amdgcn_readfirstlane(tid >> 6), lane = tid & 63, wr = wid >> 2, wc = wid & 3, fr = lane & 15, fq = lane >> 4;
    int Rr[2], Cc[2];
#pragma unroll
    for (int i = 0; i < 2; ++i) stage_rc(tid * 16 + i * 8192, Rr[i], Cc[i]);
    const size_t kstep = (size_t)(BK * 2);
    const unsigned ldsw = (unsigned)wid * 1024u;
    const int aoff = lds_byte(wr * 64 + fr, fq * 8), boff = lds_byte(wc * 32 + fr, fq * 8);
#define PG8_SA(b, h) (((b) * 2 + (h)) * HTB)
#define PG8_SB(b, h) ((4 + (b) * 2 + (h)) * HTB)
#define PG8_STAGE(bufoff, gbase, VO) do { _Pragma("unroll") for (int _i = 0; _i < 2; ++_i) \
        __builtin_amdgcn_global_load_lds((const unsigned*)((const char*)(gbase) + VO[_i]), (LAS unsigned*)(lds + (bufoff) + ldsw + _i * 8192), 16, 0, 0); } while (0)
#define PG8_LDA(dst, b, h) do { _Pragma("unroll") for (int m = 0; m < 4; ++m) _Pragma("unroll") for (int k = 0; k < 2; ++k) dst[m][k] = *(const LAS bf16x8*)(lds + PG8_SA(b, h) + aoff + m * 2048 + k * 1024); } while (0)
#define PG8_LDB(dst, b, h) do { _Pragma("unroll") for (int n = 0; n < 2; ++n) _Pragma("unroll") for (int k = 0; k < 2; ++k) dst[n][k] = *(const LAS bf16x8*)(lds + PG8_SB(b, h) + boff + n * 2048 + k * 1024); } while (0)
#define PG8_MMA(ai, bj, At, Bt) do { __builtin_amdgcn_s_setprio(1); _Pragma("unroll") for (int m = 0; m < 4; ++m) _Pragma("unroll") for (int n = 0; n < 2; ++n) _Pragma("unroll") for (int k = 0; k < 2; ++k) \
        acc[ai][bj][m][n] = __builtin_amdgcn_mfma_f32_16x16x32_bf16(Bt[n][k], At[m][k], acc[ai][bj][m][n], 0, 0, 0); __builtin_amdgcn_s_setprio(0); } while (0)
#define PG8_WAIT_V(n) asm volatile("s_waitcnt vmcnt(" #n ")" ::: "memory")
#define PG8_WAIT_L(n) asm volatile("s_waitcnt lgkmcnt(" #n ")" ::: "memory")
#define PG8_BAR __builtin_amdgcn_s_barrier()
#define PG8_SCHED __builtin_amdgcn_sched_barrier(0)
    Unit cur, nxt; int ti = 0, seg = 0;
    if (!S.next(0, cur)) return;
    f32x4 acc[2][2][4][2];
#pragma unroll
    for (int a = 0; a < 2; ++a)
#pragma unroll
        for (int b = 0; b < 2; ++b)
#pragma unroll
            for (int m = 0; m < 4; ++m)
#pragma unroll
                for (int n = 0; n < 2; ++n) acc[a][b][m][n] = (f32x4){0.f, 0.f, 0.f, 0.f};
    bf16x8 At[4][2], B0[2][2], B1[2][2];
    int Kc = g.K;
    unsigned voffC[2];
#pragma unroll
    for (int i = 0; i < 2; ++i) voffC[i] = (unsigned)(Rr[i] * Kc + Cc[i]) * 2u;
    size_t hstepC = (size_t)HALF * Kc * 2;
    const char* cA = (const char*)g.A + (size_t)cur.pm * 2 * hstepC; const char* cB = (const char*)g.Bt + (size_t)cur.pn * 2 * hstepC;
    PG8_STAGE(PG8_SB(0, 0), cB, voffC); PG8_STAGE(PG8_SA(0, 0), cA, voffC); PG8_STAGE(PG8_SB(0, 1), cB + hstepC, voffC); PG8_STAGE(PG8_SA(0, 1), cA + hstepC, voffC);
    if (wr == 1) PG8_BAR;
    PG8_WAIT_V(4); PG8_BAR;
    PG8_STAGE(PG8_SB(1, 0), cB + kstep, voffC); PG8_STAGE(PG8_SA(1, 0), cA + kstep, voffC); PG8_STAGE(PG8_SB(1, 1), cB + hstepC + kstep, voffC);
    PG8_WAIT_V(6); PG8_BAR;
    for (;;) {
        bool has_next; int nseg = 0;
        if (NSEG > 1 && seg + 1 < NSEG) { has_next = true; nxt = cur; nseg = seg + 1; }
        else has_next = S.next(ti + 1, nxt);
        int Kn = Kc; const char* nA = cA; const char* nB = cB;
        if (has_next) { Kn = (NSEG > 1 && nseg == 1) ? g.K1 : g.K;
            nA = (const char*)((NSEG > 1 && nseg == 1) ? g.A1 : g.A) + (size_t)nxt.pm * 256 * Kn * 2; nB = (const char*)((NSEG > 1 && nseg == 1) ? g.Bt1 : g.Bt) + (size_t)nxt.pn * 256 * Kn * 2; }
        unsigned voffN[2];
#pragma unroll
        for (int i = 0; i < 2; ++i) voffN[i] = (NSEG > 1) ? (unsigned)(Rr[i] * Kn + Cc[i]) * 2u : voffC[i];
        const size_t hstepN = (NSEG > 1) ? (size_t)HALF * Kn * 2 : hstepC;
        const int nt = Kc / BK;
        for (int t = 0; t < nt; t += 2) {
            const bool last = (t == nt - 2);
            const char* a1 = cA + (size_t)(t + 1) * kstep;
            const char* a2 = last ? nA : cA + (size_t)(t + 2) * kstep; const char* b2 = last ? nB : cB + (size_t)(t + 2) * kstep;
            const char* a3 = a2 + kstep; const char* b3 = b2 + kstep;
            unsigned v2[2]; v2[0] = (NSEG > 1 && last) ? voffN[0] : voffC[0]; v2[1] = (NSEG > 1 && last) ? voffN[1] : voffC[1];
            const size_t h2 = (NSEG > 1 && last) ? hstepN : hstepC;
            PG8_LDB(B0, 0, 0); PG8_SCHED; PG8_LDA(At, 0, 0); PG8_STAGE(PG8_SA(1, 1), a1 + hstepC, voffC);
            PG8_WAIT_L(8); PG8_BAR; PG8_WAIT_L(0); PG8_MMA(0, 0, At, B0); PG8_BAR; PG8_SCHED;
            PG8_LDB(B1, 0, 1); PG8_STAGE(PG8_SB(0, 0), b2, v2);
            PG8_BAR; PG8_WAIT_L(0); PG8_MMA(0, 1, At, B1); PG8_BAR;
            PG8_LDA(At, 0, 1); PG8_STAGE(PG8_SA(0, 0), a2, v2);
            PG8_BAR; PG8_WAIT_L(0); PG8_MMA(1, 0, At, B0); PG8_BAR; PG8_SCHED;
            PG8_STAGE(PG8_SB(0, 1), b2 + h2, v2);
            PG8_WAIT_V(6); PG8_BAR; PG8_MMA(1, 1, At, B1); PG8_BAR;
            PG8_LDB(B0, 1, 0); PG8_SCHED; PG8_LDA(At, 1, 0); PG8_STAGE(PG8_SA(0, 1), a2 + h2, v2);
            PG8_WAIT_L(8); PG8_BAR; PG8_WAIT_L(0); PG8_MMA(0, 0, At, B0); PG8_BAR; PG8_SCHED;
            PG8_LDB(B1, 1, 1); PG8_STAGE(PG8_SB(1, 0), b3, v2);
            PG8_BAR; PG8_WAIT_L(0); PG8_MMA(0, 1, At, B1); PG8_BAR;
            PG8_LDA(At, 1, 1); PG8_STAGE(PG8_SA(1, 0), a3, v2);
            PG8_BAR; PG8_WAIT_L(0); PG8_MMA(1, 0, At, B0); PG8_BAR; PG8_SCHED;
            PG8_STAGE(PG8_SB(1, 1), b3 + h2, v2);
            PG8_WAIT_V(6); PG8_BAR; PG8_MMA(1, 1, At, B1); PG8_BAR;
        }
        if constexpr (NSEG > 1) { if (seg + 1 < NSEG) E.mid(acc, cur, wr, wc, fr, fq); else E(acc, cur, wr, wc, fr, fq); }
        else E(acc, cur, wr, wc, fr, fq);
        if (!has_next) break;
        if (NSEG == 1 || nseg == 0) {
#pragma unroll
            for (int a = 0; a < 2; ++a)
#pragma unroll
                for (int b = 0; b < 2; ++b)
#pragma unroll
                    for (int m = 0; m < 4; ++m)
#pragma unroll
                        for (int n = 0; n < 2; ++n) acc[a][b][m][n] = (f32x4){0.f, 0.f, 0.f, 0.f};
            ++ti;
        }
        cur = nxt; cA = nA; cB = nB; seg = nseg;
        if (NSEG > 1) { Kc = Kn; voffC[0] = voffN[0]; voffC[1] = voffN[1]; hstepC = hstepN; }
    }
    PG8_WAIT_V(0);
    if (wr == 0) PG8_BAR;
    PG8_BAR;
#undef PG8_SA
#undef PG8_SB
#undef PG8_STAGE
#undef PG8_LDA
#undef PG8_LDB
#undef PG8_MMA
#undef PG8_WAIT_V
#undef PG8_WAIT_L
#undef PG8_BAR
#undef PG8_SCHED
}
}
using pg8::Unit;
typedef f32x4 AccT[2][2][4][2];

DI u32x4 pack8(const f32x4& v0, const f32x4& v1) { u32x4 w; w.x = cvt_pk_bf16(v0[0], v0[1]); w.y = cvt_pk_bf16(v0[2], v0[3]); w.z = cvt_pk_bf16(v1[0], v1[1]); w.w = cvt_pk_bf16(v1[2], v1[3]); return w; }

struct EpiStoreBf16 {
    bf16_t* O; int ld;
    DI void operator()(const AccT& acc, const Unit& u, int wr, int wc, int fr, int fq) const {
        const int row0 = u.pm * 256 + wr * 64 + fr, col0 = u.pn * 256 + wc * 32 + 8 * fq;
#pragma unroll
        for (int ai = 0; ai < 2; ++ai)
#pragma unroll
            for (int m = 0; m < 4; ++m) { bf16_t* rowp = O + (size_t)(row0 + ai * 128 + m * 16) * ld + col0;
#pragma unroll
                for (int bj = 0; bj < 2; ++bj) *(u32x4*)(rowp + bj * 128) = pack8(acc[ai][bj][m][0], acc[ai][bj][m][1]); }
    }
};

template <int HD>
DI void rope_store(const AccT& acc, int rowbase, const int* pos, bf16_t* dst, int ld, int c1, int half, int ibase, float scale) {
    int pi[2][4];
#pragma unroll
    for (int ai = 0; ai < 2; ++ai)
#pragma unroll
        for (int m = 0; m < 4; ++m) pi[ai][m] = pos[rowbase + ai * 128 + m * 16];
    float invf[2][4];
#pragma unroll
    for (int n = 0; n < 2; ++n)
#pragma unroll
        for (int j = 0; j < 4; ++j) invf[n][j] = exp2f(-(float)(ibase + 4 * n + j) * (2.0f / HD) * 13.287712379549449f);
#pragma unroll
    for (int ai = 0; ai < 2; ++ai)
#pragma unroll
        for (int m = 0; m < 4; ++m) {
            const int row = rowbase + ai * 128 + m * 16; const float ps = (float)pi[ai][m];
            f32x4 o1[2], o2[2];
#pragma unroll
            for (int n = 0; n < 2; ++n)
#pragma unroll
                for (int j = 0; j < 4; ++j) {
                    const float ang = ps * invf[n][j]; const float rev = __builtin_amdgcn_fractf(ang * 0.15915494309189535f);
                    const float sn = __builtin_amdgcn_sinf(rev), cs = __builtin_amdgcn_cosf(rev);
                    const float t1 = acc[ai][0][m][n][j], t2 = acc[ai][1][m][n][j];
                    o1[n][j] = (t1 * cs - t2 * sn) * scale; o2[n][j] = (t2 * cs + t1 * sn) * scale;
                }
            bf16_t* rowp = dst + (size_t)row * ld + c1;
            *(u32x4*)rowp = pack8(o1[0], o1[1]); *(u32x4*)(rowp + half) = pack8(o2[0], o2[1]);
        }
}

struct EpiInProj {
    bf16_t *rq, *rk, *rv, *aq, *ak, *av; const int* pos;
    DI void operator()(const AccT& acc, const Unit& u, int wr, int wc, int fr, int fq) const {
        const int pn = u.pn, rowbase = u.pm * 256 + wr * 64 + fr;
        if (pn < 16) {
            bf16_t* dst = pn < 8 ? rq : rk; const float scale = pn < 8 ? 1.0f : 0.0625f;
            rope_store<256>(acc, rowbase, pos, dst, 2048, 256 * (pn & 7) + 32 * wc + 8 * fq, 128, 32 * wc + 8 * fq, scale);
        } else if (pn < 32) {
            const int col0 = (pn - 16) * 256 + wc * 32 + 8 * fq;
#pragma unroll
            for (int ai = 0; ai < 2; ++ai)
#pragma unroll
                for (int m = 0; m < 4; ++m) { bf16_t* rowp = rv + (size_t)(rowbase + ai * 128 + m * 16) * 4096 + col0;
#pragma unroll
                    for (int bj = 0; bj < 2; ++bj) *(u32x4*)(rowp + bj * 128) = pack8(acc[ai][bj][m][0], acc[ai][bj][m][1]); }
        } else if (pn < 66) {
            const int q9 = pn - 48; bf16_t* dst = q9 < 9 ? aq : ak; const int t9 = q9 < 9 ? q9 : q9 - 9;
            const int head = 2 * t9 + (wc >> 1), ib = 32 * (wc & 1) + 8 * fq;
            rope_store<128>(acc, rowbase, pos, dst, 2304, head * 128 + ib, 64, ib, 1.0f);
        } else {
            const int col0 = (pn - 66) * 256 + wc * 32 + 8 * fq;
#pragma unroll
            for (int ai = 0; ai < 2; ++ai)
#pragma unroll
                for (int m = 0; m < 4; ++m) { bf16_t* rowp = av + (size_t)(rowbase + ai * 128 + m * 16) * 2304 + col0;
#pragma unroll
                    for (int bj = 0; bj < 2; ++bj) *(u32x4*)(rowp + bj * 128) = pack8(acc[ai][bj][m][0], acc[ai][bj][m][1]); }
        }
    }
};

struct EpiRetGate {
    bf16_t* ret; const float* retss; const float* gain;
    DI void operator()(const AccT& acc, const Unit& u, int wr, int wc, int fr, int fq) const {
        const int rowbase = u.pm * 256 + wr * 64 + fr, head = u.pn >> 1, colb = u.pn * 256 + wc * 32 + 8 * fq;
        f32x4 gn[2][2];
#pragma unroll
        for (int bj = 0; bj < 2; ++bj) { gn[bj][0] = *(const f32x4*)(gain + colb + bj * 128); gn[bj][1] = *(const f32x4*)(gain + colb + bj * 128 + 4); }
#pragma unroll
        for (int ai = 0; ai < 2; ++ai) {
            f32x4 sA[4], sB[4]; u32x4 rr[4][2];
#pragma unroll
            for (int m = 0; m < 4; ++m) { const float* ps = retss + ((size_t)(rowbase + ai * 128 + m * 16) * 8 + head) * 8; sA[m] = *(const f32x4*)ps; sB[m] = *(const f32x4*)(ps + 4); }
#pragma unroll
            for (int m = 0; m < 4; ++m)
#pragma unroll
                for (int bj = 0; bj < 2; ++bj) rr[m][bj] = *(const u32x4*)(ret + (size_t)(rowbase + ai * 128 + m * 16) * 4096 + colb + bj * 128);
#pragma unroll
            for (int m = 0; m < 4; ++m) {
                const f32x4 s0 = sA[m], s1 = sB[m];
                const float rsv = __builtin_amdgcn_rsqf((((s0[0] + s0[1]) + (s0[2] + s0[3])) + ((s1[0] + s1[1]) + (s1[2] + s1[3]))) * (1.0f / 512.0f) + 1e-6f);
#pragma unroll
                for (int bj = 0; bj < 2; ++bj) {
                    const u32x4 r4 = rr[m][bj];
                    const float rf[8] = {bflo(r4.x), bfhi(r4.x), bflo(r4.y), bfhi(r4.y), bflo(r4.z), bfhi(r4.z), bflo(r4.w), bfhi(r4.w)};
                    f32x4 o0, o1;
#pragma unroll
                    for (int j = 0; j < 4; ++j) {
                        const float a0 = acc[ai][bj][m][0][j], a1 = acc[ai][bj][m][1][j];
                        o0[j] = a0 * sigmoidf_(a0) * (rf[j] * rsv * gn[bj][0][j]); o1[j] = a1 * sigmoidf_(a1) * (rf[4 + j] * rsv * gn[bj][1][j]);
                    }
                    *(u32x4*)(ret + (size_t)(rowbase + ai * 128 + m * 16) * 4096 + colb + bj * 128) = pack8(o0, o1);
                }
            }
        }
    }
};

struct EpiGates {
    bf16_t* O; const float* bias;
    DI void operator()(const AccT& acc, const Unit& u, int wr, int wc, int fr, int fq) const {
        const int rowbase = u.pm * 256 + wr * 64 + fr;
#pragma unroll
        for (int bj = 0; bj < 2; ++bj) {
            const int col = u.pn * 256 + bj * 128 + wc * 32 + 8 * fq;
            const f32x4 b0 = *(const f32x4*)(bias + col), b1 = *(const f32x4*)(bias + col + 4);
#pragma unroll
            for (int ai = 0; ai < 2; ++ai)
#pragma unroll
                for (int m = 0; m < 4; ++m) {
                    f32x4 o0, o1;
#pragma unroll
                    for (int j = 0; j < 4; ++j) { o0[j] = sigmoidf_(acc[ai][bj][m][0][j] + b0[j]); o1[j] = sigmoidf_(acc[ai][bj][m][1][j] + b1[j]); }
                    *(u32x4*)(O + (size_t)(rowbase + ai * 128 + m * 16) * 4096 + col) = pack8(o0, o1);
                }
        }
    }
};

struct EpiYMerge {
    const bf16_t* gates; bf16_t* U2;
    DI void mid(AccT& acc, const Unit& u, int wr, int wc, int fr, int fq) const {
        const int rowbase = u.pm * 256 + wr * 64 + fr, colb = u.pn * 256 + wc * 32 + 8 * fq;
#pragma unroll
        for (int ai = 0; ai < 2; ++ai) {
            u32x4 gr[4][2], ga[4][2];
#pragma unroll
            for (int m = 0; m < 4; ++m)
#pragma unroll
                for (int bj = 0; bj < 2; ++bj) { const bf16_t* pg = gates + (size_t)(rowbase + ai * 128 + m * 16) * 4096 + colb + bj * 128; gr[m][bj] = *(const u32x4*)pg; ga[m][bj] = *(const u32x4*)(pg + 2048); }
#pragma unroll
            for (int m = 0; m < 4; ++m)
#pragma unroll
                for (int bj = 0; bj < 2; ++bj) {
                    const u32x4 g1 = gr[m][bj], g2 = ga[m][bj];
                    const float r[8] = {bflo(g1.x), bfhi(g1.x), bflo(g1.y), bfhi(g1.y), bflo(g1.z), bfhi(g1.z), bflo(g1.w), bfhi(g1.w)};
                    const float a[8] = {bflo(g2.x), bfhi(g2.x), bflo(g2.y), bfhi(g2.y), bflo(g2.z), bfhi(g2.z), bflo(g2.w), bfhi(g2.w)};
#pragma unroll
                    for (int j = 0; j < 4; ++j) { acc[ai][bj][m][0][j] *= r[j] * __builtin_amdgcn_rcpf(fmaxf(a[j], 1e-30f)); acc[ai][bj][m][1][j] *= r[4 + j] * __builtin_amdgcn_rcpf(fmaxf(a[4 + j], 1e-30f)); }
                }
        }
    }
    DI void operator()(const AccT& acc, const Unit& u, int wr, int wc, int fr, int fq) const {
        const int rowbase = u.pm * 256 + wr * 64 + fr, colb = u.pn * 256 + wc * 32 + 8 * fq;
        u32x4 gg[2][4][2];
#pragma unroll
        for (int ai = 0; ai < 2; ++ai)
#pragma unroll
            for (int m = 0; m < 4; ++m)
#pragma unroll
                for (int bj = 0; bj < 2; ++bj) gg[ai][m][bj] = *(const u32x4*)(gates + (size_t)(rowbase + ai * 128 + m * 16) * 4096 + 2048 + colb + bj * 128);
#pragma unroll
        for (int ai = 0; ai < 2; ++ai)
#pragma unroll
            for (int m = 0; m < 4; ++m)
#pragma unroll
                for (int bj = 0; bj < 2; ++bj) {
                    const u32x4 g4 = gg[ai][m][bj];
                    f32x4 o0 = acc[ai][bj][m][0], o1 = acc[ai][bj][m][1];
                    o0[0] *= bflo(g4.x); o0[1] *= bfhi(g4.x); o0[2] *= bflo(g4.y); o0[3] *= bfhi(g4.y);
                    o1[0] *= bflo(g4.z); o1[1] *= bfhi(g4.z); o1[2] *= bflo(g4.w); o1[3] *= bfhi(g4.w);
                    *(u32x4*)(U2 + (size_t)(rowbase + ai * 128 + m * 16) * 2048 + colb + bj * 128) = pack8(o0, o1);
                }
    }
};

DI float gelu_tanh(float v) {
    const float uu = 0.7978845608028654f * (v + 0.044715f * v * v * v);
    const float e = __builtin_amdgcn_exp2f(2.8853900817779268f * uu);
    return v - v * __builtin_amdgcn_rcpf(e + 1.0f);
}
struct EpiConvAct {
    const bf16_t* A; bf16_t* ACT; const float* conv_w; const float* conv_b;
    DI void operator()(const AccT& acc, const Unit& u, int wr, int wc, int fr, int fq) const {
        const int rowbase = u.pm * 256 + wr * 64 + fr;
#pragma unroll
        for (int bj = 0; bj < 2; ++bj) {
            const int col = u.pn * 256 + bj * 128 + wc * 32 + 8 * fq;
            f32x4 w0[2], w1[2], w2[2], cb[2];
#pragma unroll
            for (int hh = 0; hh < 2; ++hh) { w0[hh] = *(const f32x4*)(conv_w + col + 4 * hh); w1[hh] = *(const f32x4*)(conv_w + FF + col + 4 * hh); w2[hh] = *(const f32x4*)(conv_w + 2 * FF + col + 4 * hh); cb[hh] = *(const f32x4*)(conv_b + col + 4 * hh); }
#pragma unroll
            for (int aim = 0; aim < 4; ++aim) { const int ai = aim >> 1, mb = (aim & 1) * 2;
                u32x4 a0[4], a1[4], a2[4];
#pragma unroll
                for (int m = mb; m < mb + 2; ++m) {
                    const int row = rowbase + ai * 128 + m * 16; const int sq = row & (SEQ - 1);
                    const bf16_t* pa = A + (size_t)row * FF + col;
                    a0[m] = *(const u32x4*)pa;
                    a1[m] = *(const u32x4*)(pa - (sq >= 1 ? FF : 0));
                    a2[m] = *(const u32x4*)(pa - (sq >= 2 ? 2 * FF : 0));
                }
#pragma unroll
                for (int m = mb; m < mb + 2; ++m) {
                    const int row = rowbase + ai * 128 + m * 16; const int sq = row & (SEQ - 1);
                    const float k1 = sq >= 1 ? 1.0f : 0.0f, k2 = sq >= 2 ? 1.0f : 0.0f;
                    const u32x4 x0 = a0[m], x1 = a1[m], x2 = a2[m];
                    const float f0[8] = {bflo(x0.x), bfhi(x0.x), bflo(x0.y), bfhi(x0.y), bflo(x0.z), bfhi(x0.z), bflo(x0.w), bfhi(x0.w)};
                    const float f1[8] = {bflo(x1.x), bfhi(x1.x), bflo(x1.y), bfhi(x1.y), bflo(x1.z), bfhi(x1.z), bflo(x1.w), bfhi(x1.w)};
                    const float f2[8] = {bflo(x2.x), bfhi(x2.x), bflo(x2.y), bfhi(x2.y), bflo(x2.z), bfhi(x2.z), bflo(x2.w), bfhi(x2.w)};
                    f32x4 o0, o1;
#pragma unroll
                    for (int j = 0; j < 4; ++j) {
                        const float c0 = cb[0][j] + w0[0][j] * f0[j] + k1 * (w1[0][j] * f1[j]) + k2 * (w2[0][j] * f2[j]);
                        const float c1 = cb[1][j] + w0[1][j] * f0[4 + j] + k1 * (w1[1][j] * f1[4 + j]) + k2 * (w2[1][j] * f2[4 + j]);
                        o0[j] = gelu_tanh(c0) * acc[ai][bj][m][0][j]; o1[j] = gelu_tanh(c1) * acc[ai][bj][m][1][j];
                    }
                    *(u32x4*)(ACT + (size_t)row * FF + col) = pack8(o0, o1);
                }
            }
        }
    }
};

DI int invperm32(int c) { return 16 * ((c >> 2) & 1) + 4 * (c >> 3) + (c & 3); }
DI int slot_std(int c) { return (c & ~31) | invperm32(c & 31); }
DI int slot_win(int c) {
    if (c >= 12288 && c < 16896) { const int tc = c & 255, hh = tc >> 7, bj = (tc >> 6) & 1, i64 = tc & 63, x = 64 * hh + i64; return (c & ~255) + 128 * bj + (x & ~31) + invperm32(x & 31); }
    return slot_std(c);
}
DI void transpose_item(const float* W, int K, int N, bf16_t* WT, int mode, LAS float* scr, int item, int lane) {
    const int nblk = N / 32, kb = item / nblk, nb = item % nblk, k0 = 64 * kb, n0 = 32 * nb;
#pragma unroll 16
    for (int i = 0; i < 32; ++i) { const int kk = 2 * i + (lane >> 5); scr[kk * 33 + (lane & 31)] = W[(size_t)(k0 + kk) * N + n0 + (lane & 31)]; }
    asm volatile("s_waitcnt lgkmcnt(0)" ::: "memory");
    const int c = lane & 7;
#pragma unroll
    for (int j = 0; j < 4; ++j) { const int n = (lane >> 3) + 8 * j; const LAS float* s = scr + (8 * c) * 33 + n;
        u32x4 o; o.x = cvt_pk_bf16(s[0 * 33], s[1 * 33]); o.y = cvt_pk_bf16(s[2 * 33], s[3 * 33]); o.z = cvt_pk_bf16(s[4 * 33], s[5 * 33]); o.w = cvt_pk_bf16(s[6 * 33], s[7 * 33]);
        const int drow = mode ? slot_win(n0 + n) : slot_std(n0 + n);
        *(u32x4*)(WT + (size_t)drow * K + k0 + 8 * c) = o; }
    asm volatile("s_waitcnt lgkmcnt(0)" ::: "memory");
}

DI void phase0(const Params& p, LAS unsigned char* lds) {
    const int tid = threadIdx.x, lane = tid & 63, wave = tid >> 6;
    LAS float* sc = (LAS float*)lds;
    LAS float* red = sc + 8192;
    float* ada = (float*)(p.ws + WS_ADA);
    for (int i = tid; i < 8192; i += 512) { const float v = p.c[i]; sc[i] = v / (1.0f + __expf(-v)); }
    __syncthreads();
    for (int cb = blockIdx.x; cb < 256; cb += gridDim.x) {
        {
            const int rg = lane / 12, cq = lane - 12 * rg;
            f32x4 a0 = {0.f, 0.f, 0.f, 0.f}, a1 = a0, a2 = a0, a3 = a0;
            if (rg < 5) {
                const float* wp = p.w_ada + 48 * cb + 4 * cq;
#pragma unroll 13
                for (int i = 0; i < 52; ++i) { const int kl = 5 * i + rg; if (kl < 256) { const int kk = 256 * wave + kl; const f32x4 wv = *(const f32x4*)(wp + (size_t)kk * 12288);
                    a0 += sc[kk] * wv; a1 += sc[2048 + kk] * wv; a2 += sc[4096 + kk] * wv; a3 += sc[6144 + kk] * wv; } }
                LAS float* rp = red + ((wave * 5 + rg) * 4) * 48 + 4 * cq;
                *(LAS f32x4*)(rp) = a0; *(LAS f32x4*)(rp + 48) = a1; *(LAS f32x4*)(rp + 96) = a2; *(LAS f32x4*)(rp + 144) = a3;
            }
        }
        __syncthreads();
        if (tid < 192) { const int b = tid / 48, l = tid % 48; float sacc = 0.f;
#pragma unroll 8
            for (int wg = 0; wg < 40; ++wg) sacc += red[(wg * 4 + b) * 48 + l];
            ada[b * 12288 + 48 * cb + l] = sacc + p.b_ada[48 * cb + l]; }
        __syncthreads();
    }
    LAS float* scr = (LAS float*)(lds + 40960 + wave * 8448);
    const int gw = blockIdx.x * 8 + wave, NGW = gridDim.x * 8;
    constexpr int I_IN = (2048 / 64) * (19200 / 32), I_GATE = (2048 / 64) * (4096 / 32), I_RET = (4096 / 64) * (2048 / 32), I_ATT = (2304 / 64) * (2048 / 32),
                  I_MIX = (2048 / 64) * (2048 / 32), I_UP = (2048 / 64) * (11264 / 32), I_DOWN = (5632 / 64) * (2048 / 32);
    constexpr int NITEMS = I_IN + I_GATE + I_RET + I_ATT + I_MIX + I_UP + I_DOWN;
    for (int it = gw; it < NITEMS; it += NGW) {
        int r = it;
        if (r < I_IN) { transpose_item(p.w_in, 2048, 19200, (bf16_t*)(p.ws + WS_WIN), 1, scr, r, lane); continue; } r -= I_IN;
        if (r < I_GATE) { transpose_item(p.w_gate, 2048, 4096, (bf16_t*)(p.ws + WS_WGATE), 0, scr, r, lane); continue; } r -= I_GATE;
        if (r < I_RET) { transpose_item(p.w_ret_out, 4096, 2048, (bf16_t*)(p.ws + WS_WRET), 0, scr, r, lane); continue; } r -= I_RET;
        if (r < I_ATT) { transpose_item(p.w_att_out, 2304, 2048, (bf16_t*)(p.ws + WS_WATT), 0, scr, r, lane); continue; } r -= I_ATT;
        if (r < I_MIX) { transpose_item(p.w_mix, 2048, 2048, (bf16_t*)(p.ws + WS_WMIX), 0, scr, r, lane); continue; } r -= I_MIX;
        if (r < I_UP) { transpose_item(p.w_up, 2048, 11264, (bf16_t*)(p.ws + WS_WUP), 0, scr, r, lane); continue; } r -= I_UP;
        transpose_item(p.w_down, 5632, 2048, (bf16_t*)(p.ws + WS_WDOWN), 0, scr, r, lane);
    }
}

constexpr int NR = 2;
DI void phase_h(const Params& p) {
    const int lane = threadIdx.x & 63, wave = threadIdx.x >> 6;
    const float* ada = (const float*)(p.ws + WS_ADA); bf16_t* H = (bf16_t*)(p.ws + WS_H);
    const int nw = gridDim.x * 8;
    for (int row0 = blockIdx.x * 8 + wave; row0 < T_TOK; row0 += nw * NR) {
        f32x4 v[NR][4][2]; float ss[NR];
#pragma unroll
        for (int q = 0; q < NR; ++q) { const float* xr = p.x + (size_t)(row0 + q * nw) * DM; ss[q] = 0.f;
#pragma unroll
            for (int it = 0; it < 4; ++it) { const int col = (it * 64 + lane) * 8; v[q][it][0] = *(const f32x4*)(xr + col); v[q][it][1] = *(const f32x4*)(xr + col + 4); } }
#pragma unroll
        for (int q = 0; q < NR; ++q) {
#pragma unroll
            for (int it = 0; it < 4; ++it)
#pragma unroll
                for (int j = 0; j < 4; ++j) ss[q] += v[q][it][0][j] * v[q][it][0][j] + v[q][it][1][j] * v[q][it][1][j];
            ss[q] = __builtin_amdgcn_rsqf(wave_sum(ss[q]) * (1.0f / DM) + 1e-6f); }
#pragma unroll
        for (int it = 0; it < 4; ++it) { const int col = (it * 64 + lane) * 8;
            f32x4 g[2], sh[NR][2], scl[NR][2];
#pragma unroll
            for (int hh = 0; hh < 2; ++hh) { g[hh] = *(const f32x4*)(p.g_pre_mix + col + 4 * hh);
#pragma unroll
                for (int q = 0; q < NR; ++q) { const int b = (row0 + q * nw) / SEQ; sh[q][hh] = *(const f32x4*)(ada + b * 12288 + col + 4 * hh); scl[q][hh] = *(const f32x4*)(ada + b * 12288 + 2048 + col + 4 * hh); } }
#pragma unroll
            for (int q = 0; q < NR; ++q) { f32x4 o[2];
#pragma unroll
                for (int hh = 0; hh < 2; ++hh)
#pragma unroll
                    for (int j = 0; j < 4; ++j) o[hh][j] = v[q][it][hh][j] * ss[q] * g[hh][j] * (1.0f + scl[q][hh][j]) + sh[q][hh][j];
                *(u32x4*)(H + (size_t)(row0 + q * nw) * DM + col) = pack8(o[0], o[1]); } }
    }
}

DI void phase_postmix(const Params& p) {
    const int lane = threadIdx.x & 63, wave = threadIdx.x >> 6;
    const float* ada = (const float*)(p.ws + WS_ADA); const bf16_t* Y = (const bf16_t*)(p.ws + WS_Y); bf16_t* H2 = (bf16_t*)(p.ws + WS_H2);
    const int nw = gridDim.x * 8;
    for (int row0 = blockIdx.x * 8 + wave; row0 < T_TOK; row0 += nw * NR) {
        f32x4 y[NR][4][2], xv[NR][4][2]; float ry[NR], r1[NR];
#pragma unroll
        for (int q = 0; q < NR; ++q) { const size_t ro = (size_t)(row0 + q * nw) * DM;
#pragma unroll
            for (int it = 0; it < 4; ++it) { const int col = (it * 64 + lane) * 8; const u32x4 w = *(const u32x4*)(Y + ro + col);
                y[q][it][0] = (f32x4){bflo(w.x), bfhi(w.x), bflo(w.y), bfhi(w.y)}; y[q][it][1] = (f32x4){bflo(w.z), bfhi(w.z), bflo(w.w), bfhi(w.w)};
                xv[q][it][0] = *(const f32x4*)(p.x + ro + col); xv[q][it][1] = *(const f32x4*)(p.x + ro + col + 4); } }
#pragma unroll
        for (int q = 0; q < NR; ++q) { float ss = 0.f;
#pragma unroll
            for (int it = 0; it < 4; ++it)
#pragma unroll
                for (int j = 0; j < 4; ++j) ss += y[q][it][0][j] * y[q][it][0][j] + y[q][it][1][j] * y[q][it][1][j];
            ry[q] = __builtin_amdgcn_rsqf(wave_sum(ss) * (1.0f / DM) + 1e-6f); }
#pragma unroll
        for (int q = 0; q < NR; ++q) { const int row = row0 + q * nw; const float* ab = ada + (row / SEQ) * 12288; float s1 = 0.f;
#pragma unroll
            for (int it = 0; it < 4; ++it) { const int col = (it * 64 + lane) * 8;
#pragma unroll
                for (int hh = 0; hh < 2; ++hh) { const f32x4 g = *(const f32x4*)(p.g_post_mix + col + 4 * hh), gt = *(const f32x4*)(ab + 4096 + col + 4 * hh);
                    f32x4 o;
#pragma unroll
                    for (int j = 0; j < 4; ++j) { o[j] = xv[q][it][hh][j] + gt[j] * (y[q][it][hh][j] * ry[q] * g[j]); s1 += o[j] * o[j]; }
                    y[q][it][hh] = o; *(f32x4*)(p.out + (size_t)row * DM + col + 4 * hh) = o; } }
            r1[q] = __builtin_amdgcn_rsqf(wave_sum(s1) * (1.0f / DM) + 1e-6f); }
#pragma unroll
        for (int q = 0; q < NR; ++q) { const int row = row0 + q * nw; const float* ab = ada + (row / SEQ) * 12288;
#pragma unroll
            for (int it = 0; it < 4; ++it) { const int col = (it * 64 + lane) * 8; f32x4 o[2];
#pragma unroll
                for (int hh = 0; hh < 2; ++hh) { const f32x4 g = *(const f32x4*)(p.g_pre_ffn + col + 4 * hh), sh = *(const f32x4*)(ab + 6144 + col + 4 * hh), scl = *(const f32x4*)(ab + 8192 + col + 4 * hh);
#pragma unroll
                    for (int j = 0; j < 4; ++j) o[hh][j] = y[q][it][hh][j] * r1[q] * g[j] * (1.0f + scl[j]) + sh[j]; }
                *(u32x4*)(H2 + (size_t)row * DM + col) = pack8(o[0], o[1]); } }
    }
}

DI void phase_final(const Params& p) {
    const int lane = threadIdx.x & 63, wave = threadIdx.x >> 6;
    const float* ada = (const float*)(p.ws + WS_ADA); const bf16_t* Y = (const bf16_t*)(p.ws + WS_Y2);
    const int nw = gridDim.x * 8;
    for (int row0 = blockIdx.x * 8 + wave; row0 < T_TOK; row0 += nw * NR) {
        f32x4 y[NR][4][2], xv[NR][4][2]; float ry[NR];
#pragma unroll
        for (int q = 0; q < NR; ++q) { const size_t ro = (size_t)(row0 + q * nw) * DM;
#pragma unroll
            for (int it = 0; it < 4; ++it) { const int col = (it * 64 + lane) * 8; const u32x4 w = *(const u32x4*)(Y + ro + col);
                y[q][it][0] = (f32x4){bflo(w.x), bfhi(w.x), bflo(w.y), bfhi(w.y)}; y[q][it][1] = (f32x4){bflo(w.z), bfhi(w.z), bflo(w.w), bfhi(w.w)};
                xv[q][it][0] = *(const f32x4*)(p.out + ro + col); xv[q][it][1] = *(const f32x4*)(p.out + ro + col + 4); } }
#pragma unroll
        for (int q = 0; q < NR; ++q) { float ss = 0.f;
#pragma unroll
            for (int it = 0; it < 4; ++it)
#pragma unroll
                for (int j = 0; j < 4; ++j) ss += y[q][it][0][j] * y[q][it][0][j] + y[q][it][1][j] * y[q][it][1][j];
            ry[q] = __builtin_amdgcn_rsqf(wave_sum(ss) * (1.0f / DM) + 1e-6f); }
#pragma unroll
        for (int q = 0; q < NR; ++q) { const int row = row0 + q * nw; const float* ab = ada + (row / SEQ) * 12288;
#pragma unroll
            for (int it = 0; it < 4; ++it) { const int col = (it * 64 + lane) * 8;
#pragma unroll
                for (int hh = 0; hh < 2; ++hh) { const f32x4 g = *(const f32x4*)(p.g_post_ffn + col + 4 * hh), gt = *(const f32x4*)(ab + 10240 + col + 4 * hh);
                    f32x4 o;
#pragma unroll
                    for (int j = 0; j < 4; ++j) o[j] = xv[q][it][hh][j] + gt[j] * (y[q][it][hh][j] * ry[q] * g[j]);
                    *(f32x4*)(p.out + (size_t)row * DM + col + 4 * hh) = o; } } }
    }
}

DI void phase_alpha(const Params& p) {
    bf16_t* att = (bf16_t*)(p.ws + WS_AQ); const float* lse = (const float*)(p.ws + WS_LSE);
    const int lane = threadIdx.x & 63, wave = threadIdx.x >> 6;
    for (int t = blockIdx.x * 8 + wave; t < T_TOK; t += gridDim.x * 8) {
        const float l = lse[(size_t)t * 18 + (lane < 18 ? lane : 0)];
        const int j = lane % 6;
        const float l0 = __shfl(l, j), l1 = __shfl(l, 6 + j), l2 = __shfl(l, 12 + j);
        const float mm = fmaxf(l0, fmaxf(l1, l2)); const float e0 = __expf(l0 - mm), e1 = __expf(l1 - mm), e2 = __expf(l2 - mm);
        const float al_lane = __expf(l - mm) / (e0 + e1 + e2);
        u32x4* row = (u32x4*)(att + (size_t)t * 2304);
        u32x4 w[5];
#pragma unroll
        for (int k = 0; k < 5; ++k) { const int ch = lane + 64 * k; if (ch < 288) w[k] = row[ch]; }
#pragma unroll
        for (int k = 0; k < 5; ++k) { const int ch = lane + 64 * k; const float al = __shfl(al_lane, (ch < 288 ? ch : 0) >> 4);
            if (ch < 288) { u32x4 o;
                o.x = cvt_pk_bf16(bflo(w[k].x) * al, bfhi(w[k].x) * al); o.y = cvt_pk_bf16(bflo(w[k].y) * al, bfhi(w[k].y) * al);
                o.z = cvt_pk_bf16(bflo(w[k].z) * al, bfhi(w[k].z) * al); o.w = cvt_pk_bf16(bflo(w[k].w) * al, bfhi(w[k].w) * al);
                row[ch] = o; } }
    }
}

DI void phase_retention(const Params& p, LAS unsigned char* lds, int cblk) {
    const int tid = threadIdx.x, lane = tid & 63, w = tid >> 6, fr = lane & 15, fq = lane >> 4;
    LAS unsigned char* Qs = lds; LAS unsigned char* Ks = lds + 33792; LAS unsigned char* Vs = lds + 67584; LAS unsigned char* St = lds + 76800; LAS unsigned char* Ps = lds + 110592;
    LAS float* red = (LAS float*)(lds + 119808);
    const bf16_t* rq = (const bf16_t*)(p.ws + WS_RQ); const bf16_t* rk = (const bf16_t*)(p.ws + WS_RK); bf16_t* rv = (bf16_t*)p.out; float* retss = (float*)(p.ws + WS_RETSS);
    for (int item = cblk; item < 256; item += gridDim.x) {
        const int q5 = item >> 3, bh = (item & 7) * 4 + (q5 & 3), slice = q5 >> 2, b = bh >> 3, h = bh & 7;
        const float lg = log1pf(-exp2f(-5.0f - (float)h));
        const float gamma_c = expf(64.0f * lg);
        const float xv = expf(-lg * (float)((tid >> 3) + 1));
        const float xo0 = expf(lg * (float)(32 * (w & 1) + fr + 1)), xo1 = expf(lg * (float)(32 * (w & 1) + 16 + fr + 1));
        const size_t tok0 = (size_t)b * SEQ;
        const bf16_t* qbase = rq + tok0 * 2048 + h * 256 + (tid & 31) * 8; const bf16_t* kbase = rk + tok0 * 2048 + h * 256 + (tid & 31) * 8;
        bf16_t* vbase = rv + tok0 * 4096 + h * 512 + slice * 64;
        u32x4 pq[4], pk[4], pv;
        f32x4 Sreg[2][4];
#pragma unroll
        for (int a = 0; a < 2; ++a)
#pragma unroll
            for (int bb = 0; bb < 4; ++bb) Sreg[a][bb] = (f32x4){0.f, 0.f, 0.f, 0.f};
        for (int i = tid; i < 33792 / 16; i += 512) ((LAS u32x4*)St)[i] = (u32x4){0u, 0u, 0u, 0u};
#define RET_LOAD(c) do { _Pragma("unroll") for (int i = 0; i < 4; ++i) { const int row = (tid + 512 * i) >> 5; \
            pq[i] = *(const u32x4*)(qbase + (size_t)(64 * (c) + row) * 2048); pk[i] = *(const u32x4*)(kbase + (size_t)(64 * (c) + row) * 2048); } \
            pv = *(const u32x4*)(vbase + (size_t)(64 * (c) + (tid >> 3)) * 4096 + (tid & 7) * 8); } while (0)
#define RET_STORE() do { _Pragma("unroll") for (int i = 0; i < 4; ++i) { const int e = tid + 512 * i, row = e >> 5, pc = e & 31; \
            *(LAS u32x4*)(Qs + row * 528 + pc * 16) = pq[i]; *(LAS u32x4*)(Ks + row * 528 + pc * 16) = pk[i]; } \
            { u32x4 o; o.x = cvt_pk_bf16(bflo(pv.x) * xv, bfhi(pv.x) * xv); o.y = cvt_pk_bf16(bflo(pv.y) * xv, bfhi(pv.y) * xv); \
              o.z = cvt_pk_bf16(bflo(pv.z) * xv, bfhi(pv.z) * xv); o.w = cvt_pk_bf16(bflo(pv.w) * xv, bfhi(pv.w) * xv); \
              *(LAS u32x4*)(Vs + (tid >> 3) * 144 + (tid & 7) * 16) = o; } } while (0)
        RET_LOAD(0); RET_STORE();
        __syncthreads();
        for (int c = 0; c < 128; ++c) {
            if (c + 1 < 128) RET_LOAD(c + 1);
            bf16x8 qfr[8][2];
            {
                const int jt = w >> 1, it0 = (w & 1) * 2;
                f32x4 sa[2] = {(f32x4){0.f, 0.f, 0.f, 0.f}, (f32x4){0.f, 0.f, 0.f, 0.f}};
#pragma unroll
                for (int ks = 0; ks < 8; ++ks) {
                    const bf16x8 kf = *(const LAS bf16x8*)(Ks + (16 * jt + fr) * 528 + (32 * ks + 8 * fq) * 2);
#pragma unroll
                    for (int t = 0; t < 2; ++t) { qfr[ks][t] = *(const LAS bf16x8*)(Qs + (16 * (it0 + t) + fr) * 528 + (32 * ks + 8 * fq) * 2); sa[t] = mfma16(kf, qfr[ks][t], sa[t]); }
                }
#pragma unroll
                for (int t = 0; t < 2; ++t) { const int iq = 16 * (it0 + t) + fr, jk0 = 16 * jt + 4 * fq;
                    u32x2 o; o.x = cvt_pk_bf16(jk0 + 0 <= iq ? sa[t][0] : 0.f, jk0 + 1 <= iq ? sa[t][1] : 0.f); o.y = cvt_pk_bf16(jk0 + 2 <= iq ? sa[t][2] : 0.f, jk0 + 3 <= iq ? sa[t][3] : 0.f);
                    *(LAS u32x2*)(Ps + iq * 144 + jk0 * 2) = o; }
            }
            {
#pragma unroll
                for (int ks = 0; ks < 2; ++ks) {
                    const int j0 = 32 * ks + 8 * fq + (fr >> 2);
                    bf16x8 kt[2], vf[4];
#pragma unroll
                    for (int dd = 0; dd < 2; ++dd) { LAS unsigned char* a0 = Ks + j0 * 528 + (16 * (2 * w + dd) + 4 * (fr & 3)) * 2; kt[dd] = tr_read2(a0, a0 + 4 * 528); }
#pragma unroll
                    for (int vt = 0; vt < 4; ++vt) { LAS unsigned char* a0 = Vs + j0 * 144 + (16 * vt + 4 * (fr & 3)) * 2; vf[vt] = tr_read2(a0, a0 + 4 * 144); }
#pragma unroll
                    for (int dd = 0; dd < 2; ++dd)
#pragma unroll
                        for (int vt = 0; vt < 4; ++vt) Sreg[dd][vt] = mfma16(kt[dd], vf[vt], Sreg[dd][vt]);
                }
#pragma unroll
                for (int dd = 0; dd < 2; ++dd)
#pragma unroll
                    for (int vt = 0; vt < 4; ++vt) Sreg[dd][vt] *= gamma_c;
            }
            __syncthreads();
            {
                const int vt = w >> 1, it0 = (w & 1) * 2;
                f32x4 oa[2] = {(f32x4){0.f, 0.f, 0.f, 0.f}, (f32x4){0.f, 0.f, 0.f, 0.f}};
#pragma unroll
                for (int ks = 0; ks < 8; ++ks) {
                    const bf16x8 sf = *(const LAS bf16x8*)(St + (16 * vt + fr) * 528 + (32 * ks + 8 * fq) * 2);
#pragma unroll
                    for (int t = 0; t < 2; ++t) oa[t] = mfma16(sf, qfr[ks][t], oa[t]);
                }
#pragma unroll
                for (int ks = 0; ks < 2; ++ks) {
                    const int j0 = 32 * ks + 8 * fq + (fr >> 2);
                    LAS unsigned char* a0 = Vs + j0 * 144 + (16 * vt + 4 * (fr & 3)) * 2; const bf16x8 vf = tr_read2(a0, a0 + 4 * 144);
#pragma unroll
                    for (int t = 0; t < 2; ++t) { const bf16x8 pf = *(const LAS bf16x8*)(Ps + (16 * (it0 + t) + fr) * 144 + (32 * ks + 8 * fq) * 2); oa[t] = mfma16(vf, pf, oa[t]); }
                }
#pragma unroll
                for (int t = 0; t < 2; ++t) { const int iq = 16 * (it0 + t) + fr; oa[t] *= (t == 0 ? xo0 : xo1);
                    u32x2 o; o.x = cvt_pk_bf16(oa[t][0], oa[t][1]); o.y = cvt_pk_bf16(oa[t][2], oa[t][3]);
                    *(u32x2*)(vbase + (size_t)(64 * c + iq) * 4096 + 16 * vt + 4 * fq) = o;
                    float ss = (oa[t][0] * oa[t][0] + oa[t][1] * oa[t][1]) + (oa[t][2] * oa[t][2] + oa[t][3] * oa[t][3]);
                    ss += __shfl_xor(ss, 16); ss += __shfl_xor(ss, 32);
                    if (fq == 0) red[iq * 4 + vt] = ss; }
            }
            __syncthreads();
#pragma unroll
            for (int dd = 0; dd < 2; ++dd)
#pragma unroll
                for (int vt = 0; vt < 4; ++vt) { u32x2 o; o.x = cvt_pk_bf16(Sreg[dd][vt][0], Sreg[dd][vt][1]); o.y = cvt_pk_bf16(Sreg[dd][vt][2], Sreg[dd][vt][3]);
                    *(LAS u32x2*)(St + (16 * vt + fr) * 528 + (16 * (2 * w + dd) + 4 * fq) * 2) = o; }
            if (c + 1 < 128) RET_STORE();
            if (tid < 64) retss[((tok0 + 64 * c + tid) * 8 + h) * 8 + slice] = (red[tid * 4 + 0] + red[tid * 4 + 1]) + (red[tid * 4 + 2] + red[tid * 4 + 3]);
            __syncthreads();
        }
#undef RET_LOAD
#undef RET_STORE
    }
}

DI void phase_attention(const Params& p, LAS unsigned char* lds) {
    const int tid = threadIdx.x, lane = tid & 63, w = tid >> 6, fr = lane & 15, fq = lane >> 4;
    LAS unsigned char* Ks = lds; LAS unsigned char* Vs = lds + 69632;
    bf16_t* aq = (bf16_t*)(p.ws + WS_AQ); const bf16_t* ak = (const bf16_t*)(p.ws + WS_AK); const bf16_t* av = (const bf16_t*)(p.ws + WS_AV); float* lse = (float*)(p.ws + WS_LSE);
    const int per = (4608 + (int)gridDim.x - 1) / (int)gridDim.x, it_lo = (int)blockIdx.x * per, it_hi = (it_lo + per < 4608) ? it_lo + per : 4608;
    int prev_key = -1;
    u32x4 kcur[4], vcur[4];
#define ATT_LOAD_CUR(item_) do { const int bh_ = (item_) >> 6, e64_ = (item_) & 63, head_ = bh_ % 18, b_ = bh_ / 18; \
        const int rsh_ = 2 * (head_ / 6), r_ = 1 << rsh_, nbc_ = 64 >> rsh_, cls_ = e64_ / nbc_, nb_ = e64_ - cls_ * nbc_; \
        _Pragma("unroll") for (int i = 0; i < 4; ++i) { const int e = tid + 512 * i, row = e >> 4, pc = e & 15; \
            const size_t off = ((size_t)b_ * SEQ + (size_t)(nb_ * 128 + row) * r_ + cls_) * 2304 + head_ * 128 + pc * 8; \
            kcur[i] = *(const u32x4*)(ak + off); vcur[i] = *(const u32x4*)(av + off); } } while (0)
    if (it_lo < it_hi) ATT_LOAD_CUR(it_lo);
    for (int item = it_lo, cnt = 0; item < it_hi; ++item, ++cnt) {
        const int bh = item >> 6, e64 = item & 63, head = bh % 18, b = bh / 18;
        const int g = head / 6, rsh = 2 * g, r = 1 << rsh, nbc = 64 >> rsh, cls = e64 / nbc, nb = e64 - cls * nbc;
        const int pq0 = nb * 128, pk0 = pq0 - 128;
        const size_t tokb = (size_t)b * SEQ;
        const int scur = cnt & 1, sprev = scur ^ 1;
        const bool reuse = (nb > 0) && (prev_key == item - 1);
#pragma unroll
        for (int i = 0; i < 4; ++i) { const int e = tid + 512 * i, row = e >> 4, pc = e & 15;
            *(LAS u32x4*)(Ks + (scur * 128 + row) * 272 + pc * 16) = kcur[i]; *(LAS u32x4*)(Vs + (scur * 128 + row) * 288 + pc * 16) = vcur[i]; }
        if (!reuse) {
#pragma unroll
            for (int i = 0; i < 4; ++i) { const int e = tid + 512 * i, row = e >> 4, pc = e & 15;
                u32x4 kv = {0u, 0u, 0u, 0u}, vv = kv;
                if (nb > 0) { const size_t off = (tokb + (size_t)(pk0 + row) * r + cls) * 2304 + head * 128 + pc * 8; kv = *(const u32x4*)(ak + off); vv = *(const u32x4*)(av + off); }
                *(LAS u32x4*)(Ks + (sprev * 128 + row) * 272 + pc * 16) = kv; *(LAS u32x4*)(Vs + (sprev * 128 + row) * 288 + pc * 16) = vv; }
        }
        if (item + 1 < it_hi) ATT_LOAD_CUR(item + 1);
        prev_key = item;
        const int qq = 16 * w + fr;
        const size_t tokq = tokb + (size_t)(pq0 + qq) * r + cls;
        bf16x8 qf[4];
        { const bf16_t* qp = aq + tokq * 2304 + head * 128 + 8 * fq;
#pragma unroll
          for (int ks = 0; ks < 4; ++ks) qf[ks] = *(const bf16x8*)(qp + 32 * ks); }
        __syncthreads();
        f32x4 sa[10];
#pragma unroll
        for (int kt = 0; kt < 10; ++kt) { sa[kt] = (f32x4){0.f, 0.f, 0.f, 0.f};
            const int T = (w + kt < 16) ? w + kt : 15;
            const int krow = ((T < 8) ? sprev : scur) * 128 + 16 * (T & 7) + fr;
#pragma unroll
            for (int ks = 0; ks < 4; ++ks) { const bf16x8 kf = *(const LAS bf16x8*)(Ks + krow * 272 + (32 * ks + 8 * fq) * 2); sa[kt] = mfma16(kf, qf[ks], sa[kt]); } }
        const float sc2 = 0.08838834764831845f * 1.4426950408889634f;
        float mrow = -INFINITY;
#pragma unroll
        for (int kt = 0; kt < 10; ++kt)
#pragma unroll
            for (int j = 0; j < 4; ++j) { const int kk = 16 * (w + kt) + 4 * fq + j; const bool valid = (kk >= qq) && (kk <= qq + 128) && (pk0 + kk >= 0);
                const float sv = valid ? sa[kt][j] * sc2 : -INFINITY; sa[kt][j] = sv; mrow = fmaxf(mrow, sv); }
        mrow = fmaxf(mrow, __shfl_xor(mrow, 16)); mrow = fmaxf(mrow, __shfl_xor(mrow, 32));
        float lsum = 0.f;
        bf16x8 pf[5];
#pragma unroll
        for (int t = 0; t < 5; ++t) { f32x4 p0, p1;
#pragma unroll
            for (int j = 0; j < 4; ++j) { p0[j] = __builtin_amdgcn_exp2f(sa[2 * t][j] - mrow); p1[j] = __builtin_amdgcn_exp2f(sa[2 * t + 1][j] - mrow); lsum += p0[j] + p1[j]; }
            const u32x4 pk4 = pack8(p0, p1); pf[t] = __builtin_bit_cast(bf16x8, pk4); }
        lsum += __shfl_xor(lsum, 16); lsum += __shfl_xor(lsum, 32);
        f32x4 oa[8];
#pragma unroll
        for (int dt = 0; dt < 8; ++dt) oa[dt] = (f32x4){0.f, 0.f, 0.f, 0.f};
#pragma unroll
        for (int t = 0; t < 5; ++t) {
            const int T0 = w + 2 * t, T1 = (T0 + 1 < 16) ? T0 + 1 : T0;
            const int r0 = ((T0 < 8) ? sprev : scur) * 128 + 16 * (T0 & 7) + 4 * fq + (fr >> 2), r1 = ((T1 < 8) ? sprev : scur) * 128 + 16 * (T1 & 7) + 4 * fq + (fr >> 2);
            LAS unsigned char* a0 = Vs + r0 * 288 + (4 * (fr & 3)) * 2; LAS unsigned char* a1 = Vs + r1 * 288 + (4 * (fr & 3)) * 2;
#pragma unroll
            for (int dt = 0; dt < 8; ++dt) { const bf16x8 vf = tr_read2(a0 + 32 * dt, a1 + 32 * dt); oa[dt] = mfma16(vf, pf[t], oa[dt]); }
        }
        const float inv = __builtin_amdgcn_rcpf(lsum);
        bf16_t* po = aq + tokq * 2304 + head * 128 + 4 * fq;
#pragma unroll
        for (int dt = 0; dt < 8; ++dt) { u32x2 o; o.x = cvt_pk_bf16(oa[dt][0] * inv, oa[dt][1] * inv); o.y = cvt_pk_bf16(oa[dt][2] * inv, oa[dt][3] * inv); *(u32x2*)(po + 16 * dt) = o; }
        if (fq == 0) lse[tokq * 18 + head] = mrow * 0.6931471805599453f + __logf(lsum);
        __syncthreads();
    }
#undef ATT_LOAD_CUR
}

constexpr size_t WS_BAR = 700000;
DI void grid_barrier(unsigned* bar, unsigned& nbar, const bool hier, const unsigned xcd, const unsigned per_xcd) {
    asm volatile("s_waitcnt vmcnt(0)" ::: "memory");
    __syncthreads();
    if (threadIdx.x == 0) {
        __builtin_amdgcn_fence(__ATOMIC_RELEASE, "agent");
        asm volatile("s_waitcnt vmcnt(0)" ::: "memory");
        const unsigned gen = nbar + 1u;
        if (hier) {
            unsigned* xc = bar + 256 + 64 * xcd; unsigned* top = bar + 1024;
            const unsigned old = __hip_atomic_fetch_add(xc, 1u, __ATOMIC_RELAXED, __HIP_MEMORY_SCOPE_AGENT);
            if (old + 1u == gen * per_xcd) __hip_atomic_fetch_add(top, 1u, __ATOMIC_RELAXED, __HIP_MEMORY_SCOPE_AGENT);
            while (__hip_atomic_load(top, __ATOMIC_RELAXED, __HIP_MEMORY_SCOPE_AGENT) < gen * 8u) __builtin_amdgcn_s_sleep(1);
        } else {
            const unsigned target = gen * gridDim.x;
            __hip_atomic_fetch_add(bar, 1u, __ATOMIC_RELAXED, __HIP_MEMORY_SCOPE_AGENT);
            while (__hip_atomic_load(bar, __ATOMIC_RELAXED, __HIP_MEMORY_SCOPE_AGENT) < target) __builtin_amdgcn_s_sleep(1);
        }
        __builtin_amdgcn_fence(__ATOMIC_ACQUIRE, "agent");
        asm volatile("s_waitcnt vmcnt(0)" ::: "memory");
    }
    __syncthreads();
    ++nbar;
}

constexpr int N_PHASES = 13;
__global__ void __launch_bounds__(512, 2) mega(Params p) {
    extern __shared__ __attribute__((aligned(16))) unsigned char shm[];
    LAS unsigned char* lds = (LAS unsigned char*)shm;
    unsigned char* ws = p.ws;
    const int G = gridDim.x, c = blockIdx.x;
    unsigned* bar = (unsigned*)(ws + WS_BAR); unsigned nbar = 0;
    int c_eff = c; unsigned my_xcd = 0, my_idx = 0; bool hier = false;
    if (p.ph_hi - p.ph_lo > 1) {
        my_xcd = (unsigned)__builtin_amdgcn_s_getreg((3 << 11) | 20) & 0xFu;
        if (threadIdx.x == 0) my_idx = __hip_atomic_fetch_add(bar + 64 + 16 * (my_xcd & 7u), 1u, __ATOMIC_RELAXED, __HIP_MEMORY_SCOPE_AGENT);
        my_idx = (unsigned)__builtin_amdgcn_readfirstlane((int)my_idx);
    }
    if (p.ph_lo <= 0 && 0 < p.ph_hi) {
        if (0 > p.ph_lo) grid_barrier(bar, nbar, hier, my_xcd, (unsigned)G / 8u);

#if (PHMASK >> 0) & 1
            phase0(p, lds);
#endif
    }
    if (p.ph_lo <= 1 && 1 < p.ph_hi) {
        if (1 > p.ph_lo) cg::this_grid().sync();
        if (p.ph_hi - p.ph_lo > 1) {
            LAS unsigned* cw = (LAS unsigned*)lds;
            if (threadIdx.x == 0) {
                bool ok = (G % 8) == 0 && my_xcd < 8u;
                for (int x = 0; x < 8; ++x) ok = ok && (__hip_atomic_load(bar + 64 + 16 * x, __ATOMIC_RELAXED, __HIP_MEMORY_SCOPE_AGENT) == (unsigned)(G / 8));
                cw[0] = ok ? (my_idx * 8u + my_xcd) : (unsigned)c; cw[1] = ok ? 1u : 0u;
            }
            __syncthreads();
            c_eff = __builtin_amdgcn_readfirstlane((int)cw[0]);
            hier = (cw[1] != 0u);
            __syncthreads();
        }

#if (PHMASK >> 1) & 1
            phase_h(p);
#endif
    }
    if (p.ph_lo <= 2 && 2 < p.ph_hi) {
        if (2 > p.ph_lo) grid_barrier(bar, nbar, hier, my_xcd, (unsigned)G / 8u);

#if (PHMASK >> 2) & 1
            pg8::Gemm g{(const bf16_t*)(ws + WS_H), (const bf16_t*)(ws + WS_WIN), T_TOK, 59 * 256, 2048, nullptr, nullptr, 0}; pg8::StaticOrder S; S.init(T_TOK, 59 * 256, G, c_eff, 32, 16);
            EpiInProj E{(bf16_t*)(ws + WS_RQ), (bf16_t*)(ws + WS_RK), (bf16_t*)p.out, (bf16_t*)(ws + WS_AQ), (bf16_t*)(ws + WS_AK), (bf16_t*)(ws + WS_AV), p.pos};
            pg8::gemm_phase<1>(lds, g, S, E);
#endif
    }
    if (p.ph_lo <= 3 && 3 < p.ph_hi) {
        if (3 > p.ph_lo) grid_barrier(bar, nbar, hier, my_xcd, (unsigned)G / 8u);

#if (PHMASK >> 3) & 1
            phase_retention(p, lds, c_eff); __syncthreads();
#endif
#if (PHMASK >> 13) & 1
            phase_attention(p, lds);
#endif
    }
    if (p.ph_lo <= 4 && 4 < p.ph_hi) {
        if (4 > p.ph_lo) grid_barrier(bar, nbar, hier, my_xcd, (unsigned)G / 8u);

#if (PHMASK >> 4) & 1
            { pg8::Gemm g{(const bf16_t*)(ws + WS_H), (const bf16_t*)(ws + WS_WIN) + (size_t)8192 * 2048, T_TOK, 4096, 2048, nullptr, nullptr, 0}; pg8::StaticOrder S; S.init(T_TOK, 4096, G, c_eff);
              EpiRetGate E{(bf16_t*)p.out, (const float*)(ws + WS_RETSS), p.ret_gain}; pg8::gemm_phase<1>(lds, g, S, E); }
#endif
#if (PHMASK >> 14) & 1
            { pg8::Gemm g{(const bf16_t*)(ws + WS_H), (const bf16_t*)(ws + WS_WGATE), T_TOK, 4096, 2048, nullptr, nullptr, 0}; pg8::StaticOrder S; S.init(T_TOK, 4096, G, c_eff);
              EpiGates E{(bf16_t*)(ws + WS_GATES), p.b_gate}; pg8::gemm_phase<1>(lds, g, S, E); }
#endif
#if (PHMASK >> 15) & 1
            phase_alpha(p);
#endif
    }
    if (p.ph_lo <= 5 && 5 < p.ph_hi) {
        if (5 > p.ph_lo) grid_barrier(bar, nbar, hier, my_xcd, (unsigned)G / 8u);

#if (PHMASK >> 5) & 1
            pg8::Gemm g{(const bf16_t*)p.out, (const bf16_t*)(ws + WS_WRET), T_TOK, 2048, 4096, (const bf16_t*)(ws + WS_AQ), (const bf16_t*)(ws + WS_WATT), 2304}; pg8::StaticOrder S; S.init(T_TOK, 2048, G, c_eff);
            EpiYMerge E{(const bf16_t*)(ws + WS_GATES), (bf16_t*)(ws + WS_U2)}; pg8::gemm_phase<2>(lds, g, S, E);
#endif
    }
    if (p.ph_lo <= 7 && 7 < p.ph_hi) {
        if (7 > p.ph_lo) grid_barrier(bar, nbar, hier, my_xcd, (unsigned)G / 8u);

#if (PHMASK >> 7) & 1
            pg8::Gemm g{(const bf16_t*)(ws + WS_U2), (const bf16_t*)(ws + WS_WMIX), T_TOK, 2048, 2048, nullptr, nullptr, 0}; pg8::StaticOrder S; S.init(T_TOK, 2048, G, c_eff);
            EpiStoreBf16 E{(bf16_t*)(ws + WS_Y), 2048}; pg8::gemm_phase<1>(lds, g, S, E);
#endif
    }
    if (p.ph_lo <= 8 && 8 < p.ph_hi) {
        if (8 > p.ph_lo) grid_barrier(bar, nbar, hier, my_xcd, (unsigned)G / 8u);

#if (PHMASK >> 8) & 1
            phase_postmix(p);
#endif
    }
    if (p.ph_lo <= 9 && 9 < p.ph_hi) {
        if (9 > p.ph_lo) grid_barrier(bar, nbar, hier, my_xcd, (unsigned)G / 8u);

#if (PHMASK >> 9) & 1
            pg8::Gemm g{(const bf16_t*)(ws + WS_H2), (const bf16_t*)(ws + WS_WUP), T_TOK, FF, 2048, nullptr, nullptr, 0}; pg8::StaticOrder S; S.init(T_TOK, FF, G, c_eff);
            EpiStoreBf16 E{(bf16_t*)(ws + WS_A), FF}; pg8::gemm_phase<1>(lds, g, S, E);
#endif
    }
    if (p.ph_lo <= 10 && 10 < p.ph_hi) {
        if (10 > p.ph_lo) grid_barrier(bar, nbar, hier, my_xcd, (unsigned)G / 8u);

#if (PHMASK >> 10) & 1
            pg8::Gemm g{(const bf16_t*)(ws + WS_H2), (const bf16_t*)(ws + WS_WUP) + (size_t)FF * 2048, T_TOK, FF, 2048, nullptr, nullptr, 0}; pg8::StaticOrder S; S.init(T_TOK, FF, G, c_eff);
            EpiConvAct E{(const bf16_t*)(ws + WS_A), (bf16_t*)(ws + WS_ACT), p.conv_w, p.conv_b}; pg8::gemm_phase<1>(lds, g, S, E);
#endif
    }
    if (p.ph_lo <= 11 && 11 < p.ph_hi) {
        if (11 > p.ph_lo) grid_barrier(bar, nbar, hier, my_xcd, (unsigned)G / 8u);

#if (PHMASK >> 11) & 1
            pg8::Gemm g{(const bf16_t*)(ws + WS_ACT), (const bf16_t*)(ws + WS_WDOWN), T_TOK, 2048, FF, nullptr, nullptr, 0}; pg8::StaticOrder S; S.init(T_TOK, 2048, G, c_eff);
            EpiStoreBf16 E{(bf16_t*)(ws + WS_Y2), 2048}; pg8::gemm_phase<1>(lds, g, S, E);
#endif
    }
    if (p.ph_lo <= 12 && 12 < p.ph_hi) {
        if (12 > p.ph_lo) grid_barrier(bar, nbar, hier, my_xcd, (unsigned)G / 8u);

#if (PHMASK >> 12) & 1
            phase_final(p);
#endif
    }
}

extern "C" void kernel_launch(void* const* d_in, const int* in_sizes, int n_in, void* d_out, int out_size, void* d_ws, size_t ws_size, hipStream_t stream) {
    static int grid = 0;
    if (grid == 0) {
        if (n_in != 20 || ws_size < WS_END) { fprintf(stderr, "kernel_launch: unexpected n_in %d or ws_size %zu (need %zu)\n", n_in, ws_size, (size_t)WS_END); grid = -1; return; }
        int dev = 0, cus = 0, per_cu = 0;
        hipGetDevice(&dev); hipDeviceGetAttribute(&cus, hipDeviceAttributeMultiprocessorCount, dev);
        if (hipFuncSetAttribute((const void*)mega, hipFuncAttributeMaxDynamicSharedMemorySize, LDS_BYTES) != hipSuccess) { fprintf(stderr, "kernel_launch: hipFuncSetAttribute failed\n"); grid = -1; return; }
        if (hipOccupancyMaxActiveBlocksPerMultiprocessor(&per_cu, (const void*)mega, 512, LDS_BYTES) != hipSuccess || per_cu < 1) { fprintf(stderr, "kernel_launch: occupancy query says %d\n", per_cu); per_cu = 1; }
        (void)hipGetLastError();
        grid = cus * 1;
    }
    if (grid < 0) return;
    Params p{};
    p.x = (const float*)d_in[0]; p.c = (const float*)d_in[1]; p.pos = (const int*)d_in[2]; p.w_ada = (const float*)d_in[3]; p.b_ada = (const float*)d_in[4]; p.g_pre_mix = (const float*)d_in[5];
    p.w_in = (const float*)d_in[6]; p.ret_gain = (const float*)d_in[7]; p.w_ret_out = (const float*)d_in[8]; p.w_att_out = (const float*)d_in[9]; p.w_gate = (const float*)d_in[10]; p.b_gate = (const float*)d_in[11];
    p.w_mix = (const float*)d_in[12]; p.g_post_mix = (const float*)d_in[13]; p.g_pre_ffn = (const float*)d_in[14]; p.w_up = (const float*)d_in[15]; p.conv_w = (const float*)d_in[16]; p.conv_b = (const float*)d_in[17];
    p.w_down = (const float*)d_in[18]; p.g_post_ffn = (const float*)d_in[19];
    p.out = (float*)d_out; p.ws = (unsigned char*)d_ws;
    if (hipMemsetAsync((char*)d_ws + WS_BAR, 0, 8192, stream) != hipSuccess) { fprintf(stderr, "kernel_launch: memset failed\n"); return; }
#if N_LAUNCH_PER_PHASE
    for (int ph = 0; ph < N_PHASES; ++ph) { p.ph_lo = ph; p.ph_hi = ph + 1; hipLaunchKernelGGL(mega, dim3(grid), dim3(512), LDS_BYTES, stream, p); }
#else
    p.ph_lo = 0; p.ph_hi = N_PHASES;
    void* args[] = {&p};
    hipError_t e = hipLaunchCooperativeKernel((const void*)mega, dim3(grid), dim3(512), args, LDS_BYTES, stream);
    if (e != hipSuccess) fprintf(stderr, "cooperative launch failed: %s (grid %d)\n", hipGetErrorString(e), grid);
#endif
}
```

```cpp
#include <hip/hip_runtime.h>
#include <hip/hip_cooperative_groups.h>
#include <cstdio>
#include <cstdint>
namespace cg = cooperative_groups;

#define DI __device__ __forceinline__
#define LAS __attribute__((address_space(3)))
typedef unsigned short bf16_t;
typedef short bf16x8 __attribute__((ext_vector_type(8)));
typedef short s16x4 __attribute__((ext_vector_type(4)));
typedef float f32x4 __attribute__((ext_vector_type(4)));
typedef unsigned u32x4 __attribute__((ext_vector_type(4)));
typedef unsigned u32x2 __attribute__((ext_vector_type(2)));

#ifndef PHMASK
#define PHMASK 0xFFFF
#endif
#ifndef N_LAUNCH_PER_PHASE
#define N_LAUNCH_PER_PHASE 0
#endif

constexpr int T_TOK = 32768, DM = 2048, SEQ = 8192, NB = 4;
constexpr int FF = 5632;
constexpr int LDS_BYTES = 143360;
constexpr size_t MiB = 1u << 20;
constexpr size_t WS_ADA = 0;
constexpr size_t WS_LSE = 1 * MiB;
constexpr size_t WS_RETSS = 4 * MiB;
constexpr size_t WS_WUP = 12 * MiB;
constexpr size_t WS_WDOWN = 56 * MiB;
constexpr size_t WS_WIN = 78 * MiB;
constexpr size_t WS_WGATE = 153 * MiB;
constexpr size_t WS_WRET = 169 * MiB;
constexpr size_t WS_WATT = 185 * MiB;
constexpr size_t WS_WMIX = 194 * MiB;
constexpr size_t WS_H = 206 * MiB;
constexpr size_t WS_RQ = 334 * MiB;
constexpr size_t WS_RK = 462 * MiB;
constexpr size_t WS_AQ = 590 * MiB;
constexpr size_t WS_AK = 734 * MiB;
constexpr size_t WS_AV = 878 * MiB;
constexpr size_t WS_GATES = 334 * MiB;
constexpr size_t WS_U = 734 * MiB;
constexpr size_t WS_U2 = 206 * MiB;
constexpr size_t WS_Y = 334 * MiB;
constexpr size_t WS_H2 = 78 * MiB;
constexpr size_t WS_A = 206 * MiB;
constexpr size_t WS_ACT = 558 * MiB;
constexpr size_t WS_Y2 = 78 * MiB;
constexpr size_t WS_END = 1022 * MiB;

struct Params {
    const float *x, *c; const int* pos;
    const float *w_ada, *b_ada, *g_pre_mix, *w_in, *ret_gain, *w_ret_out, *w_att_out, *w_gate, *b_gate, *w_mix, *g_post_mix, *g_pre_ffn, *w_up, *conv_w, *conv_b, *w_down, *g_post_ffn;
    float* out; unsigned char* ws; int ph_lo, ph_hi;
};

typedef __bf16 bf16x2_t __attribute__((ext_vector_type(2)));
DI unsigned cvt_pk_bf16(float lo, float hi) { bf16x2_t v = {(__bf16)lo, (__bf16)hi}; return __builtin_bit_cast(unsigned, v); }
DI float bflo(unsigned w) { return __uint_as_float(w << 16); }
DI float bfhi(unsigned w) { return __uint_as_float(w & 0xffff0000u); }
DI float wave_sum(float v) {
#pragma unroll
    for (int o = 1; o < 64; o <<= 1) v += __shfl_xor(v, o);
    return v;
}
DI float sigmoidf_(float v) { return __builtin_amdgcn_rcpf(1.0f + __builtin_amdgcn_exp2f(-1.4426950408889634f * v)); }
DI f32x4 mfma16(bf16x8 a, bf16x8 b, f32x4 c) { return __builtin_amdgcn_mfma_f32_16x16x32_bf16(a, b, c, 0, 0, 0); }
DI s16x4 tr_read(LAS unsigned char* p) { return __builtin_amdgcn_ds_read_tr16_b64_v4i16((LAS s16x4*)p); }
DI bf16x8 tr_read2(LAS unsigned char* p0, LAS unsigned char* p1) { s16x4 lo = tr_read(p0), hi = tr_read(p1); return __builtin_shufflevector(lo, hi, 0, 1, 2, 3, 4, 5, 6, 7); }

namespace pg8 {
constexpr int BM = 256, BK = 64, HALF = 128, HTB = HALF * BK * 2, STAGE_BYTES = 8 * HTB, NXCD = 8, WGM = 8;
DI int lds_byte(int r, int c) { const int st = (r >> 4) * 2 + (c >> 5), rr = r & 15, cc = c & 31, ob = rr * 64 + cc * 2; return st * 1024 + (ob ^ (((ob >> 9) & 1) << 5)); }
DI void stage_rc(int b, int& R, int& C) { const int st = b / 1024, sb = b % 1024, swz = sb ^ (((sb >> 9) & 1) << 5); R = (st >> 1) * 16 + swz / 64; C = (st & 1) * 32 + (swz % 64) / 2; }
struct Unit { int pm, pn; };
struct Gemm { const bf16_t* A; const bf16_t* Bt; int M, N, K; const bf16_t* A1; const bf16_t* Bt1; int K1; };
struct StaticOrder {
    int nM, nN, nwg, G, c, skip_lo, skip_n;
    DI void init(int M, int N, int G_, int c_, int slo = 1 << 30, int sn = 0) { nM = M / BM; nN = N / BM; nwg = nM * nN; G = G_; c = c_; skip_lo = slo; skip_n = sn; }
    DI bool next(int i, Unit& u) const {
        const long L = (long)i * G + c; if (L >= nwg) return false;
        int wgid = (int)L; { const int q = nwg / NXCD, r = nwg % NXCD, xcd = wgid % NXCD, off = wgid / NXCD; wgid = (xcd < r ? xcd * (q + 1) : r * (q + 1) + (xcd - r) * q) + off; }
        const int nig = WGM * nN, gid = wgid / nig, fm = gid * WGM, gsz = (nM - fm) < WGM ? (nM - fm) : WGM;
        u.pm = fm + ((wgid % nig) % gsz); u.pn = (wgid % nig) / gsz; if (u.pn >= skip_lo) u.pn += skip_n; return true;
    }
};

template <int NSEG, class Epi>
DI void gemm_phase(LAS unsigned char* lds, const Gemm g, const StaticOrder& S, const Epi& E) {
    const int tid = threadIdx.x, wid = __builtin_amdgcn_readfirstlane(tid >> 6), lane = tid & 63, wr = wid >> 2, wc = wid & 3, fr = lane & 15, fq = lane >> 4;
    int Rr[2], Cc[2];
#pragma unroll
    for (int i = 0; i < 2; ++i) stage_rc(tid * 16 + i * 8192, Rr[i], Cc[i]);
    const size_t kstep = (size_t)(BK * 2);
    const unsigned ldsw = (unsigned)wid * 1024u;
    const int aoff = lds_byte(wr * 64 + fr, fq * 8), boff = lds_byte(wc * 32 + fr, fq * 8);
#define PG8_SA(b, h) (((b) * 2 + (h)) * HTB)
#define PG8_SB(b, h) ((4 + (b) * 2 + (h)) * HTB)
#define PG8_STAGE(bufoff, gbase, VO) do { _Pragma("unroll") for (int _i = 0; _i < 2; ++_i) \
        __builtin_amdgcn_global_load_lds((const unsigned*)((const char*)(gbase) + VO[_i]), (LAS unsigned*)(lds + (bufoff) + ldsw + _i * 8192), 16, 0, 0); } while (0)
#define PG8_LDA(dst, b, h) do { _Pragma("unroll") for (int m = 0; m < 4; ++m) _Pragma("unroll") for (int k = 0; k < 2; ++k) dst[m][k] = *(const LAS bf16x8*)(lds + PG8_SA(b, h) + aoff + m * 2048 + k * 1024); } while (0)
#define PG8_LDB(dst, b, h) do { _Pragma("unroll") for (int n = 0; n < 2; ++n) _Pragma("unroll") for (int k = 0; k < 2; ++k) dst[n][k] = *(const LAS bf16x8*)(lds + PG8_SB(b, h) + boff + n * 2048 + k * 1024); } while (0)
#define PG8_MMA(ai, bj, At, Bt) do { __builtin_amdgcn_s_setprio(1); _Pragma("unroll") for (int m = 0; m < 4; ++m) _Pragma("unroll") for (int n = 0; n < 2; ++n) _Pragma("unroll") for (int k = 0; k < 2; ++k) \
        acc[ai][bj][m][n] = __builtin_amdgcn_mfma_f32_16x16x32_bf16(Bt[n][k], At[m][k], acc[ai][bj][m][n], 0, 0, 0); __builtin_amdgcn_s_setprio(0); } while (0)
#define PG8_WAIT_V(n) asm volatile("s_waitcnt vmcnt(" #n ")" ::: "memory")
#define PG8_WAIT_L(n) asm volatile("s_waitcnt lgkmcnt(" #n ")" ::: "memory")
#define PG8_BAR __builtin_amdgcn_s_barrier()
#define PG8_SCHED __builtin_amdgcn_sched_barrier(0)
    Unit cur, nxt; int ti = 0, seg = 0;
    if (!S.next(0, cur)) return;
    f32x4 acc[2][2][4][2];
#pragma unroll
    for (int a = 0; a < 2; ++a)
#pragma unroll
        for (int b = 0; b < 2; ++b)
#pragma unroll
            for (int m = 0; m < 4; ++m)
#pragma unroll
                for (int n = 0; n < 2; ++n) acc[a][b][m][n] = (f32x4){0.f, 0.f, 0.f, 0.f};
    bf16x8 At[4][2], B0[2][2], B1[2][2];
    int Kc = g.K;
    unsigned voffC[2];
#pragma unroll
    for (int i = 0; i < 2; ++i) voffC[i] = (unsigned)(Rr[i] * Kc + Cc[i]) * 2u;
    size_t hstepC = (size_t)HALF * Kc * 2;
    const char* cA = (const char*)g.A + (size_t)cur.pm * 2 * hstepC; const char* cB = (const char*)g.Bt + (size_t)cur.pn * 2 * hstepC;
    PG8_STAGE(PG8_SB(0, 0), cB, voffC); PG8_STAGE(PG8_SA(0, 0), cA, voffC); PG8_STAGE(PG8_SB(0, 1), cB + hstepC, voffC); PG8_STAGE(PG8_SA(0, 1), cA + hstepC, voffC);
    if (wr == 1) PG8_BAR;
    PG8_WAIT_V(4); PG8_BAR;
    PG8_STAGE(PG8_SB(1, 0), cB + kstep, voffC); PG8_STAGE(PG8_SA(1, 0), cA + kstep, voffC); PG8_STAGE(PG8_SB(1, 1), cB + hstepC + kstep, voffC);
    PG8_WAIT_V(6); PG8_BAR;
    for (;;) {
        bool has_next; int nseg = 0;
        if (NSEG > 1 && seg + 1 < NSEG) { has_next = true; nxt = cur; nseg = seg + 1; }
        else has_next = S.next(ti + 1, nxt);
        int Kn = Kc; const char* nA = cA; const char* nB = cB;
        if (has_next) { Kn = (NSEG > 1 && nseg == 1) ? g.K1 : g.K;
            nA = (const char*)((NSEG > 1 && nseg == 1) ? g.A1 : g.A) + (size_t)nxt.pm * 256 * Kn * 2; nB = (const char*)((NSEG > 1 && nseg == 1) ? g.Bt1 : g.Bt) + (size_t)nxt.pn * 256 * Kn * 2; }
        unsigned voffN[2];
#pragma unroll
        for (int i = 0; i < 2; ++i) voffN[i] = (NSEG > 1) ? (unsigned)(Rr[i] * Kn + Cc[i]) * 2u : voffC[i];
        const size_t hstepN = (NSEG > 1) ? (size_t)HALF * Kn * 2 : hstepC;
        const int nt = Kc / BK;
        for (int t = 0; t < nt; t += 2) {
            const bool last = (t == nt - 2);
            const char* a1 = cA + (size_t)(t + 1) * kstep;
            const char* a2 = last ? nA : cA + (size_t)(t + 2) * kstep; const char* b2 = last ? nB : cB + (size_t)(t + 2) * kstep;
            const char* a3 = a2 + kstep; const char* b3 = b2 + kstep;
            unsigned v2[2]; v2[0] = (NSEG > 1 && last) ? voffN[0] : voffC[0]; v2[1] = (NSEG > 1 && last) ? voffN[1] : voffC[1];
            const size_t h2 = (NSEG > 1 && last) ? hstepN : hstepC;
            PG8_LDB(B0, 0, 0); PG8_SCHED; PG8_LDA(At, 0, 0); PG8_STAGE(PG8_SA(1, 1), a1 + hstepC, voffC);
            PG8_WAIT_L(8); PG8_BAR; PG8_WAIT_L(0); PG8_MMA(0, 0, At, B0); PG8_BAR; PG8_SCHED;
            PG8_LDB(B1, 0, 1); PG8_STAGE(PG8_SB(0, 0), b2, v2);
            PG8_BAR; PG8_WAIT_L(0); PG8_MMA(0, 1, At, B1); PG8_BAR;
            PG8_LDA(At, 0, 1); PG8_STAGE(PG8_SA(0, 0), a2, v2);
            PG8_BAR; PG8_WAIT_L(0); PG8_MMA(1, 0, At, B0); PG8_BAR; PG8_SCHED;
            PG8_STAGE(PG8_SB(0, 1), b2 + h2, v2);
            PG8_WAIT_V(6); PG8_BAR; PG8_MMA(1, 1, At, B1); PG8_BAR;
            PG8_LDB(B0, 1, 0); PG8_SCHED; PG8_LDA(At, 1, 0); PG8_STAGE(PG8_SA(0, 1), a2 + h2, v2);
            PG8_WAIT_L(8); PG8_BAR; PG8_WAIT_L(0); PG8_MMA(0, 0, At, B0); PG8_BAR; PG8_SCHED;
            PG8_LDB(B1, 1, 1); PG8_STAGE(PG8_SB(1, 0), b3, v2);
            PG8_BAR; PG8_WAIT_L(0); PG8_MMA(0, 1, At, B1); PG8_BAR;
            PG8_LDA(At, 1, 1); PG8_STAGE(PG8_SA(1, 0), a3, v2);
            PG8_BAR; PG8_WAIT_L(0); PG8_MMA(1, 0, At, B0); PG8_BAR; PG8_SCHED;
            PG8_STAGE(PG8_SB(1, 1), b3 + h2, v2);
            PG8_WAIT_V(6); PG8_BAR; PG8_MMA(1, 1, At, B1); PG8_BAR;
        }
        if constexpr (NSEG > 1) { if (seg + 1 < NSEG) E.mid(acc, cur, wr, wc, fr, fq); else E(acc, cur, wr, wc, fr, fq); }
        else E(acc, cur, wr, wc, fr, fq);
        if (!has_next) break;
        if (NSEG == 1 || nseg == 0) {
#pragma unroll
            for (int a = 0; a < 2; ++a)
#pragma unroll
                for (int b = 0; b < 2; ++b)
#pragma unroll
                    for (int m = 0; m < 4; ++m)
#pragma unroll
                        for (int n = 0; n < 2; ++n) acc[a][b][m][n] = (f32x4){0.f, 0.f, 0.f, 0.f};
            ++ti;
        }
        cur = nxt; cA = nA; cB = nB; seg = nseg;
        if (NSEG > 1) { Kc = Kn; voffC[0] = voffN[0]; voffC[1] = voffN[1]; hstepC = hstepN; }
    }
    PG8_WAIT_V(0);
    if (wr == 0) PG8_BAR;
    PG8_BAR;
#undef PG8_SA
#undef PG8_SB
#undef PG8_STAGE
#undef PG8_LDA
#undef PG8_LDB
#undef PG8_MMA
#undef PG8_WAIT_V
#undef PG8_WAIT_L
#undef PG8_BAR
#undef PG8_SCHED
}
}
using pg8::Unit;
typedef f32x4 AccT[2][2][4][2];

DI u32x4 pack8(const f32x4& v0, const f32x4& v1) { u32x4 w; w.x = cvt_pk_bf16(v0[0], v0[1]); w.y = cvt_pk_bf16(v0[2], v0[3]); w.z = cvt_pk_bf16(v1[0], v1[1]); w.w = cvt_pk_bf16(v1[2], v1[3]); return w; }

struct EpiStoreBf16 {
    bf16_t* O; int ld;
    DI void operator()(const AccT& acc, const Unit& u, int wr, int wc, int fr, int fq) const {
        const int row0 = u.pm * 256 + wr * 64 + fr, col0 = u.pn * 256 + wc * 32 + 8 * fq;
#pragma unroll
        for (int ai = 0; ai < 2; ++ai)
#pragma unroll
            for (int m = 0; m < 4; ++m) { bf16_t* rowp = O + (size_t)(row0 + ai * 128 + m * 16) * ld + col0;
#pragma unroll
                for (int bj = 0; bj < 2; ++bj) *(u32x4*)(rowp + bj * 128) = pack8(acc[ai][bj][m][0], acc[ai][bj][m][1]); }
    }
};

template <int HD>
DI void rope_store(const AccT& acc, int rowbase, const int* pos, bf16_t* dst, int ld, int c1, int half, int ibase, float scale) {
    int pi[2][4];
#pragma unroll
    for (int ai = 0; ai < 2; ++ai)
#pragma unroll
        for (int m = 0; m < 4; ++m) pi[ai][m] = pos[rowbase + ai * 128 + m * 16];
    float invf[2][4];
#pragma unroll
    for (int n = 0; n < 2; ++n)
#pragma unroll
        for (int j = 0; j < 4; ++j) invf[n][j] = exp2f(-(float)(ibase + 4 * n + j) * (2.0f / HD) * 13.287712379549449f);
#pragma unroll
    for (int ai = 0; ai < 2; ++ai)
#pragma unroll
        for (int m = 0; m < 4; ++m) {
            const int row = rowbase + ai * 128 + m * 16; const float ps = (float)pi[ai][m];
            f32x4 o1[2], o2[2];
#pragma unroll
            for (int n = 0; n < 2; ++n)
#pragma unroll
                for (int j = 0; j < 4; ++j) {
                    const float ang = ps * invf[n][j]; const float rev = __builtin_amdgcn_fractf(ang * 0.15915494309189535f);
                    const float sn = __builtin_amdgcn_sinf(rev), cs = __builtin_amdgcn_cosf(rev);
                    const float t1 = acc[ai][0][m][n][j], t2 = acc[ai][1][m][n][j];
                    o1[n][j] = (t1 * cs - t2 * sn) * scale; o2[n][j] = (t2 * cs + t1 * sn) * scale;
                }
            bf16_t* rowp = dst + (size_t)row * ld + c1;
            *(u32x4*)rowp = pack8(o1[0], o1[1]); *(u32x4*)(rowp + half) = pack8(o2[0], o2[1]);
        }
}

struct EpiInProj {
    bf16_t *rq, *rk, *rv, *aq, *ak, *av; const int* pos;
    DI void operator()(const AccT& acc, const Unit& u, int wr, int wc, int fr, int fq) const {
        const int pn = u.pn, rowbase = u.pm * 256 + wr * 64 + fr;
        if (pn < 16) {
            bf16_t* dst = pn < 8 ? rq : rk; const float scale = pn < 8 ? 1.0f : 0.0625f;
            rope_store<256>(acc, rowbase, pos, dst, 2048, 256 * (pn & 7) + 32 * wc + 8 * fq, 128, 32 * wc + 8 * fq, scale);
        } else if (pn < 32) {
            const int col0 = (pn - 16) * 256 + wc * 32 + 8 * fq;
#pragma unroll
            for (int ai = 0; ai < 2; ++ai)
#pragma unroll
                for (int m = 0; m < 4; ++m) { bf16_t* rowp = rv + (size_t)(rowbase + ai * 128 + m * 16) * 4096 + col0;
#pragma unroll
                    for (int bj = 0; bj < 2; ++bj) *(u32x4*)(rowp + bj * 128) = pack8(acc[ai][bj][m][0], acc[ai][bj][m][1]); }
        } else if (pn < 66) {
            const int q9 = pn - 48; bf16_t* dst = q9 < 9 ? aq : ak; const int t9 = q9 < 9 ? q9 : q9 - 9;
            const int head = 2 * t9 + (wc >> 1), ib = 32 * (wc & 1) + 8 * fq;
            rope_store<128>(acc, rowbase, pos, dst, 2304, head * 128 + ib, 64, ib, 1.0f);
        } else {
            const int col0 = (pn - 66) * 256 + wc * 32 + 8 * fq;
#pragma unroll
            for (int ai = 0; ai < 2; ++ai)
#pragma unroll
                for (int m = 0; m < 4; ++m) { bf16_t* rowp = av + (size_t)(rowbase + ai * 128 + m * 16) * 2304 + col0;
#pragma unroll
                    for (int bj = 0; bj < 2; ++bj) *(u32x4*)(rowp + bj * 128) = pack8(acc[ai][bj][m][0], acc[ai][bj][m][1]); }
        }
    }
};

struct EpiRetGate {
    bf16_t* ret; const float* retss; const float* gain;
    DI void operator()(const AccT& acc, const Unit& u, int wr, int wc, int fr, int fq) const {
        const int rowbase = u.pm * 256 + wr * 64 + fr, head = u.pn >> 1, colb = u.pn * 256 + wc * 32 + 8 * fq;
        f32x4 gn[2][2];
#pragma unroll
        for (int bj = 0; bj < 2; ++bj) { gn[bj][0] = *(const f32x4*)(gain + colb + bj * 128); gn[bj][1] = *(const f32x4*)(gain + colb + bj * 128 + 4); }
#pragma unroll
        for (int ai = 0; ai < 2; ++ai) {
            f32x4 sA[4], sB[4]; u32x4 rr[4][2];
#pragma unroll
            for (int m = 0; m < 4; ++m) { const float* ps = retss + ((size_t)(rowbase + ai * 128 + m * 16) * 8 + head) * 8; sA[m] = *(const f32x4*)ps; sB[m] = *(const f32x4*)(ps + 4); }
#pragma unroll
            for (int m = 0; m < 4; ++m)
#pragma unroll
                for (int bj = 0; bj < 2; ++bj) rr[m][bj] = *(const u32x4*)(ret + (size_t)(rowbase + ai * 128 + m * 16) * 4096 + colb + bj * 128);
#pragma unroll
            for (int m = 0; m < 4; ++m) {
                const f32x4 s0 = sA[m], s1 = sB[m];
                const float rsv = __builtin_amdgcn_rsqf((((s0[0] + s0[1]) + (s0[2] + s0[3])) + ((s1[0] + s1[1]) + (s1[2] + s1[3]))) * (1.0f / 512.0f) + 1e-6f);
#pragma unroll
                for (int bj = 0; bj < 2; ++bj) {
                    const u32x4 r4 = rr[m][bj];
                    const float rf[8] = {bflo(r4.x), bfhi(r4.x), bflo(r4.y), bfhi(r4.y), bflo(r4.z), bfhi(r4.z), bflo(r4.w), bfhi(r4.w)};
                    f32x4 o0, o1;
#pragma unroll
                    for (int j = 0; j < 4; ++j) {
                        const float a0 = acc[ai][bj][m][0][j], a1 = acc[ai][bj][m][1][j];
                        o0[j] = a0 * sigmoidf_(a0) * (rf[j] * rsv * gn[bj][0][j]); o1[j] = a1 * sigmoidf_(a1) * (rf[4 + j] * rsv * gn[bj][1][j]);
                    }
                    *(u32x4*)(ret + (size_t)(rowbase + ai * 128 + m * 16) * 4096 + colb + bj * 128) = pack8(o0, o1);
                }
            }
        }
    }
};

struct EpiGates {
    bf16_t* O; const float* bias;
    DI void operator()(const AccT& acc, const Unit& u, int wr, int wc, int fr, int fq) const {
        const int rowbase = u.pm * 256 + wr * 64 + fr;
#pragma unroll
        for (int bj = 0; bj < 2; ++bj) {
            const int col = u.pn * 256 + bj * 128 + wc * 32 + 8 * fq;
            const f32x4 b0 = *(const f32x4*)(bias + col), b1 = *(const f32x4*)(bias + col + 4);
#pragma unroll
            for (int ai = 0; ai < 2; ++ai)
#pragma unroll
                for (int m = 0; m < 4; ++m) {
                    f32x4 o0, o1;
#pragma unroll
                    for (int j = 0; j < 4; ++j) { o0[j] = sigmoidf_(acc[ai][bj][m][0][j] + b0[j]); o1[j] = sigmoidf_(acc[ai][bj][m][1][j] + b1[j]); }
                    *(u32x4*)(O + (size_t)(rowbase + ai * 128 + m * 16) * 4096 + col) = pack8(o0, o1);
                }
        }
    }
};

struct EpiYMerge {
    const bf16_t* gates; bf16_t* U2;
    DI void mid(AccT& acc, const Unit& u, int wr, int wc, int fr, int fq) const {
        const int rowbase = u.pm * 256 + wr * 64 + fr, colb = u.pn * 256 + wc * 32 + 8 * fq;
#pragma unroll
        for (int ai = 0; ai < 2; ++ai) {
            u32x4 gr[4][2], ga[4][2];
#pragma unroll
            for (int m = 0; m < 4; ++m)
#pragma unroll
                for (int bj = 0; bj < 2; ++bj) { const bf16_t* pg = gates + (size_t)(rowbase + ai * 128 + m * 16) * 4096 + colb + bj * 128; gr[m][bj] = *(const u32x4*)pg; ga[m][bj] = *(const u32x4*)(pg + 2048); }
#pragma unroll
            for (int m = 0; m < 4; ++m)
#pragma unroll
                for (int bj = 0; bj < 2; ++bj) {
                    const u32x4 g1 = gr[m][bj], g2 = ga[m][bj];
                    const float r[8] = {bflo(g1.x), bfhi(g1.x), bflo(g1.y), bfhi(g1.y), bflo(g1.z), bfhi(g1.z), bflo(g1.w), bfhi(g1.w)};
                    const float a[8] = {bflo(g2.x), bfhi(g2.x), bflo(g2.y), bfhi(g2.y), bflo(g2.z), bfhi(g2.z), bflo(g2.w), bfhi(g2.w)};
#pragma unroll
                    for (int j = 0; j < 4; ++j) { acc[ai][bj][m][0][j] *= r[j] * __builtin_amdgcn_rcpf(fmaxf(a[j], 1e-30f)); acc[ai][bj][m][1][j] *= r[4 + j] * __builtin_amdgcn_rcpf(fmaxf(a[4 + j], 1e-30f)); }
                }
        }
    }
    DI void operator()(const AccT& acc, const Unit& u, int wr, int wc, int fr, int fq) const {
        const int rowbase = u.pm * 256 + wr * 64 + fr, colb = u.pn * 256 + wc * 32 + 8 * fq;
        u32x4 gg[2][4][2];
#pragma unroll
        for (int ai = 0; ai < 2; ++ai)
#pragma unroll
            for (int m = 0; m < 4; ++m)
#pragma unroll
                for (int bj = 0; bj < 2; ++bj) gg[ai][m][bj] = *(const u32x4*)(gates + (size_t)(rowbase + ai * 128 + m * 16) * 4096 + 2048 + colb + bj * 128);
#pragma unroll
        for (int ai = 0; ai < 2; ++ai)
#pragma unroll
            for (int m = 0; m < 4; ++m)
#pragma unroll
                for (int bj = 0; bj < 2; ++bj) {
                    const u32x4 g4 = gg[ai][m][bj];
                    f32x4 o0 = acc[ai][bj][m][0], o1 = acc[ai][bj][m][1];
                    o0[0] *= bflo(g4.x); o0[1] *= bfhi(g4.x); o0[2] *= bflo(g4.y); o0[3] *= bfhi(g4.y);
                    o1[0] *= bflo(g4.z); o1[1] *= bfhi(g4.z); o1[2] *= bflo(g4.w); o1[3] *= bfhi(g4.w);
                    *(u32x4*)(U2 + (size_t)(rowbase + ai * 128 + m * 16) * 2048 + colb + bj * 128) = pack8(o0, o1);
                }
    }
};

DI float gelu_tanh(float v) {
    const float uu = 0.7978845608028654f * (v + 0.044715f * v * v * v);
    const float e = __builtin_amdgcn_exp2f(2.8853900817779268f * uu);
    return v - v * __builtin_amdgcn_rcpf(e + 1.0f);
}
struct EpiConvAct {
    const bf16_t* A; bf16_t* ACT; const float* conv_w; const float* conv_b;
    DI void operator()(const AccT& acc, const Unit& u, int wr, int wc, int fr, int fq) const {
        const int rowbase = u.pm * 256 + wr * 64 + fr;
#pragma unroll
        for (int bj = 0; bj < 2; ++bj) {
            const int col = u.pn * 256 + bj * 128 + wc * 32 + 8 * fq;
            f32x4 w0[2], w1[2], w2[2], cb[2];
#pragma unroll
            for (int hh = 0; hh < 2; ++hh) { w0[hh] = *(const f32x4*)(conv_w + col + 4 * hh); w1[hh] = *(const f32x4*)(conv_w + FF + col + 4 * hh); w2[hh] = *(const f32x4*)(conv_w + 2 * FF + col + 4 * hh); cb[hh] = *(const f32x4*)(conv_b + col + 4 * hh); }
#pragma unroll
            for (int aim = 0; aim < 4; ++aim) { const int ai = aim >> 1, mb = (aim & 1) * 2;
                u32x4 a0[4], a1[4], a2[4];
#pragma unroll
                for (int m = mb; m < mb + 2; ++m) {
                    const int row = rowbase + ai * 128 + m * 16; const int sq = row & (SEQ - 1);
                    const bf16_t* pa = A + (size_t)row * FF + col;
                    a0[m] = *(const u32x4*)pa;
                    a1[m] = *(const u32x4*)(pa - (sq >= 1 ? FF : 0));
                    a2[m] = *(const u32x4*)(pa - (sq >= 2 ? 2 * FF : 0));
                }
#pragma unroll
                for (int m = mb; m < mb + 2; ++m) {
                    const int row = rowbase + ai * 128 + m * 16; const int sq = row & (SEQ - 1);
                    const float k1 = sq >= 1 ? 1.0f : 0.0f, k2 = sq >= 2 ? 1.0f : 0.0f;
                    const u32x4 x0 = a0[m], x1 = a1[m], x2 = a2[m];
                    const float f0[8] = {bflo(x0.x), bfhi(x0.x), bflo(x0.y), bfhi(x0.y), bflo(x0.z), bfhi(x0.z), bflo(x0.w), bfhi(x0.w)};
                    const float f1[8] = {bflo(x1.x), bfhi(x1.x), bflo(x1.y), bfhi(x1.y), bflo(x1.z), bfhi(x1.z), bflo(x1.w), bfhi(x1.w)};
                    const float f2[8] = {bflo(x2.x), bfhi(x2.x), bflo(x2.y), bfhi(x2.y), bflo(x2.z), bfhi(x2.z), bflo(x2.w), bfhi(x2.w)};
                    f32x4 o0, o1;
#pragma unroll
                    for (int j = 0; j < 4; ++j) {
                        const float c0 = cb[0][j] + w0[0][j] * f0[j] + k1 * (w1[0][j] * f1[j]) + k2 * (w2[0][j] * f2[j]);
                        const float c1 = cb[1][j] + w0[1][j] * f0[4 + j] + k1 * (w1[1][j] * f1[4 + j]) + k2 * (w2[1][j] * f2[4 + j]);
                        o0[j] = gelu_tanh(c0) * acc[ai][bj][m][0][j]; o1[j] = gelu_tanh(c1) * acc[ai][bj][m][1][j];
                    }
                    *(u32x4*)(ACT + (size_t)row * FF + col) = pack8(o0, o1);
                }
            }
        }
    }
};

DI int invperm32(int c) { return 16 * ((c >> 2) & 1) + 4 * (c >> 3) + (c & 3); }
DI int slot_std(int c) { return (c & ~31) | invperm32(c & 31); }
DI int slot_win(int c) {
    if (c >= 12288 && c < 16896) { const int tc = c & 255, hh = tc >> 7, bj = (tc >> 6) & 1, i64 = tc & 63, x = 64 * hh + i64; return (c & ~255) + 128 * bj + (x & ~31) + invperm32(x & 31); }
    return slot_std(c);
}
DI void transpose_item(const float* W, int K, int N, bf16_t* WT, int mode, LAS float* scr, int item, int lane) {
    const int nblk = N / 32, kb = item / nblk, nb = item % nblk, k0 = 64 * kb, n0 = 32 * nb;
#pragma unroll 16
    for (int i = 0; i < 32; ++i) { const int kk = 2 * i + (lane >> 5); scr[kk * 33 + (lane & 31)] = W[(size_t)(k0 + kk) * N + n0 + (lane & 31)]; }
    asm volatile("s_waitcnt lgkmcnt(0)" ::: "memory");
    const int c = lane & 7;
#pragma unroll
    for (int j = 0; j < 4; ++j) { const int n = (lane >> 3) + 8 * j; const LAS float* s = scr + (8 * c) * 33 + n;
        u32x4 o; o.x = cvt_pk_bf16(s[0 * 33], s[1 * 33]); o.y = cvt_pk_bf16(s[2 * 33], s[3 * 33]); o.z = cvt_pk_bf16(s[4 * 33], s[5 * 33]); o.w = cvt_pk_bf16(s[6 * 33], s[7 * 33]);
        const int drow = mode ? slot_win(n0 + n) : slot_std(n0 + n);
        *(u32x4*)(WT + (size_t)drow * K + k0 + 8 * c) = o; }
    asm volatile("s_waitcnt lgkmcnt(0)" ::: "memory");
}

DI void phase0(const Params& p, LAS unsigned char* lds) {
    const int tid = threadIdx.x, lane = tid & 63, wave = tid >> 6;
    LAS float* sc = (LAS float*)lds;
    LAS float* red = sc + 8192;
    float* ada = (float*)(p.ws + WS_ADA);
    for (int i = tid; i < 8192; i += 512) { const float v = p.c[i]; sc[i] = v / (1.0f + __expf(-v)); }
    __syncthreads();
    for (int cb = blockIdx.x; cb < 256; cb += gridDim.x) {
        {
            const int rg = lane / 12, cq = lane - 12 * rg;
            f32x4 a0 = {0.f, 0.f, 0.f, 0.f}, a1 = a0, a2 = a0, a3 = a0;
            if (rg < 5) {
                const float* wp = p.w_ada + 48 * cb + 4 * cq;
#pragma unroll 13
                for (int i = 0; i < 52; ++i) { const int kl = 5 * i + rg; if (kl < 256) { const int kk = 256 * wave + kl; const f32x4 wv = *(const f32x4*)(wp + (size_t)kk * 12288);
                    a0 += sc[kk] * wv; a1 += sc[2048 + kk] * wv; a2 += sc[4096 + kk] * wv; a3 += sc[6144 + kk] * wv; } }
                LAS float* rp = red + ((wave * 5 + rg) * 4) * 48 + 4 * cq;
                *(LAS f32x4*)(rp) = a0; *(LAS f32x4*)(rp + 48) = a1; *(LAS f32x4*)(rp + 96) = a2; *(LAS f32x4*)(rp + 144) = a3;
            }
        }
        __syncthreads();
        if (tid < 192) { const int b = tid / 48, l = tid % 48; float sacc = 0.f;
#pragma unroll 8
            for (int wg = 0; wg < 40; ++wg) sacc += red[(wg * 4 + b) * 48 + l];
            ada[b * 12288 + 48 * cb + l] = sacc + p.b_ada[48 * cb + l]; }
        __syncthreads();
    }
    LAS float* scr = (LAS float*)(lds + 40960 + wave * 8448);
    const int gw = blockIdx.x * 8 + wave, NGW = gridDim.x * 8;
    constexpr int I_IN = (2048 / 64) * (19200 / 32), I_GATE = (2048 / 64) * (4096 / 32), I_RET = (4096 / 64) * (2048 / 32), I_ATT = (2304 / 64) * (2048 / 32),
                  I_MIX = (2048 / 64) * (2048 / 32), I_UP = (2048 / 64) * (11264 / 32), I_DOWN = (5632 / 64) * (2048 / 32);
    constexpr int NITEMS = I_IN + I_GATE + I_RET + I_ATT + I_MIX + I_UP + I_DOWN;
    for (int it = gw; it < NITEMS; it += NGW) {
        int r = it;
        if (r < I_IN) { transpose_item(p.w_in, 2048, 19200, (bf16_t*)(p.ws + WS_WIN), 1, scr, r, lane); continue; } r -= I_IN;
        if (r < I_GATE) { transpose_item(p.w_gate, 2048, 4096, (bf16_t*)(p.ws + WS_WGATE), 0, scr, r, lane); continue; } r -= I_GATE;
        if (r < I_RET) { transpose_item(p.w_ret_out, 4096, 2048, (bf16_t*)(p.ws + WS_WRET), 0, scr, r, lane); continue; } r -= I_RET;
        if (r < I_ATT) { transpose_item(p.w_att_out, 2304, 2048, (bf16_t*)(p.ws + WS_WATT), 0, scr, r, lane); continue; } r -= I_ATT;
        if (r < I_MIX) { transpose_item(p.w_mix, 2048, 2048, (bf16_t*)(p.ws + WS_WMIX), 0, scr, r, lane); continue; } r -= I_MIX;
        if (r < I_UP) { transpose_item(p.w_up, 2048, 11264, (bf16_t*)(p.ws + WS_WUP), 0, scr, r, lane); continue; } r -= I_UP;
        transpose_item(p.w_down, 5632, 2048, (bf16_t*)(p.ws + WS_WDOWN), 0, scr, r, lane);
    }
}

constexpr int NR = 2;
DI void phase_h(const Params& p) {
    const int lane = threadIdx.x & 63, wave = threadIdx.x >> 6;
    const float* ada = (const float*)(p.ws + WS_ADA); bf16_t* H = (bf16_t*)(p.ws + WS_H);
    const int nw = gridDim.x * 8;
    for (int row0 = blockIdx.x * 8 + wave; row0 < T_TOK; row0 += nw * NR) {
        f32x4 v[NR][4][2]; float ss[NR];
#pragma unroll
        for (int q = 0; q < NR; ++q) { const float* xr = p.x + (size_t)(row0 + q * nw) * DM; ss[q] = 0.f;
#pragma unroll
            for (int it = 0; it < 4; ++it) { const int col = (it * 64 + lane) * 8; v[q][it][0] = *(const f32x4*)(xr + col); v[q][it][1] = *(const f32x4*)(xr + col + 4); } }
#pragma unroll
        for (int q = 0; q < NR; ++q) {
#pragma unroll
            for (int it = 0; it < 4; ++it)
#pragma unroll
                for (int j = 0; j < 4; ++j) ss[q] += v[q][it][0][j] * v[q][it][0][j] + v[q][it][1][j] * v[q][it][1][j];
            ss[q] = __builtin_amdgcn_rsqf(wave_sum(ss[q]) * (1.0f / DM) + 1e-6f); }
#pragma unroll
        for (int it = 0; it < 4; ++it) { const int col = (it * 64 + lane) * 8;
            f32x4 g[2], sh[NR][2], scl[NR][2];
#pragma unroll
            for (int hh = 0; hh < 2; ++hh) { g[hh] = *(const f32x4*)(p.g_pre_mix + col + 4 * hh);
#pragma unroll
                for (int q = 0; q < NR; ++q) { const int b = (row0 + q * nw) / SEQ; sh[q][hh] = *(const f32x4*)(ada + b * 12288 + col + 4 * hh); scl[q][hh] = *(const f32x4*)(ada + b * 12288 + 2048 + col + 4 * hh); } }
#pragma unroll
            for (int q = 0; q < NR; ++q) { f32x4 o[2];
#pragma unroll
                for (int hh = 0; hh < 2; ++hh)
#pragma unroll
                    for (int j = 0; j < 4; ++j) o[hh][j] = v[q][it][hh][j] * ss[q] * g[hh][j] * (1.0f + scl[q][hh][j]) + sh[q][hh][j];
                *(u32x4*)(H + (size_t)(row0 + q * nw) * DM + col) = pack8(o[0], o[1]); } }
    }
}

DI void phase_postmix(const Params& p) {
    const int lane = threadIdx.x & 63, wave = threadIdx.x >> 6;
    const float* ada = (const float*)(p.ws + WS_ADA); const bf16_t* Y = (const bf16_t*)(p.ws + WS_Y); bf16_t* H2 = (bf16_t*)(p.ws + WS_H2);
    const int nw = gridDim.x * 8;
    for (int row0 = blockIdx.x * 8 + wave; row0 < T_TOK; row0 += nw * NR) {
        f32x4 y[NR][4][2], xv[NR][4][2]; float ry[NR], r1[NR];
#pragma unroll
        for (int q = 0; q < NR; ++q) { const size_t ro = (size_t)(row0 + q * nw) * DM;
#pragma unroll
            for (int it = 0; it < 4; ++it) { const int col = (it * 64 + lane) * 8; const u32x4 w = *(const u32x4*)(Y + ro + col);
                y[q][it][0] = (f32x4){bflo(w.x), bfhi(w.x), bflo(w.y), bfhi(w.y)}; y[q][it][1] = (f32x4){bflo(w.z), bfhi(w.z), bflo(w.w), bfhi(w.w)};
                xv[q][it][0] = *(const f32x4*)(p.x + ro + col); xv[q][it][1] = *(const f32x4*)(p.x + ro + col + 4); } }
#pragma unroll
        for (int q = 0; q < NR; ++q) { float ss = 0.f;
#pragma unroll
            for (int it = 0; it < 4; ++it)
#pragma unroll
                for (int j = 0; j < 4; ++j) ss += y[q][it][0][j] * y[q][it][0][j] + y[q][it][1][j] * y[q][it][1][j];
            ry[q] = __builtin_amdgcn_rsqf(wave_sum(ss) * (1.0f / DM) + 1e-6f); }
#pragma unroll
        for (int q = 0; q < NR; ++q) { const int row = row0 + q * nw; const float* ab = ada + (row / SEQ) * 12288; float s1 = 0.f;
#pragma unroll
            for (int it = 0; it < 4; ++it) { const int col = (it * 64 + lane) * 8;
#pragma unroll
                for (int hh = 0; hh < 2; ++hh) { const f32x4 g = *(const f32x4*)(p.g_post_mix + col + 4 * hh), gt = *(const f32x4*)(ab + 4096 + col + 4 * hh);
                    f32x4 o;
#pragma unroll
                    for (int j = 0; j < 4; ++j) { o[j] = xv[q][it][hh][j] + gt[j] * (y[q][it][hh][j] * ry[q] * g[j]); s1 += o[j] * o[j]; }
                    y[q][it][hh] = o; }
                *(u32x4*)((bf16_t*)(p.out + (size_t)row * DM + DM / 2) + col) = pack8(y[q][it][0], y[q][it][1]); }
            r1[q] = __builtin_amdgcn_rsqf(wave_sum(s1) * (1.0f / DM) + 1e-6f); }
#pragma unroll
        for (int q = 0; q < NR; ++q) { const int row = row0 + q * nw; const float* ab = ada + (row / SEQ) * 12288;
#pragma unroll
            for (int it = 0; it < 4; ++it) { const int col = (it * 64 + lane) * 8; f32x4 o[2];
#pragma unroll
                for (int hh = 0; hh < 2; ++hh) { const f32x4 g = *(const f32x4*)(p.g_pre_ffn + col + 4 * hh), sh = *(const f32x4*)(ab + 6144 + col + 4 * hh), scl = *(const f32x4*)(ab + 8192 + col + 4 * hh);
#pragma unroll
                    for (int j = 0; j < 4; ++j) o[hh][j] = y[q][it][hh][j] * r1[q] * g[j] * (1.0f + scl[j]) + sh[j]; }
                *(u32x4*)(H2 + (size_t)row * DM + col) = pack8(o[0], o[1]); } }
    }
}

DI void phase_final(const Params& p) {
    const int lane = threadIdx.x & 63, wave = threadIdx.x >> 6;
    const float* ada = (const float*)(p.ws + WS_ADA); const bf16_t* Y = (const bf16_t*)(p.ws + WS_Y2);
    const int nw = gridDim.x * 8;
    for (int row0 = blockIdx.x * 8 + wave; row0 < T_TOK; row0 += nw * NR) {
        f32x4 y[NR][4][2], xv[NR][4][2]; float ry[NR];
#pragma unroll
        for (int q = 0; q < NR; ++q) { const size_t ro = (size_t)(row0 + q * nw) * DM;
#pragma unroll
            for (int it = 0; it < 4; ++it) { const int col = (it * 64 + lane) * 8; const u32x4 w = *(const u32x4*)(Y + ro + col);
                y[q][it][0] = (f32x4){bflo(w.x), bfhi(w.x), bflo(w.y), bfhi(w.y)}; y[q][it][1] = (f32x4){bflo(w.z), bfhi(w.z), bflo(w.w), bfhi(w.w)};
                const u32x4 xw = *(const u32x4*)((const bf16_t*)(p.out + ro + DM / 2) + col);
                xv[q][it][0] = (f32x4){bflo(xw.x), bfhi(xw.x), bflo(xw.y), bfhi(xw.y)}; xv[q][it][1] = (f32x4){bflo(xw.z), bfhi(xw.z), bflo(xw.w), bfhi(xw.w)}; } }
#pragma unroll
        for (int q = 0; q < NR; ++q) { float ss = 0.f;
#pragma unroll
            for (int it = 0; it < 4; ++it)
#pragma unroll
                for (int j = 0; j < 4; ++j) ss += y[q][it][0][j] * y[q][it][0][j] + y[q][it][1][j] * y[q][it][1][j];
            ry[q] = __builtin_amdgcn_rsqf(wave_sum(ss) * (1.0f / DM) + 1e-6f); }
#pragma unroll
        for (int q = 0; q < NR; ++q) { const int row = row0 + q * nw; const float* ab = ada + (row / SEQ) * 12288;
#pragma unroll
            for (int it = 0; it < 4; ++it) { const int col = (it * 64 + lane) * 8;
#pragma unroll
                for (int hh = 0; hh < 2; ++hh) { const f32x4 g = *(const f32x4*)(p.g_post_ffn + col + 4 * hh), gt = *(const f32x4*)(ab + 10240 + col + 4 * hh);
                    f32x4 o;
#pragma unroll
                    for (int j = 0; j < 4; ++j) o[j] = xv[q][it][hh][j] + gt[j] * (y[q][it][hh][j] * ry[q] * g[j]);
                    *(f32x4*)(p.out + (size_t)row * DM + col + 4 * hh) = o; } } }
    }
}

DI void phase_alpha(const Params& p) {
    bf16_t* att = (bf16_t*)(p.ws + WS_AQ); const float* lse = (const float*)(p.ws + WS_LSE);
    const int lane = threadIdx.x & 63, wave = threadIdx.x >> 6;
    for (int t = blockIdx.x * 8 + wave; t < T_TOK; t += gridDim.x * 8) {
        const float l = lse[(size_t)t * 18 + (lane < 18 ? lane : 0)];
        const int j = lane % 6;
        const float l0 = __shfl(l, j), l1 = __shfl(l, 6 + j), l2 = __shfl(l, 12 + j);
        const float mm = fmaxf(l0, fmaxf(l1, l2)); const float e0 = __expf(l0 - mm), e1 = __expf(l1 - mm), e2 = __expf(l2 - mm);
        const float al_lane = __expf(l - mm) / (e0 + e1 + e2);
        u32x4* row = (u32x4*)(att + (size_t)t * 2304);
        u32x4 w[5];
#pragma unroll
        for (int k = 0; k < 5; ++k) { const int ch = lane + 64 * k; if (ch < 288) w[k] = row[ch]; }
#pragma unroll
        for (int k = 0; k < 5; ++k) { const int ch = lane + 64 * k; const float al = __shfl(al_lane, (ch < 288 ? ch : 0) >> 4);
            if (ch < 288) { u32x4 o;
                o.x = cvt_pk_bf16(bflo(w[k].x) * al, bfhi(w[k].x) * al); o.y = cvt_pk_bf16(bflo(w[k].y) * al, bfhi(w[k].y) * al);
                o.z = cvt_pk_bf16(bflo(w[k].z) * al, bfhi(w[k].z) * al); o.w = cvt_pk_bf16(bflo(w[k].w) * al, bfhi(w[k].w) * al);
                row[ch] = o; } }
    }
}

DI void phase_retention(const Params& p, LAS unsigned char* lds, int cblk) {
    const int tid = threadIdx.x, lane = tid & 63, w = tid >> 6, fr = lane & 15, fq = lane >> 4;
    LAS unsigned char* Qs = lds; LAS unsigned char* Ks = lds + 33792; LAS unsigned char* Vs = lds + 67584; LAS unsigned char* St = lds + 76800; LAS unsigned char* Ps = lds + 110592;
    LAS float* red = (LAS float*)(lds + 119808);
    const bf16_t* rq = (const bf16_t*)(p.ws + WS_RQ); const bf16_t* rk = (const bf16_t*)(p.ws + WS_RK); bf16_t* rv = (bf16_t*)p.out; float* retss = (float*)(p.ws + WS_RETSS);
    for (int item = cblk; item < 256; item += gridDim.x) {
        const int q5 = item >> 3, bh = (item & 7) * 4 + (q5 & 3), slice = q5 >> 2, b = bh >> 3, h = bh & 7;
        const float lg = log1pf(-exp2f(-5.0f - (float)h));
        const float gamma_c = expf(64.0f * lg);
        const float xv = expf(-lg * (float)((tid >> 3) + 1));
        const float xo0 = expf(lg * (float)(32 * (w & 1) + fr + 1)), xo1 = expf(lg * (float)(32 * (w & 1) + 16 + fr + 1));
        const size_t tok0 = (size_t)b * SEQ;
        const bf16_t* qbase = rq + tok0 * 2048 + h * 256 + (tid & 31) * 8; const bf16_t* kbase = rk + tok0 * 2048 + h * 256 + (tid & 31) * 8;
        bf16_t* vbase = rv + tok0 * 4096 + h * 512 + slice * 64;
        u32x4 pq[4], pk[4], pv;
        f32x4 Sreg[2][4];
#pragma unroll
        for (int a = 0; a < 2; ++a)
#pragma unroll
            for (int bb = 0; bb < 4; ++bb) Sreg[a][bb] = (f32x4){0.f, 0.f, 0.f, 0.f};
        for (int i = tid; i < 33792 / 16; i += 512) ((LAS u32x4*)St)[i] = (u32x4){0u, 0u, 0u, 0u};
#define RET_LOAD(c) do { _Pragma("unroll") for (int i = 0; i < 4; ++i) { const int row = (tid + 512 * i) >> 5; \
            pq[i] = *(const u32x4*)(qbase + (size_t)(64 * (c) + row) * 2048); pk[i] = *(const u32x4*)(kbase + (size_t)(64 * (c) + row) * 2048); } \
            pv = *(const u32x4*)(vbase + (size_t)(64 * (c) + (tid >> 3)) * 4096 + (tid & 7) * 8); } while (0)
#define RET_STORE() do { _Pragma("unroll") for (int i = 0; i < 4; ++i) { const int e = tid + 512 * i, row = e >> 5, pc = e & 31; \
            *(LAS u32x4*)(Qs + row * 528 + pc * 16) = pq[i]; *(LAS u32x4*)(Ks + row * 528 + pc * 16) = pk[i]; } \
            { u32x4 o; o.x = cvt_pk_bf16(bflo(pv.x) * xv, bfhi(pv.x) * xv); o.y = cvt_pk_bf16(bflo(pv.y) * xv, bfhi(pv.y) * xv); \
              o.z = cvt_pk_bf16(bflo(pv.z) * xv, bfhi(pv.z) * xv); o.w = cvt_pk_bf16(bflo(pv.w) * xv, bfhi(pv.w) * xv); \
              *(LAS u32x4*)(Vs + (tid >> 3) * 144 + (tid & 7) * 16) = o; } } while (0)
        RET_LOAD(0); RET_STORE();
        __syncthreads();
        for (int c = 0; c < 128; ++c) {
            if (c + 1 < 128) RET_LOAD(c + 1);
            bf16x8 qfr[8][2];
            {
                const int jt = w >> 1, it0 = (w & 1) * 2;
                f32x4 sa[2] = {(f32x4){0.f, 0.f, 0.f, 0.f}, (f32x4){0.f, 0.f, 0.f, 0.f}};
#pragma unroll
                for (int ks = 0; ks < 8; ++ks) {
                    const bf16x8 kf = *(const LAS bf16x8*)(Ks + (16 * jt + fr) * 528 + (32 * ks + 8 * fq) * 2);
#pragma unroll
                    for (int t = 0; t < 2; ++t) { qfr[ks][t] = *(const LAS bf16x8*)(Qs + (16 * (it0 + t) + fr) * 528 + (32 * ks + 8 * fq) * 2); sa[t] = mfma16(kf, qfr[ks][t], sa[t]); }
                }
#pragma unroll
                for (int t = 0; t < 2; ++t) { const int iq = 16 * (it0 + t) + fr, jk0 = 16 * jt + 4 * fq;
                    u32x2 o; o.x = cvt_pk_bf16(jk0 + 0 <= iq ? sa[t][0] : 0.f, jk0 + 1 <= iq ? sa[t][1] : 0.f); o.y = cvt_pk_bf16(jk0 + 2 <= iq ? sa[t][2] : 0.f, jk0 + 3 <= iq ? sa[t][3] : 0.f);
                    *(LAS u32x2*)(Ps + iq * 144 + jk0 * 2) = o; }
            }
            {
#pragma unroll
                for (int ks = 0; ks < 2; ++ks) {
                    const int j0 = 32 * ks + 8 * fq + (fr >> 2);
                    bf16x8 kt[2], vf[4];
#pragma unroll
                    for (int dd = 0; dd < 2; ++dd) { LAS unsigned char* a0 = Ks + j0 * 528 + (16 * (2 * w + dd) + 4 * (fr & 3)) * 2; kt[dd] = tr_read2(a0, a0 + 4 * 528); }
#pragma unroll
                    for (int vt = 0; vt < 4; ++vt) { LAS unsigned char* a0 = Vs + j0 * 144 + (16 * vt + 4 * (fr & 3)) * 2; vf[vt] = tr_read2(a0, a0 + 4 * 144); }
#pragma unroll
                    for (int dd = 0; dd < 2; ++dd)
#pragma unroll
                        for (int vt = 0; vt < 4; ++vt) Sreg[dd][vt] = mfma16(kt[dd], vf[vt], Sreg[dd][vt]);
                }
#pragma unroll
                for (int dd = 0; dd < 2; ++dd)
#pragma unroll
                    for (int vt = 0; vt < 4; ++vt) Sreg[dd][vt] *= gamma_c;
            }
            __syncthreads();
            {
                const int vt = w >> 1, it0 = (w & 1) * 2;
                f32x4 oa[2] = {(f32x4){0.f, 0.f, 0.f, 0.f}, (f32x4){0.f, 0.f, 0.f, 0.f}};
#pragma unroll
                for (int ks = 0; ks < 8; ++ks) {
                    const bf16x8 sf = *(const LAS bf16x8*)(St + (16 * vt + fr) * 528 + (32 * ks + 8 * fq) * 2);
#pragma unroll
                    for (int t = 0; t < 2; ++t) oa[t] = mfma16(sf, qfr[ks][t], oa[t]);
                }
#pragma unroll
                for (int ks = 0; ks < 2; ++ks) {
                    const int j0 = 32 * ks + 8 * fq + (fr >> 2);
                    LAS unsigned char* a0 = Vs + j0 * 144 + (16 * vt + 4 * (fr & 3)) * 2; const bf16x8 vf = tr_read2(a0, a0 + 4 * 144);
#pragma unroll
                    for (int t = 0; t < 2; ++t) { const bf16x8 pf = *(const LAS bf16x8*)(Ps + (16 * (it0 + t) + fr) * 144 + (32 * ks + 8 * fq) * 2); oa[t] = mfma16(vf, pf, oa[t]); }
                }
#pragma unroll
                for (int t = 0; t < 2; ++t) { const int iq = 16 * (it0 + t) + fr; oa[t] *= (t == 0 ? xo0 : xo1);
                    u32x2 o; o.x = cvt_pk_bf16(oa[t][0], oa[t][1]); o.y = cvt_pk_bf16(oa[t][2], oa[t][3]);
                    *(u32x2*)(vbase + (size_t)(64 * c + iq) * 4096 + 16 * vt + 4 * fq) = o;
                    float ss = (oa[t][0] * oa[t][0] + oa[t][1] * oa[t][1]) + (oa[t][2] * oa[t][2] + oa[t][3] * oa[t][3]);
                    ss += __shfl_xor(ss, 16); ss += __shfl_xor(ss, 32);
                    if (fq == 0) red[iq * 4 + vt] = ss; }
            }
            __syncthreads();
#pragma unroll
            for (int dd = 0; dd < 2; ++dd)
#pragma unroll
                for (int vt = 0; vt < 4; ++vt) { u32x2 o; o.x = cvt_pk_bf16(Sreg[dd][vt][0], Sreg[dd][vt][1]); o.y = cvt_pk_bf16(Sreg[dd][vt][2], Sreg[dd][vt][3]);
                    *(LAS u32x2*)(St + (16 * vt + fr) * 528 + (16 * (2 * w + dd) + 4 * fq) * 2) = o; }
            if (c + 1 < 128) RET_STORE();
            if (tid < 64) retss[((tok0 + 64 * c + tid) * 8 + h) * 8 + slice] = (red[tid * 4 + 0] + red[tid * 4 + 1]) + (red[tid * 4 + 2] + red[tid * 4 + 3]);
            __syncthreads();
        }
#undef RET_LOAD
#undef RET_STORE
    }
}

DI void phase_attention(const Params& p, LAS unsigned char* lds) {
    const int tid = threadIdx.x, lane = tid & 63, w = tid >> 6, fr = lane & 15, fq = lane >> 4;
    LAS unsigned char* Ks = lds; LAS unsigned char* Vs = lds + 69632;
    bf16_t* aq = (bf16_t*)(p.ws + WS_AQ); const bf16_t* ak = (const bf16_t*)(p.ws + WS_AK); const bf16_t* av = (const bf16_t*)(p.ws + WS_AV); float* lse = (float*)(p.ws + WS_LSE);
    const int per = (4608 + (int)gridDim.x - 1) / (int)gridDim.x, it_lo = (int)blockIdx.x * per, it_hi = (it_lo + per < 4608) ? it_lo + per : 4608;
    int prev_key = -1;
    u32x4 kcur[4], vcur[4];
#define ATT_LOAD_CUR(item_) do { const int bh_ = (item_) >> 6, e64_ = (item_) & 63, head_ = bh_ % 18, b_ = bh_ / 18; \
        const int rsh_ = 2 * (head_ / 6), r_ = 1 << rsh_, nbc_ = 64 >> rsh_, cls_ = e64_ / nbc_, nb_ = e64_ - cls_ * nbc_; \
        _Pragma("unroll") for (int i = 0; i < 4; ++i) { const int e = tid + 512 * i, row = e >> 4, pc = e & 15; \
            const size_t off = ((size_t)b_ * SEQ + (size_t)(nb_ * 128 + row) * r_ + cls_) * 2304 + head_ * 128 + pc * 8; \
            kcur[i] = *(const u32x4*)(ak + off); vcur[i] = *(const u32x4*)(av + off); } } while (0)
    if (it_lo < it_hi) ATT_LOAD_CUR(it_lo);
    for (int item = it_lo, cnt = 0; item < it_hi; ++item, ++cnt) {
        const int bh = item >> 6, e64 = item & 63, head = bh % 18, b = bh / 18;
        const int g = head / 6, rsh = 2 * g, r = 1 << rsh, nbc = 64 >> rsh, cls = e64 / nbc, nb = e64 - cls * nbc;
        const int pq0 = nb * 128, pk0 = pq0 - 128;
        const size_t tokb = (size_t)b * SEQ;
        const int scur = cnt & 1, sprev = scur ^ 1;
        const bool reuse = (nb > 0) && (prev_key == item - 1);
#pragma unroll
        for (int i = 0; i < 4; ++i) { const int e = tid + 512 * i, row = e >> 4, pc = e & 15;
            *(LAS u32x4*)(Ks + (scur * 128 + row) * 272 + pc * 16) = kcur[i]; *(LAS u32x4*)(Vs + (scur * 128 + row) * 288 + pc * 16) = vcur[i]; }
        if (!reuse) {
#pragma unroll
            for (int i = 0; i < 4; ++i) { const int e = tid + 512 * i, row = e >> 4, pc = e & 15;
                u32x4 kv = {0u, 0u, 0u, 0u}, vv = kv;
                if (nb > 0) { const size_t off = (tokb + (size_t)(pk0 + row) * r + cls) * 2304 + head * 128 + pc * 8; kv = *(const u32x4*)(ak + off); vv = *(const u32x4*)(av + off); }
                *(LAS u32x4*)(Ks + (sprev * 128 + row) * 272 + pc * 16) = kv; *(LAS u32x4*)(Vs + (sprev * 128 + row) * 288 + pc * 16) = vv; }
        }
        if (item + 1 < it_hi) ATT_LOAD_CUR(item + 1);
        prev_key = item;
        const int qq = 16 * w + fr;
        const size_t tokq = tokb + (size_t)(pq0 + qq) * r + cls;
        bf16x8 qf[4];
        { const bf16_t* qp = aq + tokq * 2304 + head * 128 + 8 * fq;
#pragma unroll
          for (int ks = 0; ks < 4; ++ks) qf[ks] = *(const bf16x8*)(qp + 32 * ks); }
        __syncthreads();
        f32x4 sa[10];
#pragma unroll
        for (int kt = 0; kt < 10; ++kt) { sa[kt] = (f32x4){0.f, 0.f, 0.f, 0.f};
            const int T = (w + kt < 16) ? w + kt : 15;
            const int krow = ((T < 8) ? sprev : scur) * 128 + 16 * (T & 7) + fr;
#pragma unroll
            for (int ks = 0; ks < 4; ++ks) { const bf16x8 kf = *(const LAS bf16x8*)(Ks + krow * 272 + (32 * ks + 8 * fq) * 2); sa[kt] = mfma16(kf, qf[ks], sa[kt]); } }
        const float sc2 = 0.08838834764831845f * 1.4426950408889634f;
        float mrow = -INFINITY;
#pragma unroll
        for (int kt = 0; kt < 10; ++kt)
#pragma unroll
            for (int j = 0; j < 4; ++j) { const int kk = 16 * (w + kt) + 4 * fq + j; const bool valid = (kk >= qq) && (kk <= qq + 128) && (pk0 + kk >= 0);
                const float sv = valid ? sa[kt][j] * sc2 : -INFINITY; sa[kt][j] = sv; mrow = fmaxf(mrow, sv); }
        mrow = fmaxf(mrow, __shfl_xor(mrow, 16)); mrow = fmaxf(mrow, __shfl_xor(mrow, 32));
        float lsum = 0.f;
        bf16x8 pf[5];
#pragma unroll
        for (int t = 0; t < 5; ++t) { f32x4 p0, p1;
#pragma unroll
            for (int j = 0; j < 4; ++j) { p0[j] = __builtin_amdgcn_exp2f(sa[2 * t][j] - mrow); p1[j] = __builtin_amdgcn_exp2f(sa[2 * t + 1][j] - mrow); lsum += p0[j] + p1[j]; }
            const u32x4 pk4 = pack8(p0, p1); pf[t] = __builtin_bit_cast(bf16x8, pk4); }
        lsum += __shfl_xor(lsum, 16); lsum += __shfl_xor(lsum, 32);
        f32x4 oa[8];
#pragma unroll
        for (int dt = 0; dt < 8; ++dt) oa[dt] = (f32x4){0.f, 0.f, 0.f, 0.f};
#pragma unroll
        for (int t = 0; t < 5; ++t) {
            const int T0 = w + 2 * t, T1 = (T0 + 1 < 16) ? T0 + 1 : T0;
            const int r0 = ((T0 < 8) ? sprev : scur) * 128 + 16 * (T0 & 7) + 4 * fq + (fr >> 2), r1 = ((T1 < 8) ? sprev : scur) * 128 + 16 * (T1 & 7) + 4 * fq + (fr >> 2);
            LAS unsigned char* a0 = Vs + r0 * 288 + (4 * (fr & 3)) * 2; LAS unsigned char* a1 = Vs + r1 * 288 + (4 * (fr & 3)) * 2;
#pragma unroll
            for (int dt = 0; dt < 8; ++dt) { const bf16x8 vf = tr_read2(a0 + 32 * dt, a1 + 32 * dt); oa[dt] = mfma16(vf, pf[t], oa[dt]); }
        }
        const float inv = __builtin_amdgcn_rcpf(lsum);
        bf16_t* po = aq + tokq * 2304 + head * 128 + 4 * fq;
#pragma unroll
        for (int dt = 0; dt < 8; ++dt) { u32x2 o; o.x = cvt_pk_bf16(oa[dt][0] * inv, oa[dt][1] * inv); o.y = cvt_pk_bf16(oa[dt][2] * inv, oa[dt][3] * inv); *(u32x2*)(po + 16 * dt) = o; }
        if (fq == 0) lse[tokq * 18 + head] = mrow * 0.6931471805599453f + __logf(lsum);
        __syncthreads();
    }
#undef ATT_LOAD_CUR
}

constexpr size_t WS_BAR = 700000;
DI void grid_barrier(unsigned* bar, unsigned& nbar, const bool hier, const unsigned xcd, const unsigned per_xcd) {
    asm volatile("s_waitcnt vmcnt(0)" ::: "memory");
    __syncthreads();
    if (threadIdx.x == 0) {
        __builtin_amdgcn_fence(__ATOMIC_RELEASE, "agent");
        asm volatile("s_waitcnt vmcnt(0)" ::: "memory");
        const unsigned gen = nbar + 1u;
        if (hier) {
            unsigned* xc = bar + 256 + 64 * xcd; unsigned* top = bar + 1024;
            const unsigned old = __hip_atomic_fetch_add(xc, 1u, __ATOMIC_RELAXED, __HIP_MEMORY_SCOPE_AGENT);
            if (old + 1u == gen * per_xcd) __hip_atomic_fetch_add(top, 1u, __ATOMIC_RELAXED, __HIP_MEMORY_SCOPE_AGENT);
            while (__hip_atomic_load(top, __ATOMIC_RELAXED, __HIP_MEMORY_SCOPE_AGENT) < gen * 8u) __builtin_amdgcn_s_sleep(1);
        } else {
            const unsigned target = gen * gridDim.x;
            __hip_atomic_fetch_add(bar, 1u, __ATOMIC_RELAXED, __HIP_MEMORY_SCOPE_AGENT);
            while (__hip_atomic_load(bar, __ATOMIC_RELAXED, __HIP_MEMORY_SCOPE_AGENT) < target) __builtin_amdgcn_s_sleep(1);
        }
        __builtin_amdgcn_fence(__ATOMIC_ACQUIRE, "agent");
        asm volatile("s_waitcnt vmcnt(0)" ::: "memory");
    }
    __syncthreads();
    ++nbar;
}

constexpr int N_PHASES = 13;
__global__ void __launch_bounds__(512, 2) mega(Params p) {
    extern __shared__ __attribute__((aligned(16))) unsigned char shm[];
    LAS unsigned char* lds = (LAS unsigned char*)shm;
    unsigned char* ws = p.ws;
    const int G = gridDim.x, c = blockIdx.x;
    unsigned* bar = (unsigned*)(ws + WS_BAR); unsigned nbar = 0;
    int c_eff = c; unsigned my_xcd = 0, my_idx = 0; bool hier = false;
    if (p.ph_hi - p.ph_lo > 1) {
        my_xcd = (unsigned)__builtin_amdgcn_s_getreg((3 << 11) | 20) & 0xFu;
        if (threadIdx.x == 0) my_idx = __hip_atomic_fetch_add(bar + 64 + 16 * (my_xcd & 7u), 1u, __ATOMIC_RELAXED, __HIP_MEMORY_SCOPE_AGENT);
        my_idx = (unsigned)__builtin_amdgcn_readfirstlane((int)my_idx);
    }
    if (p.ph_lo <= 0 && 0 < p.ph_hi) {
        if (0 > p.ph_lo) grid_barrier(bar, nbar, hier, my_xcd, (unsigned)G / 8u);

#if (PHMASK >> 0) & 1
            phase0(p, lds);
#endif
    }
    if (p.ph_lo <= 1 && 1 < p.ph_hi) {
        if (1 > p.ph_lo) cg::this_grid().sync();
        if (p.ph_hi - p.ph_lo > 1) {
            LAS unsigned* cw = (LAS unsigned*)lds;
            if (threadIdx.x == 0) {
                bool ok = (G % 8) == 0 && my_xcd < 8u;
                for (int x = 0; x < 8; ++x) ok = ok && (__hip_atomic_load(bar + 64 + 16 * x, __ATOMIC_RELAXED, __HIP_MEMORY_SCOPE_AGENT) == (unsigned)(G / 8));
                cw[0] = ok ? (my_idx * 8u + my_xcd) : (unsigned)c; cw[1] = ok ? 1u : 0u;
            }
            __syncthreads();
            c_eff = __builtin_amdgcn_readfirstlane((int)cw[0]);
            hier = (cw[1] != 0u);
            __syncthreads();
        }

#if (PHMASK >> 1) & 1
            phase_h(p);
#endif
    }
    if (p.ph_lo <= 2 && 2 < p.ph_hi) {
        if (2 > p.ph_lo) grid_barrier(bar, nbar, hier, my_xcd, (unsigned)G / 8u);

#if (PHMASK >> 2) & 1
            pg8::Gemm g{(const bf16_t*)(ws + WS_H), (const bf16_t*)(ws + WS_WIN), T_TOK, 59 * 256, 2048, nullptr, nullptr, 0}; pg8::StaticOrder S; S.init(T_TOK, 59 * 256, G, c_eff, 32, 16);
            EpiInProj E{(bf16_t*)(ws + WS_RQ), (bf16_t*)(ws + WS_RK), (bf16_t*)p.out, (bf16_t*)(ws + WS_AQ), (bf16_t*)(ws + WS_AK), (bf16_t*)(ws + WS_AV), p.pos};
            pg8::gemm_phase<1>(lds, g, S, E);
#endif
    }
    if (p.ph_lo <= 3 && 3 < p.ph_hi) {
        if (3 > p.ph_lo) grid_barrier(bar, nbar, hier, my_xcd, (unsigned)G / 8u);

#if (PHMASK >> 3) & 1
            phase_retention(p, lds, c_eff); __syncthreads();
#endif
#if (PHMASK >> 13) & 1
            phase_attention(p, lds);
#endif
    }
    if (p.ph_lo <= 4 && 4 < p.ph_hi) {
        if (4 > p.ph_lo) grid_barrier(bar, nbar, hier, my_xcd, (unsigned)G / 8u);

#if (PHMASK >> 4) & 1
            { pg8::Gemm g{(const bf16_t*)(ws + WS_H), (const bf16_t*)(ws + WS_WIN) + (size_t)8192 * 2048, T_TOK, 4096, 2048, nullptr, nullptr, 0}; pg8::StaticOrder S; S.init(T_TOK, 4096, G, c_eff);
              EpiRetGate E{(bf16_t*)p.out, (const float*)(ws + WS_RETSS), p.ret_gain}; pg8::gemm_phase<1>(lds, g, S, E); }
#endif
#if (PHMASK >> 14) & 1
            { pg8::Gemm g{(const bf16_t*)(ws + WS_H), (const bf16_t*)(ws + WS_WGATE), T_TOK, 4096, 2048, nullptr, nullptr, 0}; pg8::StaticOrder S; S.init(T_TOK, 4096, G, c_eff);
              EpiGates E{(bf16_t*)(ws + WS_GATES), p.b_gate}; pg8::gemm_phase<1>(lds, g, S, E); }
#endif
#if (PHMASK >> 15) & 1
            phase_alpha(p);
#endif
    }
    if (p.ph_lo <= 5 && 5 < p.ph_hi) {
        if (5 > p.ph_lo) grid_barrier(bar, nbar, hier, my_xcd, (unsigned)G / 8u);

#if (PHMASK >> 5) & 1
            pg8::Gemm g{(const bf16_t*)p.out, (const bf16_t*)(ws + WS_WRET), T_TOK, 2048, 4096, (const bf16_t*)(ws + WS_AQ), (const bf16_t*)(ws + WS_WATT), 2304}; pg8::StaticOrder S; S.init(T_TOK, 2048, G, c_eff);
            EpiYMerge E{(const bf16_t*)(ws + WS_GATES), (bf16_t*)(ws + WS_U2)}; pg8::gemm_phase<2>(lds, g, S, E);
#endif
    }
    if (p.ph_lo <= 7 && 7 < p.ph_hi) {
        if (7 > p.ph_lo) grid_barrier(bar, nbar, hier, my_xcd, (unsigned)G / 8u);

#if (PHMASK >> 7) & 1
            pg8::Gemm g{(const bf16_t*)(ws + WS_U2), (const bf16_t*)(ws + WS_WMIX), T_TOK, 2048, 2048, nullptr, nullptr, 0}; pg8::StaticOrder S; S.init(T_TOK, 2048, G, c_eff);
            EpiStoreBf16 E{(bf16_t*)(ws + WS_Y), 2048}; pg8::gemm_phase<1>(lds, g, S, E);
#endif
    }
    if (p.ph_lo <= 8 && 8 < p.ph_hi) {
        if (8 > p.ph_lo) grid_barrier(bar, nbar, hier, my_xcd, (unsigned)G / 8u);

#if (PHMASK >> 8) & 1
            phase_postmix(p);
#endif
    }
    if (p.ph_lo <= 9 && 9 < p.ph_hi) {
        if (9 > p.ph_lo) grid_barrier(bar, nbar, hier, my_xcd, (unsigned)G / 8u);

#if (PHMASK >> 9) & 1
            pg8::Gemm g{(const bf16_t*)(ws + WS_H2), (const bf16_t*)(ws + WS_WUP), T_TOK, FF, 2048, nullptr, nullptr, 0}; pg8::StaticOrder S; S.init(T_TOK, FF, G, c_eff);
            EpiStoreBf16 E{(bf16_t*)(ws + WS_A), FF}; pg8::gemm_phase<1>(lds, g, S, E);
#endif
    }
    if (p.ph_lo <= 10 && 10 < p.ph_hi) {
        if (10 > p.ph_lo) grid_barrier(bar, nbar, hier, my_xcd, (unsigned)G / 8u);

#if (PHMASK >> 10) & 1
            pg8::Gemm g{(const bf16_t*)(ws + WS_H2), (const bf16_t*)(ws + WS_WUP) + (size_t)FF * 2048, T_TOK, FF, 2048, nullptr, nullptr, 0}; pg8::StaticOrder S; S.init(T_TOK, FF, G, c_eff);
            EpiConvAct E{(const bf16_t*)(ws + WS_A), (bf16_t*)(ws + WS_ACT), p.conv_w, p.conv_b}; pg8::gemm_phase<1>(lds, g, S, E);
#endif
    }
    if (p.ph_lo <= 11 && 11 < p.ph_hi) {
        if (11 > p.ph_lo) grid_barrier(bar, nbar, hier, my_xcd, (unsigned)G / 8u);

#if (PHMASK >> 11) & 1
            pg8::Gemm g{(const bf16_t*)(ws + WS_ACT), (const bf16_t*)(ws + WS_WDOWN), T_TOK, 2048, FF, nullptr, nullptr, 0}; pg8::StaticOrder S; S.init(T_TOK, 2048, G, c_eff);
            EpiStoreBf16 E{(bf16_t*)(ws + WS_Y2), 2048}; pg8::gemm_phase<1>(lds, g, S, E);
#endif
    }
    if (p.ph_lo <= 12 && 12 < p.ph_hi) {
        if (12 > p.ph_lo) grid_barrier(bar, nbar, hier, my_xcd, (unsigned)G / 8u);

#if (PHMASK >> 12) & 1
            phase_final(p);
#endif
    }
}

extern "C" void kernel_launch(void* const* d_in, const int* in_sizes, int n_in, void* d_out, int out_size, void* d_ws, size_t ws_size, hipStream_t stream) {
    static int grid = 0;
    if (grid == 0) {
        if (n_in != 20 || ws_size < WS_END) { fprintf(stderr, "kernel_launch: unexpected n_in %d or ws_size %zu (need %zu)\n", n_in, ws_size, (size_t)WS_END); grid = -1; return; }
        int dev = 0, cus = 0, per_cu = 0;
        hipGetDevice(&dev); hipDeviceGetAttribute(&cus, hipDeviceAttributeMultiprocessorCount, dev);
        if (hipFuncSetAttribute((const void*)mega, hipFuncAttributeMaxDynamicSharedMemorySize, LDS_BYTES) != hipSuccess) { fprintf(stderr, "kernel_launch: hipFuncSetAttribute failed\n"); grid = -1; return; }
        if (hipOccupancyMaxActiveBlocksPerMultiprocessor(&per_cu, (const void*)mega, 512, LDS_BYTES) != hipSuccess || per_cu < 1) { fprintf(stderr, "kernel_launch: occupancy query says %d\n", per_cu); per_cu = 1; }
        (void)hipGetLastError();
        grid = cus * 1;
    }
    if (grid < 0) return;
    Params p{};
    p.x = (const float*)d_in[0]; p.c = (const float*)d_in[1]; p.pos = (const int*)d_in[2]; p.w_ada = (const float*)d_in[3]; p.b_ada = (const float*)d_in[4]; p.g_pre_mix = (const float*)d_in[5];
    p.w_in = (const float*)d_in[6]; p.ret_gain = (const float*)d_in[7]; p.w_ret_out = (const float*)d_in[8]; p.w_att_out = (const float*)d_in[9]; p.w_gate = (const float*)d_in[10]; p.b_gate = (const float*)d_in[11];
    p.w_mix = (const float*)d_in[12]; p.g_post_mix = (const float*)d_in[13]; p.g_pre_ffn = (const float*)d_in[14]; p.w_up = (const float*)d_in[15]; p.conv_w = (const float*)d_in[16]; p.conv_b = (const float*)d_in[17];
    p.w_down = (const float*)d_in[18]; p.g_post_ffn = (const float*)d_in[19];
    p.out = (float*)d_out; p.ws = (unsigned char*)d_ws;
    if (hipMemsetAsync((char*)d_ws + WS_BAR, 0, 8192, stream) != hipSuccess) { fprintf(stderr, "kernel_launch: memset failed\n"); return; }
#if N_LAUNCH_PER_PHASE
    for (int ph = 0; ph < N_PHASES; ++ph) { p.ph_lo = ph; p.ph_hi = ph + 1; hipLaunchKernelGGL(mega, dim3(grid), dim3(512), LDS_BYTES, stream, p); }
#else
    p.ph_lo = 0; p.ph_hi = N_PHASES;
    void* args[] = {&p};
    hipError_t e = hipLaunchCooperativeKernel((const void*)mega, dim3(grid), dim3(512), args, LDS_BYTES, stream);
    if (e != hipSuccess) fprintf(stderr, "cooperative launch failed: %s (grid %d)\n", hipGetErrorString(e), grid);
#endif
}
```

```cpp
#include <hip/hip_runtime.h>
#include <hip/hip_cooperative_groups.h>
#include <cstdio>
#include <cstdint>
namespace cg = cooperative_groups;

#define DI __device__ __forceinline__
#define LAS __attribute__((address_space(3)))
typedef unsigned short bf16_t;
typedef short bf16x8 __attribute__((ext_vector_type(8)));
typedef short s16x4 __attribute__((ext_vector_type(4)));
typedef float f32x4 __attribute__((ext_vector_type(4)));
typedef unsigned u32x4 __attribute__((ext_vector_type(4)));
typedef unsigned u32x2 __attribute__((ext_vector_type(2)));

#ifndef PHMASK
#define PHMASK 0xFFFF
#endif
#ifndef N_LAUNCH_PER_PHASE
#define N_LAUNCH_PER_PHASE 0
#endif

constexpr int T_TOK = 32768, DM = 2048, SEQ = 8192, NB = 4;
constexpr int FF = 5632;
constexpr int LDS_BYTES = 143360;
constexpr size_t MiB = 1u << 20;
constexpr size_t WS_ADA = 0;
constexpr size_t WS_LSE = 1 * MiB;
constexpr size_t WS_RETSS = 4 * MiB;
constexpr size_t WS_WUP = 12 * MiB;
constexpr size_t WS_WDOWN = 56 * MiB;
constexpr size_t WS_WIN = 78 * MiB;
constexpr size_t WS_WGATE = 153 * MiB;
constexpr size_t WS_WRET = 169 * MiB;
constexpr size_t WS_WATT = 185 * MiB;
constexpr size_t WS_WMIX = 194 * MiB;
constexpr size_t WS_H = 206 * MiB;
constexpr size_t WS_RQ = 334 * MiB;
constexpr size_t WS_RK = 462 * MiB;
constexpr size_t WS_AQ = 590 * MiB;
constexpr size_t WS_AK = 734 * MiB;
constexpr size_t WS_AV = 878 * MiB;
constexpr size_t WS_GATES = 334 * MiB;
constexpr size_t WS_U = 734 * MiB;
constexpr size_t WS_U2 = 206 * MiB;
constexpr size_t WS_Y = 334 * MiB;
constexpr size_t WS_H2 = 78 * MiB;
constexpr size_t WS_A = 206 * MiB;
constexpr size_t WS_ACT = 558 * MiB;
constexpr size_t WS_Y2 = 78 * MiB;
constexpr size_t WS_END = 1022 * MiB;

struct Params {
    const float *x, *c; const int* pos;
    const float *w_ada, *b_ada, *g_pre_mix, *w_in, *ret_gain, *w_ret_out, *w_att_out, *w_gate, *b_gate, *w_mix, *g_post_mix, *g_pre_ffn, *w_up, *conv_w, *conv_b, *w_down, *g_post_ffn;
    float* out; unsigned char* ws; int ph_lo, ph_hi;
};

typedef __bf16 bf16x2_t __attribute__((ext_vector_type(2)));
DI unsigned cvt_pk_bf16(float lo, float hi) { bf16x2_t v = {(__bf16)lo, (__bf16)hi}; return __builtin_bit_cast(unsigned, v); }
DI float bflo(unsigned w) { return __uint_as_float(w << 16); }
DI float bfhi(unsigned w) { return __uint_as_float(w & 0xffff0000u); }
DI float wave_sum(float v) {
#pragma unroll
    for (int o = 1; o < 64; o <<= 1) v += __shfl_xor(v, o);
    return v;
}
DI float sigmoidf_(float v) { return __builtin_amdgcn_rcpf(1.0f + __builtin_amdgcn_exp2f(-1.4426950408889634f * v)); }
DI f32x4 mfma16(bf16x8 a, bf16x8 b, f32x4 c) { return __builtin_amdgcn_mfma_f32_16x16x32_bf16(a, b, c, 0, 0, 0); }
DI s16x4 tr_read(LAS unsigned char* p) { return __builtin_amdgcn_ds_read_tr16_b64_v4i16((LAS s16x4*)p); }
DI bf16x8 tr_read2(LAS unsigned char* p0, LAS unsigned char* p1) { s16x4 lo = tr_read(p0), hi = tr_read(p1); return __builtin_shufflevector(lo, hi, 0, 1, 2, 3, 4, 5, 6, 7); }

namespace pg8 {
constexpr int BM = 256, BK = 64, HALF = 128, HTB = HALF * BK * 2, STAGE_BYTES = 8 * HTB, NXCD = 8, WGM = 8;
DI int lds_byte(int r, int c) { const int st = (r >> 4) * 2 + (c >> 5), rr = r & 15, cc = c & 31, ob = rr * 64 + cc * 2; return st * 1024 + (ob ^ (((ob >> 9) & 1) << 5)); }
DI void stage_rc(int b, int& R, int& C) { const int st = b / 1024, sb = b % 1024, swz = sb ^ (((sb >> 9) & 1) << 5); R = (st >> 1) * 16 + swz / 64; C = (st & 1) * 32 + (swz % 64) / 2; }
struct Unit { int pm, pn; };
struct Gemm { const bf16_t* A; const bf16_t* Bt; int M, N, K; const bf16_t* A1; const bf16_t* Bt1; int K1; };
struct StaticOrder {
    int nM, nN, nwg, G, c, skip_lo, skip_n;
    DI void init(int M, int N, int G_, int c_, int slo = 1 << 30, int sn = 0) { nM = M / BM; nN = N / BM; nwg = nM * nN; G = G_; c = c_; skip_lo = slo; skip_n = sn; }
    DI bool next(int i, Unit& u) const {
        const long L = (long)i * G + c; if (L >= nwg) return false;
        int wgid = (int)L; { const int q = nwg / NXCD, r = nwg % NXCD, xcd = wgid % NXCD, off = wgid / NXCD; wgid = (xcd < r ? xcd * (q + 1) : r * (q + 1) + (xcd - r) * q) + off; }
        const int nig = WGM * nN, gid = wgid / nig, fm = gid * WGM, gsz = (nM - fm) < WGM ? (nM - fm) : WGM;
        u.pm = fm + ((wgid % nig) % gsz); u.pn = (wgid % nig) / gsz; if (u.pn >= skip_lo) u.pn += skip_n; return true;
    }
};

template <int NSEG, class Epi>
DI void gemm_phase(LAS unsigned char* lds, const Gemm g, const StaticOrder& S, const Epi& E) {
    const int tid = threadIdx.x, wid = __builtin_amdgcn_readfirstlane(tid >> 6), lane = tid & 63, wr = wid >> 2, wc = wid & 3, fr = lane & 15, fq = lane >> 4;
    int Rr[2], Cc[2];
#pragma unroll
    for (int i = 0; i < 2; ++i) stage_rc(tid * 16 + i * 8192, Rr[i], Cc[i]);
    const size_t kstep = (size_t)(BK * 2);
    const unsigned ldsw = (unsigned)wid * 1024u;
    const int aoff = lds_byte(wr * 64 + fr, fq * 8), boff = lds_byte(wc * 32 + fr, fq * 8);
#define PG8_SA(b, h) (((b) * 2 + (h)) * HTB)
#define PG8_SB(b, h) ((4 + (b) * 2 + (h)) * HTB)
#define PG8_STAGE(bufoff, gbase, VO) do { _Pragma("unroll") for (int _i = 0; _i < 2; ++_i) \
        __builtin_amdgcn_global_load_lds((const unsigned*)((const char*)(gbase) + VO[_i]), (LAS unsigned*)(lds + (bufoff) + ldsw + _i * 8192), 16, 0, 0); } while (0)
#define PG8_LDA(dst, b, h) do { _Pragma("unroll") for (int m = 0; m < 4; ++m) _Pragma("unroll") for (int k = 0; k < 2; ++k) dst[m][k] = *(const LAS bf16x8*)(lds + PG8_SA(b, h) + aoff + m * 2048 + k * 1024); } while (0)
#define PG8_LDB(dst, b, h) do { _Pragma("unroll") for (int n = 0; n < 2; ++n) _Pragma("unroll") for (int k = 0; k < 2; ++k) dst[n][k] = *(const LAS bf16x8*)(lds + PG8_SB(b, h) + boff + n * 2048 + k * 1024); } while (0)
#define PG8_MMA(ai, bj, At, Bt) do { __builtin_amdgcn_s_setprio(1); _Pragma("unroll") for (int m = 0; m < 4; ++m) _Pragma("unroll") for (int n = 0; n < 2; ++n) _Pragma("unroll") for (int k = 0; k < 2; ++k) \
        acc[ai][bj][m][n] = __builtin_amdgcn_mfma_f32_16x16x32_bf16(Bt[n][k], At[m][k], acc[ai][bj][m][n], 0, 0, 0); __builtin_amdgcn_s_setprio(0); } while (0)
#define PG8_WAIT_V(n) asm volatile("s_waitcnt vmcnt(" #n ")" ::: "memory")
#define PG8_WAIT_L(n) asm volatile("s_waitcnt lgkmcnt(" #n ")" ::: "memory")
#define PG8_BAR __builtin_amdgcn_s_barrier()
#define PG8_SCHED __builtin_amdgcn_sched_barrier(0)
    Unit cur, nxt; int ti = 0, seg = 0;
    if (!S.next(0, cur)) return;
    f32x4 acc[2][2][4][2];
#pragma unroll
    for (int a = 0; a < 2; ++a)
#pragma unroll
        for (int b = 0; b < 2; ++b)
#pragma unroll
            for (int m = 0; m < 4; ++m)
#pragma unroll
                for (int n = 0; n < 2; ++n) acc[a][b][m][n] = (f32x4){0.f, 0.f, 0.f, 0.f};
    bf16x8 At[4][2], B0[2][2], B1[2][2];
    int Kc = g.K;
    unsigned voffC[2];
#pragma unroll
    for (int i = 0; i < 2; ++i) voffC[i] = (unsigned)(Rr[i] * Kc + Cc[i]) * 2u;
    size_t hstepC = (size_t)HALF * Kc * 2;
    const char* cA = (const char*)g.A + (size_t)cur.pm * 2 * hstepC; const char* cB = (const char*)g.Bt + (size_t)cur.pn * 2 * hstepC;
    PG8_STAGE(PG8_SB(0, 0), cB, voffC); PG8_STAGE(PG8_SA(0, 0), cA, voffC); PG8_STAGE(PG8_SB(0, 1), cB + hstepC, voffC); PG8_STAGE(PG8_SA(0, 1), cA + hstepC, voffC);
    if (wr == 1) PG8_BAR;
    PG8_WAIT_V(4); PG8_BAR;
    PG8_STAGE(PG8_SB(1, 0), cB + kstep, voffC); PG8_STAGE(PG8_SA(1, 0), cA + kstep, voffC); PG8_STAGE(PG8_SB(1, 1), cB + hstepC + kstep, voffC);
    PG8_WAIT_V(6); PG8_BAR;
    for (;;) {
        bool has_next; int nseg = 0;
        if (NSEG > 1 && seg + 1 < NSEG) { has_next = true; nxt = cur; nseg = seg + 1; }
        else has_next = S.next(ti + 1, nxt);
        int Kn = Kc; const char* nA = cA; const char* nB = cB;
        if (has_next) { Kn = (NSEG > 1 && nseg == 1) ? g.K1 : g.K;
            nA = (const char*)((NSEG > 1 && nseg == 1) ? g.A1 : g.A) + (size_t)nxt.pm * 256 * Kn * 2; nB = (const char*)((NSEG > 1 && nseg == 1) ? g.Bt1 : g.Bt) + (size_t)nxt.pn * 256 * Kn * 2; }
        unsigned voffN[2];
#pragma unroll
        for (int i = 0; i < 2; ++i) voffN[i] = (NSEG > 1) ? (unsigned)(Rr[i] * Kn + Cc[i]) * 2u : voffC[i];
        const size_t hstepN = (NSEG > 1) ? (size_t)HALF * Kn * 2 : hstepC;
        const int nt = Kc / BK;
        for (int t = 0; t < nt; t += 2) {
            const bool last = (t == nt - 2);
            const char* a1 = cA + (size_t)(t + 1) * kstep;
            const char* a2 = last ? nA : cA + (size_t)(t + 2) * kstep; const char* b2 = last ? nB : cB + (size_t)(t + 2) * kstep;
            const char* a3 = a2 + kstep; const char* b3 = b2 + kstep;
            unsigned v2[2]; v2[0] = (NSEG > 1 && last) ? voffN[0] : voffC[0]; v2[1] = (NSEG > 1 && last) ? voffN[1] : voffC[1];
            const size_t h2 = (NSEG > 1 && last) ? hstepN : hstepC;
            PG8_LDB(B0, 0, 0); PG8_SCHED; PG8_LDA(At, 0, 0); PG8_STAGE(PG8_SA(1, 1), a1 + hstepC, voffC);
            PG8_WAIT_L(8); PG8_BAR; PG8_WAIT_L(0); PG8_MMA(0, 0, At, B0); PG8_BAR; PG8_SCHED;
            PG8_LDB(B1, 0, 1); PG8_STAGE(PG8_SB(0, 0), b2, v2);
            PG8_BAR; PG8_WAIT_L(0); PG8_MMA(0, 1, At, B1); PG8_BAR;
            PG8_LDA(At, 0, 1); PG8_STAGE(PG8_SA(0, 0), a2, v2);
            PG8_BAR; PG8_WAIT_L(0); PG8_MMA(1, 0, At, B0); PG8_BAR; PG8_SCHED;
            PG8_STAGE(PG8_SB(0, 1), b2 + h2, v2);
            PG8_WAIT_V(6); PG8_BAR; PG8_MMA(1, 1, At, B1); PG8_BAR;
            PG8_LDB(B0, 1, 0); PG8_SCHED; PG8_LDA(At, 1, 0); PG8_STAGE(PG8_SA(0, 1), a2 + h2, v2);
            PG8_WAIT_L(8); PG8_BAR; PG8_WAIT_L(0); PG8_MMA(0, 0, At, B0); PG8_BAR; PG8_SCHED;
            PG8_LDB(B1, 1, 1); PG8_STAGE(PG8_SB(1, 0), b3, v2);
            PG8_BAR; PG8_WAIT_L(0); PG8_MMA(0, 1, At, B1); PG8_BAR;
            PG8_LDA(At, 1, 1); PG8_STAGE(PG8_SA(1, 0), a3, v2);
            PG8_BAR; PG8_WAIT_L(0); PG8_MMA(1, 0, At, B0); PG8_BAR; PG8_SCHED;
            PG8_STAGE(PG8_SB(1, 1), b3 + h2, v2);
            PG8_WAIT_V(6); PG8_BAR; PG8_MMA(1, 1, At, B1); PG8_BAR;
        }
        if constexpr (NSEG > 1) { if (seg + 1 < NSEG) E.mid(acc, cur, wr, wc, fr, fq); else E(acc, cur, wr, wc, fr, fq); }
        else E(acc, cur, wr, wc, fr, fq);
        if (!has_next) break;
        if (NSEG == 1 || nseg == 0) {
#pragma unroll
            for (int a = 0; a < 2; ++a)
#pragma unroll
                for (int b = 0; b < 2; ++b)
#pragma unroll
                    for (int m = 0; m < 4; ++m)
#pragma unroll
                        for (int n = 0; n < 2; ++n) acc[a][b][m][n] = (f32x4){0.f, 0.f, 0.f, 0.f};
            ++ti;
        }
        cur = nxt; cA = nA; cB = nB; seg = nseg;
        if (NSEG > 1) { Kc = Kn; voffC[0] = voffN[0]; voffC[1] = voffN[1]; hstepC = hstepN; }
    }
    PG8_WAIT_V(0);
    if (wr == 0) PG8_BAR;
    PG8_BAR;
#undef PG8_SA
#undef PG8_SB
#undef PG8_STAGE
#undef PG8_LDA
#undef PG8_LDB
#undef PG8_MMA
#undef PG8_WAIT_V
#undef PG8_WAIT_L
#undef PG8_BAR
#undef PG8_SCHED
}
}
using pg8::Unit;
typedef f32x4 AccT[2][2][4][2];

DI u32x4 pack8(const f32x4& v0, const f32x4& v1) { u32x4 w; w.x = cvt_pk_bf16(v0[0], v0[1]); w.y = cvt_pk_bf16(v0[2], v0[3]); w.z = cvt_pk_bf16(v1[0], v1[1]); w.w = cvt_pk_bf16(v1[2], v1[3]); return w; }

struct EpiStoreBf16 {
    bf16_t* O; int ld;
    DI void operator()(const AccT& acc, const Unit& u, int wr, int wc, int fr, int fq) const {
        const int row0 = u.pm * 256 + wr * 64 + fr, col0 = u.pn * 256 + wc * 32 + 8 * fq;
#pragma unroll
        for (int ai = 0; ai < 2; ++ai)
#pragma unroll
            for (int m = 0; m < 4; ++m) { bf16_t* rowp = O + (size_t)(row0 + ai * 128 + m * 16) * ld + col0;
#pragma unroll
                for (int bj = 0; bj < 2; ++bj) *(u32x4*)(rowp + bj * 128) = pack8(acc[ai][bj][m][0], acc[ai][bj][m][1]); }
    }
};

template <int HD>
DI void rope_store(const AccT& acc, int rowbase, const int* pos, bf16_t* dst, int ld, int c1, int half, int ibase, float scale) {
    int pi[2][4];
#pragma unroll
    for (int ai = 0; ai < 2; ++ai)
#pragma unroll
        for (int m = 0; m < 4; ++m) pi[ai][m] = pos[rowbase + ai * 128 + m * 16];
    float invf[2][4];
#pragma unroll
    for (int n = 0; n < 2; ++n)
#pragma unroll
        for (int j = 0; j < 4; ++j) invf[n][j] = exp2f(-(float)(ibase + 4 * n + j) * (2.0f / HD) * 13.287712379549449f);
#pragma unroll
    for (int ai = 0; ai < 2; ++ai)
#pragma unroll
        for (int m = 0; m < 4; ++m) {
            const int row = rowbase + ai * 128 + m * 16; const float ps = (float)pi[ai][m];
            f32x4 o1[2], o2[2];
#pragma unroll
            for (int n = 0; n < 2; ++n)
#pragma unroll
                for (int j = 0; j < 4; ++j) {
                    const float ang = ps * invf[n][j]; const float rev = __builtin_amdgcn_fractf(ang * 0.15915494309189535f);
                    const float sn = __builtin_amdgcn_sinf(rev), cs = __builtin_amdgcn_cosf(rev);
                    const float t1 = acc[ai][0][m][n][j], t2 = acc[ai][1][m][n][j];
                    o1[n][j] = (t1 * cs - t2 * sn) * scale; o2[n][j] = (t2 * cs + t1 * sn) * scale;
                }
            bf16_t* rowp = dst + (size_t)row * ld + c1;
            *(u32x4*)rowp = pack8(o1[0], o1[1]); *(u32x4*)(rowp + half) = pack8(o2[0], o2[1]);
        }
}

struct EpiInProj {
    bf16_t *rq, *rk, *rv, *aq, *ak, *av; const int* pos;
    DI void operator()(const AccT& acc, const Unit& u, int wr, int wc, int fr, int fq) const {
        const int pn = u.pn, rowbase = u.pm * 256 + wr * 64 + fr;
        if (pn < 16) {
            bf16_t* dst = pn < 8 ? rq : rk; const float scale = pn < 8 ? 1.0f : 0.0625f;
            rope_store<256>(acc, rowbase, pos, dst, 2048, 256 * (pn & 7) + 32 * wc + 8 * fq, 128, 32 * wc + 8 * fq, scale);
        } else if (pn < 32) {
            const int col0 = (pn - 16) * 256 + wc * 32 + 8 * fq;
#pragma unroll
            for (int ai = 0; ai < 2; ++ai)
#pragma unroll
                for (int m = 0; m < 4; ++m) { bf16_t* rowp = rv + (size_t)(rowbase + ai * 128 + m * 16) * 4096 + col0;
#pragma unroll
                    for (int bj = 0; bj < 2; ++bj) *(u32x4*)(rowp + bj * 128) = pack8(acc[ai][bj][m][0], acc[ai][bj][m][1]); }
        } else if (pn < 66) {
            const int q9 = pn - 48; bf16_t* dst = q9 < 9 ? aq : ak; const int t9 = q9 < 9 ? q9 : q9 - 9;
            const int head = 2 * t9 + (wc >> 1), ib = 32 * (wc & 1) + 8 * fq;
            rope_store<128>(acc, rowbase, pos, dst, 2304, head * 128 + ib, 64, ib, 1.0f);
        } else {
            const int col0 = (pn - 66) * 256 + wc * 32 + 8 * fq;
#pragma unroll
            for (int ai = 0; ai < 2; ++ai)
#pragma unroll
                for (int m = 0; m < 4; ++m) { bf16_t* rowp = av + (size_t)(rowbase + ai * 128 + m * 16) * 2304 + col0;
#pragma unroll
                    for (int bj = 0; bj < 2; ++bj) *(u32x4*)(rowp + bj * 128) = pack8(acc[ai][bj][m][0], acc[ai][bj][m][1]); }
        }
    }
};

struct EpiRetGate {
    bf16_t* ret; const float* retss; const float* gain;
    DI void operator()(const AccT& acc, const Unit& u, int wr, int wc, int fr, int fq) const {
        const int rowbase = u.pm * 256 + wr * 64 + fr, head = u.pn >> 1, colb = u.pn * 256 + wc * 32 + 8 * fq;
        f32x4 gn[2][2];
#pragma unroll
        for (int bj = 0; bj < 2; ++bj) { gn[bj][0] = *(const f32x4*)(gain + colb + bj * 128); gn[bj][1] = *(const f32x4*)(gain + colb + bj * 128 + 4); }
#pragma unroll
        for (int ai = 0; ai < 2; ++ai) {
            f32x4 sA[4], sB[4]; u32x4 rr[4][2];
#pragma unroll
            for (int m = 0; m < 4; ++m) { const float* ps = retss + ((size_t)(rowbase + ai * 128 + m * 16) * 8 + head) * 8; sA[m] = *(const f32x4*)ps; sB[m] = *(const f32x4*)(ps + 4); }
#pragma unroll
            for (int m = 0; m < 4; ++m)
#pragma unroll
                for (int bj = 0; bj < 2; ++bj) rr[m][bj] = *(const u32x4*)(ret + (size_t)(rowbase + ai * 128 + m * 16) * 4096 + colb + bj * 128);
#pragma unroll
            for (int m = 0; m < 4; ++m) {
                const f32x4 s0 = sA[m], s1 = sB[m];
                const float rsv = __builtin_amdgcn_rsqf((((s0[0] + s0[1]) + (s0[2] + s0[3])) + ((s1[0] + s1[1]) + (s1[2] + s1[3]))) * (1.0f / 512.0f) + 1e-6f);
#pragma unroll
                for (int bj = 0; bj < 2; ++bj) {
                    const u32x4 r4 = rr[m][bj];
                    const float rf[8] = {bflo(r4.x), bfhi(r4.x), bflo(r4.y), bfhi(r4.y), bflo(r4.z), bfhi(r4.z), bflo(r4.w), bfhi(r4.w)};
                    f32x4 o0, o1;
#pragma unroll
                    for (int j = 0; j < 4; ++j) {
                        const float a0 = acc[ai][bj][m][0][j], a1 = acc[ai][bj][m][1][j];
                        o0[j] = a0 * sigmoidf_(a0) * (rf[j] * rsv * gn[bj][0][j]); o1[j] = a1 * sigmoidf_(a1) * (rf[4 + j] * rsv * gn[bj][1][j]);
                    }
                    *(u32x4*)(ret + (size_t)(rowbase + ai * 128 + m * 16) * 4096 + colb + bj * 128) = pack8(o0, o1);
                }
            }
        }
    }
};

struct EpiGates {
    bf16_t* O; const float* bias;
    DI void operator()(const AccT& acc, const Unit& u, int wr, int wc, int fr, int fq) const {
        const int rowbase = u.pm * 256 + wr * 64 + fr;
#pragma unroll
        for (int bj = 0; bj < 2; ++bj) {
            const int col = u.pn * 256 + bj * 128 + wc * 32 + 8 * fq;
            const f32x4 b0 = *(const f32x4*)(bias + col), b1 = *(const f32x4*)(bias + col + 4);
#pragma unroll
            for (int ai = 0; ai < 2; ++ai)
#pragma unroll
                for (int m = 0; m < 4; ++m) {
                    f32x4 o0, o1;
#pragma unroll
                    for (int j = 0; j < 4; ++j) { o0[j] = sigmoidf_(acc[ai][bj][m][0][j] + b0[j]); o1[j] = sigmoidf_(acc[ai][bj][m][1][j] + b1[j]); }
                    *(u32x4*)(O + (size_t)(rowbase + ai * 128 + m * 16) * 4096 + col) = pack8(o0, o1);
                }
        }
    }
};

struct EpiYMerge {
    const bf16_t* gates; bf16_t* U2;
    DI void mid(AccT& acc, const Unit& u, int wr, int wc, int fr, int fq) const {
        const int rowbase = u.pm * 256 + wr * 64 + fr, colb = u.pn * 256 + wc * 32 + 8 * fq;
#pragma unroll
        for (int ai = 0; ai < 2; ++ai) {
            u32x4 gr[4][2], ga[4][2];
#pragma unroll
            for (int m = 0; m < 4; ++m)
#pragma unroll
                for (int bj = 0; bj < 2; ++bj) { const bf16_t* pg = gates + (size_t)(rowbase + ai * 128 + m * 16) * 4096 + colb + bj * 128; gr[m][bj] = *(const u32x4*)pg; ga[m][bj] = *(const u32x4*)(pg + 2048); }
#pragma unroll
            for (int m = 0; m < 4; ++m)
#pragma unroll
                for (int bj = 0; bj < 2; ++bj) {
                    const u32x4 g1 = gr[m][bj], g2 = ga[m][bj];
                    const float r[8] = {bflo(g1.x), bfhi(g1.x), bflo(g1.y), bfhi(g1.y), bflo(g1.z), bfhi(g1.z), bflo(g1.w), bfhi(g1.w)};
                    const float a[8] = {bflo(g2.x), bfhi(g2.x), bflo(g2.y), bfhi(g2.y), bflo(g2.z), bfhi(g2.z), bflo(g2.w), bfhi(g2.w)};
#pragma unroll
                    for (int j = 0; j < 4; ++j) { acc[ai][bj][m][0][j] *= r[j] * __builtin_amdgcn_rcpf(fmaxf(a[j], 1e-30f)); acc[ai][bj][m][1][j] *= r[4 + j] * __builtin_amdgcn_rcpf(fmaxf(a[4 + j], 1e-30f)); }
                }
        }
    }
    DI void operator()(const AccT& acc, const Unit& u, int wr, int wc, int fr, int fq) const {
        const int rowbase = u.pm * 256 + wr * 64 + fr, colb = u.pn * 256 + wc * 32 + 8 * fq;
        u32x4 gg[2][4][2];
#pragma unroll
        for (int ai = 0; ai < 2; ++ai)
#pragma unroll
            for (int m = 0; m < 4; ++m)
#pragma unroll
                for (int bj = 0; bj < 2; ++bj) gg[ai][m][bj] = *(const u32x4*)(gates + (size_t)(rowbase + ai * 128 + m * 16) * 4096 + 2048 + colb + bj * 128);
#pragma unroll
        for (int ai = 0; ai < 2; ++ai)
#pragma unroll
            for (int m = 0; m < 4; ++m)
#pragma unroll
                for (int bj = 0; bj < 2; ++bj) {
                    const u32x4 g4 = gg[ai][m][bj];
                    f32x4 o0 = acc[ai][bj][m][0], o1 = acc[ai][bj][m][1];
                    o0[0] *= bflo(g4.x); o0[1] *= bfhi(g4.x); o0[2] *= bflo(g4.y); o0[3] *= bfhi(g4.y);
                    o1[0] *= bflo(g4.z); o1[1] *= bfhi(g4.z); o1[2] *= bflo(g4.w); o1[3] *= bfhi(g4.w);
                    *(u32x4*)(U2 + (size_t)(rowbase + ai * 128 + m * 16) * 2048 + colb + bj * 128) = pack8(o0, o1);
                }
    }
};

DI float gelu_tanh(float v) {
    const float uu = 0.7978845608028654f * (v + 0.044715f * v * v * v);
    const float e = __builtin_amdgcn_exp2f(2.8853900817779268f * uu);
    return v - v * __builtin_amdgcn_rcpf(e + 1.0f);
}
struct EpiConvAct {
    const bf16_t* A; bf16_t* ACT; const float* conv_w; const float* conv_b;
    DI void operator()(const AccT& acc, const Unit& u, int wr, int wc, int fr, int fq) const {
        const int rowbase = u.pm * 256 + wr * 64 + fr;
#pragma unroll
        for (int bj = 0; bj < 2; ++bj) {
            const int col = u.pn * 256 + bj * 128 + wc * 32 + 8 * fq;
            f32x4 w0[2], w1[2], w2[2], cb[2];
#pragma unroll
            for (int hh = 0; hh < 2; ++hh) { w0[hh] = *(const f32x4*)(conv_w + col + 4 * hh); w1[hh] = *(const f32x4*)(conv_w + FF + col + 4 * hh); w2[hh] = *(const f32x4*)(conv_w + 2 * FF + col + 4 * hh); cb[hh] = *(const f32x4*)(conv_b + col + 4 * hh); }
#pragma unroll
            for (int aim = 0; aim < 4; ++aim) { const int ai = aim >> 1, mb = (aim & 1) * 2;
                u32x4 a0[4], a1[4], a2[4];
#pragma unroll
                for (int m = mb; m < mb + 2; ++m) {
                    const int row = rowbase + ai * 128 + m * 16; const int sq = row & (SEQ - 1);
                    const bf16_t* pa = A + (size_t)row * FF + col;
                    a0[m] = *(const u32x4*)pa;
                    a1[m] = *(const u32x4*)(pa - (sq >= 1 ? FF : 0));
                    a2[m] = *(const u32x4*)(pa - (sq >= 2 ? 2 * FF : 0));
                }
#pragma unroll
                for (int m = mb; m < mb + 2; ++m) {
                    const int row = rowbase + ai * 128 + m * 16; const int sq = row & (SEQ - 1);
                    const float k1 = sq >= 1 ? 1.0f : 0.0f, k2 = sq >= 2 ? 1.0f : 0.0f;
                    const u32x4 x0 = a0[m], x1 = a1[m], x2 = a2[m];
                    const float f0[8] = {bflo(x0.x), bfhi(x0.x), bflo(x0.y), bfhi(x0.y), bflo(x0.z), bfhi(x0.z), bflo(x0.w), bfhi(x0.w)};
                    const float f1[8] = {bflo(x1.x), bfhi(x1.x), bflo(x1.y), bfhi(x1.y), bflo(x1.z), bfhi(x1.z), bflo(x1.w), bfhi(x1.w)};
                    const float f2[8] = {bflo(x2.x), bfhi(x2.x), bflo(x2.y), bfhi(x2.y), bflo(x2.z), bfhi(x2.z), bflo(x2.w), bfhi(x2.w)};
                    f32x4 o0, o1;
#pragma unroll
                    for (int j = 0; j < 4; ++j) {
                        const float c0 = cb[0][j] + w0[0][j] * f0[j] + k1 * (w1[0][j] * f1[j]) + k2 * (w2[0][j] * f2[j]);
                        const float c1 = cb[1][j] + w0[1][j] * f0[4 + j] + k1 * (w1[1][j] * f1[4 + j]) + k2 * (w2[1][j] * f2[4 + j]);
                        o0[j] = gelu_tanh(c0) * acc[ai][bj][m][0][j]; o1[j] = gelu_tanh(c1) * acc[ai][bj][m][1][j];
                    }
                    *(u32x4*)(ACT + (size_t)row * FF + col) = pack8(o0, o1);
                }
            }
        }
    }
};

DI int invperm32(int c) { return 16 * ((c >> 2) & 1) + 4 * (c >> 3) + (c & 3); }
DI int slot_std(int c) { return (c & ~31) | invperm32(c & 31); }
DI int slot_win(int c) {
    if (c >= 12288 && c < 16896) { const int tc = c & 255, hh = tc >> 7, bj = (tc >> 6) & 1, i64 = tc & 63, x = 64 * hh + i64; return (c & ~255) + 128 * bj + (x & ~31) + invperm32(x & 31); }
    return slot_std(c);
}
DI void transpose_item(const float* W, int K, int N, bf16_t* WT, int mode, LAS float* scr, int item, int lane) {
    const int nblk = N / 32, kb = item / nblk, nb = item % nblk, k0 = 64 * kb, n0 = 32 * nb;
#pragma unroll 16
    for (int i = 0; i < 32; ++i) { const int kk = 2 * i + (lane >> 5); scr[kk * 33 + (lane & 31)] = W[(size_t)(k0 + kk) * N + n0 + (lane & 31)]; }
    asm volatile("s_waitcnt lgkmcnt(0)" ::: "memory");
    const int c = lane & 7;
#pragma unroll
    for (int j = 0; j < 4; ++j) { const int n = (lane >> 3) + 8 * j; const LAS float* s = scr + (8 * c) * 33 + n;
        u32x4 o; o.x = cvt_pk_bf16(s[0 * 33], s[1 * 33]); o.y = cvt_pk_bf16(s[2 * 33], s[3 * 33]); o.z = cvt_pk_bf16(s[4 * 33], s[5 * 33]); o.w = cvt_pk_bf16(s[6 * 33], s[7 * 33]);
        const int drow = mode ? slot_win(n0 + n) : slot_std(n0 + n);
        *(u32x4*)(WT + (size_t)drow * K + k0 + 8 * c) = o; }
    asm volatile("s_waitcnt lgkmcnt(0)" ::: "memory");
}

DI void phase0(const Params& p, LAS unsigned char* lds) {
    const int tid = threadIdx.x, lane = tid & 63, wave = tid >> 6;
    LAS float* sc = (LAS float*)lds;
    LAS float* red = sc + 8192;
    float* ada = (float*)(p.ws + WS_ADA);
    for (int i = tid; i < 8192; i += 512) { const float v = p.c[i]; sc[i] = v / (1.0f + __expf(-v)); }
    __syncthreads();
    for (int cb = blockIdx.x; cb < 256; cb += gridDim.x) {
        {
            const int rg = lane / 12, cq = lane - 12 * rg;
            f32x4 a0 = {0.f, 0.f, 0.f, 0.f}, a1 = a0, a2 = a0, a3 = a0;
            if (rg < 5) {
                const float* wp = p.w_ada + 48 * cb + 4 * cq;
#pragma unroll 13
                for (int i = 0; i < 52; ++i) { const int kl = 5 * i + rg; if (kl < 256) { const int kk = 256 * wave + kl; const f32x4 wv = *(const f32x4*)(wp + (size_t)kk * 12288);
                    a0 += sc[kk] * wv; a1 += sc[2048 + kk] * wv; a2 += sc[4096 + kk] * wv; a3 += sc[6144 + kk] * wv; } }
                LAS float* rp = red + ((wave * 5 + rg) * 4) * 48 + 4 * cq;
                *(LAS f32x4*)(rp) = a0; *(LAS f32x4*)(rp + 48) = a1; *(LAS f32x4*)(rp + 96) = a2; *(LAS f32x4*)(rp + 144) = a3;
            }
        }
        __syncthreads();
        if (tid < 192) { const int b = tid / 48, l = tid % 48; float sacc = 0.f;
#pragma unroll 8
            for (int wg = 0; wg < 40; ++wg) sacc += red[(wg * 4 + b) * 48 + l];
            ada[b * 12288 + 48 * cb + l] = sacc + p.b_ada[48 * cb + l]; }
        __syncthreads();
    }
    LAS float* scr = (LAS float*)(lds + 40960 + wave * 8448);
    const int gw = blockIdx.x * 8 + wave, NGW = gridDim.x * 8;
    constexpr int I_IN = (2048 / 64) * (19200 / 32), I_GATE = (2048 / 64) * (4096 / 32), I_RET = (4096 / 64) * (2048 / 32), I_ATT = (2304 / 64) * (2048 / 32),
                  I_MIX = (2048 / 64) * (2048 / 32), I_UP = (2048 / 64) * (11264 / 32), I_DOWN = (5632 / 64) * (2048 / 32);
    constexpr int NITEMS = I_IN + I_GATE + I_RET + I_ATT + I_MIX + I_UP + I_DOWN;
    for (int it = gw; it < NITEMS; it += NGW) {
        int r = it;
        if (r < I_IN) { transpose_item(p.w_in, 2048, 19200, (bf16_t*)(p.ws + WS_WIN), 1, scr, r, lane); continue; } r -= I_IN;
        if (r < I_GATE) { transpose_item(p.w_gate, 2048, 4096, (bf16_t*)(p.ws + WS_WGATE), 0, scr, r, lane); continue; } r -= I_GATE;
        if (r < I_RET) { transpose_item(p.w_ret_out, 4096, 2048, (bf16_t*)(p.ws + WS_WRET), 0, scr, r, lane); continue; } r -= I_RET;
        if (r < I_ATT) { transpose_item(p.w_att_out, 2304, 2048, (bf16_t*)(p.ws + WS_WATT), 0, scr, r, lane); continue; } r -= I_ATT;
        if (r < I_MIX) { transpose_item(p.w_mix, 2048, 2048, (bf16_t*)(p.ws + WS_WMIX), 0, scr, r, lane); continue; } r -= I_MIX;
        if (r < I_UP) { transpose_item(p.w_up, 2048, 11264, (bf16_t*)(p.ws + WS_WUP), 0, scr, r, lane); continue; } r -= I_UP;
        transpose_item(p.w_down, 5632, 2048, (bf16_t*)(p.ws + WS_WDOWN), 0, scr, r, lane);
    }
}

constexpr int NR = 2;
DI void phase_h(const Params& p) {
    const int lane = threadIdx.x & 63, wave = threadIdx.x >> 6;
    const float* ada = (const float*)(p.ws + WS_ADA); bf16_t* H = (bf16_t*)(p.ws + WS_H);
    const int nw = gridDim.x * 8;
    for (int row0 = blockIdx.x * 8 + wave; row0 < T_TOK; row0 += nw * NR) {
        f32x4 v[NR][4][2]; float ss[NR];
#pragma unroll
        for (int q = 0; q < NR; ++q) { const float* xr = p.x + (size_t)(row0 + q * nw) * DM; ss[q] = 0.f;
#pragma unroll
            for (int it = 0; it < 4; ++it) { const int col = (it * 64 + lane) * 8; v[q][it][0] = *(const f32x4*)(xr + col); v[q][it][1] = *(const f32x4*)(xr + col + 4); } }
#pragma unroll
        for (int q = 0; q < NR; ++q) {
#pragma unroll
            for (int it = 0; it < 4; ++it)
#pragma unroll
                for (int j = 0; j < 4; ++j) ss[q] += v[q][it][0][j] * v[q][it][0][j] + v[q][it][1][j] * v[q][it][1][j];
            ss[q] = __builtin_amdgcn_rsqf(wave_sum(ss[q]) * (1.0f / DM) + 1e-6f); }
#pragma unroll
        for (int it = 0; it < 4; ++it) { const int col = (it * 64 + lane) * 8;
            f32x4 g[2], sh[NR][2], scl[NR][2];
#pragma unroll
            for (int hh = 0; hh < 2; ++hh) { g[hh] = *(const f32x4*)(p.g_pre_mix + col + 4 * hh);
#pragma unroll
                for (int q = 0; q < NR; ++q) { const int b = (row0 + q * nw) / SEQ; sh[q][hh] = *(const f32x4*)(ada + b * 12288 + col + 4 * hh); scl[q][hh] = *(const f32x4*)(ada + b * 12288 + 2048 + col + 4 * hh); } }
#pragma unroll
            for (int q = 0; q < NR; ++q) { f32x4 o[2];
#pragma unroll
                for (int hh = 0; hh < 2; ++hh)
#pragma unroll
                    for (int j = 0; j < 4; ++j) o[hh][j] = v[q][it][hh][j] * ss[q] * g[hh][j] * (1.0f + scl[q][hh][j]) + sh[q][hh][j];
                *(u32x4*)(H + (size_t)(row0 + q * nw) * DM + col) = pack8(o[0], o[1]); } }
    }
}

DI void phase_postmix(const Params& p) {
    const int lane = threadIdx.x & 63, wave = threadIdx.x >> 6;
    const float* ada = (const float*)(p.ws + WS_ADA); const bf16_t* Y = (const bf16_t*)(p.ws + WS_Y); bf16_t* H2 = (bf16_t*)(p.ws + WS_H2);
    const int nw = gridDim.x * 8;
    for (int row0 = blockIdx.x * 8 + wave; row0 < T_TOK; row0 += nw * NR) {
        f32x4 y[NR][4][2], xv[NR][4][2]; float ry[NR], r1[NR];
#pragma unroll
        for (int q = 0; q < NR; ++q) { const size_t ro = (size_t)(row0 + q * nw) * DM;
#pragma unroll
            for (int it = 0; it < 4; ++it) { const int col = (it * 64 + lane) * 8; const u32x4 w = *(const u32x4*)(Y + ro + col);
                y[q][it][0] = (f32x4){bflo(w.x), bfhi(w.x), bflo(w.y), bfhi(w.y)}; y[q][it][1] = (f32x4){bflo(w.z), bfhi(w.z), bflo(w.w), bfhi(w.w)};
                xv[q][it][0] = *(const f32x4*)(p.x + ro + col); xv[q][it][1] = *(const f32x4*)(p.x + ro + col + 4); } }
#pragma unroll
        for (int q = 0; q < NR; ++q) { float ss = 0.f;
#pragma unroll
            for (int it = 0; it < 4; ++it)
#pragma unroll
                for (int j = 0; j < 4; ++j) ss += y[q][it][0][j] * y[q][it][0][j] + y[q][it][1][j] * y[q][it][1][j];
            ry[q] = __builtin_amdgcn_rsqf(wave_sum(ss) * (1.0f / DM) + 1e-6f); }
#pragma unroll
        for (int q = 0; q < NR; ++q) { const int row = row0 + q * nw; const float* ab = ada + (row / SEQ) * 12288; float s1 = 0.f;
#pragma unroll
            for (int it = 0; it < 4; ++it) { const int col = (it * 64 + lane) * 8;
#pragma unroll
                for (int hh = 0; hh < 2; ++hh) { const f32x4 g = *(const f32x4*)(p.g_post_mix + col + 4 * hh), gt = *(const f32x4*)(ab + 4096 + col + 4 * hh);
                    f32x4 o;
#pragma unroll
                    for (int j = 0; j < 4; ++j) { o[j] = xv[q][it][hh][j] + gt[j] * (y[q][it][hh][j] * ry[q] * g[j]); s1 += o[j] * o[j]; }
                    y[q][it][hh] = o; }
                *(u32x4*)((bf16_t*)(p.out + (size_t)row * DM + DM / 2) + col) = pack8(y[q][it][0], y[q][it][1]); }
            r1[q] = __builtin_amdgcn_rsqf(wave_sum(s1) * (1.0f / DM) + 1e-6f); }
#pragma unroll
        for (int q = 0; q < NR; ++q) { const int row = row0 + q * nw; const float* ab = ada + (row / SEQ) * 12288;
#pragma unroll
            for (int it = 0; it < 4; ++it) { const int col = (it * 64 + lane) * 8; f32x4 o[2];
#pragma unroll
                for (int hh = 0; hh < 2; ++hh) { const f32x4 g = *(const f32x4*)(p.g_pre_ffn + col + 4 * hh), sh = *(const f32x4*)(ab + 6144 + col + 4 * hh), scl = *(const f32x4*)(ab + 8192 + col + 4 * hh);
#pragma unroll
                    for (int j = 0; j < 4; ++j) o[hh][j] = y[q][it][hh][j] * r1[q] * g[j] * (1.0f + scl[j]) + sh[j]; }
                *(u32x4*)(H2 + (size_t)row * DM + col) = pack8(o[0], o[1]); } }
    }
}

DI void phase_final(const Params& p) {
    const int lane = threadIdx.x & 63, wave = threadIdx.x >> 6;
    const float* ada = (const float*)(p.ws + WS_ADA); const bf16_t* Y = (const bf16_t*)(p.ws + WS_Y2);
    const int nw = gridDim.x * 8;
    for (int row0 = blockIdx.x * 8 + wave; row0 < T_TOK; row0 += nw * NR) {
        f32x4 y[NR][4][2], xv[NR][4][2]; float ry[NR];
#pragma unroll
        for (int q = 0; q < NR; ++q) { const size_t ro = (size_t)(row0 + q * nw) * DM;
#pragma unroll
            for (int it = 0; it < 4; ++it) { const int col = (it * 64 + lane) * 8; const u32x4 w = *(const u32x4*)(Y + ro + col);
                y[q][it][0] = (f32x4){bflo(w.x), bfhi(w.x), bflo(w.y), bfhi(w.y)}; y[q][it][1] = (f32x4){bflo(w.z), bfhi(w.z), bflo(w.w), bfhi(w.w)};
                const u32x4 xw = *(const u32x4*)((const bf16_t*)(p.out + ro + DM / 2) + col);
                xv[q][it][0] = (f32x4){bflo(xw.x), bfhi(xw.x), bflo(xw.y), bfhi(xw.y)}; xv[q][it][1] = (f32x4){bflo(xw.z), bfhi(xw.z), bflo(xw.w), bfhi(xw.w)}; } }
#pragma unroll
        for (int q = 0; q < NR; ++q) { float ss = 0.f;
#pragma unroll
            for (int it = 0; it < 4; ++it)
#pragma unroll
                for (int j = 0; j < 4; ++j) ss += y[q][it][0][j] * y[q][it][0][j] + y[q][it][1][j] * y[q][it][1][j];
            ry[q] = __builtin_amdgcn_rsqf(wave_sum(ss) * (1.0f / DM) + 1e-6f); }
#pragma unroll
        for (int q = 0; q < NR; ++q) { const int row = row0 + q * nw; const float* ab = ada + (row / SEQ) * 12288;
#pragma unroll
            for (int it = 0; it < 4; ++it) { const int col = (it * 64 + lane) * 8;
#pragma unroll
                for (int hh = 0; hh < 2; ++hh) { const f32x4 g = *(const f32x4*)(p.g_post_ffn + col + 4 * hh), gt = *(const f32x4*)(ab + 10240 + col + 4 * hh);
                    f32x4 o;
#pragma unroll
                    for (int j = 0; j < 4; ++j) o[j] = xv[q][it][hh][j] + gt[j] * (y[q][it][hh][j] * ry[q] * g[j]);
                    *(f32x4*)(p.out + (size_t)row * DM + col + 4 * hh) = o; } } }
    }
}

DI void phase_alpha(const Params& p) {
    bf16_t* att = (bf16_t*)(p.ws + WS_AQ); const float* lse = (const float*)(p.ws + WS_LSE);
    const int lane = threadIdx.x & 63, wave = threadIdx.x >> 6;
    for (int t = blockIdx.x * 8 + wave; t < T_TOK; t += gridDim.x * 8) {
        const float l = lse[(size_t)t * 18 + (lane < 18 ? lane : 0)];
        const int j = lane % 6;
        const float l0 = __shfl(l, j), l1 = __shfl(l, 6 + j), l2 = __shfl(l, 12 + j);
        const float mm = fmaxf(l0, fmaxf(l1, l2)); const float e0 = __expf(l0 - mm), e1 = __expf(l1 - mm), e2 = __expf(l2 - mm);
        const float al_lane = __expf(l - mm) / (e0 + e1 + e2);
        u32x4* row = (u32x4*)(att + (size_t)t * 2304);
        u32x4 w[5];
#pragma unroll
        for (int k = 0; k < 5; ++k) { const int ch = lane + 64 * k; if (ch < 288) w[k] = row[ch]; }
#pragma unroll
        for (int k = 0; k < 5; ++k) { const int ch = lane + 64 * k; const float al = __shfl(al_lane, (ch < 288 ? ch : 0) >> 4);
            if (ch < 288) { u32x4 o;
                o.x = cvt_pk_bf16(bflo(w[k].x) * al, bfhi(w[k].x) * al); o.y = cvt_pk_bf16(bflo(w[k].y) * al, bfhi(w[k].y) * al);
                o.z = cvt_pk_bf16(bflo(w[k].z) * al, bfhi(w[k].z) * al); o.w = cvt_pk_bf16(bflo(w[k].w) * al, bfhi(w[k].w) * al);
                row[ch] = o; } }
    }
}

DI void phase_retention(const Params& p, LAS unsigned char* lds, int cblk) {
    const int tid = threadIdx.x, lane = tid & 63, w = tid >> 6, fr = lane & 15, fq = lane >> 4;
    LAS unsigned char* Qs = lds; LAS unsigned char* Ks = lds + 33792; LAS unsigned char* Vs = lds + 67584; LAS unsigned char* St = lds + 76800; LAS unsigned char* Ps = lds + 110592;
    LAS float* red = (LAS float*)(lds + 119808);
    const bf16_t* rq = (const bf16_t*)(p.ws + WS_RQ); const bf16_t* rk = (const bf16_t*)(p.ws + WS_RK); bf16_t* rv = (bf16_t*)p.out; float* retss = (float*)(p.ws + WS_RETSS);
    for (int item = cblk; item < 256; item += gridDim.x) {
        const int q5 = item >> 3, bh = (item & 7) * 4 + (q5 & 3), slice = q5 >> 2, b = bh >> 3, h = bh & 7;
        const float lg = log1pf(-exp2f(-5.0f - (float)h));
        const float gamma_c = expf(64.0f * lg);
        const float xv = expf(-lg * (float)((tid >> 3) + 1));
        const float xo0 = expf(lg * (float)(32 * (w & 1) + fr + 1)), xo1 = expf(lg * (float)(32 * (w & 1) + 16 + fr + 1));
        const size_t tok0 = (size_t)b * SEQ;
        const bf16_t* qbase = rq + tok0 * 2048 + h * 256 + (tid & 31) * 8; const bf16_t* kbase = rk + tok0 * 2048 + h * 256 + (tid & 31) * 8;
        bf16_t* vbase = rv + tok0 * 4096 + h * 512 + slice * 64;
        u32x4 pq[4], pk[4], pv;
        f32x4 Sreg[2][4];
#pragma unroll
        for (int a = 0; a < 2; ++a)
#pragma unroll
            for (int bb = 0; bb < 4; ++bb) Sreg[a][bb] = (f32x4){0.f, 0.f, 0.f, 0.f};
        for (int i = tid; i < 33792 / 16; i += 512) ((LAS u32x4*)St)[i] = (u32x4){0u, 0u, 0u, 0u};
#define RET_LOAD(c) do { _Pragma("unroll") for (int i = 0; i < 4; ++i) { const int row = (tid + 512 * i) >> 5; \
            pq[i] = *(const u32x4*)(qbase + (size_t)(64 * (c) + row) * 2048); pk[i] = *(const u32x4*)(kbase + (size_t)(64 * (c) + row) * 2048); } \
            pv = *(const u32x4*)(vbase + (size_t)(64 * (c) + (tid >> 3)) * 4096 + (tid & 7) * 8); } while (0)
#define RET_STORE() do { _Pragma("unroll") for (int i = 0; i < 4; ++i) { const int e = tid + 512 * i, row = e >> 5, pc = e & 31; \
            *(LAS u32x4*)(Qs + row * 528 + pc * 16) = pq[i]; *(LAS u32x4*)(Ks + row * 528 + pc * 16) = pk[i]; } \
            { u32x4 o; o.x = cvt_pk_bf16(bflo(pv.x) * xv, bfhi(pv.x) * xv); o.y = cvt_pk_bf16(bflo(pv.y) * xv, bfhi(pv.y) * xv); \
              o.z = cvt_pk_bf16(bflo(pv.z) * xv, bfhi(pv.z) * xv); o.w = cvt_pk_bf16(bflo(pv.w) * xv, bfhi(pv.w) * xv); \
              *(LAS u32x4*)(Vs + (tid >> 3) * 144 + (tid & 7) * 16) = o; } } while (0)
        RET_LOAD(0); RET_STORE();
        __syncthreads();
        for (int c = 0; c < 128; ++c) {
            if (c + 1 < 128) RET_LOAD(c + 1);
            bf16x8 qfr[8][2];
            {
                const int jt = w >> 1, it0 = (w & 1) * 2;
                f32x4 sa[2] = {(f32x4){0.f, 0.f, 0.f, 0.f}, (f32x4){0.f, 0.f, 0.f, 0.f}};
#pragma unroll
                for (int ks = 0; ks < 8; ++ks) {
                    const bf16x8 kf = *(const LAS bf16x8*)(Ks + (16 * jt + fr) * 528 + (32 * ks + 8 * fq) * 2);
#pragma unroll
                    for (int t = 0; t < 2; ++t) { qfr[ks][t] = *(const LAS bf16x8*)(Qs + (16 * (it0 + t) + fr) * 528 + (32 * ks + 8 * fq) * 2); sa[t] = mfma16(kf, qfr[ks][t], sa[t]); }
                }
#pragma unroll
                for (int t = 0; t < 2; ++t) { const int iq = 16 * (it0 + t) + fr, jk0 = 16 * jt + 4 * fq;
                    u32x2 o; o.x = cvt_pk_bf16(jk0 + 0 <= iq ? sa[t][0] : 0.f, jk0 + 1 <= iq ? sa[t][1] : 0.f); o.y = cvt_pk_bf16(jk0 + 2 <= iq ? sa[t][2] : 0.f, jk0 + 3 <= iq ? sa[t][3] : 0.f);
                    *(LAS u32x2*)(Ps + iq * 144 + jk0 * 2) = o; }
            }
            {
#pragma unroll
                for (int ks = 0; ks < 2; ++ks) {
                    const int j0 = 32 * ks + 8 * fq + (fr >> 2);
                    bf16x8 kt[2], vf[4];
#pragma unroll
                    for (int dd = 0; dd < 2; ++dd) { LAS unsigned char* a0 = Ks + j0 * 528 + (16 * (2 * w + dd) + 4 * (fr & 3)) * 2; kt[dd] = tr_read2(a0, a0 + 4 * 528); }
#pragma unroll
                    for (int vt = 0; vt < 4; ++vt) { LAS unsigned char* a0 = Vs + j0 * 144 + (16 * vt + 4 * (fr & 3)) * 2; vf[vt] = tr_read2(a0, a0 + 4 * 144); }
#pragma unroll
                    for (int dd = 0; dd < 2; ++dd)
#pragma unroll
                        for (int vt = 0; vt < 4; ++vt) Sreg[dd][vt] = mfma16(kt[dd], vf[vt], Sreg[dd][vt]);
                }
#pragma unroll
                for (int dd = 0; dd < 2; ++dd)
#pragma unroll
                    for (int vt = 0; vt < 4; ++vt) Sreg[dd][vt] *= gamma_c;
            }
            __syncthreads();
            {
                const int vt = w >> 1, it0 = (w & 1) * 2;
                f32x4 oa[2] = {(f32x4){0.f, 0.f, 0.f, 0.f}, (f32x4){0.f, 0.f, 0.f, 0.f}};
#pragma unroll
                for (int ks = 0; ks < 8; ++ks) {
                    const bf16x8 sf = *(const LAS bf16x8*)(St + (16 * vt + fr) * 528 + (32 * ks + 8 * fq) * 2);
#pragma unroll
                    for (int t = 0; t < 2; ++t) oa[t] = mfma16(sf, qfr[ks][t], oa[t]);
                }
#pragma unroll
                for (int ks = 0; ks < 2; ++ks) {
                    const int j0 = 32 * ks + 8 * fq + (fr >> 2);
                    LAS unsigned char* a0 = Vs + j0 * 144 + (16 * vt + 4 * (fr & 3)) * 2; const bf16x8 vf = tr_read2(a0, a0 + 4 * 144);
#pragma unroll
                    for (int t = 0; t < 2; ++t) { const bf16x8 pf = *(const LAS bf16x8*)(Ps + (16 * (it0 + t) + fr) * 144 + (32 * ks + 8 * fq) * 2); oa[t] = mfma16(vf, pf, oa[t]); }
                }
#pragma unroll
                for (int t = 0; t < 2; ++t) { const int iq = 16 * (it0 + t) + fr; oa[t] *= (t == 0 ? xo0 : xo1);
                    u32x2 o; o.x = cvt_pk_bf16(oa[t][0], oa[t][1]); o.y = cvt_pk_bf16(oa[t][2], oa[t][3]);
                    *(u32x2*)(vbase + (size_t)(64 * c + iq) * 4096 + 16 * vt + 4 * fq) = o;
                    float ss = (oa[t][0] * oa[t][0] + oa[t][1] * oa[t][1]) + (oa[t][2] * oa[t][2] + oa[t][3] * oa[t][3]);
                    ss += __shfl_xor(ss, 16); ss += __shfl_xor(ss, 32);
                    if (fq == 0) red[iq * 4 + vt] = ss; }
            }
            __syncthreads();
#pragma unroll
            for (int dd = 0; dd < 2; ++dd)
#pragma unroll
                for (int vt = 0; vt < 4; ++vt) { u32x2 o; o.x = cvt_pk_bf16(Sreg[dd][vt][0], Sreg[dd][vt][1]); o.y = cvt_pk_bf16(Sreg[dd][vt][2], Sreg[dd][vt][3]);
                    *(LAS u32x2*)(St + (16 * vt + fr) * 528 + (16 * (2 * w + dd) + 4 * fq) * 2) = o; }
            if (c + 1 < 128) RET_STORE();
            if (tid < 64) retss[((tok0 + 64 * c + tid) * 8 + h) * 8 + slice] = (red[tid * 4 + 0] + red[tid * 4 + 1]) + (red[tid * 4 + 2] + red[tid * 4 + 3]);
            __syncthreads();
        }
#undef RET_LOAD
#undef RET_STORE
    }
}

DI void phase_attention(const Params& p, LAS unsigned char* lds) {
    const int tid = threadIdx.x, lane = tid & 63, w = tid >> 6, fr = lane & 15, fq = lane >> 4;
    LAS unsigned char* Ks = lds; LAS unsigned char* Vs = lds + 69632;
    bf16_t* aq = (bf16_t*)(p.ws + WS_AQ); const bf16_t* ak = (const bf16_t*)(p.ws + WS_AK); const bf16_t* av = (const bf16_t*)(p.ws + WS_AV); float* lse = (float*)(p.ws + WS_LSE);
    const int per = (4608 + (int)gridDim.x - 1) / (int)gridDim.x, it_lo = (int)blockIdx.x * per, it_hi = (it_lo + per < 4608) ? it_lo + per : 4608;
    int prev_key = -1;
    u32x4 kcur[4], vcur[4];
#define ATT_LOAD_CUR(item_) do { const int bh_ = (item_) >> 6, e64_ = (item_) & 63, head_ = bh_ % 18, b_ = bh_ / 18; \
        const int rsh_ = 2 * (head_ / 6), r_ = 1 << rsh_, nbc_ = 64 >> rsh_, cls_ = e64_ / nbc_, nb_ = e64_ - cls_ * nbc_; \
        _Pragma("unroll") for (int i = 0; i < 4; ++i) { const int e = tid + 512 * i, row = e >> 4, pc = e & 15; \
            const size_t off = ((size_t)b_ * SEQ + (size_t)(nb_ * 128 + row) * r_ + cls_) * 2304 + head_ * 128 + pc * 8; \
            kcur[i] = *(const u32x4*)(ak + off); vcur[i] = *(const u32x4*)(av + off); } } while (0)
    if (it_lo < it_hi) ATT_LOAD_CUR(it_lo);
    for (int item = it_lo, cnt = 0; item < it_hi; ++item, ++cnt) {
        const int bh = item >> 6, e64 = item & 63, head = bh % 18, b = bh / 18;
        const int g = head / 6, rsh = 2 * g, r = 1 << rsh, nbc = 64 >> rsh, cls = e64 / nbc, nb = e64 - cls * nbc;
        const int pq0 = nb * 128, pk0 = pq0 - 128;
        const size_t tokb = (size_t)b * SEQ;
        const int scur = cnt & 1, sprev = scur ^ 1;
        const bool reuse = (nb > 0) && (prev_key == item - 1);
#pragma unroll
        for (int i = 0; i < 4; ++i) { const int e = tid + 512 * i, row = e >> 4, pc = e & 15;
            *(LAS u32x4*)(Ks + (scur * 128 + row) * 272 + pc * 16) = kcur[i]; *(LAS u32x4*)(Vs + (scur * 128 + row) * 288 + pc * 16) = vcur[i]; }
        if (!reuse) {
#pragma unroll
            for (int i = 0; i < 4; ++i) { const int e = tid + 512 * i, row = e >> 4, pc = e & 15;
                u32x4 kv = {0u, 0u, 0u, 0u}, vv = kv;
                if (nb > 0) { const size_t off = (tokb + (size_t)(pk0 + row) * r + cls) * 2304 + head * 128 + pc * 8; kv = *(const u32x4*)(ak + off); vv = *(const u32x4*)(av + off); }
                *(LAS u32x4*)(Ks + (sprev * 128 + row) * 272 + pc * 16) = kv; *(LAS u32x4*)(Vs + (sprev * 128 + row) * 288 + pc * 16) = vv; }
        }
        if (item + 1 < it_hi) ATT_LOAD_CUR(item + 1);
        prev_key = item;
        const int qq = 16 * w + fr;
        const size_t tokq = tokb + (size_t)(pq0 + qq) * r + cls;
        bf16x8 qf[4];
        { const bf16_t* qp = aq + tokq * 2304 + head * 128 + 8 * fq;
#pragma unroll
          for (int ks = 0; ks < 4; ++ks) qf[ks] = *(const bf16x8*)(qp + 32 * ks); }
        __syncthreads();
        f32x4 sa[10];
#pragma unroll
        for (int kt = 0; kt < 10; ++kt) { sa[kt] = (f32x4){0.f, 0.f, 0.f, 0.f};
            const int T = (w + kt < 16) ? w + kt : 15;
            const int krow = ((T < 8) ? sprev : scur) * 128 + 16 * (T & 7) + fr;
#pragma unroll
            for (int ks = 0; ks < 4; ++ks) { const bf16x8 kf = *(const LAS bf16x8*)(Ks + krow * 272 + (32 * ks + 8 * fq) * 2); sa[kt] = mfma16(kf, qf[ks], sa[kt]); } }
        const float sc2 = 0.08838834764831845f * 1.4426950408889634f;
        float mrow = -INFINITY;
#pragma unroll
        for (int kt = 0; kt < 10; ++kt)
#pragma unroll
            for (int j = 0; j < 4; ++j) { const int kk = 16 * (w + kt) + 4 * fq + j; const bool valid = (kk >= qq) && (kk <= qq + 128) && (pk0 + kk >= 0);
                const float sv = valid ? sa[kt][j] * sc2 : -INFINITY; sa[kt][j] = sv; mrow = fmaxf(mrow, sv); }
        mrow = fmaxf(mrow, __shfl_xor(mrow, 16)); mrow = fmaxf(mrow, __shfl_xor(mrow, 32));
        float lsum = 0.f;
        bf16x8 pf[5];
#pragma unroll
        for (int t = 0; t < 5; ++t) { f32x4 p0, p1;
#pragma unroll
            for (int j = 0; j < 4; ++j) { p0[j] = __builtin_amdgcn_exp2f(sa[2 * t][j] - mrow); p1[j] = __builtin_amdgcn_exp2f(sa[2 * t + 1][j] - mrow); lsum += p0[j] + p1[j]; }
            const u32x4 pk4 = pack8(p0, p1); pf[t] = __builtin_bit_cast(bf16x8, pk4); }
        lsum += __shfl_xor(lsum, 16); lsum += __shfl_xor(lsum, 32);
        f32x4 oa[8];
#pragma unroll
        for (int dt = 0; dt < 8; ++dt) oa[dt] = (f32x4){0.f, 0.f, 0.f, 0.f};
#pragma unroll
        for (int t = 0; t < 5; ++t) {
            const int T0 = w + 2 * t, T1 = (T0 + 1 < 16) ? T0 + 1 : T0;
            const int r0 = ((T0 < 8) ? sprev : scur) * 128 + 16 * (T0 & 7) + 4 * fq + (fr >> 2), r1 = ((T1 < 8) ? sprev : scur) * 128 + 16 * (T1 & 7) + 4 * fq + (fr >> 2);
            LAS unsigned char* a0 = Vs + r0 * 288 + (4 * (fr & 3)) * 2; LAS unsigned char* a1 = Vs + r1 * 288 + (4 * (fr & 3)) * 2;
#pragma unroll
            for (int dt = 0; dt < 8; ++dt) { const bf16x8 vf = tr_read2(a0 + 32 * dt, a1 + 32 * dt); oa[dt] = mfma16(vf, pf[t], oa[dt]); }
        }
        const float inv = __builtin_amdgcn_rcpf(lsum);
        bf16_t* po = aq + tokq * 2304 + head * 128 + 4 * fq;
#pragma unroll
        for (int dt = 0; dt < 8; ++dt) { u32x2 o; o.x = cvt_pk_bf16(oa[dt][0] * inv, oa[dt][1] * inv); o.y = cvt_pk_bf16(oa[dt][2] * inv, oa[dt][3] * inv); *(u32x2*)(po + 16 * dt) = o; }
        if (fq == 0) lse[tokq * 18 + head] = mrow * 0.6931471805599453f + __logf(lsum);
        __syncthreads();
    }
#undef ATT_LOAD_CUR
}

constexpr size_t WS_BAR = 700000;
DI void grid_barrier(unsigned* bar, unsigned& nbar, const bool hier, const unsigned xcd, const unsigned per_xcd) {
    asm volatile("s_waitcnt vmcnt(0)" ::: "memory");
    __syncthreads();
    if (threadIdx.x == 0) {
        __builtin_amdgcn_fence(__ATOMIC_RELEASE, "agent");
        asm volatile("s_waitcnt vmcnt(0)" ::: "memory");
        const unsigned gen = hier ? nbar : nbar + 1u;
        if (hier) {
            unsigned* xc = bar + 256 + 64 * xcd; unsigned* top = bar + 1024;
            const unsigned old = __hip_atomic_fetch_add(xc, 1u, __ATOMIC_RELAXED, __HIP_MEMORY_SCOPE_AGENT);
            if (old + 1u == gen * per_xcd) __hip_atomic_fetch_add(top, 1u, __ATOMIC_RELAXED, __HIP_MEMORY_SCOPE_AGENT);
            while (__hip_atomic_load(top, __ATOMIC_RELAXED, __HIP_MEMORY_SCOPE_AGENT) < gen * 8u) __builtin_amdgcn_s_sleep(1);
        } else {
            const unsigned target = gen * gridDim.x;
            __hip_atomic_fetch_add(bar, 1u, __ATOMIC_RELAXED, __HIP_MEMORY_SCOPE_AGENT);
            while (__hip_atomic_load(bar, __ATOMIC_RELAXED, __HIP_MEMORY_SCOPE_AGENT) < target) __builtin_amdgcn_s_sleep(1);
        }
        __builtin_amdgcn_fence(__ATOMIC_ACQUIRE, "agent");
        asm volatile("s_waitcnt vmcnt(0)" ::: "memory");
    }
    __syncthreads();
    ++nbar;
}

constexpr int N_PHASES = 13;
__global__ void __launch_bounds__(512, 2) mega(Params p) {
    extern __shared__ __attribute__((aligned(16))) unsigned char shm[];
    LAS unsigned char* lds = (LAS unsigned char*)shm;
    unsigned char* ws = p.ws;
    const int G = gridDim.x, c = blockIdx.x;
    unsigned* bar = (unsigned*)(ws + WS_BAR); unsigned nbar = 0;
    int c_eff = c; unsigned my_xcd = 0, my_idx = 0; bool hier = false;
    if (p.ph_hi - p.ph_lo > 1) {
        my_xcd = (unsigned)__builtin_amdgcn_s_getreg((3 << 11) | 20) & 0xFu;
        if (threadIdx.x == 0) my_idx = __hip_atomic_fetch_add(bar + 64 + 16 * (my_xcd & 7u), 1u, __ATOMIC_RELAXED, __HIP_MEMORY_SCOPE_AGENT);
        my_idx = (unsigned)__builtin_amdgcn_readfirstlane((int)my_idx);
    }
    if (p.ph_lo <= 0 && 0 < p.ph_hi) {
        if (0 > p.ph_lo) grid_barrier(bar, nbar, hier, my_xcd, (unsigned)G / 8u);

#if (PHMASK >> 0) & 1
            phase0(p, lds);
#endif
    }
    if (p.ph_lo <= 1 && 1 < p.ph_hi) {
        if (1 > p.ph_lo) grid_barrier(bar, nbar, false, my_xcd, (unsigned)G / 8u);
        if (p.ph_lo > 1000) cg::this_grid().sync();
        if (p.ph_hi - p.ph_lo > 1) {
            LAS unsigned* cw = (LAS unsigned*)lds;
            if (threadIdx.x == 0) {
                bool ok = (G % 8) == 0 && my_xcd < 8u;
                for (int x = 0; x < 8; ++x) ok = ok && (__hip_atomic_load(bar + 64 + 16 * x, __ATOMIC_RELAXED, __HIP_MEMORY_SCOPE_AGENT) == (unsigned)(G / 8));
                cw[0] = ok ? (my_idx * 8u + my_xcd) : (unsigned)c; cw[1] = ok ? 1u : 0u;
            }
            __syncthreads();
            c_eff = __builtin_amdgcn_readfirstlane((int)cw[0]);
            hier = (cw[1] != 0u);
            __syncthreads();
        }

#if (PHMASK >> 1) & 1
            phase_h(p);
#endif
    }
    if (p.ph_lo <= 2 && 2 < p.ph_hi) {
        if (2 > p.ph_lo) grid_barrier(bar, nbar, hier, my_xcd, (unsigned)G / 8u);

#if (PHMASK >> 2) & 1
            pg8::Gemm g{(const bf16_t*)(ws + WS_H), (const bf16_t*)(ws + WS_WIN), T_TOK, 59 * 256, 2048, nullptr, nullptr, 0}; pg8::StaticOrder S; S.init(T_TOK, 59 * 256, G, c_eff, 32, 16);
            EpiInProj E{(bf16_t*)(ws + WS_RQ), (bf16_t*)(ws + WS_RK), (bf16_t*)p.out, (bf16_t*)(ws + WS_AQ), (bf16_t*)(ws + WS_AK), (bf16_t*)(ws + WS_AV), p.pos};
            pg8::gemm_phase<1>(lds, g, S, E);
#endif
    }
    if (p.ph_lo <= 3 && 3 < p.ph_hi) {
        if (3 > p.ph_lo) grid_barrier(bar, nbar, hier, my_xcd, (unsigned)G / 8u);

#if (PHMASK >> 3) & 1
            phase_retention(p, lds, c_eff); __syncthreads();
#endif
#if (PHMASK >> 13) & 1
            phase_attention(p, lds);
#endif
    }
    if (p.ph_lo <= 4 && 4 < p.ph_hi) {
        if (4 > p.ph_lo) grid_barrier(bar, nbar, hier, my_xcd, (unsigned)G / 8u);

#if (PHMASK >> 4) & 1
            { pg8::Gemm g{(const bf16_t*)(ws + WS_H), (const bf16_t*)(ws + WS_WIN) + (size_t)8192 * 2048, T_TOK, 4096, 2048, nullptr, nullptr, 0}; pg8::StaticOrder S; S.init(T_TOK, 4096, G, c_eff);
              EpiRetGate E{(bf16_t*)p.out, (const float*)(ws + WS_RETSS), p.ret_gain}; pg8::gemm_phase<1>(lds, g, S, E); }
#endif
#if (PHMASK >> 14) & 1
            { pg8::Gemm g{(const bf16_t*)(ws + WS_H), (const bf16_t*)(ws + WS_WGATE), T_TOK, 4096, 2048, nullptr, nullptr, 0}; pg8::StaticOrder S; S.init(T_TOK, 4096, G, c_eff);
              EpiGates E{(bf16_t*)(ws + WS_GATES), p.b_gate}; pg8::gemm_phase<1>(lds, g, S, E); }
#endif
#if (PHMASK >> 15) & 1
            phase_alpha(p);
#endif
    }
    if (p.ph_lo <= 5 && 5 < p.ph_hi) {
        if (5 > p.ph_lo) grid_barrier(bar, nbar, hier, my_xcd, (unsigned)G / 8u);

#if (PHMASK >> 5) & 1
            pg8::Gemm g{(const bf16_t*)p.out, (const bf16_t*)(ws + WS_WRET), T_TOK, 2048, 4096, (const bf16_t*)(ws + WS_AQ), (const bf16_t*)(ws + WS_WATT), 2304}; pg8::StaticOrder S; S.init(T_TOK, 2048, G, c_eff);
            EpiYMerge E{(const bf16_t*)(ws + WS_GATES), (bf16_t*)(ws + WS_U2)}; pg8::gemm_phase<2>(lds, g, S, E);
#endif
    }
    if (p.ph_lo <= 7 && 7 < p.ph_hi) {
        if (7 > p.ph_lo) grid_barrier(bar, nbar, hier, my_xcd, (unsigned)G / 8u);

#if (PHMASK >> 7) & 1
            pg8::Gemm g{(const bf16_t*)(ws + WS_U2), (const bf16_t*)(ws + WS_WMIX), T_TOK, 2048, 2048, nullptr, nullptr, 0}; pg8::StaticOrder S; S.init(T_TOK, 2048, G, c_eff);
            EpiStoreBf16 E{(bf16_t*)(ws + WS_Y), 2048}; pg8::gemm_phase<1>(lds, g, S, E);
#endif
    }
    if (p.ph_lo <= 8 && 8 < p.ph_hi) {
        if (8 > p.ph_lo) grid_barrier(bar, nbar, hier, my_xcd, (unsigned)G / 8u);

#if (PHMASK >> 8) & 1
            phase_postmix(p);
#endif
    }
    if (p.ph_lo <= 9 && 9 < p.ph_hi) {
        if (9 > p.ph_lo) grid_barrier(bar, nbar, hier, my_xcd, (unsigned)G / 8u);

#if (PHMASK >> 9) & 1
            pg8::Gemm g{(const bf16_t*)(ws + WS_H2), (const bf16_t*)(ws + WS_WUP), T_TOK, FF, 2048, nullptr, nullptr, 0}; pg8::StaticOrder S; S.init(T_TOK, FF, G, c_eff);
            EpiStoreBf16 E{(bf16_t*)(ws + WS_A), FF}; pg8::gemm_phase<1>(lds, g, S, E);
#endif
    }
    if (p.ph_lo <= 10 && 10 < p.ph_hi) {
        if (10 > p.ph_lo) grid_barrier(bar, nbar, hier, my_xcd, (unsigned)G / 8u);

#if (PHMASK >> 10) & 1
            pg8::Gemm g{(const bf16_t*)(ws + WS_H2), (const bf16_t*)(ws + WS_WUP) + (size_t)FF * 2048, T_TOK, FF, 2048, nullptr, nullptr, 0}; pg8::StaticOrder S; S.init(T_TOK, FF, G, c_eff);
            EpiConvAct E{(const bf16_t*)(ws + WS_A), (bf16_t*)(ws + WS_ACT), p.conv_w, p.conv_b}; pg8::gemm_phase<1>(lds, g, S, E);
#endif
    }
    if (p.ph_lo <= 11 && 11 < p.ph_hi) {
        if (11 > p.ph_lo) grid_barrier(bar, nbar, hier, my_xcd, (unsigned)G / 8u);

#if (PHMASK >> 11) & 1
            pg8::Gemm g{(const bf16_t*)(ws + WS_ACT), (const bf16_t*)(ws + WS_WDOWN), T_TOK, 2048, FF, nullptr, nullptr, 0}; pg8::StaticOrder S; S.init(T_TOK, 2048, G, c_eff);
            EpiStoreBf16 E{(bf16_t*)(ws + WS_Y2), 2048}; pg8::gemm_phase<1>(lds, g, S, E);
#endif
    }
    if (p.ph_lo <= 12 && 12 < p.ph_hi) {
        if (12 > p.ph_lo) grid_barrier(bar, nbar, hier, my_xcd, (unsigned)G / 8u);

#if (PHMASK >> 12) & 1
            phase_final(p);
#endif
    }
}

extern "C" void kernel_launch(void* const* d_in, const int* in_sizes, int n_in, void* d_out, int out_size, void* d_ws, size_t ws_size, hipStream_t stream) {
    static int grid = 0;
    if (grid == 0) {
        if (n_in != 20 || ws_size < WS_END) { fprintf(stderr, "kernel_launch: unexpected n_in %d or ws_size %zu (need %zu)\n", n_in, ws_size, (size_t)WS_END); grid = -1; return; }
        int dev = 0, cus = 0, per_cu = 0;
        hipGetDevice(&dev); hipDeviceGetAttribute(&cus, hipDeviceAttributeMultiprocessorCount, dev);
        if (hipFuncSetAttribute((const void*)mega, hipFuncAttributeMaxDynamicSharedMemorySize, LDS_BYTES) != hipSuccess) { fprintf(stderr, "kernel_launch: hipFuncSetAttribute failed\n"); grid = -1; return; }
        if (hipOccupancyMaxActiveBlocksPerMultiprocessor(&per_cu, (const void*)mega, 512, LDS_BYTES) != hipSuccess || per_cu < 1) { fprintf(stderr, "kernel_launch: occupancy query says %d\n", per_cu); per_cu = 1; }
        (void)hipGetLastError();
        grid = cus * 1;
    }
    if (grid < 0) return;
    Params p{};
    p.x = (const float*)d_in[0]; p.c = (const float*)d_in[1]; p.pos = (const int*)d_in[2]; p.w_ada = (const float*)d_in[3]; p.b_ada = (const float*)d_in[4]; p.g_pre_mix = (const float*)d_in[5];
    p.w_in = (const float*)d_in[6]; p.ret_gain = (const float*)d_in[7]; p.w_ret_out = (const float*)d_in[8]; p.w_att_out = (const float*)d_in[9]; p.w_gate = (const float*)d_in[10]; p.b_gate = (const float*)d_in[11];
    p.w_mix = (const float*)d_in[12]; p.g_post_mix = (const float*)d_in[13]; p.g_pre_ffn = (const float*)d_in[14]; p.w_up = (const float*)d_in[15]; p.conv_w = (const float*)d_in[16]; p.conv_b = (const float*)d_in[17];
    p.w_down = (const float*)d_in[18]; p.g_post_ffn = (const float*)d_in[19];
    p.out = (float*)d_out; p.ws = (unsigned char*)d_ws;
    if (hipMemsetAsync((char*)d_ws + WS_BAR, 0, 8192, stream) != hipSuccess) { fprintf(stderr, "kernel_launch: memset failed\n"); return; }
#if N_LAUNCH_PER_PHASE
    for (int ph = 0; ph < N_PHASES; ++ph) { p.ph_lo = ph; p.ph_hi = ph + 1; hipLaunchKernelGGL(mega, dim3(grid), dim3(512), LDS_BYTES, stream, p); }
#else
    p.ph_lo = 0; p.ph_hi = N_PHASES;
    void* args[] = {&p};
    hipError_t e = hipLaunchCooperativeKernel((const void*)mega, dim3(grid), dim3(512), args, LDS_BYTES, stream);
    if (e != hipSuccess) fprintf(stderr, "cooperative launch failed: %s (grid %d)\n", hipGetErrorString(e), grid);
#endif
}
```

```cpp
#include <hip/hip_runtime.h>
#include <hip/hip_cooperative_groups.h>
#include <cstdio>
#include <cstdint>
namespace cg = cooperative_groups;

#define DI __device__ __forceinline__
#define LAS __attribute__((address_space(3)))
typedef unsigned short bf16_t;
typedef short bf16x8 __attribute__((ext_vector_type(8)));
typedef short s16x4 __attribute__((ext_vector_type(4)));
typedef float f32x4 __attribute__((ext_vector_type(4)));
typedef unsigned u32x4 __attribute__((ext_vector_type(4)));
typedef unsigned u32x2 __attribute__((ext_vector_type(2)));

#ifndef PHMASK
#define PHMASK 0xFFFF
#endif
#ifndef N_LAUNCH_PER_PHASE
#define N_LAUNCH_PER_PHASE 0
#endif

constexpr int T_TOK = 32768, DM = 2048, SEQ = 8192, NB = 4;
constexpr int FF = 5632;
constexpr int LDS_BYTES = 143360;
constexpr size_t MiB = 1u << 20;
constexpr size_t WS_ADA = 0;
constexpr size_t WS_LSE = 1 * MiB;
constexpr size_t WS_RETSS = 4 * MiB;
constexpr size_t WS_WUP = 12 * MiB;
constexpr size_t WS_WDOWN = 56 * MiB;
constexpr size_t WS_WIN = 78 * MiB;
constexpr size_t WS_WGATE = 153 * MiB;
constexpr size_t WS_WRET = 169 * MiB;
constexpr size_t WS_WATT = 185 * MiB;
constexpr size_t WS_WMIX = 194 * MiB;
constexpr size_t WS_H = 206 * MiB;
constexpr size_t WS_RQ = 334 * MiB;
constexpr size_t WS_RK = 462 * MiB;
constexpr size_t WS_AQ = 590 * MiB;
constexpr size_t WS_AK = 734 * MiB;
constexpr size_t WS_AV = 878 * MiB;
constexpr size_t WS_GATES = 334 * MiB;
constexpr size_t WS_U = 734 * MiB;
constexpr size_t WS_U2 = 206 * MiB;
constexpr size_t WS_Y = 334 * MiB;
constexpr size_t WS_H2 = 78 * MiB;
constexpr size_t WS_A = 206 * MiB;
constexpr size_t WS_ACT = 558 * MiB;
constexpr size_t WS_Y2 = 78 * MiB;
constexpr size_t WS_END = 1022 * MiB;

struct Params {
    const float *x, *c; const int* pos;
    const float *w_ada, *b_ada, *g_pre_mix, *w_in, *ret_gain, *w_ret_out, *w_att_out, *w_gate, *b_gate, *w_mix, *g_post_mix, *g_pre_ffn, *w_up, *conv_w, *conv_b, *w_down, *g_post_ffn;
    float* out; unsigned char* ws; int ph_lo, ph_hi;
};

typedef __bf16 bf16x2_t __attribute__((ext_vector_type(2)));
DI unsigned cvt_pk_bf16(float lo, float hi) { bf16x2_t v = {(__bf16)lo, (__bf16)hi}; return __builtin_bit_cast(unsigned, v); }
DI float bflo(unsigned w) { return __uint_as_float(w << 16); }
DI float bfhi(unsigned w) { return __uint_as_float(w & 0xffff0000u); }
DI float wave_sum(float v) {
#pragma unroll
    for (int o = 1; o < 64; o <<= 1) v += __shfl_xor(v, o);
    return v;
}
DI float sigmoidf_(float v) { return __builtin_amdgcn_rcpf(1.0f + __builtin_amdgcn_exp2f(-1.4426950408889634f * v)); }
DI f32x4 mfma16(bf16x8 a, bf16x8 b, f32x4 c) { return __builtin_amdgcn_mfma_f32_16x16x32_bf16(a, b, c, 0, 0, 0); }
DI s16x4 tr_read(LAS unsigned char* p) { return __builtin_amdgcn_ds_read_tr16_b64_v4i16((LAS s16x4*)p); }
DI bf16x8 tr_read2(LAS unsigned char* p0, LAS unsigned char* p1) { s16x4 lo = tr_read(p0), hi = tr_read(p1); return __builtin_shufflevector(lo, hi, 0, 1, 2, 3, 4, 5, 6, 7); }

namespace pg8 {
constexpr int BM = 256, BK = 64, HALF = 128, HTB = HALF * BK * 2, STAGE_BYTES = 8 * HTB, NXCD = 8, WGM = 8;
DI int lds_byte(int r, int c) { const int st = (r >> 4) * 2 + (c >> 5), rr = r & 15, cc = c & 31, ob = rr * 64 + cc * 2; return st * 1024 + (ob ^ (((ob >> 9) & 1) << 5)); }
DI void stage_rc(int b, int& R, int& C) { const int st = b / 1024, sb = b % 1024, swz = sb ^ (((sb >> 9) & 1) << 5); R = (st >> 1) * 16 + swz / 64; C = (st & 1) * 32 + (swz % 64) / 2; }
struct Unit { int pm, pn; };
struct Gemm { const bf16_t* A; const bf16_t* Bt; int M, N, K; const bf16_t* A1; const bf16_t* Bt1; int K1; };
struct StaticOrder {
    int nM, nN, nwg, G, c, skip_lo, skip_n;
    DI void init(int M, int N, int G_, int c_, int slo = 1 << 30, int sn = 0) { nM = M / BM; nN = N / BM; nwg = nM * nN; G = G_; c = c_; skip_lo = slo; skip_n = sn; }
    DI bool next(int i, Unit& u) const {
        const long L = (long)i * G + c; if (L >= nwg) return false;
        int wgid = (int)L; { const int q = nwg / NXCD, r = nwg % NXCD, xcd = wgid % NXCD, off = wgid / NXCD; wgid = (xcd < r ? xcd * (q + 1) : r * (q + 1) + (xcd - r) * q) + off; }
        const int nig = WGM * nN, gid = wgid / nig, fm = gid * WGM, gsz = (nM - fm) < WGM ? (nM - fm) : WGM;
        u.pm = fm + ((wgid % nig) % gsz); u.pn = (wgid % nig) / gsz; if (u.pn >= skip_lo) u.pn += skip_n; return true;
    }
};

#ifndef PG8_ALIGN
#define PG8_ALIGN true
#endif
#ifndef PG8_SP2
#define PG8_SP2 true
#endif
template <int NSEG, class Epi, bool ALIGN_EPI = PG8_ALIGN, bool SP2 = PG8_SP2>
DI void gemm_phase(LAS unsigned char* lds, const Gemm g, const StaticOrder& S, const Epi& E) {
    const int tid = threadIdx.x, wid = __builtin_amdgcn_readfirstlane(tid >> 6), lane = tid & 63, wr = wid >> 2, wc = wid & 3, fr = lane & 15, fq = lane >> 4;
    int Rr[2], Cc[2];
#pragma unroll
    for (int i = 0; i < 2; ++i) stage_rc(tid * 16 + i * 8192, Rr[i], Cc[i]);
    const size_t kstep = (size_t)(BK * 2);
    const unsigned ldsw = (unsigned)wid * 1024u;
    const int aoff = lds_byte(wr * 64 + fr, fq * 8), boff = lds_byte(wc * 32 + fr, fq * 8);
#define PG8_SA(b, h) (((b) * 2 + (h)) * HTB)
#define PG8_SB(b, h) ((4 + (b) * 2 + (h)) * HTB)
#define PG8_STAGE(bufoff, gbase, VO) do { _Pragma("unroll") for (int _i = 0; _i < 2; ++_i) \
        __builtin_amdgcn_global_load_lds((const unsigned*)((const char*)(gbase) + VO[_i]), (LAS unsigned*)(lds + (bufoff) + ldsw + _i * 8192), 16, 0, 0); } while (0)
#define PG8_LDA(dst, b, h) do { _Pragma("unroll") for (int m = 0; m < 4; ++m) _Pragma("unroll") for (int k = 0; k < 2; ++k) dst[m][k] = *(const LAS bf16x8*)(lds + PG8_SA(b, h) + aoff + m * 2048 + k * 1024); } while (0)
#define PG8_LDB(dst, b, h) do { _Pragma("unroll") for (int n = 0; n < 2; ++n) _Pragma("unroll") for (int k = 0; k < 2; ++k) dst[n][k] = *(const LAS bf16x8*)(lds + PG8_SB(b, h) + boff + n * 2048 + k * 1024); } while (0)
#define PG8_MMA(ai, bj, At, Bt) do { __builtin_amdgcn_s_setprio(1); _Pragma("unroll") for (int m = 0; m < 4; ++m) _Pragma("unroll") for (int n = 0; n < 2; ++n) _Pragma("unroll") for (int k = 0; k < 2; ++k) \
        acc[ai][bj][m][n] = __builtin_amdgcn_mfma_f32_16x16x32_bf16(Bt[n][k], At[m][k], acc[ai][bj][m][n], 0, 0, 0); __builtin_amdgcn_s_setprio(0); } while (0)
#define PG8_WAIT_V(n) asm volatile("s_waitcnt vmcnt(" #n ")" ::: "memory")
#define PG8_WAIT_L(n) asm volatile("s_waitcnt lgkmcnt(" #n ")" ::: "memory")
#define PG8_BAR __builtin_amdgcn_s_barrier()
#define PG8_SCHED __builtin_amdgcn_sched_barrier(0)
    Unit cur, nxt; int ti = 0, seg = 0;
    if (!S.next(0, cur)) return;
    f32x4 acc[2][2][4][2];
#pragma unroll
    for (int a = 0; a < 2; ++a)
#pragma unroll
        for (int b = 0; b < 2; ++b)
#pragma unroll
            for (int m = 0; m < 4; ++m)
#pragma unroll
                for (int n = 0; n < 2; ++n) acc[a][b][m][n] = (f32x4){0.f, 0.f, 0.f, 0.f};
    bf16x8 At[4][2], B0[2][2], B1[2][2];
    int Kc = g.K;
    unsigned voffC[2];
#pragma unroll
    for (int i = 0; i < 2; ++i) voffC[i] = (unsigned)(Rr[i] * Kc + Cc[i]) * 2u;
    size_t hstepC = (size_t)HALF * Kc * 2;
    const char* cA = (const char*)g.A + (size_t)cur.pm * 2 * hstepC; const char* cB = (const char*)g.Bt + (size_t)cur.pn * 2 * hstepC;
    if constexpr (SP2) {
        PG8_STAGE(PG8_SB(0, 0), cB, voffC); PG8_STAGE(PG8_SB(0, 1), cB + hstepC, voffC); PG8_STAGE(PG8_SA(0, 0), cA, voffC); PG8_STAGE(PG8_SA(0, 1), cA + hstepC, voffC);
        if (wr == 1) PG8_BAR;
        PG8_WAIT_V(2); PG8_BAR;
        PG8_STAGE(PG8_SB(1, 0), cB + kstep, voffC); PG8_STAGE(PG8_SA(1, 0), cA + kstep, voffC); PG8_STAGE(PG8_SB(1, 1), cB + hstepC + kstep, voffC);
        PG8_WAIT_V(6); PG8_BAR;
    } else {
        PG8_STAGE(PG8_SB(0, 0), cB, voffC); PG8_STAGE(PG8_SA(0, 0), cA, voffC); PG8_STAGE(PG8_SB(0, 1), cB + hstepC, voffC); PG8_STAGE(PG8_SA(0, 1), cA + hstepC, voffC);
        if (wr == 1) PG8_BAR;
        PG8_WAIT_V(4); PG8_BAR;
        PG8_STAGE(PG8_SB(1, 0), cB + kstep, voffC); PG8_STAGE(PG8_SA(1, 0), cA + kstep, voffC); PG8_STAGE(PG8_SB(1, 1), cB + hstepC + kstep, voffC);
        PG8_WAIT_V(6); PG8_BAR;
    }
    for (;;) {
        bool has_next; int nseg = 0;
        if (NSEG > 1 && seg + 1 < NSEG) { has_next = true; nxt = cur; nseg = seg + 1; }
        else has_next = S.next(ti + 1, nxt);
        int Kn = Kc; const char* nA = cA; const char* nB = cB;
        if (has_next) { Kn = (NSEG > 1 && nseg == 1) ? g.K1 : g.K;
            nA = (const char*)((NSEG > 1 && nseg == 1) ? g.A1 : g.A) + (size_t)nxt.pm * 256 * Kn * 2; nB = (const char*)((NSEG > 1 && nseg == 1) ? g.Bt1 : g.Bt) + (size_t)nxt.pn * 256 * Kn * 2; }
        unsigned voffN[2];
#pragma unroll
        for (int i = 0; i < 2; ++i) voffN[i] = (NSEG > 1) ? (unsigned)(Rr[i] * Kn + Cc[i]) * 2u : voffC[i];
        const size_t hstepN = (NSEG > 1) ? (size_t)HALF * Kn * 2 : hstepC;
        const int nt = Kc / BK;
        for (int t = 0; t < nt; t += 2) {
            const bool last = (t == nt - 2);
            const char* a1 = cA + (size_t)(t + 1) * kstep;
            const char* a2 = last ? nA : cA + (size_t)(t + 2) * kstep; const char* b2 = last ? nB : cB + (size_t)(t + 2) * kstep;
            const char* a3 = a2 + kstep; const char* b3 = b2 + kstep;
            unsigned v2[2]; v2[0] = (NSEG > 1 && last) ? voffN[0] : voffC[0]; v2[1] = (NSEG > 1 && last) ? voffN[1] : voffC[1];
            const size_t h2 = (NSEG > 1 && last) ? hstepN : hstepC;
            if constexpr (SP2) {
            PG8_LDB(B0, 0, 0); PG8_LDB(B1, 0, 1); PG8_SCHED; PG8_LDA(At, 0, 0); PG8_STAGE(PG8_SA(1, 1), a1 + hstepC, voffC);
            PG8_WAIT_V(8); PG8_WAIT_L(0); PG8_BAR; PG8_MMA(0, 0, At, B0); PG8_MMA(0, 1, At, B1); PG8_BAR; PG8_SCHED;
            PG8_LDA(At, 0, 1); PG8_STAGE(PG8_SB(0, 0), b2, v2); PG8_STAGE(PG8_SB(0, 1), b2 + h2, v2); PG8_STAGE(PG8_SA(0, 0), a2, v2);
            PG8_WAIT_V(8); PG8_WAIT_L(0); PG8_BAR; PG8_MMA(1, 0, At, B0); PG8_MMA(1, 1, At, B1); PG8_BAR; PG8_SCHED;
            PG8_LDB(B0, 1, 0); PG8_LDB(B1, 1, 1); PG8_SCHED; PG8_LDA(At, 1, 0); PG8_STAGE(PG8_SA(0, 1), a2 + h2, v2);
            PG8_WAIT_V(8); PG8_WAIT_L(0); PG8_BAR; PG8_MMA(0, 0, At, B0); PG8_MMA(0, 1, At, B1); PG8_BAR; PG8_SCHED;
            PG8_LDA(At, 1, 1); PG8_STAGE(PG8_SB(1, 0), b3, v2); PG8_STAGE(PG8_SB(1, 1), b3 + h2, v2); PG8_STAGE(PG8_SA(1, 0), a3, v2);
            PG8_WAIT_V(8); PG8_WAIT_L(0); PG8_BAR; PG8_MMA(1, 0, At, B0); PG8_MMA(1, 1, At, B1); PG8_BAR; PG8_SCHED;
            } else {
            PG8_LDB(B0, 0, 0); PG8_SCHED; PG8_LDA(At, 0, 0); PG8_STAGE(PG8_SA(1, 1), a1 + hstepC, voffC);
            PG8_WAIT_L(8); PG8_BAR; PG8_WAIT_L(0); PG8_MMA(0, 0, At, B0); PG8_BAR; PG8_SCHED;
            PG8_LDB(B1, 0, 1); PG8_STAGE(PG8_SB(0, 0), b2, v2);
            PG8_BAR; PG8_WAIT_L(0); PG8_MMA(0, 1, At, B1); PG8_BAR;
            PG8_LDA(At, 0, 1); PG8_STAGE(PG8_SA(0, 0), a2, v2);
            PG8_BAR; PG8_WAIT_L(0); PG8_MMA(1, 0, At, B0); PG8_BAR; PG8_SCHED;
            PG8_STAGE(PG8_SB(0, 1), b2 + h2, v2);
            PG8_WAIT_V(6); PG8_BAR; PG8_MMA(1, 1, At, B1); PG8_BAR;
            PG8_LDB(B0, 1, 0); PG8_SCHED; PG8_LDA(At, 1, 0); PG8_STAGE(PG8_SA(0, 1), a2 + h2, v2);
            PG8_WAIT_L(8); PG8_BAR; PG8_WAIT_L(0); PG8_MMA(0, 0, At, B0); PG8_BAR; PG8_SCHED;
            PG8_LDB(B1, 1, 1); PG8_STAGE(PG8_SB(1, 0), b3, v2);
            PG8_BAR; PG8_WAIT_L(0); PG8_MMA(0, 1, At, B1); PG8_BAR;
            PG8_LDA(At, 1, 1); PG8_STAGE(PG8_SA(1, 0), a3, v2);
            PG8_BAR; PG8_WAIT_L(0); PG8_MMA(1, 0, At, B0); PG8_BAR; PG8_SCHED;
            PG8_STAGE(PG8_SB(1, 1), b3 + h2, v2);
            PG8_WAIT_V(6); PG8_BAR; PG8_MMA(1, 1, At, B1); PG8_BAR;
            }
        }
        if constexpr (ALIGN_EPI) { if (wr == 0) PG8_BAR; }
        if constexpr (NSEG > 1) { if (seg + 1 < NSEG) E.mid(acc, cur, wr, wc, fr, fq); else E(acc, cur, wr, wc, fr, fq); }
        else E(acc, cur, wr, wc, fr, fq);
        if (!has_next) break;
        if (NSEG == 1 || nseg == 0) {
#pragma unroll
            for (int a = 0; a < 2; ++a)
#pragma unroll
                for (int b = 0; b < 2; ++b)
#pragma unroll
                    for (int m = 0; m < 4; ++m)
#pragma unroll
                        for (int n = 0; n < 2; ++n) acc[a][b][m][n] = (f32x4){0.f, 0.f, 0.f, 0.f};
            ++ti;
        }
        cur = nxt; cA = nA; cB = nB; seg = nseg;
        if (NSEG > 1) { Kc = Kn; voffC[0] = voffN[0]; voffC[1] = voffN[1]; hstepC = hstepN; }
        if constexpr (ALIGN_EPI) { if (wr == 1) PG8_BAR; }
    }
    PG8_WAIT_V(0);
    if constexpr (!ALIGN_EPI) { if (wr == 0) PG8_BAR; }
    PG8_BAR;
#undef PG8_SA
#undef PG8_SB
#undef PG8_STAGE
#undef PG8_LDA
#undef PG8_LDB
#undef PG8_MMA
#undef PG8_WAIT_V
#undef PG8_WAIT_L
#undef PG8_BAR
#undef PG8_SCHED
}
}
using pg8::Unit;
typedef f32x4 AccT[2][2][4][2];

DI u32x4 pack8(const f32x4& v0, const f32x4& v1) { u32x4 w; w.x = cvt_pk_bf16(v0[0], v0[1]); w.y = cvt_pk_bf16(v0[2], v0[3]); w.z = cvt_pk_bf16(v1[0], v1[1]); w.w = cvt_pk_bf16(v1[2], v1[3]); return w; }

struct EpiStoreBf16 {
    bf16_t* O; int ld;
    DI void operator()(const AccT& acc, const Unit& u, int wr, int wc, int fr, int fq) const {
        const int row0 = u.pm * 256 + wr * 64 + fr, col0 = u.pn * 256 + wc * 32 + 8 * fq;
#pragma unroll
        for (int ai = 0; ai < 2; ++ai)
#pragma unroll
            for (int m = 0; m < 4; ++m) { bf16_t* rowp = O + (size_t)(row0 + ai * 128 + m * 16) * ld + col0;
#pragma unroll
                for (int bj = 0; bj < 2; ++bj) *(u32x4*)(rowp + bj * 128) = pack8(acc[ai][bj][m][0], acc[ai][bj][m][1]); }
    }
};

template <int HD>
DI void rope_store(const AccT& acc, int rowbase, const int* pos, bf16_t* dst, int ld, int c1, int half, int ibase, float scale) {
    int pi[2][4];
#pragma unroll
    for (int ai = 0; ai < 2; ++ai)
#pragma unroll
        for (int m = 0; m < 4; ++m) pi[ai][m] = pos[rowbase + ai * 128 + m * 16];
    float invf[2][4];
#pragma unroll
    for (int n = 0; n < 2; ++n)
#pragma unroll
        for (int j = 0; j < 4; ++j) invf[n][j] = exp2f(-(float)(ibase + 4 * n + j) * (2.0f / HD) * 13.287712379549449f);
#pragma unroll
    for (int ai = 0; ai < 2; ++ai)
#pragma unroll
        for (int m = 0; m < 4; ++m) {
            const int row = rowbase + ai * 128 + m * 16; const float ps = (float)pi[ai][m];
            f32x4 o1[2], o2[2];
#pragma unroll
            for (int n = 0; n < 2; ++n)
#pragma unroll
                for (int j = 0; j < 4; ++j) {
                    const float ang = ps * invf[n][j]; const float rev = __builtin_amdgcn_fractf(ang * 0.15915494309189535f);
                    const float sn = __builtin_amdgcn_sinf(rev), cs = __builtin_amdgcn_cosf(rev);
                    const float t1 = acc[ai][0][m][n][j], t2 = acc[ai][1][m][n][j];
                    o1[n][j] = (t1 * cs - t2 * sn) * scale; o2[n][j] = (t2 * cs + t1 * sn) * scale;
                }
            bf16_t* rowp = dst + (size_t)row * ld + c1;
            *(u32x4*)rowp = pack8(o1[0], o1[1]); *(u32x4*)(rowp + half) = pack8(o2[0], o2[1]);
        }
}

struct EpiInProj {
    bf16_t *rq, *rk, *rv, *aq, *ak, *av; const int* pos;
    DI void operator()(const AccT& acc, const Unit& u, int wr, int wc, int fr, int fq) const {
        const int pn = u.pn, rowbase = u.pm * 256 + wr * 64 + fr;
        if (pn < 16) {
            bf16_t* dst = pn < 8 ? rq : rk; const float scale = pn < 8 ? 1.0f : 0.0625f;
            rope_store<256>(acc, rowbase, pos, dst, 2048, 256 * (pn & 7) + 32 * wc + 8 * fq, 128, 32 * wc + 8 * fq, scale);
        } else if (pn < 32) {
            const int col0 = (pn - 16) * 256 + wc * 32 + 8 * fq;
#pragma unroll
            for (int ai = 0; ai < 2; ++ai)
#pragma unroll
                for (int m = 0; m < 4; ++m) { bf16_t* rowp = rv + (size_t)(rowbase + ai * 128 + m * 16) * 4096 + col0;
#pragma unroll
                    for (int bj = 0; bj < 2; ++bj) *(u32x4*)(rowp + bj * 128) = pack8(acc[ai][bj][m][0], acc[ai][bj][m][1]); }
        } else if (pn < 66) {
            const int q9 = pn - 48; bf16_t* dst = q9 < 9 ? aq : ak; const int t9 = q9 < 9 ? q9 : q9 - 9;
            const int head = 2 * t9 + (wc >> 1), ib = 32 * (wc & 1) + 8 * fq;
            rope_store<128>(acc, rowbase, pos, dst, 2304, head * 128 + ib, 64, ib, 1.0f);
        } else {
            const int col0 = (pn - 66) * 256 + wc * 32 + 8 * fq;
#pragma unroll
            for (int ai = 0; ai < 2; ++ai)
#pragma unroll
                for (int m = 0; m < 4; ++m) { bf16_t* rowp = av + (size_t)(rowbase + ai * 128 + m * 16) * 2304 + col0;
#pragma unroll
                    for (int bj = 0; bj < 2; ++bj) *(u32x4*)(rowp + bj * 128) = pack8(acc[ai][bj][m][0], acc[ai][bj][m][1]); }
        }
    }
};

struct EpiRetGate {
    bf16_t* ret; const float* retss; const float* gain;
    DI void operator()(const AccT& acc, const Unit& u, int wr, int wc, int fr, int fq) const {
        const int rowbase = u.pm * 256 + wr * 64 + fr, head = u.pn >> 1, colb = u.pn * 256 + wc * 32 + 8 * fq;
        f32x4 gn[2][2];
#pragma unroll
        for (int bj = 0; bj < 2; ++bj) { gn[bj][0] = *(const f32x4*)(gain + colb + bj * 128); gn[bj][1] = *(const f32x4*)(gain + colb + bj * 128 + 4); }
#pragma unroll
        for (int ai = 0; ai < 2; ++ai) {
            f32x4 sA[4], sB[4]; u32x4 rr[4][2];
#pragma unroll
            for (int m = 0; m < 4; ++m) { const float* ps = retss + ((size_t)(rowbase + ai * 128 + m * 16) * 8 + head) * 8; sA[m] = *(const f32x4*)ps; sB[m] = *(const f32x4*)(ps + 4); }
#pragma unroll
            for (int m = 0; m < 4; ++m)
#pragma unroll
                for (int bj = 0; bj < 2; ++bj) rr[m][bj] = *(const u32x4*)(ret + (size_t)(rowbase + ai * 128 + m * 16) * 4096 + colb + bj * 128);
#pragma unroll
            for (int m = 0; m < 4; ++m) {
                const f32x4 s0 = sA[m], s1 = sB[m];
                const float rsv = __builtin_amdgcn_rsqf((((s0[0] + s0[1]) + (s0[2] + s0[3])) + ((s1[0] + s1[1]) + (s1[2] + s1[3]))) * (1.0f / 512.0f) + 1e-6f);
#pragma unroll
                for (int bj = 0; bj < 2; ++bj) {
                    const u32x4 r4 = rr[m][bj];
                    const float rf[8] = {bflo(r4.x), bfhi(r4.x), bflo(r4.y), bfhi(r4.y), bflo(r4.z), bfhi(r4.z), bflo(r4.w), bfhi(r4.w)};
                    f32x4 o0, o1;
#pragma unroll
                    for (int j = 0; j < 4; ++j) {
                        const float a0 = acc[ai][bj][m][0][j], a1 = acc[ai][bj][m][1][j];
                        o0[j] = a0 * sigmoidf_(a0) * (rf[j] * rsv * gn[bj][0][j]); o1[j] = a1 * sigmoidf_(a1) * (rf[4 + j] * rsv * gn[bj][1][j]);
                    }
                    *(u32x4*)(ret + (size_t)(rowbase + ai * 128 + m * 16) * 4096 + colb + bj * 128) = pack8(o0, o1);
                }
            }
        }
    }
};

struct EpiGates {
    bf16_t* O; const float* bias;
    DI void operator()(const AccT& acc, const Unit& u, int wr, int wc, int fr, int fq) const {
        const int rowbase = u.pm * 256 + wr * 64 + fr;
#pragma unroll
        for (int bj = 0; bj < 2; ++bj) {
            const int col = u.pn * 256 + bj * 128 + wc * 32 + 8 * fq;
            const f32x4 b0 = *(const f32x4*)(bias + col), b1 = *(const f32x4*)(bias + col + 4);
#pragma unroll
            for (int ai = 0; ai < 2; ++ai)
#pragma unroll
                for (int m = 0; m < 4; ++m) {
                    f32x4 o0, o1;
#pragma unroll
                    for (int j = 0; j < 4; ++j) { o0[j] = sigmoidf_(acc[ai][bj][m][0][j] + b0[j]); o1[j] = sigmoidf_(acc[ai][bj][m][1][j] + b1[j]); }
                    *(u32x4*)(O + (size_t)(rowbase + ai * 128 + m * 16) * 4096 + col) = pack8(o0, o1);
                }
        }
    }
};

struct EpiYMerge {
    const bf16_t* gates; bf16_t* U2;
    DI void mid(AccT& acc, const Unit& u, int wr, int wc, int fr, int fq) const {
        const int rowbase = u.pm * 256 + wr * 64 + fr, colb = u.pn * 256 + wc * 32 + 8 * fq;
#pragma unroll
        for (int ai = 0; ai < 2; ++ai) {
            u32x4 gr[4][2], ga[4][2];
#pragma unroll
            for (int m = 0; m < 4; ++m)
#pragma unroll
                for (int bj = 0; bj < 2; ++bj) { const bf16_t* pg = gates + (size_t)(rowbase + ai * 128 + m * 16) * 4096 + colb + bj * 128; gr[m][bj] = *(const u32x4*)pg; ga[m][bj] = *(const u32x4*)(pg + 2048); }
#pragma unroll
            for (int m = 0; m < 4; ++m)
#pragma unroll
                for (int bj = 0; bj < 2; ++bj) {
                    const u32x4 g1 = gr[m][bj], g2 = ga[m][bj];
                    const float r[8] = {bflo(g1.x), bfhi(g1.x), bflo(g1.y), bfhi(g1.y), bflo(g1.z), bfhi(g1.z), bflo(g1.w), bfhi(g1.w)};
                    const float a[8] = {bflo(g2.x), bfhi(g2.x), bflo(g2.y), bfhi(g2.y), bflo(g2.z), bfhi(g2.z), bflo(g2.w), bfhi(g2.w)};
#pragma unroll
                    for (int j = 0; j < 4; ++j) { acc[ai][bj][m][0][j] *= r[j] * __builtin_amdgcn_rcpf(fmaxf(a[j], 1e-30f)); acc[ai][bj][m][1][j] *= r[4 + j] * __builtin_amdgcn_rcpf(fmaxf(a[4 + j], 1e-30f)); }
                }
        }
    }
    DI void operator()(const AccT& acc, const Unit& u, int wr, int wc, int fr, int fq) const {
        const int rowbase = u.pm * 256 + wr * 64 + fr, colb = u.pn * 256 + wc * 32 + 8 * fq;
        u32x4 gg[2][4][2];
#pragma unroll
        for (int ai = 0; ai < 2; ++ai)
#pragma unroll
            for (int m = 0; m < 4; ++m)
#pragma unroll
                for (int bj = 0; bj < 2; ++bj) gg[ai][m][bj] = *(const u32x4*)(gates + (size_t)(rowbase + ai * 128 + m * 16) * 4096 + 2048 + colb + bj * 128);
#pragma unroll
        for (int ai = 0; ai < 2; ++ai)
#pragma unroll
            for (int m = 0; m < 4; ++m)
#pragma unroll
                for (int bj = 0; bj < 2; ++bj) {
                    const u32x4 g4 = gg[ai][m][bj];
                    f32x4 o0 = acc[ai][bj][m][0], o1 = acc[ai][bj][m][1];
                    o0[0] *= bflo(g4.x); o0[1] *= bfhi(g4.x); o0[2] *= bflo(g4.y); o0[3] *= bfhi(g4.y);
                    o1[0] *= bflo(g4.z); o1[1] *= bfhi(g4.z); o1[2] *= bflo(g4.w); o1[3] *= bfhi(g4.w);
                    *(u32x4*)(U2 + (size_t)(rowbase + ai * 128 + m * 16) * 2048 + colb + bj * 128) = pack8(o0, o1);
                }
    }
};

DI float gelu_tanh(float v) {
    const float uu = 0.7978845608028654f * (v + 0.044715f * v * v * v);
    const float e = __builtin_amdgcn_exp2f(2.8853900817779268f * uu);
    return v - v * __builtin_amdgcn_rcpf(e + 1.0f);
}
struct EpiConvAct {
    const bf16_t* A; bf16_t* ACT; const float* conv_w; const float* conv_b;
    DI void operator()(const AccT& acc, const Unit& u, int wr, int wc, int fr, int fq) const {
        const int rowbase = u.pm * 256 + wr * 64 + fr;
#pragma unroll
        for (int bj = 0; bj < 2; ++bj) {
            const int col = u.pn * 256 + bj * 128 + wc * 32 + 8 * fq;
            f32x4 w0[2], w1[2], w2[2], cb[2];
#pragma unroll
            for (int hh = 0; hh < 2; ++hh) { w0[hh] = *(const f32x4*)(conv_w + col + 4 * hh); w1[hh] = *(const f32x4*)(conv_w + FF + col + 4 * hh); w2[hh] = *(const f32x4*)(conv_w + 2 * FF + col + 4 * hh); cb[hh] = *(const f32x4*)(conv_b + col + 4 * hh); }
#pragma unroll
            for (int aim = 0; aim < 4; ++aim) { const int ai = aim >> 1, mb = (aim & 1) * 2;
                u32x4 a0[4], a1[4], a2[4];
#pragma unroll
                for (int m = mb; m < mb + 2; ++m) {
                    const int row = rowbase + ai * 128 + m * 16; const int sq = row & (SEQ - 1);
                    const bf16_t* pa = A + (size_t)row * FF + col;
                    a0[m] = *(const u32x4*)pa;
                    a1[m] = *(const u32x4*)(pa - (sq >= 1 ? FF : 0));
                    a2[m] = *(const u32x4*)(pa - (sq >= 2 ? 2 * FF : 0));
                }
#pragma unroll
                for (int m = mb; m < mb + 2; ++m) {
                    const int row = rowbase + ai * 128 + m * 16; const int sq = row & (SEQ - 1);
                    const float k1 = sq >= 1 ? 1.0f : 0.0f, k2 = sq >= 2 ? 1.0f : 0.0f;
                    const u32x4 x0 = a0[m], x1 = a1[m], x2 = a2[m];
                    const float f0[8] = {bflo(x0.x), bfhi(x0.x), bflo(x0.y), bfhi(x0.y), bflo(x0.z), bfhi(x0.z), bflo(x0.w), bfhi(x0.w)};
                    const float f1[8] = {bflo(x1.x), bfhi(x1.x), bflo(x1.y), bfhi(x1.y), bflo(x1.z), bfhi(x1.z), bflo(x1.w), bfhi(x1.w)};
                    const float f2[8] = {bflo(x2.x), bfhi(x2.x), bflo(x2.y), bfhi(x2.y), bflo(x2.z), bfhi(x2.z), bflo(x2.w), bfhi(x2.w)};
                    f32x4 o0, o1;
#pragma unroll
                    for (int j = 0; j < 4; ++j) {
                        const float c0 = cb[0][j] + w0[0][j] * f0[j] + k1 * (w1[0][j] * f1[j]) + k2 * (w2[0][j] * f2[j]);
                        const float c1 = cb[1][j] + w0[1][j] * f0[4 + j] + k1 * (w1[1][j] * f1[4 + j]) + k2 * (w2[1][j] * f2[4 + j]);
                        o0[j] = gelu_tanh(c0) * acc[ai][bj][m][0][j]; o1[j] = gelu_tanh(c1) * acc[ai][bj][m][1][j];
                    }
                    *(u32x4*)(ACT + (size_t)row * FF + col) = pack8(o0, o1);
                }
            }
        }
    }
};

DI int invperm32(int c) { return 16 * ((c >> 2) & 1) + 4 * (c >> 3) + (c & 3); }
DI int slot_std(int c) { return (c & ~31) | invperm32(c & 31); }
DI int slot_win(int c) {
    if (c >= 12288 && c < 16896) { const int tc = c & 255, hh = tc >> 7, bj = (tc >> 6) & 1, i64 = tc & 63, x = 64 * hh + i64; return (c & ~255) + 128 * bj + (x & ~31) + invperm32(x & 31); }
    return slot_std(c);
}
DI void transpose_item(const float* W, int K, int N, bf16_t* WT, int mode, LAS float* scr, int item, int lane) {
    const int nblk = N / 32, kb = item / nblk, nb = item % nblk, k0 = 64 * kb, n0 = 32 * nb;
#pragma unroll 16
    for (int i = 0; i < 32; ++i) { const int kk = 2 * i + (lane >> 5); scr[kk * 33 + (lane & 31)] = W[(size_t)(k0 + kk) * N + n0 + (lane & 31)]; }
    asm volatile("s_waitcnt lgkmcnt(0)" ::: "memory");
    const int c = lane & 7;
#pragma unroll
    for (int j = 0; j < 4; ++j) { const int n = (lane >> 3) + 8 * j; const LAS float* s = scr + (8 * c) * 33 + n;
        u32x4 o; o.x = cvt_pk_bf16(s[0 * 33], s[1 * 33]); o.y = cvt_pk_bf16(s[2 * 33], s[3 * 33]); o.z = cvt_pk_bf16(s[4 * 33], s[5 * 33]); o.w = cvt_pk_bf16(s[6 * 33], s[7 * 33]);
        const int drow = mode ? slot_win(n0 + n) : slot_std(n0 + n);
        *(u32x4*)(WT + (size_t)drow * K + k0 + 8 * c) = o; }
    asm volatile("s_waitcnt lgkmcnt(0)" ::: "memory");
}

DI void phase0(const Params& p, LAS unsigned char* lds) {
    const int tid = threadIdx.x, lane = tid & 63, wave = tid >> 6;
    LAS float* sc = (LAS float*)lds;
    LAS float* red = sc + 8192;
    float* ada = (float*)(p.ws + WS_ADA);
    for (int i = tid; i < 8192; i += 512) { const float v = p.c[i]; sc[i] = v / (1.0f + __expf(-v)); }
    __syncthreads();
    for (int cb = blockIdx.x; cb < 256; cb += gridDim.x) {
        {
            const int rg = lane / 12, cq = lane - 12 * rg;
            f32x4 a0 = {0.f, 0.f, 0.f, 0.f}, a1 = a0, a2 = a0, a3 = a0;
            if (rg < 5) {
                const float* wp = p.w_ada + 48 * cb + 4 * cq;
#pragma unroll 13
                for (int i = 0; i < 52; ++i) { const int kl = 5 * i + rg; if (kl < 256) { const int kk = 256 * wave + kl; const f32x4 wv = *(const f32x4*)(wp + (size_t)kk * 12288);
                    a0 += sc[kk] * wv; a1 += sc[2048 + kk] * wv; a2 += sc[4096 + kk] * wv; a3 += sc[6144 + kk] * wv; } }
                LAS float* rp = red + ((wave * 5 + rg) * 4) * 48 + 4 * cq;
                *(LAS f32x4*)(rp) = a0; *(LAS f32x4*)(rp + 48) = a1; *(LAS f32x4*)(rp + 96) = a2; *(LAS f32x4*)(rp + 144) = a3;
            }
        }
        __syncthreads();
        if (tid < 192) { const int b = tid / 48, l = tid % 48; float sacc = 0.f;
#pragma unroll 8
            for (int wg = 0; wg < 40; ++wg) sacc += red[(wg * 4 + b) * 48 + l];
            ada[b * 12288 + 48 * cb + l] = sacc + p.b_ada[48 * cb + l]; }
        __syncthreads();
    }
    LAS float* scr = (LAS float*)(lds + 40960 + wave * 8448);
    const int gw = blockIdx.x * 8 + wave, NGW = gridDim.x * 8;
    constexpr int I_IN = (2048 / 64) * (19200 / 32), I_GATE = (2048 / 64) * (4096 / 32), I_RET = (4096 / 64) * (2048 / 32), I_ATT = (2304 / 64) * (2048 / 32),
                  I_MIX = (2048 / 64) * (2048 / 32), I_UP = (2048 / 64) * (11264 / 32), I_DOWN = (5632 / 64) * (2048 / 32);
    constexpr int NITEMS = I_IN + I_GATE + I_RET + I_ATT + I_MIX + I_UP + I_DOWN;
    for (int it = gw; it < NITEMS; it += NGW) {
        int r = it;
        if (r < I_IN) { transpose_item(p.w_in, 2048, 19200, (bf16_t*)(p.ws + WS_WIN), 1, scr, r, lane); continue; } r -= I_IN;
        if (r < I_GATE) { transpose_item(p.w_gate, 2048, 4096, (bf16_t*)(p.ws + WS_WGATE), 0, scr, r, lane); continue; } r -= I_GATE;
        if (r < I_RET) { transpose_item(p.w_ret_out, 4096, 2048, (bf16_t*)(p.ws + WS_WRET), 0, scr, r, lane); continue; } r -= I_RET;
        if (r < I_ATT) { transpose_item(p.w_att_out, 2304, 2048, (bf16_t*)(p.ws + WS_WATT), 0, scr, r, lane); continue; } r -= I_ATT;
        if (r < I_MIX) { transpose_item(p.w_mix, 2048, 2048, (bf16_t*)(p.ws + WS_WMIX), 0, scr, r, lane); continue; } r -= I_MIX;
        if (r < I_UP) { transpose_item(p.w_up, 2048, 11264, (bf16_t*)(p.ws + WS_WUP), 0, scr, r, lane); continue; } r -= I_UP;
        transpose_item(p.w_down, 5632, 2048, (bf16_t*)(p.ws + WS_WDOWN), 0, scr, r, lane);
    }
}

constexpr int NR = 2;
DI void phase_h(const Params& p) {
    const int lane = threadIdx.x & 63, wave = threadIdx.x >> 6;
    const float* ada = (const float*)(p.ws + WS_ADA); bf16_t* H = (bf16_t*)(p.ws + WS_H);
    const int nw = gridDim.x * 8;
    for (int row0 = blockIdx.x * 8 + wave; row0 < T_TOK; row0 += nw * NR) {
        f32x4 v[NR][4][2]; float ss[NR];
#pragma unroll
        for (int q = 0; q < NR; ++q) { const float* xr = p.x + (size_t)(row0 + q * nw) * DM; ss[q] = 0.f;
#pragma unroll
            for (int it = 0; it < 4; ++it) { const int col = (it * 64 + lane) * 8; v[q][it][0] = *(const f32x4*)(xr + col); v[q][it][1] = *(const f32x4*)(xr + col + 4); } }
#pragma unroll
        for (int q = 0; q < NR; ++q) {
#pragma unroll
            for (int it = 0; it < 4; ++it)
#pragma unroll
                for (int j = 0; j < 4; ++j) ss[q] += v[q][it][0][j] * v[q][it][0][j] + v[q][it][1][j] * v[q][it][1][j];
            ss[q] = __builtin_amdgcn_rsqf(wave_sum(ss[q]) * (1.0f / DM) + 1e-6f); }
#pragma unroll
        for (int it = 0; it < 4; ++it) { const int col = (it * 64 + lane) * 8;
            f32x4 g[2], sh[NR][2], scl[NR][2];
#pragma unroll
            for (int hh = 0; hh < 2; ++hh) { g[hh] = *(const f32x4*)(p.g_pre_mix + col + 4 * hh);
#pragma unroll
                for (int q = 0; q < NR; ++q) { const int b = (row0 + q * nw) / SEQ; sh[q][hh] = *(const f32x4*)(ada + b * 12288 + col + 4 * hh); scl[q][hh] = *(const f32x4*)(ada + b * 12288 + 2048 + col + 4 * hh); } }
#pragma unroll
            for (int q = 0; q < NR; ++q) { f32x4 o[2];
#pragma unroll
                for (int hh = 0; hh < 2; ++hh)
#pragma unroll
                    for (int j = 0; j < 4; ++j) o[hh][j] = v[q][it][hh][j] * ss[q] * g[hh][j] * (1.0f + scl[q][hh][j]) + sh[q][hh][j];
                *(u32x4*)(H + (size_t)(row0 + q * nw) * DM + col) = pack8(o[0], o[1]); } }
    }
}

DI void phase_postmix(const Params& p) {
    const int lane = threadIdx.x & 63, wave = threadIdx.x >> 6;
    const float* ada = (const float*)(p.ws + WS_ADA); const bf16_t* Y = (const bf16_t*)(p.ws + WS_Y); bf16_t* H2 = (bf16_t*)(p.ws + WS_H2);
    const int nw = gridDim.x * 8;
    for (int row0 = blockIdx.x * 8 + wave; row0 < T_TOK; row0 += nw * NR) {
        f32x4 y[NR][4][2], xv[NR][4][2]; float ry[NR], r1[NR];
#pragma unroll
        for (int q = 0; q < NR; ++q) { const size_t ro = (size_t)(row0 + q * nw) * DM;
#pragma unroll
            for (int it = 0; it < 4; ++it) { const int col = (it * 64 + lane) * 8; const u32x4 w = *(const u32x4*)(Y + ro + col);
                y[q][it][0] = (f32x4){bflo(w.x), bfhi(w.x), bflo(w.y), bfhi(w.y)}; y[q][it][1] = (f32x4){bflo(w.z), bfhi(w.z), bflo(w.w), bfhi(w.w)};
                xv[q][it][0] = *(const f32x4*)(p.x + ro + col); xv[q][it][1] = *(const f32x4*)(p.x + ro + col + 4); } }
#pragma unroll
        for (int q = 0; q < NR; ++q) { float ss = 0.f;
#pragma unroll
            for (int it = 0; it < 4; ++it)
#pragma unroll
                for (int j = 0; j < 4; ++j) ss += y[q][it][0][j] * y[q][it][0][j] + y[q][it][1][j] * y[q][it][1][j];
            ry[q] = __builtin_amdgcn_rsqf(wave_sum(ss) * (1.0f / DM) + 1e-6f); }
#pragma unroll
        for (int q = 0; q < NR; ++q) { const int row = row0 + q * nw; const float* ab = ada + (row / SEQ) * 12288; float s1 = 0.f;
#pragma unroll
            for (int it = 0; it < 4; ++it) { const int col = (it * 64 + lane) * 8;
#pragma unroll
                for (int hh = 0; hh < 2; ++hh) { const f32x4 g = *(const f32x4*)(p.g_post_mix + col + 4 * hh), gt = *(const f32x4*)(ab + 4096 + col + 4 * hh);
                    f32x4 o;
#pragma unroll
                    for (int j = 0; j < 4; ++j) { o[j] = xv[q][it][hh][j] + gt[j] * (y[q][it][hh][j] * ry[q] * g[j]); s1 += o[j] * o[j]; }
                    y[q][it][hh] = o; }
                *(u32x4*)((bf16_t*)(p.out + (size_t)row * DM + DM / 2) + col) = pack8(y[q][it][0], y[q][it][1]); }
            r1[q] = __builtin_amdgcn_rsqf(wave_sum(s1) * (1.0f / DM) + 1e-6f); }
#pragma unroll
        for (int q = 0; q < NR; ++q) { const int row = row0 + q * nw; const float* ab = ada + (row / SEQ) * 12288;
#pragma unroll
            for (int it = 0; it < 4; ++it) { const int col = (it * 64 + lane) * 8; f32x4 o[2];
#pragma unroll
                for (int hh = 0; hh < 2; ++hh) { const f32x4 g = *(const f32x4*)(p.g_pre_ffn + col + 4 * hh), sh = *(const f32x4*)(ab + 6144 + col + 4 * hh), scl = *(const f32x4*)(ab + 8192 + col + 4 * hh);
#pragma unroll
                    for (int j = 0; j < 4; ++j) o[hh][j] = y[q][it][hh][j] * r1[q] * g[j] * (1.0f + scl[j]) + sh[j]; }
                *(u32x4*)(H2 + (size_t)row * DM + col) = pack8(o[0], o[1]); } }
    }
}

DI void phase_final(const Params& p) {
    const int lane = threadIdx.x & 63, wave = threadIdx.x >> 6;
    const float* ada = (const float*)(p.ws + WS_ADA); const bf16_t* Y = (const bf16_t*)(p.ws + WS_Y2);
    const int nw = gridDim.x * 8;
    for (int row0 = blockIdx.x * 8 + wave; row0 < T_TOK; row0 += nw * NR) {
        f32x4 y[NR][4][2], xv[NR][4][2]; float ry[NR];
#pragma unroll
        for (int q = 0; q < NR; ++q) { const size_t ro = (size_t)(row0 + q * nw) * DM;
#pragma unroll
            for (int it = 0; it < 4; ++it) { const int col = (it * 64 + lane) * 8; const u32x4 w = *(const u32x4*)(Y + ro + col);
                y[q][it][0] = (f32x4){bflo(w.x), bfhi(w.x), bflo(w.y), bfhi(w.y)}; y[q][it][1] = (f32x4){bflo(w.z), bfhi(w.z), bflo(w.w), bfhi(w.w)};
                const u32x4 xw = *(const u32x4*)((const bf16_t*)(p.out + ro + DM / 2) + col);
                xv[q][it][0] = (f32x4){bflo(xw.x), bfhi(xw.x), bflo(xw.y), bfhi(xw.y)}; xv[q][it][1] = (f32x4){bflo(xw.z), bfhi(xw.z), bflo(xw.w), bfhi(xw.w)}; } }
#pragma unroll
        for (int q = 0; q < NR; ++q) { float ss = 0.f;
#pragma unroll
            for (int it = 0; it < 4; ++it)
#pragma unroll
                for (int j = 0; j < 4; ++j) ss += y[q][it][0][j] * y[q][it][0][j] + y[q][it][1][j] * y[q][it][1][j];
            ry[q] = __builtin_amdgcn_rsqf(wave_sum(ss) * (1.0f / DM) + 1e-6f); }
#pragma unroll
        for (int q = 0; q < NR; ++q) { const int row = row0 + q * nw; const float* ab = ada + (row / SEQ) * 12288;
#pragma unroll
            for (int it = 0; it < 4; ++it) { const int col = (it * 64 + lane) * 8;
#pragma unroll
                for (int hh = 0; hh < 2; ++hh) { const f32x4 g = *(const f32x4*)(p.g_post_ffn + col + 4 * hh), gt = *(const f32x4*)(ab + 10240 + col + 4 * hh);
                    f32x4 o;
#pragma unroll
                    for (int j = 0; j < 4; ++j) o[j] = xv[q][it][hh][j] + gt[j] * (y[q][it][hh][j] * ry[q] * g[j]);
                    *(f32x4*)(p.out + (size_t)row * DM + col + 4 * hh) = o; } } }
    }
}

DI void phase_alpha(const Params& p) {
    bf16_t* att = (bf16_t*)(p.ws + WS_AQ); const float* lse = (const float*)(p.ws + WS_LSE);
    const int lane = threadIdx.x & 63, wave = threadIdx.x >> 6;
    for (int t = blockIdx.x * 8 + wave; t < T_TOK; t += gridDim.x * 8) {
        const float l = lse[(size_t)t * 18 + (lane < 18 ? lane : 0)];
        const int j = lane % 6;
        const float l0 = __shfl(l, j), l1 = __shfl(l, 6 + j), l2 = __shfl(l, 12 + j);
        const float mm = fmaxf(l0, fmaxf(l1, l2)); const float e0 = __expf(l0 - mm), e1 = __expf(l1 - mm), e2 = __expf(l2 - mm);
        const float al_lane = __expf(l - mm) / (e0 + e1 + e2);
        u32x4* row = (u32x4*)(att + (size_t)t * 2304);
        u32x4 w[5];
#pragma unroll
        for (int k = 0; k < 5; ++k) { const int ch = lane + 64 * k; if (ch < 288) w[k] = row[ch]; }
#pragma unroll
        for (int k = 0; k < 5; ++k) { const int ch = lane + 64 * k; const float al = __shfl(al_lane, (ch < 288 ? ch : 0) >> 4);
            if (ch < 288) { u32x4 o;
                o.x = cvt_pk_bf16(bflo(w[k].x) * al, bfhi(w[k].x) * al); o.y = cvt_pk_bf16(bflo(w[k].y) * al, bfhi(w[k].y) * al);
                o.z = cvt_pk_bf16(bflo(w[k].z) * al, bfhi(w[k].z) * al); o.w = cvt_pk_bf16(bflo(w[k].w) * al, bfhi(w[k].w) * al);
                row[ch] = o; } }
    }
}

DI void phase_retention(const Params& p, LAS unsigned char* lds, int cblk) {
    const int tid = threadIdx.x, lane = tid & 63, w = tid >> 6, fr = lane & 15, fq = lane >> 4;
    LAS unsigned char* Qs = lds; LAS unsigned char* Ks = lds + 33792; LAS unsigned char* Vs = lds + 67584; LAS unsigned char* St = lds + 76800; LAS unsigned char* Ps = lds + 110592;
    LAS float* red = (LAS float*)(lds + 119808);
    const bf16_t* rq = (const bf16_t*)(p.ws + WS_RQ); const bf16_t* rk = (const bf16_t*)(p.ws + WS_RK); bf16_t* rv = (bf16_t*)p.out; float* retss = (float*)(p.ws + WS_RETSS);
    for (int item = cblk; item < 256; item += gridDim.x) {
        const int q5 = item >> 3, bh = (item & 7) * 4 + (q5 & 3), slice = q5 >> 2, b = bh >> 3, h = bh & 7;
        const float lg = log1pf(-exp2f(-5.0f - (float)h));
        const float gamma_c = expf(64.0f * lg);
        const float xv = expf(-lg * (float)((tid >> 3) + 1));
        const float xo0 = expf(lg * (float)(32 * (w & 1) + fr + 1)), xo1 = expf(lg * (float)(32 * (w & 1) + 16 + fr + 1));
        const size_t tok0 = (size_t)b * SEQ;
        const bf16_t* qbase = rq + tok0 * 2048 + h * 256 + (tid & 31) * 8; const bf16_t* kbase = rk + tok0 * 2048 + h * 256 + (tid & 31) * 8;
        bf16_t* vbase = rv + tok0 * 4096 + h * 512 + slice * 64;
        u32x4 pq[4], pk[4], pv;
        f32x4 Sreg[2][4];
#pragma unroll
        for (int a = 0; a < 2; ++a)
#pragma unroll
            for (int bb = 0; bb < 4; ++bb) Sreg[a][bb] = (f32x4){0.f, 0.f, 0.f, 0.f};
        for (int i = tid; i < 33792 / 16; i += 512) ((LAS u32x4*)St)[i] = (u32x4){0u, 0u, 0u, 0u};
#define RET_LOAD(c) do { _Pragma("unroll") for (int i = 0; i < 4; ++i) { const int row = (tid + 512 * i) >> 5; \
            pq[i] = *(const u32x4*)(qbase + (size_t)(64 * (c) + row) * 2048); pk[i] = *(const u32x4*)(kbase + (size_t)(64 * (c) + row) * 2048); } \
            pv = *(const u32x4*)(vbase + (size_t)(64 * (c) + (tid >> 3)) * 4096 + (tid & 7) * 8); } while (0)
#define RET_STORE() do { _Pragma("unroll") for (int i = 0; i < 4; ++i) { const int e = tid + 512 * i, row = e >> 5, pc = e & 31; \
            *(LAS u32x4*)(Qs + row * 528 + pc * 16) = pq[i]; *(LAS u32x4*)(Ks + row * 528 + pc * 16) = pk[i]; } \
            { u32x4 o; o.x = cvt_pk_bf16(bflo(pv.x) * xv, bfhi(pv.x) * xv); o.y = cvt_pk_bf16(bflo(pv.y) * xv, bfhi(pv.y) * xv); \
              o.z = cvt_pk_bf16(bflo(pv.z) * xv, bfhi(pv.z) * xv); o.w = cvt_pk_bf16(bflo(pv.w) * xv, bfhi(pv.w) * xv); \
              *(LAS u32x4*)(Vs + (tid >> 3) * 144 + (tid & 7) * 16) = o; } } while (0)
        RET_LOAD(0); RET_STORE();
        __syncthreads();
        for (int c = 0; c < 128; ++c) {
            if (c + 1 < 128) RET_LOAD(c + 1);
            bf16x8 qfr[8][2];
            {
                const int jt = w >> 1, it0 = (w & 1) * 2;
                f32x4 sa[2] = {(f32x4){0.f, 0.f, 0.f, 0.f}, (f32x4){0.f, 0.f, 0.f, 0.f}};
#pragma unroll
                for (int ks = 0; ks < 8; ++ks) {
                    const bf16x8 kf = *(const LAS bf16x8*)(Ks + (16 * jt + fr) * 528 + (32 * ks + 8 * fq) * 2);
#pragma unroll
                    for (int t = 0; t < 2; ++t) { qfr[ks][t] = *(const LAS bf16x8*)(Qs + (16 * (it0 + t) + fr) * 528 + (32 * ks + 8 * fq) * 2); sa[t] = mfma16(kf, qfr[ks][t], sa[t]); }
                }
#pragma unroll
                for (int t = 0; t < 2; ++t) { const int iq = 16 * (it0 + t) + fr, jk0 = 16 * jt + 4 * fq;
                    u32x2 o; o.x = cvt_pk_bf16(jk0 + 0 <= iq ? sa[t][0] : 0.f, jk0 + 1 <= iq ? sa[t][1] : 0.f); o.y = cvt_pk_bf16(jk0 + 2 <= iq ? sa[t][2] : 0.f, jk0 + 3 <= iq ? sa[t][3] : 0.f);
                    *(LAS u32x2*)(Ps + iq * 144 + jk0 * 2) = o; }
            }
            {
#pragma unroll
                for (int ks = 0; ks < 2; ++ks) {
                    const int j0 = 32 * ks + 8 * fq + (fr >> 2);
                    bf16x8 kt[2], vf[4];
#pragma unroll
                    for (int dd = 0; dd < 2; ++dd) { LAS unsigned char* a0 = Ks + j0 * 528 + (16 * (2 * w + dd) + 4 * (fr & 3)) * 2; kt[dd] = tr_read2(a0, a0 + 4 * 528); }
#pragma unroll
                    for (int vt = 0; vt < 4; ++vt) { LAS unsigned char* a0 = Vs + j0 * 144 + (16 * vt + 4 * (fr & 3)) * 2; vf[vt] = tr_read2(a0, a0 + 4 * 144); }
#pragma unroll
                    for (int dd = 0; dd < 2; ++dd)
#pragma unroll
                        for (int vt = 0; vt < 4; ++vt) Sreg[dd][vt] = mfma16(kt[dd], vf[vt], Sreg[dd][vt]);
                }
#pragma unroll
                for (int dd = 0; dd < 2; ++dd)
#pragma unroll
                    for (int vt = 0; vt < 4; ++vt) Sreg[dd][vt] *= gamma_c;
            }
            __syncthreads();
            {
                const int vt = w >> 1, it0 = (w & 1) * 2;
                f32x4 oa[2] = {(f32x4){0.f, 0.f, 0.f, 0.f}, (f32x4){0.f, 0.f, 0.f, 0.f}};
#pragma unroll
                for (int ks = 0; ks < 8; ++ks) {
                    const bf16x8 sf = *(const LAS bf16x8*)(St + (16 * vt + fr) * 528 + (32 * ks + 8 * fq) * 2);
#pragma unroll
                    for (int t = 0; t < 2; ++t) oa[t] = mfma16(sf, qfr[ks][t], oa[t]);
                }
#pragma unroll
                for (int ks = 0; ks < 2; ++ks) {
                    const int j0 = 32 * ks + 8 * fq + (fr >> 2);
                    LAS unsigned char* a0 = Vs + j0 * 144 + (16 * vt + 4 * (fr & 3)) * 2; const bf16x8 vf = tr_read2(a0, a0 + 4 * 144);
#pragma unroll
                    for (int t = 0; t < 2; ++t) { const bf16x8 pf = *(const LAS bf16x8*)(Ps + (16 * (it0 + t) + fr) * 144 + (32 * ks + 8 * fq) * 2); oa[t] = mfma16(vf, pf, oa[t]); }
                }
#pragma unroll
                for (int t = 0; t < 2; ++t) { const int iq = 16 * (it0 + t) + fr; oa[t] *= (t == 0 ? xo0 : xo1);
                    u32x2 o; o.x = cvt_pk_bf16(oa[t][0], oa[t][1]); o.y = cvt_pk_bf16(oa[t][2], oa[t][3]);
                    *(u32x2*)(vbase + (size_t)(64 * c + iq) * 4096 + 16 * vt + 4 * fq) = o;
                    float ss = (oa[t][0] * oa[t][0] + oa[t][1] * oa[t][1]) + (oa[t][2] * oa[t][2] + oa[t][3] * oa[t][3]);
                    ss += __shfl_xor(ss, 16); ss += __shfl_xor(ss, 32);
                    if (fq == 0) red[iq * 4 + vt] = ss; }
            }
            __syncthreads();
#pragma unroll
            for (int dd = 0; dd < 2; ++dd)
#pragma unroll
                for (int vt = 0; vt < 4; ++vt) { u32x2 o; o.x = cvt_pk_bf16(Sreg[dd][vt][0], Sreg[dd][vt][1]); o.y = cvt_pk_bf16(Sreg[dd][vt][2], Sreg[dd][vt][3]);
                    *(LAS u32x2*)(St + (16 * vt + fr) * 528 + (16 * (2 * w + dd) + 4 * fq) * 2) = o; }
            if (c + 1 < 128) RET_STORE();
            if (tid < 64) retss[((tok0 + 64 * c + tid) * 8 + h) * 8 + slice] = (red[tid * 4 + 0] + red[tid * 4 + 1]) + (red[tid * 4 + 2] + red[tid * 4 + 3]);
            __syncthreads();
        }
#undef RET_LOAD
#undef RET_STORE
    }
}

DI void phase_attention(const Params& p, LAS unsigned char* lds) {
    const int tid = threadIdx.x, lane = tid & 63, w = tid >> 6, fr = lane & 15, fq = lane >> 4;
    LAS unsigned char* Ks = lds; LAS unsigned char* Vs = lds + 69632;
    bf16_t* aq = (bf16_t*)(p.ws + WS_AQ); const bf16_t* ak = (const bf16_t*)(p.ws + WS_AK); const bf16_t* av = (const bf16_t*)(p.ws + WS_AV); float* lse = (float*)(p.ws + WS_LSE);
    const int per = (4608 + (int)gridDim.x - 1) / (int)gridDim.x, it_lo = (int)blockIdx.x * per, it_hi = (it_lo + per < 4608) ? it_lo + per : 4608;
    int prev_key = -1;
    u32x4 kcur[4], vcur[4];
#define ATT_LOAD_CUR(item_) do { const int bh_ = (item_) >> 6, e64_ = (item_) & 63, head_ = bh_ % 18, b_ = bh_ / 18; \
        const int rsh_ = 2 * (head_ / 6), r_ = 1 << rsh_, nbc_ = 64 >> rsh_, cls_ = e64_ / nbc_, nb_ = e64_ - cls_ * nbc_; \
        _Pragma("unroll") for (int i = 0; i < 4; ++i) { const int e = tid + 512 * i, row = e >> 4, pc = e & 15; \
            const size_t off = ((size_t)b_ * SEQ + (size_t)(nb_ * 128 + row) * r_ + cls_) * 2304 + head_ * 128 + pc * 8; \
            kcur[i] = *(const u32x4*)(ak + off); vcur[i] = *(const u32x4*)(av + off); } } while (0)
    if (it_lo < it_hi) ATT_LOAD_CUR(it_lo);
    for (int item = it_lo, cnt = 0; item < it_hi; ++item, ++cnt) {
        const int bh = item >> 6, e64 = item & 63, head = bh % 18, b = bh / 18;
        const int g = head / 6, rsh = 2 * g, r = 1 << rsh, nbc = 64 >> rsh, cls = e64 / nbc, nb = e64 - cls * nbc;
        const int pq0 = nb * 128, pk0 = pq0 - 128;
        const size_t tokb = (size_t)b * SEQ;
        const int scur = cnt & 1, sprev = scur ^ 1;
        const bool reuse = (nb > 0) && (prev_key == item - 1);
#pragma unroll
        for (int i = 0; i < 4; ++i) { const int e = tid + 512 * i, row = e >> 4, pc = e & 15;
            *(LAS u32x4*)(Ks + (scur * 128 + row) * 272 + pc * 16) = kcur[i]; *(LAS u32x4*)(Vs + (scur * 128 + row) * 288 + pc * 16) = vcur[i]; }
        if (!reuse) {
#pragma unroll
            for (int i = 0; i < 4; ++i) { const int e = tid + 512 * i, row = e >> 4, pc = e & 15;
                u32x4 kv = {0u, 0u, 0u, 0u}, vv = kv;
                if (nb > 0) { const size_t off = (tokb + (size_t)(pk0 + row) * r + cls) * 2304 + head * 128 + pc * 8; kv = *(const u32x4*)(ak + off); vv = *(const u32x4*)(av + off); }
                *(LAS u32x4*)(Ks + (sprev * 128 + row) * 272 + pc * 16) = kv; *(LAS u32x4*)(Vs + (sprev * 128 + row) * 288 + pc * 16) = vv; }
        }
        if (item + 1 < it_hi) ATT_LOAD_CUR(item + 1);
        prev_key = item;
        const int qq = 16 * w + fr;
        const size_t tokq = tokb + (size_t)(pq0 + qq) * r + cls;
        bf16x8 qf[4];
        { const bf16_t* qp = aq + tokq * 2304 + head * 128 + 8 * fq;
#pragma unroll
          for (int ks = 0; ks < 4; ++ks) qf[ks] = *(const bf16x8*)(qp + 32 * ks); }
        __syncthreads();
        f32x4 sa[10];
#pragma unroll
        for (int kt = 0; kt < 10; ++kt) { sa[kt] = (f32x4){0.f, 0.f, 0.f, 0.f};
            const int T = (w + kt < 16) ? w + kt : 15;
            const int krow = ((T < 8) ? sprev : scur) * 128 + 16 * (T & 7) + fr;
#pragma unroll
            for (int ks = 0; ks < 4; ++ks) { const bf16x8 kf = *(const LAS bf16x8*)(Ks + krow * 272 + (32 * ks + 8 * fq) * 2); sa[kt] = mfma16(kf, qf[ks], sa[kt]); } }
        const float sc2 = 0.08838834764831845f * 1.4426950408889634f;
        float mrow = -INFINITY;
#pragma unroll
        for (int kt = 0; kt < 10; ++kt)
#pragma unroll
            for (int j = 0; j < 4; ++j) { const int kk = 16 * (w + kt) + 4 * fq + j; const bool valid = (kk >= qq) && (kk <= qq + 128) && (pk0 + kk >= 0);
                const float sv = valid ? sa[kt][j] * sc2 : -INFINITY; sa[kt][j] = sv; mrow = fmaxf(mrow, sv); }
        mrow = fmaxf(mrow, __shfl_xor(mrow, 16)); mrow = fmaxf(mrow, __shfl_xor(mrow, 32));
        float lsum = 0.f;
        bf16x8 pf[5];
#pragma unroll
        for (int t = 0; t < 5; ++t) { f32x4 p0, p1;
#pragma unroll
            for (int j = 0; j < 4; ++j) { p0[j] = __builtin_amdgcn_exp2f(sa[2 * t][j] - mrow); p1[j] = __builtin_amdgcn_exp2f(sa[2 * t + 1][j] - mrow); lsum += p0[j] + p1[j]; }
            const u32x4 pk4 = pack8(p0, p1); pf[t] = __builtin_bit_cast(bf16x8, pk4); }
        lsum += __shfl_xor(lsum, 16); lsum += __shfl_xor(lsum, 32);
        f32x4 oa[8];
#pragma unroll
        for (int dt = 0; dt < 8; ++dt) oa[dt] = (f32x4){0.f, 0.f, 0.f, 0.f};
#pragma unroll
        for (int t = 0; t < 5; ++t) {
            const int T0 = w + 2 * t, T1 = (T0 + 1 < 16) ? T0 + 1 : T0;
            const int r0 = ((T0 < 8) ? sprev : scur) * 128 + 16 * (T0 & 7) + 4 * fq + (fr >> 2), r1 = ((T1 < 8) ? sprev : scur) * 128 + 16 * (T1 & 7) + 4 * fq + (fr >> 2);
            LAS unsigned char* a0 = Vs + r0 * 288 + (4 * (fr & 3)) * 2; LAS unsigned char* a1 = Vs + r1 * 288 + (4 * (fr & 3)) * 2;
#pragma unroll
            for (int dt = 0; dt < 8; ++dt) { const bf16x8 vf = tr_read2(a0 + 32 * dt, a1 + 32 * dt); oa[dt] = mfma16(vf, pf[t], oa[dt]); }
        }
        const float inv = __builtin_amdgcn_rcpf(lsum);
        bf16_t* po = aq + tokq * 2304 + head * 128 + 4 * fq;
#pragma unroll
        for (int dt = 0; dt < 8; ++dt) { u32x2 o; o.x = cvt_pk_bf16(oa[dt][0] * inv, oa[dt][1] * inv); o.y = cvt_pk_bf16(oa[dt][2] * inv, oa[dt][3] * inv); *(u32x2*)(po + 16 * dt) = o; }
        if (fq == 0) lse[tokq * 18 + head] = mrow * 0.6931471805599453f + __logf(lsum);
        __syncthreads();
    }
#undef ATT_LOAD_CUR
}

constexpr size_t WS_BAR = 700000;
DI void grid_barrier(unsigned* bar, unsigned& nbar, const bool hier, const unsigned xcd, const unsigned per_xcd) {
    asm volatile("s_waitcnt vmcnt(0)" ::: "memory");
    __syncthreads();
    if (threadIdx.x == 0) {
        __builtin_amdgcn_fence(__ATOMIC_RELEASE, "agent");
        asm volatile("s_waitcnt vmcnt(0)" ::: "memory");
        const unsigned gen = nbar + 1u;
        if (hier) {
            unsigned* xc = bar + 256 + 64 * xcd; unsigned* top = bar + 1024;
            const unsigned old = __hip_atomic_fetch_add(xc, 1u, __ATOMIC_RELAXED, __HIP_MEMORY_SCOPE_AGENT);
            if (old + 1u == gen * per_xcd) __hip_atomic_fetch_add(top, 1u, __ATOMIC_RELAXED, __HIP_MEMORY_SCOPE_AGENT);
            while (__hip_atomic_load(top, __ATOMIC_RELAXED, __HIP_MEMORY_SCOPE_AGENT) < gen * 8u) __builtin_amdgcn_s_sleep(1);
        } else {
            const unsigned target = gen * gridDim.x;
            __hip_atomic_fetch_add(bar, 1u, __ATOMIC_RELAXED, __HIP_MEMORY_SCOPE_AGENT);
            while (__hip_atomic_load(bar, __ATOMIC_RELAXED, __HIP_MEMORY_SCOPE_AGENT) < target) __builtin_amdgcn_s_sleep(1);
        }
        __builtin_amdgcn_fence(__ATOMIC_ACQUIRE, "agent");
        asm volatile("s_waitcnt vmcnt(0)" ::: "memory");
    }
    __syncthreads();
    ++nbar;
}

constexpr int N_PHASES = 13;
__global__ void __launch_bounds__(512, 2) mega(Params p) {
    extern __shared__ __attribute__((aligned(16))) unsigned char shm[];
    LAS unsigned char* lds = (LAS unsigned char*)shm;
    unsigned char* ws = p.ws;
    const int G = gridDim.x, c = blockIdx.x;
    unsigned* bar = (unsigned*)(ws + WS_BAR); unsigned nbar = 0;
    int c_eff = c; unsigned my_xcd = 0, my_idx = 0; bool hier = false;
    if (p.ph_hi - p.ph_lo > 1) {
        my_xcd = (unsigned)__builtin_amdgcn_s_getreg((3 << 11) | 20) & 0xFu;
        if (threadIdx.x == 0) my_idx = __hip_atomic_fetch_add(bar + 64 + 16 * (my_xcd & 7u), 1u, __ATOMIC_RELAXED, __HIP_MEMORY_SCOPE_AGENT);
        my_idx = (unsigned)__builtin_amdgcn_readfirstlane((int)my_idx);
    }
    if (p.ph_lo <= 0 && 0 < p.ph_hi) {
        if (0 > p.ph_lo) grid_barrier(bar, nbar, hier, my_xcd, (unsigned)G / 8u);

#if (PHMASK >> 0) & 1
            phase0(p, lds);
#endif
    }
    if (p.ph_lo <= 1 && 1 < p.ph_hi) {
        if (1 > p.ph_lo) cg::this_grid().sync();
        if (p.ph_hi - p.ph_lo > 1) {
            LAS unsigned* cw = (LAS unsigned*)lds;
            if (threadIdx.x == 0) {
                bool ok = (G % 8) == 0 && my_xcd < 8u;
                for (int x = 0; x < 8; ++x) ok = ok && (__hip_atomic_load(bar + 64 + 16 * x, __ATOMIC_RELAXED, __HIP_MEMORY_SCOPE_AGENT) == (unsigned)(G / 8));
                cw[0] = ok ? (my_idx * 8u + my_xcd) : (unsigned)c; cw[1] = ok ? 1u : 0u;
            }
            __syncthreads();
            c_eff = __builtin_amdgcn_readfirstlane((int)cw[0]);
            hier = (cw[1] != 0u);
            __syncthreads();
        }

#if (PHMASK >> 1) & 1
            phase_h(p);
#endif
    }
    if (p.ph_lo <= 2 && 2 < p.ph_hi) {
        if (2 > p.ph_lo) grid_barrier(bar, nbar, hier, my_xcd, (unsigned)G / 8u);

#if (PHMASK >> 2) & 1
            pg8::Gemm g{(const bf16_t*)(ws + WS_H), (const bf16_t*)(ws + WS_WIN), T_TOK, 59 * 256, 2048, nullptr, nullptr, 0}; pg8::StaticOrder S; S.init(T_TOK, 59 * 256, G, c_eff, 32, 16);
            EpiInProj E{(bf16_t*)(ws + WS_RQ), (bf16_t*)(ws + WS_RK), (bf16_t*)p.out, (bf16_t*)(ws + WS_AQ), (bf16_t*)(ws + WS_AK), (bf16_t*)(ws + WS_AV), p.pos};
            pg8::gemm_phase<1>(lds, g, S, E);
#endif
    }
    if (p.ph_lo <= 3 && 3 < p.ph_hi) {
        if (3 > p.ph_lo) grid_barrier(bar, nbar, hier, my_xcd, (unsigned)G / 8u);

#if (PHMASK >> 3) & 1
            phase_retention(p, lds, c_eff); __syncthreads();
#endif
#if (PHMASK >> 13) & 1
            phase_attention(p, lds);
#endif
    }
    if (p.ph_lo <= 4 && 4 < p.ph_hi) {
        if (4 > p.ph_lo) grid_barrier(bar, nbar, hier, my_xcd, (unsigned)G / 8u);

#if (PHMASK >> 4) & 1
            { pg8::Gemm g{(const bf16_t*)(ws + WS_H), (const bf16_t*)(ws + WS_WIN) + (size_t)8192 * 2048, T_TOK, 4096, 2048, nullptr, nullptr, 0}; pg8::StaticOrder S; S.init(T_TOK, 4096, G, c_eff);
              EpiRetGate E{(bf16_t*)p.out, (const float*)(ws + WS_RETSS), p.ret_gain}; pg8::gemm_phase<1>(lds, g, S, E); }
#endif
#if (PHMASK >> 14) & 1
            { pg8::Gemm g{(const bf16_t*)(ws + WS_H), (const bf16_t*)(ws + WS_WGATE), T_TOK, 4096, 2048, nullptr, nullptr, 0}; pg8::StaticOrder S; S.init(T_TOK, 4096, G, c_eff);
              EpiGates E{(bf16_t*)(ws + WS_GATES), p.b_gate}; pg8::gemm_phase<1>(lds, g, S, E); }
#endif
#if (PHMASK >> 15) & 1
            phase_alpha(p);
#endif
    }
    if (p.ph_lo <= 5 && 5 < p.ph_hi) {
        if (5 > p.ph_lo) grid_barrier(bar, nbar, hier, my_xcd, (unsigned)G / 8u);

#if (PHMASK >> 5) & 1
            pg8::Gemm g{(const bf16_t*)p.out, (const bf16_t*)(ws + WS_WRET), T_TOK, 2048, 4096, (const bf16_t*)(ws + WS_AQ), (const bf16_t*)(ws + WS_WATT), 2304}; pg8::StaticOrder S; S.init(T_TOK, 2048, G, c_eff);
            EpiYMerge E{(const bf16_t*)(ws + WS_GATES), (bf16_t*)(ws + WS_U2)}; pg8::gemm_phase<2>(lds, g, S, E);
#endif
    }
    if (p.ph_lo <= 7 && 7 < p.ph_hi) {
        if (7 > p.ph_lo) grid_barrier(bar, nbar, hier, my_xcd, (unsigned)G / 8u);

#if (PHMASK >> 7) & 1
            pg8::Gemm g{(const bf16_t*)(ws + WS_U2), (const bf16_t*)(ws + WS_WMIX), T_TOK, 2048, 2048, nullptr, nullptr, 0}; pg8::StaticOrder S; S.init(T_TOK, 2048, G, c_eff);
            EpiStoreBf16 E{(bf16_t*)(ws + WS_Y), 2048}; pg8::gemm_phase<1>(lds, g, S, E);
#endif
    }
    if (p.ph_lo <= 8 && 8 < p.ph_hi) {
        if (8 > p.ph_lo) grid_barrier(bar, nbar, hier, my_xcd, (unsigned)G / 8u);

#if (PHMASK >> 8) & 1
            phase_postmix(p);
#endif
    }
    if (p.ph_lo <= 9 && 9 < p.ph_hi) {
        if (9 > p.ph_lo) grid_barrier(bar, nbar, hier, my_xcd, (unsigned)G / 8u);

#if (PHMASK >> 9) & 1
            pg8::Gemm g{(const bf16_t*)(ws + WS_H2), (const bf16_t*)(ws + WS_WUP), T_TOK, FF, 2048, nullptr, nullptr, 0}; pg8::StaticOrder S; S.init(T_TOK, FF, G, c_eff);
            EpiStoreBf16 E{(bf16_t*)(ws + WS_A), FF}; pg8::gemm_phase<1>(lds, g, S, E);
#endif
    }
    if (p.ph_lo <= 10 && 10 < p.ph_hi) {
        if (10 > p.ph_lo) grid_barrier(bar, nbar, hier, my_xcd, (unsigned)G / 8u);

#if (PHMASK >> 10) & 1
            pg8::Gemm g{(const bf16_t*)(ws + WS_H2), (const bf16_t*)(ws + WS_WUP) + (size_t)FF * 2048, T_TOK, FF, 2048, nullptr, nullptr, 0}; pg8::StaticOrder S; S.init(T_TOK, FF, G, c_eff);
            EpiConvAct E{(const bf16_t*)(ws + WS_A), (bf16_t*)(ws + WS_ACT), p.conv_w, p.conv_b}; pg8::gemm_phase<1>(lds, g, S, E);
#endif
    }
    if (p.ph_lo <= 11 && 11 < p.ph_hi) {
        if (11 > p.ph_lo) grid_barrier(bar, nbar, hier, my_xcd, (unsigned)G / 8u);

#if (PHMASK >> 11) & 1
            pg8::Gemm g{(const bf16_t*)(ws + WS_ACT), (const bf16_t*)(ws + WS_WDOWN), T_TOK, 2048, FF, nullptr, nullptr, 0}; pg8::StaticOrder S; S.init(T_TOK, 2048, G, c_eff);
            EpiStoreBf16 E{(bf16_t*)(ws + WS_Y2), 2048}; pg8::gemm_phase<1>(lds, g, S, E);
#endif
    }
    if (p.ph_lo <= 12 && 12 < p.ph_hi) {
        if (12 > p.ph_lo) grid_barrier(bar, nbar, hier, my_xcd, (unsigned)G / 8u);

#if (PHMASK >> 12) & 1
            phase_final(p);
#endif
    }
}

extern "C" void kernel_launch(void* const* d_in, const int* in_sizes, int n_in, void* d_out, int out_size, void* d_ws, size_t ws_size, hipStream_t stream) {
    static int grid = 0;
    if (grid == 0) {
        if (n_in != 20 || ws_size < WS_END) { fprintf(stderr, "kernel_launch: unexpected n_in %d or ws_size %zu (need %zu)\n", n_in, ws_size, (size_t)WS_END); grid = -1; return; }
        int dev = 0, cus = 0, per_cu = 0;
        hipGetDevice(&dev); hipDeviceGetAttribute(&cus, hipDeviceAttributeMultiprocessorCount, dev);
        if (hipFuncSetAttribute((const void*)mega, hipFuncAttributeMaxDynamicSharedMemorySize, LDS_BYTES) != hipSuccess) { fprintf(stderr, "kernel_launch: hipFuncSetAttribute failed\n"); grid = -1; return; }
        if (hipOccupancyMaxActiveBlocksPerMultiprocessor(&per_cu, (const void*)mega, 512, LDS_BYTES) != hipSuccess || per_cu < 1) { fprintf(stderr, "kernel_launch: occupancy query says %d\n", per_cu); per_cu = 1; }
        (void)hipGetLastError();
        grid = cus * 1;
    }
    if (grid < 0) return;
    Params p{};
    p.x = (const float*)d_in[0]; p.c = (const float*)d_in[1]; p.pos = (const int*)d_in[2]; p.w_ada = (const float*)d_in[3]; p.b_ada = (const float*)d_in[4]; p.g_pre_mix = (const float*)d_in[5];
    p.w_in = (const float*)d_in[6]; p.ret_gain = (const float*)d_in[7]; p.w_ret_out = (const float*)d_in[8]; p.w_att_out = (const float*)d_in[9]; p.w_gate = (const float*)d_in[10]; p.b_gate = (const float*)d_in[11];
    p.w_mix = (const float*)d_in[12]; p.g_post_mix = (const float*)d_in[13]; p.g_pre_ffn = (const float*)d_in[14]; p.w_up = (const float*)d_in[15]; p.conv_w = (const float*)d_in[16]; p.conv_b = (const float*)d_in[17];
    p.w_down = (const float*)d_in[18]; p.g_post_ffn = (const float*)d_in[19];
    p.out = (float*)d_out; p.ws = (unsigned char*)d_ws;
    if (hipMemsetAsync((char*)d_ws + WS_BAR, 0, 8192, stream) != hipSuccess) { fprintf(stderr, "kernel_launch: memset failed\n"); return; }
#if N_LAUNCH_PER_PHASE
    for (int ph = 0; ph < N_PHASES; ++ph) { p.ph_lo = ph; p.ph_hi = ph + 1; hipLaunchKernelGGL(mega, dim3(grid), dim3(512), LDS_BYTES, stream, p); }
#else
    p.ph_lo = 0; p.ph_hi = N_PHASES;
    void* args[] = {&p};
    hipError_t e = hipLaunchCooperativeKernel((const void*)mega, dim3(grid), dim3(512), args, LDS_BYTES, stream);
    if (e != hipSuccess) fprintf(stderr, "cooperative launch failed: %s (grid %d)\n", hipGetErrorString(e), grid);
#endif
}
```

```cpp
#include <hip/hip_runtime.h>
#include <hip/hip_cooperative_groups.h>
#include <cstdio>
#include <cstdint>
namespace cg = cooperative_groups;

#define DI __device__ __forceinline__
#define LAS __attribute__((address_space(3)))
typedef unsigned short bf16_t;
typedef short bf16x8 __attribute__((ext_vector_type(8)));
typedef short s16x4 __attribute__((ext_vector_type(4)));
typedef float f32x4 __attribute__((ext_vector_type(4)));
typedef unsigned u32x4 __attribute__((ext_vector_type(4)));
typedef unsigned u32x2 __attribute__((ext_vector_type(2)));

#ifndef PHMASK
#define PHMASK 0xFFFF
#endif
#ifndef N_LAUNCH_PER_PHASE
#define N_LAUNCH_PER_PHASE 0
#endif

constexpr int T_TOK = 32768, DM = 2048, SEQ = 8192, NB = 4;
constexpr int FF = 5632;
constexpr int LDS_BYTES = 143360;
constexpr size_t MiB = 1u << 20;
constexpr size_t WS_ADA = 0;
constexpr size_t WS_LSE = 1 * MiB;
constexpr size_t WS_RETSS = 4 * MiB;
constexpr size_t WS_WUP = 12 * MiB;
constexpr size_t WS_WDOWN = 56 * MiB;
constexpr size_t WS_WIN = 78 * MiB;
constexpr size_t WS_WGATE = 153 * MiB;
constexpr size_t WS_WRET = 169 * MiB;
constexpr size_t WS_WATT = 185 * MiB;
constexpr size_t WS_WMIX = 194 * MiB;
constexpr size_t WS_H = 206 * MiB;
constexpr size_t WS_RQ = 334 * MiB;
constexpr size_t WS_RK = 462 * MiB;
constexpr size_t WS_AQ = 590 * MiB;
constexpr size_t WS_AK = 734 * MiB;
constexpr size_t WS_AV = 878 * MiB;
constexpr size_t WS_GATES = 334 * MiB;
constexpr size_t WS_U = 734 * MiB;
constexpr size_t WS_U2 = 206 * MiB;
constexpr size_t WS_Y = 334 * MiB;
constexpr size_t WS_H2 = 78 * MiB;
constexpr size_t WS_A = 206 * MiB;
constexpr size_t WS_ACT = 558 * MiB;
constexpr size_t WS_Y2 = 78 * MiB;
constexpr size_t WS_END = 1022 * MiB;

struct Params {
    const float *x, *c; const int* pos;
    const float *w_ada, *b_ada, *g_pre_mix, *w_in, *ret_gain, *w_ret_out, *w_att_out, *w_gate, *b_gate, *w_mix, *g_post_mix, *g_pre_ffn, *w_up, *conv_w, *conv_b, *w_down, *g_post_ffn;
    float* out; unsigned char* ws; int ph_lo, ph_hi;
};

typedef __bf16 bf16x2_t __attribute__((ext_vector_type(2)));
DI unsigned cvt_pk_bf16(float lo, float hi) { bf16x2_t v = {(__bf16)lo, (__bf16)hi}; return __builtin_bit_cast(unsigned, v); }
DI float bflo(unsigned w) { return __uint_as_float(w << 16); }
DI float bfhi(unsigned w) { return __uint_as_float(w & 0xffff0000u); }
DI float wave_sum(float v) {
#pragma unroll
    for (int o = 1; o < 64; o <<= 1) v += __shfl_xor(v, o);
    return v;
}
DI float sigmoidf_(float v) { return __builtin_amdgcn_rcpf(1.0f + __builtin_amdgcn_exp2f(-1.4426950408889634f * v)); }
DI f32x4 mfma16(bf16x8 a, bf16x8 b, f32x4 c) { return __builtin_amdgcn_mfma_f32_16x16x32_bf16(a, b, c, 0, 0, 0); }
DI s16x4 tr_read(LAS unsigned char* p) { return __builtin_amdgcn_ds_read_tr16_b64_v4i16((LAS s16x4*)p); }
DI bf16x8 tr_read2(LAS unsigned char* p0, LAS unsigned char* p1) { s16x4 lo = tr_read(p0), hi = tr_read(p1); return __builtin_shufflevector(lo, hi, 0, 1, 2, 3, 4, 5, 6, 7); }

namespace pg8 {
constexpr int BM = 256, BK = 64, HALF = 128, HTB = HALF * BK * 2, STAGE_BYTES = 8 * HTB, NXCD = 8, WGM = 8;
DI int lds_byte(int r, int c) { const int st = (r >> 4) * 2 + (c >> 5), rr = r & 15, cc = c & 31, ob = rr * 64 + cc * 2; return st * 1024 + (ob ^ (((ob >> 9) & 1) << 5)); }
DI void stage_rc(int b, int& R, int& C) { const int st = b / 1024, sb = b % 1024, swz = sb ^ (((sb >> 9) & 1) << 5); R = (st >> 1) * 16 + swz / 64; C = (st & 1) * 32 + (swz % 64) / 2; }
struct Unit { int pm, pn; };
struct Gemm { const bf16_t* A; const bf16_t* Bt; int M, N, K; const bf16_t* A1; const bf16_t* Bt1; int K1; };
struct StaticOrder {
    int nM, nN, nwg, G, c, skip_lo, skip_n;
    DI void init(int M, int N, int G_, int c_, int slo = 1 << 30, int sn = 0) { nM = M / BM; nN = N / BM; nwg = nM * nN; G = G_; c = c_; skip_lo = slo; skip_n = sn; }
    DI bool next(int i, Unit& u) const {
        const long L = (long)i * G + c; if (L >= nwg) return false;
        int wgid = (int)L; { const int q = nwg / NXCD, r = nwg % NXCD, xcd = wgid % NXCD, off = wgid / NXCD; wgid = (xcd < r ? xcd * (q + 1) : r * (q + 1) + (xcd - r) * q) + off; }
        const int nig = WGM * nN, gid = wgid / nig, fm = gid * WGM, gsz = (nM - fm) < WGM ? (nM - fm) : WGM;
        u.pm = fm + ((wgid % nig) % gsz); u.pn = (wgid % nig) / gsz; if (u.pn >= skip_lo) u.pn += skip_n; return true;
    }
};

#ifndef PG8_ALIGN
#define PG8_ALIGN true
#endif
#ifndef PG8_SP2
#define PG8_SP2 true
#endif
template <int NSEG, class Epi, bool ALIGN_EPI = PG8_ALIGN, bool SP2 = PG8_SP2>
DI void gemm_phase(LAS unsigned char* lds, const Gemm g, const StaticOrder& S, const Epi& E) {
    const int tid = threadIdx.x, wid = __builtin_amdgcn_readfirstlane(tid >> 6), lane = tid & 63, wr = wid >> 2, wc = wid & 3, fr = lane & 15, fq = lane >> 4;
    int Rr[2], Cc[2];
#pragma unroll
    for (int i = 0; i < 2; ++i) stage_rc(tid * 16 + i * 8192, Rr[i], Cc[i]);
    const size_t kstep = (size_t)(BK * 2);
    const unsigned ldsw = (unsigned)wid * 1024u;
    const int aoff = lds_byte(wr * 64 + fr, fq * 8), boff = lds_byte(wc * 32 + fr, fq * 8);
#define PG8_SA(b, h) (((b) * 2 + (h)) * HTB)
#define PG8_SB(b, h) ((4 + (b) * 2 + (h)) * HTB)
#define PG8_STAGE(bufoff, gbase, VO) do { _Pragma("unroll") for (int _i = 0; _i < 2; ++_i) \
        __builtin_amdgcn_global_load_lds((const unsigned*)((const char*)(gbase) + VO[_i]), (LAS unsigned*)(lds + (bufoff) + ldsw + _i * 8192), 16, 0, 0); } while (0)
#define PG8_LDA(dst, b, h) do { _Pragma("unroll") for (int m = 0; m < 4; ++m) _Pragma("unroll") for (int k = 0; k < 2; ++k) dst[m][k] = *(const LAS bf16x8*)(lds + PG8_SA(b, h) + aoff + m * 2048 + k * 1024); } while (0)
#define PG8_LDB(dst, b, h) do { _Pragma("unroll") for (int n = 0; n < 2; ++n) _Pragma("unroll") for (int k = 0; k < 2; ++k) dst[n][k] = *(const LAS bf16x8*)(lds + PG8_SB(b, h) + boff + n * 2048 + k * 1024); } while (0)
#define PG8_MMA(ai, bj, At, Bt) do { __builtin_amdgcn_s_setprio(1); _Pragma("unroll") for (int m = 0; m < 4; ++m) _Pragma("unroll") for (int n = 0; n < 2; ++n) _Pragma("unroll") for (int k = 0; k < 2; ++k) \
        acc[ai][bj][m][n] = __builtin_amdgcn_mfma_f32_16x16x32_bf16(Bt[n][k], At[m][k], acc[ai][bj][m][n], 0, 0, 0); __builtin_amdgcn_s_setprio(0); } while (0)
#define PG8_WAIT_V(n) asm volatile("s_waitcnt vmcnt(" #n ")" ::: "memory")
#define PG8_WAIT_L(n) asm volatile("s_waitcnt lgkmcnt(" #n ")" ::: "memory")
#define PG8_BAR __builtin_amdgcn_s_barrier()
#define PG8_SCHED __builtin_amdgcn_sched_barrier(0)
    Unit cur, nxt; int ti = 0, seg = 0;
    if (!S.next(0, cur)) return;
    f32x4 acc[2][2][4][2];
#pragma unroll
    for (int a = 0; a < 2; ++a)
#pragma unroll
        for (int b = 0; b < 2; ++b)
#pragma unroll
            for (int m = 0; m < 4; ++m)
#pragma unroll
                for (int n = 0; n < 2; ++n) acc[a][b][m][n] = (f32x4){0.f, 0.f, 0.f, 0.f};
    bf16x8 At[4][2], B0[2][2], B1[2][2];
    int Kc = g.K;
    unsigned voffC[2];
#pragma unroll
    for (int i = 0; i < 2; ++i) voffC[i] = (unsigned)(Rr[i] * Kc + Cc[i]) * 2u;
    size_t hstepC = (size_t)HALF * Kc * 2;
    const char* cA = (const char*)g.A + (size_t)cur.pm * 2 * hstepC; const char* cB = (const char*)g.Bt + (size_t)cur.pn * 2 * hstepC;
    if constexpr (SP2) {
        PG8_STAGE(PG8_SB(0, 0), cB, voffC); PG8_STAGE(PG8_SB(0, 1), cB + hstepC, voffC); PG8_STAGE(PG8_SA(0, 0), cA, voffC); PG8_STAGE(PG8_SA(0, 1), cA + hstepC, voffC);
        if (wr == 1) PG8_BAR;
        PG8_WAIT_V(2); PG8_BAR;
        PG8_STAGE(PG8_SB(1, 0), cB + kstep, voffC); PG8_STAGE(PG8_SA(1, 0), cA + kstep, voffC); PG8_STAGE(PG8_SB(1, 1), cB + hstepC + kstep, voffC);
        PG8_WAIT_V(6); PG8_BAR;
    } else {
        PG8_STAGE(PG8_SB(0, 0), cB, voffC); PG8_STAGE(PG8_SA(0, 0), cA, voffC); PG8_STAGE(PG8_SB(0, 1), cB + hstepC, voffC); PG8_STAGE(PG8_SA(0, 1), cA + hstepC, voffC);
        if (wr == 1) PG8_BAR;
        PG8_WAIT_V(4); PG8_BAR;
        PG8_STAGE(PG8_SB(1, 0), cB + kstep, voffC); PG8_STAGE(PG8_SA(1, 0), cA + kstep, voffC); PG8_STAGE(PG8_SB(1, 1), cB + hstepC + kstep, voffC);
        PG8_WAIT_V(6); PG8_BAR;
    }
    for (;;) {
        bool has_next; int nseg = 0;
        if (NSEG > 1 && seg + 1 < NSEG) { has_next = true; nxt = cur; nseg = seg + 1; }
        else has_next = S.next(ti + 1, nxt);
        int Kn = Kc; const char* nA = cA; const char* nB = cB;
        if (has_next) { Kn = (NSEG > 1 && nseg == 1) ? g.K1 : g.K;
            nA = (const char*)((NSEG > 1 && nseg == 1) ? g.A1 : g.A) + (size_t)nxt.pm * 256 * Kn * 2; nB = (const char*)((NSEG > 1 && nseg == 1) ? g.Bt1 : g.Bt) + (size_t)nxt.pn * 256 * Kn * 2; }
        unsigned voffN[2];
#pragma unroll
        for (int i = 0; i < 2; ++i) voffN[i] = (NSEG > 1) ? (unsigned)(Rr[i] * Kn + Cc[i]) * 2u : voffC[i];
        const size_t hstepN = (NSEG > 1) ? (size_t)HALF * Kn * 2 : hstepC;
        const int nt = Kc / BK;
        for (int t = 0; t < nt; t += 2) {
            const bool last = (t == nt - 2);
            const char* a1 = cA + (size_t)(t + 1) * kstep;
            const char* a2 = last ? nA : cA + (size_t)(t + 2) * kstep; const char* b2 = last ? nB : cB + (size_t)(t + 2) * kstep;
            const char* a3 = a2 + kstep; const char* b3 = b2 + kstep;
            unsigned v2[2]; v2[0] = (NSEG > 1 && last) ? voffN[0] : voffC[0]; v2[1] = (NSEG > 1 && last) ? voffN[1] : voffC[1];
            const size_t h2 = (NSEG > 1 && last) ? hstepN : hstepC;
            if constexpr (SP2) {
            PG8_LDB(B0, 0, 0); PG8_LDB(B1, 0, 1); PG8_SCHED; PG8_LDA(At, 0, 0); PG8_STAGE(PG8_SA(1, 1), a1 + hstepC, voffC);
            PG8_WAIT_V(8); PG8_WAIT_L(0); PG8_BAR; PG8_MMA(0, 0, At, B0); PG8_MMA(0, 1, At, B1); PG8_BAR; PG8_SCHED;
            PG8_LDA(At, 0, 1); PG8_STAGE(PG8_SB(0, 0), b2, v2); PG8_STAGE(PG8_SB(0, 1), b2 + h2, v2); PG8_STAGE(PG8_SA(0, 0), a2, v2);
            PG8_WAIT_V(8); PG8_WAIT_L(0); PG8_BAR; PG8_MMA(1, 0, At, B0); PG8_MMA(1, 1, At, B1); PG8_BAR; PG8_SCHED;
            PG8_LDB(B0, 1, 0); PG8_LDB(B1, 1, 1); PG8_SCHED; PG8_LDA(At, 1, 0); PG8_STAGE(PG8_SA(0, 1), a2 + h2, v2);
            PG8_WAIT_V(8); PG8_WAIT_L(0); PG8_BAR; PG8_MMA(0, 0, At, B0); PG8_MMA(0, 1, At, B1); PG8_BAR; PG8_SCHED;
            PG8_LDA(At, 1, 1); PG8_STAGE(PG8_SB(1, 0), b3, v2); PG8_STAGE(PG8_SB(1, 1), b3 + h2, v2); PG8_STAGE(PG8_SA(1, 0), a3, v2);
            PG8_WAIT_V(8); PG8_WAIT_L(0); PG8_BAR; PG8_MMA(1, 0, At, B0); PG8_MMA(1, 1, At, B1); PG8_BAR; PG8_SCHED;
            } else {
            PG8_LDB(B0, 0, 0); PG8_SCHED; PG8_LDA(At, 0, 0); PG8_STAGE(PG8_SA(1, 1), a1 + hstepC, voffC);
            PG8_WAIT_L(8); PG8_BAR; PG8_WAIT_L(0); PG8_MMA(0, 0, At, B0); PG8_BAR; PG8_SCHED;
            PG8_LDB(B1, 0, 1); PG8_STAGE(PG8_SB(0, 0), b2, v2);
            PG8_BAR; PG8_WAIT_L(0); PG8_MMA(0, 1, At, B1); PG8_BAR;
            PG8_LDA(At, 0, 1); PG8_STAGE(PG8_SA(0, 0), a2, v2);
            PG8_BAR; PG8_WAIT_L(0); PG8_MMA(1, 0, At, B0); PG8_BAR; PG8_SCHED;
            PG8_STAGE(PG8_SB(0, 1), b2 + h2, v2);
            PG8_WAIT_V(6); PG8_BAR; PG8_MMA(1, 1, At, B1); PG8_BAR;
            PG8_LDB(B0, 1, 0); PG8_SCHED; PG8_LDA(At, 1, 0); PG8_STAGE(PG8_SA(0, 1), a2 + h2, v2);
            PG8_WAIT_L(8); PG8_BAR; PG8_WAIT_L(0); PG8_MMA(0, 0, At, B0); PG8_BAR; PG8_SCHED;
            PG8_LDB(B1, 1, 1); PG8_STAGE(PG8_SB(1, 0), b3, v2);
            PG8_BAR; PG8_WAIT_L(0); PG8_MMA(0, 1, At, B1); PG8_BAR;
            PG8_LDA(At, 1, 1); PG8_STAGE(PG8_SA(1, 0), a3, v2);
            PG8_BAR; PG8_WAIT_L(0); PG8_MMA(1, 0, At, B0); PG8_BAR; PG8_SCHED;
            PG8_STAGE(PG8_SB(1, 1), b3 + h2, v2);
            PG8_WAIT_V(6); PG8_BAR; PG8_MMA(1, 1, At, B1); PG8_BAR;
            }
        }
        if constexpr (ALIGN_EPI) { if (wr == 0) PG8_BAR; }
        if constexpr (NSEG > 1) { if (seg + 1 < NSEG) E.mid(acc, cur, wr, wc, fr, fq); else E(acc, cur, wr, wc, fr, fq); }
        else E(acc, cur, wr, wc, fr, fq);
        if (!has_next) break;
        if (NSEG == 1 || nseg == 0) {
#pragma unroll
            for (int a = 0; a < 2; ++a)
#pragma unroll
                for (int b = 0; b < 2; ++b)
#pragma unroll
                    for (int m = 0; m < 4; ++m)
#pragma unroll
                        for (int n = 0; n < 2; ++n) acc[a][b][m][n] = (f32x4){0.f, 0.f, 0.f, 0.f};
            ++ti;
        }
        cur = nxt; cA = nA; cB = nB; seg = nseg;
        if (NSEG > 1) { Kc = Kn; voffC[0] = voffN[0]; voffC[1] = voffN[1]; hstepC = hstepN; }
        if constexpr (ALIGN_EPI) { if (wr == 1) PG8_BAR; }
    }
    PG8_WAIT_V(0);
    if constexpr (!ALIGN_EPI) { if (wr == 0) PG8_BAR; }
    PG8_BAR;
#undef PG8_SA
#undef PG8_SB
#undef PG8_STAGE
#undef PG8_LDA
#undef PG8_LDB
#undef PG8_MMA
#undef PG8_WAIT_V
#undef PG8_WAIT_L
#undef PG8_BAR
#undef PG8_SCHED
}
}
using pg8::Unit;
typedef f32x4 AccT[2][2][4][2];

DI u32x4 pack8(const f32x4& v0, const f32x4& v1) { u32x4 w; w.x = cvt_pk_bf16(v0[0], v0[1]); w.y = cvt_pk_bf16(v0[2], v0[3]); w.z = cvt_pk_bf16(v1[0], v1[1]); w.w = cvt_pk_bf16(v1[2], v1[3]); return w; }

struct EpiStoreBf16 {
    bf16_t* O; int ld;
    DI void operator()(const AccT& acc, const Unit& u, int wr, int wc, int fr, int fq) const {
        const int row0 = u.pm * 256 + wr * 64 + fr, col0 = u.pn * 256 + wc * 32 + 8 * fq;
#pragma unroll
        for (int ai = 0; ai < 2; ++ai)
#pragma unroll
            for (int m = 0; m < 4; ++m) { bf16_t* rowp = O + (size_t)(row0 + ai * 128 + m * 16) * ld + col0;
#pragma unroll
                for (int bj = 0; bj < 2; ++bj) *(u32x4*)(rowp + bj * 128) = pack8(acc[ai][bj][m][0], acc[ai][bj][m][1]); }
    }
};

template <int HD>
DI void rope_store(const AccT& acc, int rowbase, const int* pos, bf16_t* dst, int ld, int c1, int half, int ibase, float scale) {
    int pi[2][4];
#pragma unroll
    for (int ai = 0; ai < 2; ++ai)
#pragma unroll
        for (int m = 0; m < 4; ++m) pi[ai][m] = pos[rowbase + ai * 128 + m * 16];
    float invf[2][4];
#pragma unroll
    for (int n = 0; n < 2; ++n)
#pragma unroll
        for (int j = 0; j < 4; ++j) invf[n][j] = exp2f(-(float)(ibase + 4 * n + j) * (2.0f / HD) * 13.287712379549449f);
#pragma unroll
    for (int ai = 0; ai < 2; ++ai)
#pragma unroll
        for (int m = 0; m < 4; ++m) {
            const int row = rowbase + ai * 128 + m * 16; const float ps = (float)pi[ai][m];
            f32x4 o1[2], o2[2];
#pragma unroll
            for (int n = 0; n < 2; ++n)
#pragma unroll
                for (int j = 0; j < 4; ++j) {
                    const float ang = ps * invf[n][j]; const float rev = __builtin_amdgcn_fractf(ang * 0.15915494309189535f);
                    const float sn = __builtin_amdgcn_sinf(rev), cs = __builtin_amdgcn_cosf(rev);
                    const float t1 = acc[ai][0][m][n][j], t2 = acc[ai][1][m][n][j];
                    o1[n][j] = (t1 * cs - t2 * sn) * scale; o2[n][j] = (t2 * cs + t1 * sn) * scale;
                }
            bf16_t* rowp = dst + (size_t)row * ld + c1;
            *(u32x4*)rowp = pack8(o1[0], o1[1]); *(u32x4*)(rowp + half) = pack8(o2[0], o2[1]);
        }
}

struct EpiInProj {
    bf16_t *rq, *rk, *rv, *aq, *ak, *av; const int* pos;
    DI void operator()(const AccT& acc, const Unit& u, int wr, int wc, int fr, int fq) const {
        const int pn = u.pn, rowbase = u.pm * 256 + wr * 64 + fr;
        if (pn < 16) {
            bf16_t* dst = pn < 8 ? rq : rk; const float scale = pn < 8 ? 1.0f : 0.0625f;
            rope_store<256>(acc, rowbase, pos, dst, 2048, 256 * (pn & 7) + 32 * wc + 8 * fq, 128, 32 * wc + 8 * fq, scale);
        } else if (pn < 32) {
            const int col0 = (pn - 16) * 256 + wc * 32 + 8 * fq;
#pragma unroll
            for (int ai = 0; ai < 2; ++ai)
#pragma unroll
                for (int m = 0; m < 4; ++m) { bf16_t* rowp = rv + (size_t)(rowbase + ai * 128 + m * 16) * 4096 + col0;
#pragma unroll
                    for (int bj = 0; bj < 2; ++bj) *(u32x4*)(rowp + bj * 128) = pack8(acc[ai][bj][m][0], acc[ai][bj][m][1]); }
        } else if (pn < 66) {
            const int q9 = pn - 48; bf16_t* dst = q9 < 9 ? aq : ak; const int t9 = q9 < 9 ? q9 : q9 - 9;
            const int head = 2 * t9 + (wc >> 1), ib = 32 * (wc & 1) + 8 * fq;
            rope_store<128>(acc, rowbase, pos, dst, 2304, head * 128 + ib, 64, ib, 1.0f);
        } else {
            const int col0 = (pn - 66) * 256 + wc * 32 + 8 * fq;
#pragma unroll
            for (int ai = 0; ai < 2; ++ai)
#pragma unroll
                for (int m = 0; m < 4; ++m) { bf16_t* rowp = av + (size_t)(rowbase + ai * 128 + m * 16) * 2304 + col0;
#pragma unroll
                    for (int bj = 0; bj < 2; ++bj) *(u32x4*)(rowp + bj * 128) = pack8(acc[ai][bj][m][0], acc[ai][bj][m][1]); }
        }
    }
};

struct EpiRetGate {
    bf16_t* ret; const float* retss; const float* gain;
    DI void operator()(const AccT& acc, const Unit& u, int wr, int wc, int fr, int fq) const {
        const int rowbase = u.pm * 256 + wr * 64 + fr, head = u.pn >> 1, colb = u.pn * 256 + wc * 32 + 8 * fq;
        f32x4 gn[2][2];
#pragma unroll
        for (int bj = 0; bj < 2; ++bj) { gn[bj][0] = *(const f32x4*)(gain + colb + bj * 128); gn[bj][1] = *(const f32x4*)(gain + colb + bj * 128 + 4); }
#pragma unroll
        for (int ai = 0; ai < 2; ++ai) {
            f32x4 sA[4], sB[4]; u32x4 rr[4][2];
#pragma unroll
            for (int m = 0; m < 4; ++m) { const float* ps = retss + ((size_t)(rowbase + ai * 128 + m * 16) * 8 + head) * 8; sA[m] = *(const f32x4*)ps; sB[m] = *(const f32x4*)(ps + 4); }
#pragma unroll
            for (int m = 0; m < 4; ++m)
#pragma unroll
                for (int bj = 0; bj < 2; ++bj) rr[m][bj] = *(const u32x4*)(ret + (size_t)(rowbase + ai * 128 + m * 16) * 4096 + colb + bj * 128);
#pragma unroll
            for (int m = 0; m < 4; ++m) {
                const f32x4 s0 = sA[m], s1 = sB[m];
                const float rsv = __builtin_amdgcn_rsqf((((s0[0] + s0[1]) + (s0[2] + s0[3])) + ((s1[0] + s1[1]) + (s1[2] + s1[3]))) * (1.0f / 512.0f) + 1e-6f);
#pragma unroll
                for (int bj = 0; bj < 2; ++bj) {
                    const u32x4 r4 = rr[m][bj];
                    const float rf[8] = {bflo(r4.x), bfhi(r4.x), bflo(r4.y), bfhi(r4.y), bflo(r4.z), bfhi(r4.z), bflo(r4.w), bfhi(r4.w)};
                    f32x4 o0, o1;
#pragma unroll
                    for (int j = 0; j < 4; ++j) {
                        const float a0 = acc[ai][bj][m][0][j], a1 = acc[ai][bj][m][1][j];
                        o0[j] = a0 * sigmoidf_(a0) * (rf[j] * rsv * gn[bj][0][j]); o1[j] = a1 * sigmoidf_(a1) * (rf[4 + j] * rsv * gn[bj][1][j]);
                    }
                    *(u32x4*)(ret + (size_t)(rowbase + ai * 128 + m * 16) * 4096 + colb + bj * 128) = pack8(o0, o1);
                }
            }
        }
    }
};

struct EpiGates {
    bf16_t* O; const float* bias;
    DI void operator()(const AccT& acc, const Unit& u, int wr, int wc, int fr, int fq) const {
        const int rowbase = u.pm * 256 + wr * 64 + fr;
#pragma unroll
        for (int bj = 0; bj < 2; ++bj) {
            const int col = u.pn * 256 + bj * 128 + wc * 32 + 8 * fq;
            const f32x4 b0 = *(const f32x4*)(bias + col), b1 = *(const f32x4*)(bias + col + 4);
#pragma unroll
            for (int ai = 0; ai < 2; ++ai)
#pragma unroll
                for (int m = 0; m < 4; ++m) {
                    f32x4 o0, o1;
#pragma unroll
                    for (int j = 0; j < 4; ++j) { o0[j] = sigmoidf_(acc[ai][bj][m][0][j] + b0[j]); o1[j] = sigmoidf_(acc[ai][bj][m][1][j] + b1[j]); }
                    *(u32x4*)(O + (size_t)(rowbase + ai * 128 + m * 16) * 4096 + col) = pack8(o0, o1);
                }
        }
    }
};

struct EpiYMerge {
    const bf16_t* gates; bf16_t* U2;
    DI void mid(AccT& acc, const Unit& u, int wr, int wc, int fr, int fq) const {
        const int rowbase = u.pm * 256 + wr * 64 + fr, colb = u.pn * 256 + wc * 32 + 8 * fq;
#pragma unroll
        for (int ai = 0; ai < 2; ++ai) {
            u32x4 gr[4][2], ga[4][2];
#pragma unroll
            for (int m = 0; m < 4; ++m)
#pragma unroll
                for (int bj = 0; bj < 2; ++bj) { const bf16_t* pg = gates + (size_t)(rowbase + ai * 128 + m * 16) * 4096 + colb + bj * 128; gr[m][bj] = *(const u32x4*)pg; ga[m][bj] = *(const u32x4*)(pg + 2048); }
#pragma unroll
            for (int m = 0; m < 4; ++m)
#pragma unroll
                for (int bj = 0; bj < 2; ++bj) {
                    const u32x4 g1 = gr[m][bj], g2 = ga[m][bj];
                    const float r[8] = {bflo(g1.x), bfhi(g1.x), bflo(g1.y), bfhi(g1.y), bflo(g1.z), bfhi(g1.z), bflo(g1.w), bfhi(g1.w)};
                    const float a[8] = {bflo(g2.x), bfhi(g2.x), bflo(g2.y), bfhi(g2.y), bflo(g2.z), bfhi(g2.z), bflo(g2.w), bfhi(g2.w)};
#pragma unroll
                    for (int j = 0; j < 4; ++j) { acc[ai][bj][m][0][j] *= r[j] * __builtin_amdgcn_rcpf(fmaxf(a[j], 1e-30f)); acc[ai][bj][m][1][j] *= r[4 + j] * __builtin_amdgcn_rcpf(fmaxf(a[4 + j], 1e-30f)); }
                }
        }
    }
    DI void operator()(const AccT& acc, const Unit& u, int wr, int wc, int fr, int fq) const {
        const int rowbase = u.pm * 256 + wr * 64 + fr, colb = u.pn * 256 + wc * 32 + 8 * fq;
        u32x4 gg[2][4][2];
#pragma unroll
        for (int ai = 0; ai < 2; ++ai)
#pragma unroll
            for (int m = 0; m < 4; ++m)
#pragma unroll
                for (int bj = 0; bj < 2; ++bj) gg[ai][m][bj] = *(const u32x4*)(gates + (size_t)(rowbase + ai * 128 + m * 16) * 4096 + 2048 + colb + bj * 128);
#pragma unroll
        for (int ai = 0; ai < 2; ++ai)
#pragma unroll
            for (int m = 0; m < 4; ++m)
#pragma unroll
                for (int bj = 0; bj < 2; ++bj) {
                    const u32x4 g4 = gg[ai][m][bj];
                    f32x4 o0 = acc[ai][bj][m][0], o1 = acc[ai][bj][m][1];
                    o0[0] *= bflo(g4.x); o0[1] *= bfhi(g4.x); o0[2] *= bflo(g4.y); o0[3] *= bfhi(g4.y);
                    o1[0] *= bflo(g4.z); o1[1] *= bfhi(g4.z); o1[2] *= bflo(g4.w); o1[3] *= bfhi(g4.w);
                    *(u32x4*)(U2 + (size_t)(rowbase + ai * 128 + m * 16) * 2048 + colb + bj * 128) = pack8(o0, o1);
                }
    }
};

DI float gelu_tanh(float v) {
    const float uu = 0.7978845608028654f * (v + 0.044715f * v * v * v);
    const float e = __builtin_amdgcn_exp2f(2.8853900817779268f * uu);
    return v - v * __builtin_amdgcn_rcpf(e + 1.0f);
}
struct EpiConvAct {
    const bf16_t* A; bf16_t* ACT; const float* conv_w; const float* conv_b;
    DI void operator()(const AccT& acc, const Unit& u, int wr, int wc, int fr, int fq) const {
        const int rowbase = u.pm * 256 + wr * 64 + fr;
#pragma unroll
        for (int bj = 0; bj < 2; ++bj) {
            const int col = u.pn * 256 + bj * 128 + wc * 32 + 8 * fq;
            f32x4 w0[2], w1[2], w2[2], cb[2];
#pragma unroll
            for (int hh = 0; hh < 2; ++hh) { w0[hh] = *(const f32x4*)(conv_w + col + 4 * hh); w1[hh] = *(const f32x4*)(conv_w + FF + col + 4 * hh); w2[hh] = *(const f32x4*)(conv_w + 2 * FF + col + 4 * hh); cb[hh] = *(const f32x4*)(conv_b + col + 4 * hh); }
#pragma unroll
            for (int aim = 0; aim < 4; ++aim) { const int ai = aim >> 1, mb = (aim & 1) * 2;
                u32x4 a0[4], a1[4], a2[4];
#pragma unroll
                for (int m = mb; m < mb + 2; ++m) {
                    const int row = rowbase + ai * 128 + m * 16; const int sq = row & (SEQ - 1);
                    const bf16_t* pa = A + (size_t)row * FF + col;
                    a0[m] = *(const u32x4*)pa;
                    a1[m] = *(const u32x4*)(pa - (sq >= 1 ? FF : 0));
                    a2[m] = *(const u32x4*)(pa - (sq >= 2 ? 2 * FF : 0));
                }
#pragma unroll
                for (int m = mb; m < mb + 2; ++m) {
                    const int row = rowbase + ai * 128 + m * 16; const int sq = row & (SEQ - 1);
                    const float k1 = sq >= 1 ? 1.0f : 0.0f, k2 = sq >= 2 ? 1.0f : 0.0f;
                    const u32x4 x0 = a0[m], x1 = a1[m], x2 = a2[m];
                    const float f0[8] = {bflo(x0.x), bfhi(x0.x), bflo(x0.y), bfhi(x0.y), bflo(x0.z), bfhi(x0.z), bflo(x0.w), bfhi(x0.w)};
                    const float f1[8] = {bflo(x1.x), bfhi(x1.x), bflo(x1.y), bfhi(x1.y), bflo(x1.z), bfhi(x1.z), bflo(x1.w), bfhi(x1.w)};
                    const float f2[8] = {bflo(x2.x), bfhi(x2.x), bflo(x2.y), bfhi(x2.y), bflo(x2.z), bfhi(x2.z), bflo(x2.w), bfhi(x2.w)};
                    f32x4 o0, o1;
#pragma unroll
                    for (int j = 0; j < 4; ++j) {
                        const float c0 = cb[0][j] + w0[0][j] * f0[j] + k1 * (w1[0][j] * f1[j]) + k2 * (w2[0][j] * f2[j]);
                        const float c1 = cb[1][j] + w0[1][j] * f0[4 + j] + k1 * (w1[1][j] * f1[4 + j]) + k2 * (w2[1][j] * f2[4 + j]);
                        o0[j] = gelu_tanh(c0) * acc[ai][bj][m][0][j]; o1[j] = gelu_tanh(c1) * acc[ai][bj][m][1][j];
                    }
                    *(u32x4*)(ACT + (size_t)row * FF + col) = pack8(o0, o1);
                }
            }
        }
    }
};

DI int invperm32(int c) { return 16 * ((c >> 2) & 1) + 4 * (c >> 3) + (c & 3); }
DI int slot_std(int c) { return (c & ~31) | invperm32(c & 31); }
DI int slot_win(int c) {
    if (c >= 12288 && c < 16896) { const int tc = c & 255, hh = tc >> 7, bj = (tc >> 6) & 1, i64 = tc & 63, x = 64 * hh + i64; return (c & ~255) + 128 * bj + (x & ~31) + invperm32(x & 31); }
    return slot_std(c);
}
DI void transpose_item(const float* W, int K, int N, bf16_t* WT, int mode, LAS float* scr, int item, int lane) {
    const int nblk = N / 32, kb = item / nblk, nb = item % nblk, k0 = 64 * kb, n0 = 32 * nb;
#pragma unroll 8
    for (int i = 0; i < 32; ++i) { const int kk = 2 * i + (lane >> 5); scr[kk * 33 + (lane & 31)] = W[(size_t)(k0 + kk) * N + n0 + (lane & 31)]; }
    asm volatile("s_waitcnt lgkmcnt(0)" ::: "memory");
    const int c = lane & 7;
#pragma unroll
    for (int j = 0; j < 4; ++j) { const int n = (lane >> 3) + 8 * j; const LAS float* s = scr + (8 * c) * 33 + n;
        u32x4 o; o.x = cvt_pk_bf16(s[0 * 33], s[1 * 33]); o.y = cvt_pk_bf16(s[2 * 33], s[3 * 33]); o.z = cvt_pk_bf16(s[4 * 33], s[5 * 33]); o.w = cvt_pk_bf16(s[6 * 33], s[7 * 33]);
        const int drow = mode ? slot_win(n0 + n) : slot_std(n0 + n);
        *(u32x4*)(WT + (size_t)drow * K + k0 + 8 * c) = o; }
    asm volatile("s_waitcnt lgkmcnt(0)" ::: "memory");
}

DI void phase0(const Params& p, LAS unsigned char* lds) {
    const int tid = threadIdx.x, lane = tid & 63, wave = tid >> 6;
    LAS float* sc = (LAS float*)lds;
    LAS float* red = sc + 8192;
    float* ada = (float*)(p.ws + WS_ADA);
    for (int i = tid; i < 8192; i += 512) { const float v = p.c[i]; sc[i] = v / (1.0f + __expf(-v)); }
    __syncthreads();
    for (int cb = blockIdx.x; cb < 256; cb += gridDim.x) {
        {
            const int rg = lane / 12, cq = lane - 12 * rg;
            f32x4 a0 = {0.f, 0.f, 0.f, 0.f}, a1 = a0, a2 = a0, a3 = a0;
            if (rg < 5) {
                const float* wp = p.w_ada + 48 * cb + 4 * cq;
#pragma unroll 13
                for (int i = 0; i < 52; ++i) { const int kl = 5 * i + rg; if (kl < 256) { const int kk = 256 * wave + kl; const f32x4 wv = *(const f32x4*)(wp + (size_t)kk * 12288);
                    a0 += sc[kk] * wv; a1 += sc[2048 + kk] * wv; a2 += sc[4096 + kk] * wv; a3 += sc[6144 + kk] * wv; } }
                LAS float* rp = red + ((wave * 5 + rg) * 4) * 48 + 4 * cq;
                *(LAS f32x4*)(rp) = a0; *(LAS f32x4*)(rp + 48) = a1; *(LAS f32x4*)(rp + 96) = a2; *(LAS f32x4*)(rp + 144) = a3;
            }
        }
        __syncthreads();
        if (tid < 192) { const int b = tid / 48, l = tid % 48; float sacc = 0.f;
#pragma unroll 8
            for (int wg = 0; wg < 40; ++wg) sacc += red[(wg * 4 + b) * 48 + l];
            ada[b * 12288 + 48 * cb + l] = sacc + p.b_ada[48 * cb + l]; }
        __syncthreads();
    }
    LAS float* scr = (LAS float*)(lds + 40960 + wave * 8448);
    const int gw = blockIdx.x * 8 + wave, NGW = gridDim.x * 8;
    constexpr int I_IN = (2048 / 64) * (19200 / 32), I_GATE = (2048 / 64) * (4096 / 32), I_RET = (4096 / 64) * (2048 / 32), I_ATT = (2304 / 64) * (2048 / 32),
                  I_MIX = (2048 / 64) * (2048 / 32), I_UP = (2048 / 64) * (11264 / 32), I_DOWN = (5632 / 64) * (2048 / 32);
    constexpr int NITEMS = I_IN + I_GATE + I_RET + I_ATT + I_MIX + I_UP + I_DOWN;
    for (int it = gw; it < NITEMS - I_UP - I_DOWN; it += NGW) {
        int r = it;
        if (r < I_IN) { transpose_item(p.w_in, 2048, 19200, (bf16_t*)(p.ws + WS_WIN), 1, scr, r, lane); continue; } r -= I_IN;
        if (r < I_GATE) { transpose_item(p.w_gate, 2048, 4096, (bf16_t*)(p.ws + WS_WGATE), 0, scr, r, lane); continue; } r -= I_GATE;
        if (r < I_RET) { transpose_item(p.w_ret_out, 4096, 2048, (bf16_t*)(p.ws + WS_WRET), 0, scr, r, lane); continue; } r -= I_RET;
        if (r < I_ATT) { transpose_item(p.w_att_out, 2304, 2048, (bf16_t*)(p.ws + WS_WATT), 0, scr, r, lane); continue; } r -= I_ATT;
        transpose_item(p.w_mix, 2048, 2048, (bf16_t*)(p.ws + WS_WMIX), 0, scr, r, lane);
    }
}
DI void convert_ffn_weights(const Params& p, LAS unsigned char* lds, int idx, int nshare) {
    const int lane = threadIdx.x & 63, wave = threadIdx.x >> 6;
    LAS float* scr = (LAS float*)(lds + wave * 8448);
    constexpr int I_UP = (2048 / 64) * (11264 / 32), I_DOWN = (5632 / 64) * (2048 / 32);
    for (int it = idx * 8 + wave; it < I_UP + I_DOWN; it += nshare * 8) {
        if (it < I_UP) transpose_item(p.w_up, 2048, 11264, (bf16_t*)(p.ws + WS_WUP), 0, scr, it, lane);
        else transpose_item(p.w_down, 5632, 2048, (bf16_t*)(p.ws + WS_WDOWN), 0, scr, it - I_UP, lane);
    }
}

constexpr int NR = 2;
DI void phase_h(const Params& p) {
    const int lane = threadIdx.x & 63, wave = threadIdx.x >> 6;
    const float* ada = (const float*)(p.ws + WS_ADA); bf16_t* H = (bf16_t*)(p.ws + WS_H);
    const int nw = gridDim.x * 8;
    for (int row0 = blockIdx.x * 8 + wave; row0 < T_TOK; row0 += nw * NR) {
        f32x4 v[NR][4][2]; float ss[NR];
#pragma unroll
        for (int q = 0; q < NR; ++q) { const float* xr = p.x + (size_t)(row0 + q * nw) * DM; ss[q] = 0.f;
#pragma unroll
            for (int it = 0; it < 4; ++it) { const int col = (it * 64 + lane) * 8; v[q][it][0] = *(const f32x4*)(xr + col); v[q][it][1] = *(const f32x4*)(xr + col + 4); } }
#pragma unroll
        for (int q = 0; q < NR; ++q) {
#pragma unroll
            for (int it = 0; it < 4; ++it)
#pragma unroll
                for (int j = 0; j < 4; ++j) ss[q] += v[q][it][0][j] * v[q][it][0][j] + v[q][it][1][j] * v[q][it][1][j];
            ss[q] = __builtin_amdgcn_rsqf(wave_sum(ss[q]) * (1.0f / DM) + 1e-6f); }
#pragma unroll
        for (int it = 0; it < 4; ++it) { const int col = (it * 64 + lane) * 8;
            f32x4 g[2], sh[NR][2], scl[NR][2];
#pragma unroll
            for (int hh = 0; hh < 2; ++hh) { g[hh] = *(const f32x4*)(p.g_pre_mix + col + 4 * hh);
#pragma unroll
                for (int q = 0; q < NR; ++q) { const int b = (row0 + q * nw) / SEQ; sh[q][hh] = *(const f32x4*)(ada + b * 12288 + col + 4 * hh); scl[q][hh] = *(const f32x4*)(ada + b * 12288 + 2048 + col + 4 * hh); } }
#pragma unroll
            for (int q = 0; q < NR; ++q) { f32x4 o[2];
#pragma unroll
                for (int hh = 0; hh < 2; ++hh)
#pragma unroll
                    for (int j = 0; j < 4; ++j) o[hh][j] = v[q][it][hh][j] * ss[q] * g[hh][j] * (1.0f + scl[q][hh][j]) + sh[q][hh][j];
                *(u32x4*)(H + (size_t)(row0 + q * nw) * DM + col) = pack8(o[0], o[1]); } }
    }
}

DI void phase_postmix(const Params& p) {
    const int lane = threadIdx.x & 63, wave = threadIdx.x >> 6;
    const float* ada = (const float*)(p.ws + WS_ADA); const bf16_t* Y = (const bf16_t*)(p.ws + WS_Y); bf16_t* H2 = (bf16_t*)(p.ws + WS_H2);
    const int nw = gridDim.x * 8;
    for (int row0 = blockIdx.x * 8 + wave; row0 < T_TOK; row0 += nw * NR) {
        f32x4 y[NR][4][2], xv[NR][4][2]; float ry[NR], r1[NR];
#pragma unroll
        for (int q = 0; q < NR; ++q) { const size_t ro = (size_t)(row0 + q * nw) * DM;
#pragma unroll
            for (int it = 0; it < 4; ++it) { const int col = (it * 64 + lane) * 8; const u32x4 w = *(const u32x4*)(Y + ro + col);
                y[q][it][0] = (f32x4){bflo(w.x), bfhi(w.x), bflo(w.y), bfhi(w.y)}; y[q][it][1] = (f32x4){bflo(w.z), bfhi(w.z), bflo(w.w), bfhi(w.w)};
                xv[q][it][0] = *(const f32x4*)(p.x + ro + col); xv[q][it][1] = *(const f32x4*)(p.x + ro + col + 4); } }
#pragma unroll
        for (int q = 0; q < NR; ++q) { float ss = 0.f;
#pragma unroll
            for (int it = 0; it < 4; ++it)
#pragma unroll
                for (int j = 0; j < 4; ++j) ss += y[q][it][0][j] * y[q][it][0][j] + y[q][it][1][j] * y[q][it][1][j];
            ry[q] = __builtin_amdgcn_rsqf(wave_sum(ss) * (1.0f / DM) + 1e-6f); }
#pragma unroll
        for (int q = 0; q < NR; ++q) { const int row = row0 + q * nw; const float* ab = ada + (row / SEQ) * 12288; float s1 = 0.f;
#pragma unroll
            for (int it = 0; it < 4; ++it) { const int col = (it * 64 + lane) * 8;
#pragma unroll
                for (int hh = 0; hh < 2; ++hh) { const f32x4 g = *(const f32x4*)(p.g_post_mix + col + 4 * hh), gt = *(const f32x4*)(ab + 4096 + col + 4 * hh);
                    f32x4 o;
#pragma unroll
                    for (int j = 0; j < 4; ++j) { o[j] = xv[q][it][hh][j] + gt[j] * (y[q][it][hh][j] * ry[q] * g[j]); s1 += o[j] * o[j]; }
                    y[q][it][hh] = o; }
                *(u32x4*)((bf16_t*)(p.out + (size_t)row * DM + DM / 2) + col) = pack8(y[q][it][0], y[q][it][1]); }
            r1[q] = __builtin_amdgcn_rsqf(wave_sum(s1) * (1.0f / DM) + 1e-6f); }
#pragma unroll
        for (int q = 0; q < NR; ++q) { const int row = row0 + q * nw; const float* ab = ada + (row / SEQ) * 12288;
#pragma unroll
            for (int it = 0; it < 4; ++it) { const int col = (it * 64 + lane) * 8; f32x4 o[2];
#pragma unroll
                for (int hh = 0; hh < 2; ++hh) { const f32x4 g = *(const f32x4*)(p.g_pre_ffn + col + 4 * hh), sh = *(const f32x4*)(ab + 6144 + col + 4 * hh), scl = *(const f32x4*)(ab + 8192 + col + 4 * hh);
#pragma unroll
                    for (int j = 0; j < 4; ++j) o[hh][j] = y[q][it][hh][j] * r1[q] * g[j] * (1.0f + scl[j]) + sh[j]; }
                *(u32x4*)(H2 + (size_t)row * DM + col) = pack8(o[0], o[1]); } }
    }
}

DI void phase_final(const Params& p) {
    const int lane = threadIdx.x & 63, wave = threadIdx.x >> 6;
    const float* ada = (const float*)(p.ws + WS_ADA); const bf16_t* Y = (const bf16_t*)(p.ws + WS_Y2);
    const int nw = gridDim.x * 8;
    for (int row0 = blockIdx.x * 8 + wave; row0 < T_TOK; row0 += nw * NR) {
        f32x4 y[NR][4][2], xv[NR][4][2]; float ry[NR];
#pragma unroll
        for (int q = 0; q < NR; ++q) { const size_t ro = (size_t)(row0 + q * nw) * DM;
#pragma unroll
            for (int it = 0; it < 4; ++it) { const int col = (it * 64 + lane) * 8; const u32x4 w = *(const u32x4*)(Y + ro + col);
                y[q][it][0] = (f32x4){bflo(w.x), bfhi(w.x), bflo(w.y), bfhi(w.y)}; y[q][it][1] = (f32x4){bflo(w.z), bfhi(w.z), bflo(w.w), bfhi(w.w)};
                const u32x4 xw = *(const u32x4*)((const bf16_t*)(p.out + ro + DM / 2) + col);
                xv[q][it][0] = (f32x4){bflo(xw.x), bfhi(xw.x), bflo(xw.y), bfhi(xw.y)}; xv[q][it][1] = (f32x4){bflo(xw.z), bfhi(xw.z), bflo(xw.w), bfhi(xw.w)}; } }
#pragma unroll
        for (int q = 0; q < NR; ++q) { float ss = 0.f;
#pragma unroll
            for (int it = 0; it < 4; ++it)
#pragma unroll
                for (int j = 0; j < 4; ++j) ss += y[q][it][0][j] * y[q][it][0][j] + y[q][it][1][j] * y[q][it][1][j];
            ry[q] = __builtin_amdgcn_rsqf(wave_sum(ss) * (1.0f / DM) + 1e-6f); }
#pragma unroll
        for (int q = 0; q < NR; ++q) { const int row = row0 + q * nw; const float* ab = ada + (row / SEQ) * 12288;
#pragma unroll
            for (int it = 0; it < 4; ++it) { const int col = (it * 64 + lane) * 8;
#pragma unroll
                for (int hh = 0; hh < 2; ++hh) { const f32x4 g = *(const f32x4*)(p.g_post_ffn + col + 4 * hh), gt = *(const f32x4*)(ab + 10240 + col + 4 * hh);
                    f32x4 o;
#pragma unroll
                    for (int j = 0; j < 4; ++j) o[j] = xv[q][it][hh][j] + gt[j] * (y[q][it][hh][j] * ry[q] * g[j]);
                    *(f32x4*)(p.out + (size_t)row * DM + col + 4 * hh) = o; } } }
    }
}

DI void phase_alpha(const Params& p) {
    bf16_t* att = (bf16_t*)(p.ws + WS_AQ); const float* lse = (const float*)(p.ws + WS_LSE);
    const int lane = threadIdx.x & 63, wave = threadIdx.x >> 6;
    for (int t = blockIdx.x * 8 + wave; t < T_TOK; t += gridDim.x * 8) {
        const float l = lse[(size_t)t * 18 + (lane < 18 ? lane : 0)];
        const int j = lane % 6;
        const float l0 = __shfl(l, j), l1 = __shfl(l, 6 + j), l2 = __shfl(l, 12 + j);
        const float mm = fmaxf(l0, fmaxf(l1, l2)); const float e0 = __expf(l0 - mm), e1 = __expf(l1 - mm), e2 = __expf(l2 - mm);
        const float al_lane = __expf(l - mm) / (e0 + e1 + e2);
        u32x4* row = (u32x4*)(att + (size_t)t * 2304);
        u32x4 w[5];
#pragma unroll
        for (int k = 0; k < 5; ++k) { const int ch = lane + 64 * k; if (ch < 288) w[k] = row[ch]; }
#pragma unroll
        for (int k = 0; k < 5; ++k) { const int ch = lane + 64 * k; const float al = __shfl(al_lane, (ch < 288 ? ch : 0) >> 4);
            if (ch < 288) { u32x4 o;
                o.x = cvt_pk_bf16(bflo(w[k].x) * al, bfhi(w[k].x) * al); o.y = cvt_pk_bf16(bflo(w[k].y) * al, bfhi(w[k].y) * al);
                o.z = cvt_pk_bf16(bflo(w[k].z) * al, bfhi(w[k].z) * al); o.w = cvt_pk_bf16(bflo(w[k].w) * al, bfhi(w[k].w) * al);
                row[ch] = o; } }
    }
}

DI void phase_retention(const Params& p, LAS unsigned char* lds, int cblk) {
    const int tid = threadIdx.x, lane = tid & 63, w = tid >> 6, fr = lane & 15, fq = lane >> 4;
    LAS unsigned char* Qs = lds; LAS unsigned char* Ks = lds + 33792; LAS unsigned char* Vs = lds + 67584; LAS unsigned char* St = lds + 76800; LAS unsigned char* Ps = lds + 110592;
    LAS float* red = (LAS float*)(lds + 119808);
    const bf16_t* rq = (const bf16_t*)(p.ws + WS_RQ); const bf16_t* rk = (const bf16_t*)(p.ws + WS_RK); bf16_t* rv = (bf16_t*)p.out; float* retss = (float*)(p.ws + WS_RETSS);
    for (int item = cblk; item < 256; item += gridDim.x) {
        const int q5 = item >> 3, bh = (item & 7) * 4 + (q5 & 3), slice = q5 >> 2, b = bh >> 3, h = bh & 7;
        const float lg = log1pf(-exp2f(-5.0f - (float)h));
        const float gamma_c = expf(64.0f * lg);
        const float xv = expf(-lg * (float)((tid >> 3) + 1));
        const float xo0 = expf(lg * (float)(32 * (w & 1) + fr + 1)), xo1 = expf(lg * (float)(32 * (w & 1) + 16 + fr + 1));
        const size_t tok0 = (size_t)b * SEQ;
        const bf16_t* qbase = rq + tok0 * 2048 + h * 256 + (tid & 31) * 8; const bf16_t* kbase = rk + tok0 * 2048 + h * 256 + (tid & 31) * 8;
        bf16_t* vbase = rv + tok0 * 4096 + h * 512 + slice * 64;
        u32x4 pq[4], pk[4], pv;
        f32x4 Sreg[2][4];
#pragma unroll
        for (int a = 0; a < 2; ++a)
#pragma unroll
            for (int bb = 0; bb < 4; ++bb) Sreg[a][bb] = (f32x4){0.f, 0.f, 0.f, 0.f};
        for (int i = tid; i < 33792 / 16; i += 512) ((LAS u32x4*)St)[i] = (u32x4){0u, 0u, 0u, 0u};
#define RET_LOAD(c) do { _Pragma("unroll") for (int i = 0; i < 4; ++i) { const int row = (tid + 512 * i) >> 5; \
            pq[i] = *(const u32x4*)(qbase + (size_t)(64 * (c) + row) * 2048); pk[i] = *(const u32x4*)(kbase + (size_t)(64 * (c) + row) * 2048); } \
            pv = *(const u32x4*)(vbase + (size_t)(64 * (c) + (tid >> 3)) * 4096 + (tid & 7) * 8); } while (0)
#define RET_STORE() do { _Pragma("unroll") for (int i = 0; i < 4; ++i) { const int e = tid + 512 * i, row = e >> 5, pc = e & 31; \
            *(LAS u32x4*)(Qs + row * 528 + pc * 16) = pq[i]; *(LAS u32x4*)(Ks + row * 528 + pc * 16) = pk[i]; } \
            { u32x4 o; o.x = cvt_pk_bf16(bflo(pv.x) * xv, bfhi(pv.x) * xv); o.y = cvt_pk_bf16(bflo(pv.y) * xv, bfhi(pv.y) * xv); \
              o.z = cvt_pk_bf16(bflo(pv.z) * xv, bfhi(pv.z) * xv); o.w = cvt_pk_bf16(bflo(pv.w) * xv, bfhi(pv.w) * xv); \
              *(LAS u32x4*)(Vs + (tid >> 3) * 144 + (tid & 7) * 16) = o; } } while (0)
        RET_LOAD(0); RET_STORE();
        __syncthreads();
        for (int c = 0; c < 128; ++c) {
            if (c + 1 < 128) RET_LOAD(c + 1);
            bf16x8 qfr[8][2];
            {
                const int jt = w >> 1, it0 = (w & 1) * 2;
                f32x4 sa[2] = {(f32x4){0.f, 0.f, 0.f, 0.f}, (f32x4){0.f, 0.f, 0.f, 0.f}};
#pragma unroll
                for (int ks = 0; ks < 8; ++ks) {
                    const bf16x8 kf = *(const LAS bf16x8*)(Ks + (16 * jt + fr) * 528 + (32 * ks + 8 * fq) * 2);
#pragma unroll
                    for (int t = 0; t < 2; ++t) { qfr[ks][t] = *(const LAS bf16x8*)(Qs + (16 * (it0 + t) + fr) * 528 + (32 * ks + 8 * fq) * 2); sa[t] = mfma16(kf, qfr[ks][t], sa[t]); }
                }
#pragma unroll
                for (int t = 0; t < 2; ++t) { const int iq = 16 * (it0 + t) + fr, jk0 = 16 * jt + 4 * fq;
                    u32x2 o; o.x = cvt_pk_bf16(jk0 + 0 <= iq ? sa[t][0] : 0.f, jk0 + 1 <= iq ? sa[t][1] : 0.f); o.y = cvt_pk_bf16(jk0 + 2 <= iq ? sa[t][2] : 0.f, jk0 + 3 <= iq ? sa[t][3] : 0.f);
                    *(LAS u32x2*)(Ps + iq * 144 + jk0 * 2) = o; }
            }
            {
#pragma unroll
                for (int ks = 0; ks < 2; ++ks) {
                    const int j0 = 32 * ks + 8 * fq + (fr >> 2);
                    bf16x8 kt[2], vf[4];
#pragma unroll
                    for (int dd = 0; dd < 2; ++dd) { LAS unsigned char* a0 = Ks + j0 * 528 + (16 * (2 * w + dd) + 4 * (fr & 3)) * 2; kt[dd] = tr_read2(a0, a0 + 4 * 528); }
#pragma unroll
                    for (int vt = 0; vt < 4; ++vt) { LAS unsigned char* a0 = Vs + j0 * 144 + (16 * vt + 4 * (fr & 3)) * 2; vf[vt] = tr_read2(a0, a0 + 4 * 144); }
#pragma unroll
                    for (int dd = 0; dd < 2; ++dd)
#pragma unroll
                        for (int vt = 0; vt < 4; ++vt) Sreg[dd][vt] = mfma16(kt[dd], vf[vt], Sreg[dd][vt]);
                }
#pragma unroll
                for (int dd = 0; dd < 2; ++dd)
#pragma unroll
                    for (int vt = 0; vt < 4; ++vt) Sreg[dd][vt] *= gamma_c;
            }
            __syncthreads();
            {
                const int vt = w >> 1, it0 = (w & 1) * 2;
                f32x4 oa[2] = {(f32x4){0.f, 0.f, 0.f, 0.f}, (f32x4){0.f, 0.f, 0.f, 0.f}};
#pragma unroll
                for (int ks = 0; ks < 8; ++ks) {
                    const bf16x8 sf = *(const LAS bf16x8*)(St + (16 * vt + fr) * 528 + (32 * ks + 8 * fq) * 2);
#pragma unroll
                    for (int t = 0; t < 2; ++t) oa[t] = mfma16(sf, qfr[ks][t], oa[t]);
                }
#pragma unroll
                for (int ks = 0; ks < 2; ++ks) {
                    const int j0 = 32 * ks + 8 * fq + (fr >> 2);
                    LAS unsigned char* a0 = Vs + j0 * 144 + (16 * vt + 4 * (fr & 3)) * 2; const bf16x8 vf = tr_read2(a0, a0 + 4 * 144);
#pragma unroll
                    for (int t = 0; t < 2; ++t) { const bf16x8 pf = *(const LAS bf16x8*)(Ps + (16 * (it0 + t) + fr) * 144 + (32 * ks + 8 * fq) * 2); oa[t] = mfma16(vf, pf, oa[t]); }
                }
#pragma unroll
                for (int t = 0; t < 2; ++t) { const int iq = 16 * (it0 + t) + fr; oa[t] *= (t == 0 ? xo0 : xo1);
                    u32x2 o; o.x = cvt_pk_bf16(oa[t][0], oa[t][1]); o.y = cvt_pk_bf16(oa[t][2], oa[t][3]);
                    *(u32x2*)(vbase + (size_t)(64 * c + iq) * 4096 + 16 * vt + 4 * fq) = o;
                    float ss = (oa[t][0] * oa[t][0] + oa[t][1] * oa[t][1]) + (oa[t][2] * oa[t][2] + oa[t][3] * oa[t][3]);
                    ss += __shfl_xor(ss, 16); ss += __shfl_xor(ss, 32);
                    if (fq == 0) red[iq * 4 + vt] = ss; }
            }
            __syncthreads();
#pragma unroll
            for (int dd = 0; dd < 2; ++dd)
#pragma unroll
                for (int vt = 0; vt < 4; ++vt) { u32x2 o; o.x = cvt_pk_bf16(Sreg[dd][vt][0], Sreg[dd][vt][1]); o.y = cvt_pk_bf16(Sreg[dd][vt][2], Sreg[dd][vt][3]);
                    *(LAS u32x2*)(St + (16 * vt + fr) * 528 + (16 * (2 * w + dd) + 4 * fq) * 2) = o; }
            if (c + 1 < 128) RET_STORE();
            if (tid < 64) retss[((tok0 + 64 * c + tid) * 8 + h) * 8 + slice] = (red[tid * 4 + 0] + red[tid * 4 + 1]) + (red[tid * 4 + 2] + red[tid * 4 + 3]);
            __syncthreads();
        }
#undef RET_LOAD
#undef RET_STORE
    }
}

DI void phase_attention(const Params& p, LAS unsigned char* lds) {
    const int tid = threadIdx.x, lane = tid & 63, w = tid >> 6, fr = lane & 15, fq = lane >> 4;
    LAS unsigned char* Ks = lds; LAS unsigned char* Vs = lds + 69632;
    bf16_t* aq = (bf16_t*)(p.ws + WS_AQ); const bf16_t* ak = (const bf16_t*)(p.ws + WS_AK); const bf16_t* av = (const bf16_t*)(p.ws + WS_AV); float* lse = (float*)(p.ws + WS_LSE);
    const int per = (4608 + (int)gridDim.x - 1) / (int)gridDim.x, it_lo = (int)blockIdx.x * per, it_hi = (it_lo + per < 4608) ? it_lo + per : 4608;
    int prev_key = -1;
    u32x4 kcur[4], vcur[4];
#define ATT_LOAD_CUR(item_) do { const int bh_ = (item_) >> 6, e64_ = (item_) & 63, head_ = bh_ % 18, b_ = bh_ / 18; \
        const int rsh_ = 2 * (head_ / 6), r_ = 1 << rsh_, nbc_ = 64 >> rsh_, cls_ = e64_ / nbc_, nb_ = e64_ - cls_ * nbc_; \
        _Pragma("unroll") for (int i = 0; i < 4; ++i) { const int e = tid + 512 * i, row = e >> 4, pc = e & 15; \
            const size_t off = ((size_t)b_ * SEQ + (size_t)(nb_ * 128 + row) * r_ + cls_) * 2304 + head_ * 128 + pc * 8; \
            kcur[i] = *(const u32x4*)(ak + off); vcur[i] = *(const u32x4*)(av + off); } } while (0)
    if (it_lo < it_hi) ATT_LOAD_CUR(it_lo);
    for (int item = it_lo, cnt = 0; item < it_hi; ++item, ++cnt) {
        const int bh = item >> 6, e64 = item & 63, head = bh % 18, b = bh / 18;
        const int g = head / 6, rsh = 2 * g, r = 1 << rsh, nbc = 64 >> rsh, cls = e64 / nbc, nb = e64 - cls * nbc;
        const int pq0 = nb * 128, pk0 = pq0 - 128;
        const size_t tokb = (size_t)b * SEQ;
        const int scur = cnt & 1, sprev = scur ^ 1;
        const bool reuse = (nb > 0) && (prev_key == item - 1);
#pragma unroll
        for (int i = 0; i < 4; ++i) { const int e = tid + 512 * i, row = e >> 4, pc = e & 15;
            *(LAS u32x4*)(Ks + (scur * 128 + row) * 272 + pc * 16) = kcur[i]; *(LAS u32x4*)(Vs + (scur * 128 + row) * 288 + pc * 16) = vcur[i]; }
        if (!reuse) {
#pragma unroll
            for (int i = 0; i < 4; ++i) { const int e = tid + 512 * i, row = e >> 4, pc = e & 15;
                u32x4 kv = {0u, 0u, 0u, 0u}, vv = kv;
                if (nb > 0) { const size_t off = (tokb + (size_t)(pk0 + row) * r + cls) * 2304 + head * 128 + pc * 8; kv = *(const u32x4*)(ak + off); vv = *(const u32x4*)(av + off); }
                *(LAS u32x4*)(Ks + (sprev * 128 + row) * 272 + pc * 16) = kv; *(LAS u32x4*)(Vs + (sprev * 128 + row) * 288 + pc * 16) = vv; }
        }
        if (item + 1 < it_hi) ATT_LOAD_CUR(item + 1);
        prev_key = item;
        const int qq = 16 * w + fr;
        const size_t tokq = tokb + (size_t)(pq0 + qq) * r + cls;
        bf16x8 qf[4];
        { const bf16_t* qp = aq + tokq * 2304 + head * 128 + 8 * fq;
#pragma unroll
          for (int ks = 0; ks < 4; ++ks) qf[ks] = *(const bf16x8*)(qp + 32 * ks); }
        __syncthreads();
        f32x4 sa[10];
#pragma unroll
        for (int kt = 0; kt < 10; ++kt) { sa[kt] = (f32x4){0.f, 0.f, 0.f, 0.f};
            const int T = (w + kt < 16) ? w + kt : 15;
            const int krow = ((T < 8) ? sprev : scur) * 128 + 16 * (T & 7) + fr;
#pragma unroll
            for (int ks = 0; ks < 4; ++ks) { const bf16x8 kf = *(const LAS bf16x8*)(Ks + krow * 272 + (32 * ks + 8 * fq) * 2); sa[kt] = mfma16(kf, qf[ks], sa[kt]); } }
        const float sc2 = 0.08838834764831845f * 1.4426950408889634f;
        float mrow = -INFINITY;
#pragma unroll
        for (int kt = 0; kt < 10; ++kt)
#pragma unroll
            for (int j = 0; j < 4; ++j) { const int kk = 16 * (w + kt) + 4 * fq + j; const bool valid = (kk >= qq) && (kk <= qq + 128) && (pk0 + kk >= 0);
                const float sv = valid ? sa[kt][j] * sc2 : -INFINITY; sa[kt][j] = sv; mrow = fmaxf(mrow, sv); }
        mrow = fmaxf(mrow, __shfl_xor(mrow, 16)); mrow = fmaxf(mrow, __shfl_xor(mrow, 32));
        float lsum = 0.f;
        bf16x8 pf[5];
#pragma unroll
        for (int t = 0; t < 5; ++t) { f32x4 p0, p1;
#pragma unroll
            for (int j = 0; j < 4; ++j) { p0[j] = __builtin_amdgcn_exp2f(sa[2 * t][j] - mrow); p1[j] = __builtin_amdgcn_exp2f(sa[2 * t + 1][j] - mrow); lsum += p0[j] + p1[j]; }
            const u32x4 pk4 = pack8(p0, p1); pf[t] = __builtin_bit_cast(bf16x8, pk4); }
        lsum += __shfl_xor(lsum, 16); lsum += __shfl_xor(lsum, 32);
        __builtin_amdgcn_sched_barrier(0);
        f32x4 oa[8];
#pragma unroll
        for (int dt = 0; dt < 8; ++dt) oa[dt] = (f32x4){0.f, 0.f, 0.f, 0.f};
#pragma unroll
        for (int t = 0; t < 5; ++t) {
            const int T0 = w + 2 * t, T1 = (T0 + 1 < 16) ? T0 + 1 : T0;
            const int r0 = ((T0 < 8) ? sprev : scur) * 128 + 16 * (T0 & 7) + 4 * fq + (fr >> 2), r1 = ((T1 < 8) ? sprev : scur) * 128 + 16 * (T1 & 7) + 4 * fq + (fr >> 2);
            LAS unsigned char* a0 = Vs + r0 * 288 + (4 * (fr & 3)) * 2; LAS unsigned char* a1 = Vs + r1 * 288 + (4 * (fr & 3)) * 2;
#pragma unroll
            for (int dt = 0; dt < 8; ++dt) { const bf16x8 vf = tr_read2(a0 + 32 * dt, a1 + 32 * dt); oa[dt] = mfma16(vf, pf[t], oa[dt]); }
        }
        const float inv = __builtin_amdgcn_rcpf(lsum);
        bf16_t* po = aq + tokq * 2304 + head * 128 + 4 * fq;
#pragma unroll
        for (int dt = 0; dt < 8; ++dt) { u32x2 o; o.x = cvt_pk_bf16(oa[dt][0] * inv, oa[dt][1] * inv); o.y = cvt_pk_bf16(oa[dt][2] * inv, oa[dt][3] * inv); *(u32x2*)(po + 16 * dt) = o; }
        if (fq == 0) lse[tokq * 18 + head] = mrow * 0.6931471805599453f + __logf(lsum);
        __syncthreads();
    }
#undef ATT_LOAD_CUR
}

constexpr size_t WS_BAR = 700000;
DI void grid_barrier(unsigned* bar, unsigned& nbar, const bool hier, const unsigned xcd, const unsigned per_xcd) {
    asm volatile("s_waitcnt vmcnt(0)" ::: "memory");
    __syncthreads();
    if (threadIdx.x == 0) {
        __builtin_amdgcn_fence(__ATOMIC_RELEASE, "agent");
        asm volatile("s_waitcnt vmcnt(0)" ::: "memory");
        const unsigned gen = nbar + 1u;
        if (hier) {
            unsigned* xc = bar + 256 + 64 * xcd; unsigned* top = bar + 1024;
            const unsigned old = __hip_atomic_fetch_add(xc, 1u, __ATOMIC_RELAXED, __HIP_MEMORY_SCOPE_AGENT);
            if (old + 1u == gen * per_xcd) __hip_atomic_fetch_add(top, 1u, __ATOMIC_RELAXED, __HIP_MEMORY_SCOPE_AGENT);
            while (__hip_atomic_load(top, __ATOMIC_RELAXED, __HIP_MEMORY_SCOPE_AGENT) < gen * 8u) __builtin_amdgcn_s_sleep(1);
        } else {
            const unsigned target = gen * gridDim.x;
            __hip_atomic_fetch_add(bar, 1u, __ATOMIC_RELAXED, __HIP_MEMORY_SCOPE_AGENT);
            while (__hip_atomic_load(bar, __ATOMIC_RELAXED, __HIP_MEMORY_SCOPE_AGENT) < target) __builtin_amdgcn_s_sleep(1);
        }
        __builtin_amdgcn_fence(__ATOMIC_ACQUIRE, "agent");
        asm volatile("s_waitcnt vmcnt(0)" ::: "memory");
    }
    __syncthreads();
    ++nbar;
}

constexpr int N_PHASES = 13;
__global__ void __launch_bounds__(512, 2) mega(Params p) {
    extern __shared__ __attribute__((aligned(16))) unsigned char shm[];
    LAS unsigned char* lds = (LAS unsigned char*)shm;
    unsigned char* ws = p.ws;
    const int G = gridDim.x, c = blockIdx.x;
    unsigned* bar = (unsigned*)(ws + WS_BAR); unsigned nbar = 0;
    int c_eff = c; unsigned my_xcd = 0, my_idx = 0; bool hier = false;
    if (p.ph_hi - p.ph_lo > 1) {
        my_xcd = (unsigned)__builtin_amdgcn_s_getreg((3 << 11) | 20) & 0xFu;
        if (threadIdx.x == 0) my_idx = __hip_atomic_fetch_add(bar + 64 + 16 * (my_xcd & 7u), 1u, __ATOMIC_RELAXED, __HIP_MEMORY_SCOPE_AGENT);
        my_idx = (unsigned)__builtin_amdgcn_readfirstlane((int)my_idx);
    }
    if (p.ph_lo <= 0 && 0 < p.ph_hi) {
        if (0 > p.ph_lo) grid_barrier(bar, nbar, hier, my_xcd, (unsigned)G / 8u);

#if (PHMASK >> 0) & 1
            phase0(p, lds);
#endif
    }
    if (p.ph_lo <= 1 && 1 < p.ph_hi) {
        if (1 > p.ph_lo) cg::this_grid().sync();
        if (p.ph_hi - p.ph_lo > 1) {
            LAS unsigned* cw = (LAS unsigned*)lds;
            if (threadIdx.x == 0) {
                bool ok = (G % 8) == 0 && my_xcd < 8u;
                for (int x = 0; x < 8; ++x) ok = ok && (__hip_atomic_load(bar + 64 + 16 * x, __ATOMIC_RELAXED, __HIP_MEMORY_SCOPE_AGENT) == (unsigned)(G / 8));
                cw[0] = ok ? (my_idx * 8u + my_xcd) : (unsigned)c; cw[1] = ok ? 1u : 0u;
            }
            __syncthreads();
            c_eff = __builtin_amdgcn_readfirstlane((int)cw[0]);
            hier = (cw[1] != 0u);
            __syncthreads();
        }

#if (PHMASK >> 1) & 1
            phase_h(p);
#endif
    }
    if (p.ph_lo <= 2 && 2 < p.ph_hi) {
        if (2 > p.ph_lo) grid_barrier(bar, nbar, hier, my_xcd, (unsigned)G / 8u);

#if (PHMASK >> 2) & 1
            pg8::Gemm g{(const bf16_t*)(ws + WS_H), (const bf16_t*)(ws + WS_WIN), T_TOK, 59 * 256, 2048, nullptr, nullptr, 0}; pg8::StaticOrder S; S.init(T_TOK, 59 * 256, G, c_eff, 32, 16);
            EpiInProj E{(bf16_t*)(ws + WS_RQ), (bf16_t*)(ws + WS_RK), (bf16_t*)p.out, (bf16_t*)(ws + WS_AQ), (bf16_t*)(ws + WS_AK), (bf16_t*)(ws + WS_AV), p.pos};
            pg8::gemm_phase<1>(lds, g, S, E);
            { const int nwg2 = 128 * 59, rem = nwg2 % G;
              if (rem == 0) convert_ffn_weights(p, lds, c_eff, G); else if (c_eff >= rem) convert_ffn_weights(p, lds, c_eff - rem, G - rem); }
#endif
    }
    if (p.ph_lo <= 3 && 3 < p.ph_hi) {
        if (3 > p.ph_lo) grid_barrier(bar, nbar, hier, my_xcd, (unsigned)G / 8u);

#if (PHMASK >> 3) & 1
            phase_retention(p, lds, c_eff); __syncthreads();
#endif
#if (PHMASK >> 13) & 1
            phase_attention(p, lds);
#endif
    }
    if (p.ph_lo <= 4 && 4 < p.ph_hi) {
        if (4 > p.ph_lo) grid_barrier(bar, nbar, hier, my_xcd, (unsigned)G / 8u);

#if (PHMASK >> 4) & 1
            { pg8::Gemm g{(const bf16_t*)(ws + WS_H), (const bf16_t*)(ws + WS_WIN) + (size_t)8192 * 2048, T_TOK, 4096, 2048, nullptr, nullptr, 0}; pg8::StaticOrder S; S.init(T_TOK, 4096, G, c_eff);
              EpiRetGate E{(bf16_t*)p.out, (const float*)(ws + WS_RETSS), p.ret_gain}; pg8::gemm_phase<1>(lds, g, S, E); }
#endif
#if (PHMASK >> 14) & 1
            { pg8::Gemm g{(const bf16_t*)(ws + WS_H), (const bf16_t*)(ws + WS_WGATE), T_TOK, 4096, 2048, nullptr, nullptr, 0}; pg8::StaticOrder S; S.init(T_TOK, 4096, G, c_eff);
              EpiGates E{(bf16_t*)(ws + WS_GATES), p.b_gate}; pg8::gemm_phase<1>(lds, g, S, E); }
#endif
#if (PHMASK >> 15) & 1
            phase_alpha(p);
#endif
    }
    if (p.ph_lo <= 5 && 5 < p.ph_hi) {
        if (5 > p.ph_lo) grid_barrier(bar, nbar, hier, my_xcd, (unsigned)G / 8u);

#if (PHMASK >> 5) & 1
            pg8::Gemm g{(const bf16_t*)p.out, (const bf16_t*)(ws + WS_WRET), T_TOK, 2048, 4096, (const bf16_t*)(ws + WS_AQ), (const bf16_t*)(ws + WS_WATT), 2304}; pg8::StaticOrder S; S.init(T_TOK, 2048, G, c_eff);
            EpiYMerge E{(const bf16_t*)(ws + WS_GATES), (bf16_t*)(ws + WS_U2)}; pg8::gemm_phase<2>(lds, g, S, E);
#endif
    }
    if (p.ph_lo <= 7 && 7 < p.ph_hi) {
        if (7 > p.ph_lo) grid_barrier(bar, nbar, hier, my_xcd, (unsigned)G / 8u);

#if (PHMASK >> 7) & 1
            pg8::Gemm g{(const bf16_t*)(ws + WS_U2), (const bf16_t*)(ws + WS_WMIX), T_TOK, 2048, 2048, nullptr, nullptr, 0}; pg8::StaticOrder S; S.init(T_TOK, 2048, G, c_eff);
            EpiStoreBf16 E{(bf16_t*)(ws + WS_Y), 2048}; pg8::gemm_phase<1>(lds, g, S, E);
#endif
    }
    if (p.ph_lo <= 8 && 8 < p.ph_hi) {
        if (8 > p.ph_lo) grid_barrier(bar, nbar, hier, my_xcd, (unsigned)G / 8u);

#if (PHMASK >> 8) & 1
            phase_postmix(p);
#endif
    }
    if (p.ph_lo <= 9 && 9 < p.ph_hi) {
        if (9 > p.ph_lo) grid_barrier(bar, nbar, hier, my_xcd, (unsigned)G / 8u);

#if (PHMASK >> 9) & 1
            pg8::Gemm g{(const bf16_t*)(ws + WS_H2), (const bf16_t*)(ws + WS_WUP), T_TOK, FF, 2048, nullptr, nullptr, 0}; pg8::StaticOrder S; S.init(T_TOK, FF, G, c_eff);
            EpiStoreBf16 E{(bf16_t*)(ws + WS_A), FF}; pg8::gemm_phase<1>(lds, g, S, E);
#endif
    }
    if (p.ph_lo <= 10 && 10 < p.ph_hi) {
        if (10 > p.ph_lo) grid_barrier(bar, nbar, hier, my_xcd, (unsigned)G / 8u);

#if (PHMASK >> 10) & 1
            pg8::Gemm g{(const bf16_t*)(ws + WS_H2), (const bf16_t*)(ws + WS_WUP) + (size_t)FF * 2048, T_TOK, FF, 2048, nullptr, nullptr, 0}; pg8::StaticOrder S; S.init(T_TOK, FF, G, c_eff);
            EpiConvAct E{(const bf16_t*)(ws + WS_A), (bf16_t*)(ws + WS_ACT), p.conv_w, p.conv_b}; pg8::gemm_phase<1>(lds, g, S, E);
#endif
    }
    if (p.ph_lo <= 11 && 11 < p.ph_hi) {
        if (11 > p.ph_lo) grid_barrier(bar, nbar, hier, my_xcd, (unsigned)G / 8u);

#if (PHMASK >> 11) & 1
            pg8::Gemm g{(const bf16_t*)(ws + WS_ACT), (const bf16_t*)(ws + WS_WDOWN), T_TOK, 2048, FF, nullptr, nullptr, 0}; pg8::StaticOrder S; S.init(T_TOK, 2048, G, c_eff);
            EpiStoreBf16 E{(bf16_t*)(ws + WS_Y2), 2048}; pg8::gemm_phase<1>(lds, g, S, E);
#endif
    }
    if (p.ph_lo <= 12 && 12 < p.ph_hi) {
        if (12 > p.ph_lo) grid_barrier(bar, nbar, hier, my_xcd, (unsigned)G / 8u);

#if (PHMASK >> 12) & 1
            phase_final(p);
#endif
    }
}

extern "C" void kernel_launch(void* const* d_in, const int* in_sizes, int n_in, void* d_out, int out_size, void* d_ws, size_t ws_size, hipStream_t stream) {
    static int grid = 0;
    if (grid == 0) {
        if (n_in != 20 || ws_size < WS_END) { fprintf(stderr, "kernel_launch: unexpected n_in %d or ws_size %zu (need %zu)\n", n_in, ws_size, (size_t)WS_END); grid = -1; return; }
        int dev = 0, cus = 0, per_cu = 0;
        hipGetDevice(&dev); hipDeviceGetAttribute(&cus, hipDeviceAttributeMultiprocessorCount, dev);
        if (hipFuncSetAttribute((const void*)mega, hipFuncAttributeMaxDynamicSharedMemorySize, LDS_BYTES) != hipSuccess) { fprintf(stderr, "kernel_launch: hipFuncSetAttribute failed\n"); grid = -1; return; }
        if (hipOccupancyMaxActiveBlocksPerMultiprocessor(&per_cu, (const void*)mega, 512, LDS_BYTES) != hipSuccess || per_cu < 1) { fprintf(stderr, "kernel_launch: occupancy query says %d\n", per_cu); per_cu = 1; }
        (void)hipGetLastError();
        grid = cus * 1;
    }
    if (grid < 0) return;
    Params p{};
    p.x = (const float*)d_in[0]; p.c = (const float*)d_in[1]; p.pos = (const int*)d_in[2]; p.w_ada = (const float*)d_in[3]; p.b_ada = (const float*)d_in[4]; p.g_pre_mix = (const float*)d_in[5];
    p.w_in = (const float*)d_in[6]; p.ret_gain = (const float*)d_in[7]; p.w_ret_out = (const float*)d_in[8]; p.w_att_out = (const float*)d_in[9]; p.w_gate = (const float*)d_in[10]; p.b_gate = (const float*)d_in[11];
    p.w_mix = (const float*)d_in[12]; p.g_post_mix = (const float*)d_in[13]; p.g_pre_ffn = (const float*)d_in[14]; p.w_up = (const float*)d_in[15]; p.conv_w = (const float*)d_in[16]; p.conv_b = (const float*)d_in[17];
    p.w_down = (const float*)d_in[18]; p.g_post_ffn = (const float*)d_in[19];
    p.out = (float*)d_out; p.ws = (unsigned char*)d_ws;
    if (hipMemsetAsync((char*)d_ws + WS_BAR, 0, 8192, stream) != hipSuccess) { fprintf(stderr, "kernel_launch: memset failed\n"); return; }
#if N_LAUNCH_PER_PHASE
    for (int ph = 0; ph < N_PHASES; ++ph) { p.ph_lo = ph; p.ph_hi = ph + 1; hipLaunchKernelGGL(mega, dim3(grid), dim3(512), LDS_BYTES, stream, p); }
#else
    p.ph_lo = 0; p.ph_hi = N_PHASES;
    void* args[] = {&p};
    hipError_t e = hipLaunchCooperativeKernel((const void*)mega, dim3(grid), dim3(512), args, LDS_BYTES, stream);
    if (e != hipSuccess) fprintf(stderr, "cooperative launch failed: %s (grid %d)\n", hipGetErrorString(e), grid);
#endif
}
```

```cpp
#include <hip/hip_runtime.h>
#include <hip/hip_cooperative_groups.h>
#include <cstdio>
#include <cstdint>
namespace cg = cooperative_groups;

#define DI __device__ __forceinline__
#define LAS __attribute__((address_space(3)))
typedef unsigned short bf16_t;
typedef short bf16x8 __attribute__((ext_vector_type(8)));
typedef short s16x4 __attribute__((ext_vector_type(4)));
typedef float f32x4 __attribute__((ext_vector_type(4)));
typedef unsigned u32x4 __attribute__((ext_vector_type(4)));
typedef unsigned u32x2 __attribute__((ext_vector_type(2)));

#ifndef PHMASK
#define PHMASK 0xFFFF
#endif
#ifndef N_LAUNCH_PER_PHASE
#define N_LAUNCH_PER_PHASE 0
#endif

constexpr int T_TOK = 32768, DM = 2048, SEQ = 8192, NB = 4;
constexpr int FF = 5632;
constexpr int LDS_BYTES = 143360;
constexpr size_t MiB = 1u << 20;
constexpr size_t WS_ADA = 0;
constexpr size_t WS_LSE = 1 * MiB;
constexpr size_t WS_RETSS = 4 * MiB;
constexpr size_t WS_WUP = 12 * MiB;
constexpr size_t WS_WDOWN = 56 * MiB;
constexpr size_t WS_WIN = 78 * MiB;
constexpr size_t WS_WGATE = 153 * MiB;
constexpr size_t WS_WRET = 169 * MiB;
constexpr size_t WS_WATT = 185 * MiB;
constexpr size_t WS_WMIX = 194 * MiB;
constexpr size_t WS_H = 206 * MiB;
constexpr size_t WS_RQ = 334 * MiB;
constexpr size_t WS_RK = 462 * MiB;
constexpr size_t WS_AQ = 590 * MiB;
constexpr size_t WS_AK = 734 * MiB;
constexpr size_t WS_AV = 878 * MiB;
constexpr size_t WS_GATES = 334 * MiB;
constexpr size_t WS_U = 734 * MiB;
constexpr size_t WS_U2 = 206 * MiB;
constexpr size_t WS_Y = 334 * MiB;
constexpr size_t WS_H2 = 78 * MiB;
constexpr size_t WS_A = 206 * MiB;
constexpr size_t WS_ACT = 558 * MiB;
constexpr size_t WS_Y2 = 78 * MiB;
constexpr size_t WS_END = 1022 * MiB;

struct Params {
    const float *x, *c; const int* pos;
    const float *w_ada, *b_ada, *g_pre_mix, *w_in, *ret_gain, *w_ret_out, *w_att_out, *w_gate, *b_gate, *w_mix, *g_post_mix, *g_pre_ffn, *w_up, *conv_w, *conv_b, *w_down, *g_post_ffn;
    float* out; unsigned char* ws; int ph_lo, ph_hi;
};

typedef __bf16 bf16x2_t __attribute__((ext_vector_type(2)));
DI unsigned cvt_pk_bf16(float lo, float hi) { bf16x2_t v = {(__bf16)lo, (__bf16)hi}; return __builtin_bit_cast(unsigned, v); }
DI float bflo(unsigned w) { return __uint_as_float(w << 16); }
DI float bfhi(unsigned w) { return __uint_as_float(w & 0xffff0000u); }
DI float wave_sum(float v) {
#pragma unroll
    for (int o = 1; o < 64; o <<= 1) v += __shfl_xor(v, o);
    return v;
}
DI float sigmoidf_(float v) { return __builtin_amdgcn_rcpf(1.0f + __builtin_amdgcn_exp2f(-1.4426950408889634f * v)); }
DI f32x4 mfma16(bf16x8 a, bf16x8 b, f32x4 c) { return __builtin_amdgcn_mfma_f32_16x16x32_bf16(a, b, c, 0, 0, 0); }
DI s16x4 tr_read(LAS unsigned char* p) { return __builtin_amdgcn_ds_read_tr16_b64_v4i16((LAS s16x4*)p); }
DI bf16x8 tr_read2(LAS unsigned char* p0, LAS unsigned char* p1) { s16x4 lo = tr_read(p0), hi = tr_read(p1); return __builtin_shufflevector(lo, hi, 0, 1, 2, 3, 4, 5, 6, 7); }

namespace pg8 {
constexpr int BM = 256, BK = 64, HALF = 128, HTB = HALF * BK * 2, STAGE_BYTES = 8 * HTB, NXCD = 8, WGM = 8;
DI int lds_byte(int r, int c) { const int st = (r >> 4) * 2 + (c >> 5), rr = r & 15, cc = c & 31, ob = rr * 64 + cc * 2; return st * 1024 + (ob ^ (((ob >> 9) & 1) << 5)); }
DI void stage_rc(int b, int& R, int& C) { const int st = b / 1024, sb = b % 1024, swz = sb ^ (((sb >> 9) & 1) << 5); R = (st >> 1) * 16 + swz / 64; C = (st & 1) * 32 + (swz % 64) / 2; }
struct Unit { int pm, pn; };
struct Gemm { const bf16_t* A; const bf16_t* Bt; int M, N, K; const bf16_t* A1; const bf16_t* Bt1; int K1; };
struct StaticOrder {
    int nM, nN, nwg, G, c, skip_lo, skip_n;
    DI void init(int M, int N, int G_, int c_, int slo = 1 << 30, int sn = 0) { nM = M / BM; nN = N / BM; nwg = nM * nN; G = G_; c = c_; skip_lo = slo; skip_n = sn; }
    DI bool next(int i, Unit& u) const {
        const long L = (long)i * G + c; if (L >= nwg) return false;
        int wgid = (int)L; { const int q = nwg / NXCD, r = nwg % NXCD, xcd = wgid % NXCD, off = wgid / NXCD; wgid = (xcd < r ? xcd * (q + 1) : r * (q + 1) + (xcd - r) * q) + off; }
        const int nig = WGM * nN, gid = wgid / nig, fm = gid * WGM, gsz = (nM - fm) < WGM ? (nM - fm) : WGM;
        u.pm = fm + ((wgid % nig) % gsz); u.pn = (wgid % nig) / gsz; if (u.pn >= skip_lo) u.pn += skip_n; return true;
    }
};

#ifndef PG8_ALIGN
#define PG8_ALIGN true
#endif
#ifndef PG8_SP2
#define PG8_SP2 true
#endif
template <int NSEG, class Epi, bool ALIGN_EPI = PG8_ALIGN, bool SP2 = PG8_SP2>
DI void gemm_phase(LAS unsigned char* lds, const Gemm g, const StaticOrder& S, const Epi& E) {
    const int tid = threadIdx.x, wid = __builtin_amdgcn_readfirstlane(tid >> 6), lane = tid & 63, wr = wid >> 2, wc = wid & 3, fr = lane & 15, fq = lane >> 4;
    int Rr[2], Cc[2];
#pragma unroll
    for (int i = 0; i < 2; ++i) stage_rc(tid * 16 + i * 8192, Rr[i], Cc[i]);
    const size_t kstep = (size_t)(BK * 2);
    const unsigned ldsw = (unsigned)wid * 1024u;
    const int aoff = lds_byte(wr * 64 + fr, fq * 8), boff = lds_byte(wc * 32 + fr, fq * 8);
#define PG8_SA(b, h) (((b) * 2 + (h)) * HTB)
#define PG8_SB(b, h) ((4 + (b) * 2 + (h)) * HTB)
#define PG8_STAGE(bufoff, gbase, VO) do { _Pragma("unroll") for (int _i = 0; _i < 2; ++_i) \
        __builtin_amdgcn_global_load_lds((const unsigned*)((const char*)(gbase) + VO[_i]), (LAS unsigned*)(lds + (bufoff) + ldsw + _i * 8192), 16, 0, 0); } while (0)
#define PG8_LDA(dst, b, h) do { _Pragma("unroll") for (int m = 0; m < 4; ++m) _Pragma("unroll") for (int k = 0; k < 2; ++k) dst[m][k] = *(const LAS bf16x8*)(lds + PG8_SA(b, h) + aoff + m * 2048 + k * 1024); } while (0)
#define PG8_LDB(dst, b, h) do { _Pragma("unroll") for (int n = 0; n < 2; ++n) _Pragma("unroll") for (int k = 0; k < 2; ++k) dst[n][k] = *(const LAS bf16x8*)(lds + PG8_SB(b, h) + boff + n * 2048 + k * 1024); } while (0)
#define PG8_MMA(ai, bj, At, Bt) do { __builtin_amdgcn_s_setprio(1); _Pragma("unroll") for (int m = 0; m < 4; ++m) _Pragma("unroll") for (int n = 0; n < 2; ++n) _Pragma("unroll") for (int k = 0; k < 2; ++k) \
        acc[ai][bj][m][n] = __builtin_amdgcn_mfma_f32_16x16x32_bf16(Bt[n][k], At[m][k], acc[ai][bj][m][n], 0, 0, 0); __builtin_amdgcn_s_setprio(0); } while (0)
#define PG8_WAIT_V(n) asm volatile("s_waitcnt vmcnt(" #n ")" ::: "memory")
#define PG8_WAIT_L(n) asm volatile("s_waitcnt lgkmcnt(" #n ")" ::: "memory")
#define PG8_BAR __builtin_amdgcn_s_barrier()
#define PG8_SCHED __builtin_amdgcn_sched_barrier(0)
    Unit cur, nxt; int ti = 0, seg = 0;
    if (!S.next(0, cur)) return;
    f32x4 acc[2][2][4][2];
#pragma unroll
    for (int a = 0; a < 2; ++a)
#pragma unroll
        for (int b = 0; b < 2; ++b)
#pragma unroll
            for (int m = 0; m < 4; ++m)
#pragma unroll
                for (int n = 0; n < 2; ++n) acc[a][b][m][n] = (f32x4){0.f, 0.f, 0.f, 0.f};
    bf16x8 At[4][2], B0[2][2], B1[2][2];
    int Kc = g.K;
    unsigned voffC[2];
#pragma unroll
    for (int i = 0; i < 2; ++i) voffC[i] = (unsigned)(Rr[i] * Kc + Cc[i]) * 2u;
    size_t hstepC = (size_t)HALF * Kc * 2;
    const char* cA = (const char*)g.A + (size_t)cur.pm * 2 * hstepC; const char* cB = (const char*)g.Bt + (size_t)cur.pn * 2 * hstepC;
    if constexpr (SP2) {
        PG8_STAGE(PG8_SB(0, 0), cB, voffC); PG8_STAGE(PG8_SB(0, 1), cB + hstepC, voffC); PG8_STAGE(PG8_SA(0, 0), cA, voffC); PG8_STAGE(PG8_SA(0, 1), cA + hstepC, voffC);
        if (wr == 1) PG8_BAR;
        PG8_WAIT_V(2); PG8_BAR;
        PG8_STAGE(PG8_SB(1, 0), cB + kstep, voffC); PG8_STAGE(PG8_SA(1, 0), cA + kstep, voffC); PG8_STAGE(PG8_SB(1, 1), cB + hstepC + kstep, voffC);
        PG8_WAIT_V(6); PG8_BAR;
    } else {
        PG8_STAGE(PG8_SB(0, 0), cB, voffC); PG8_STAGE(PG8_SA(0, 0), cA, voffC); PG8_STAGE(PG8_SB(0, 1), cB + hstepC, voffC); PG8_STAGE(PG8_SA(0, 1), cA + hstepC, voffC);
        if (wr == 1) PG8_BAR;
        PG8_WAIT_V(4); PG8_BAR;
        PG8_STAGE(PG8_SB(1, 0), cB + kstep, voffC); PG8_STAGE(PG8_SA(1, 0), cA + kstep, voffC); PG8_STAGE(PG8_SB(1, 1), cB + hstepC + kstep, voffC);
        PG8_WAIT_V(6); PG8_BAR;
    }
    for (;;) {
        bool has_next; int nseg = 0;
        if (NSEG > 1 && seg + 1 < NSEG) { has_next = true; nxt = cur; nseg = seg + 1; }
        else has_next = S.next(ti + 1, nxt);
        int Kn = Kc; const char* nA = cA; const char* nB = cB;
        if (has_next) { Kn = (NSEG > 1 && nseg == 1) ? g.K1 : g.K;
            nA = (const char*)((NSEG > 1 && nseg == 1) ? g.A1 : g.A) + (size_t)nxt.pm * 256 * Kn * 2; nB = (const char*)((NSEG > 1 && nseg == 1) ? g.Bt1 : g.Bt) + (size_t)nxt.pn * 256 * Kn * 2; }
        unsigned voffN[2];
#pragma unroll
        for (int i = 0; i < 2; ++i) voffN[i] = (NSEG > 1) ? (unsigned)(Rr[i] * Kn + Cc[i]) * 2u : voffC[i];
        const size_t hstepN = (NSEG > 1) ? (size_t)HALF * Kn * 2 : hstepC;
        const int nt = Kc / BK;
        for (int t = 0; t < nt; t += 2) {
            const bool last = (t == nt - 2);
            const char* a1 = cA + (size_t)(t + 1) * kstep;
            const char* a2 = last ? nA : cA + (size_t)(t + 2) * kstep; const char* b2 = last ? nB : cB + (size_t)(t + 2) * kstep;
            const char* a3 = a2 + kstep; const char* b3 = b2 + kstep;
            unsigned v2[2]; v2[0] = (NSEG > 1 && last) ? voffN[0] : voffC[0]; v2[1] = (NSEG > 1 && last) ? voffN[1] : voffC[1];
            const size_t h2 = (NSEG > 1 && last) ? hstepN : hstepC;
            if constexpr (SP2) {
            PG8_LDB(B0, 0, 0); PG8_LDB(B1, 0, 1); PG8_SCHED; PG8_LDA(At, 0, 0); PG8_STAGE(PG8_SA(1, 1), a1 + hstepC, voffC);
            PG8_WAIT_V(8); PG8_WAIT_L(0); PG8_BAR; PG8_MMA(0, 0, At, B0); PG8_MMA(0, 1, At, B1); PG8_BAR; PG8_SCHED;
            PG8_LDA(At, 0, 1); PG8_STAGE(PG8_SB(0, 0), b2, v2); PG8_STAGE(PG8_SB(0, 1), b2 + h2, v2); PG8_STAGE(PG8_SA(0, 0), a2, v2);
            PG8_WAIT_V(8); PG8_WAIT_L(0); PG8_BAR; PG8_MMA(1, 0, At, B0); PG8_MMA(1, 1, At, B1); PG8_BAR; PG8_SCHED;
            PG8_LDB(B0, 1, 0); PG8_LDB(B1, 1, 1); PG8_SCHED; PG8_LDA(At, 1, 0); PG8_STAGE(PG8_SA(0, 1), a2 + h2, v2);
            PG8_WAIT_V(8); PG8_WAIT_L(0); PG8_BAR; PG8_MMA(0, 0, At, B0); PG8_MMA(0, 1, At, B1); PG8_BAR; PG8_SCHED;
            PG8_LDA(At, 1, 1); PG8_STAGE(PG8_SB(1, 0), b3, v2); PG8_STAGE(PG8_SB(1, 1), b3 + h2, v2); PG8_STAGE(PG8_SA(1, 0), a3, v2);
            PG8_WAIT_V(8); PG8_WAIT_L(0); PG8_BAR; PG8_MMA(1, 0, At, B0); PG8_MMA(1, 1, At, B1); PG8_BAR; PG8_SCHED;
            } else {
            PG8_LDB(B0, 0, 0); PG8_SCHED; PG8_LDA(At, 0, 0); PG8_STAGE(PG8_SA(1, 1), a1 + hstepC, voffC);
            PG8_WAIT_L(8); PG8_BAR; PG8_WAIT_L(0); PG8_MMA(0, 0, At, B0); PG8_BAR; PG8_SCHED;
            PG8_LDB(B1, 0, 1); PG8_STAGE(PG8_SB(0, 0), b2, v2);
            PG8_BAR; PG8_WAIT_L(0); PG8_MMA(0, 1, At, B1); PG8_BAR;
            PG8_LDA(At, 0, 1); PG8_STAGE(PG8_SA(0, 0), a2, v2);
            PG8_BAR; PG8_WAIT_L(0); PG8_MMA(1, 0, At, B0); PG8_BAR; PG8_SCHED;
            PG8_STAGE(PG8_SB(0, 1), b2 + h2, v2);
            PG8_WAIT_V(6); PG8_BAR; PG8_MMA(1, 1, At, B1); PG8_BAR;
            PG8_LDB(B0, 1, 0); PG8_SCHED; PG8_LDA(At, 1, 0); PG8_STAGE(PG8_SA(0, 1), a2 + h2, v2);
            PG8_WAIT_L(8); PG8_BAR; PG8_WAIT_L(0); PG8_MMA(0, 0, At, B0); PG8_BAR; PG8_SCHED;
            PG8_LDB(B1, 1, 1); PG8_STAGE(PG8_SB(1, 0), b3, v2);
            PG8_BAR; PG8_WAIT_L(0); PG8_MMA(0, 1, At, B1); PG8_BAR;
            PG8_LDA(At, 1, 1); PG8_STAGE(PG8_SA(1, 0), a3, v2);
            PG8_BAR; PG8_WAIT_L(0); PG8_MMA(1, 0, At, B0); PG8_BAR; PG8_SCHED;
            PG8_STAGE(PG8_SB(1, 1), b3 + h2, v2);
            PG8_WAIT_V(6); PG8_BAR; PG8_MMA(1, 1, At, B1); PG8_BAR;
            }
        }
        if constexpr (ALIGN_EPI) { if (wr == 0) PG8_BAR; }
        if constexpr (NSEG > 1) { if (seg + 1 < NSEG) E.mid(acc, cur, wr, wc, fr, fq); else E(acc, cur, wr, wc, fr, fq); }
        else E(acc, cur, wr, wc, fr, fq);
        if (!has_next) break;
        if (NSEG == 1 || nseg == 0) {
#pragma unroll
            for (int a = 0; a < 2; ++a)
#pragma unroll
                for (int b = 0; b < 2; ++b)
#pragma unroll
                    for (int m = 0; m < 4; ++m)
#pragma unroll
                        for (int n = 0; n < 2; ++n) acc[a][b][m][n] = (f32x4){0.f, 0.f, 0.f, 0.f};
            ++ti;
        }
        cur = nxt; cA = nA; cB = nB; seg = nseg;
        if (NSEG > 1) { Kc = Kn; voffC[0] = voffN[0]; voffC[1] = voffN[1]; hstepC = hstepN; }
        if constexpr (ALIGN_EPI) { if (wr == 1) PG8_BAR; }
    }
    PG8_WAIT_V(0);
    if constexpr (!ALIGN_EPI) { if (wr == 0) PG8_BAR; }
    PG8_BAR;
#undef PG8_SA
#undef PG8_SB
#undef PG8_STAGE
#undef PG8_LDA
#undef PG8_LDB
#undef PG8_MMA
#undef PG8_WAIT_V
#undef PG8_WAIT_L
#undef PG8_BAR
#undef PG8_SCHED
}
}
using pg8::Unit;
typedef f32x4 AccT[2][2][4][2];

DI u32x4 pack8(const f32x4& v0, const f32x4& v1) { u32x4 w; w.x = cvt_pk_bf16(v0[0], v0[1]); w.y = cvt_pk_bf16(v0[2], v0[3]); w.z = cvt_pk_bf16(v1[0], v1[1]); w.w = cvt_pk_bf16(v1[2], v1[3]); return w; }

struct EpiStoreBf16 {
    bf16_t* O; int ld;
    DI void operator()(const AccT& acc, const Unit& u, int wr, int wc, int fr, int fq) const {
        const int row0 = u.pm * 256 + wr * 64 + fr, col0 = u.pn * 256 + wc * 32 + 8 * fq;
#pragma unroll
        for (int ai = 0; ai < 2; ++ai)
#pragma unroll
            for (int m = 0; m < 4; ++m) { bf16_t* rowp = O + (size_t)(row0 + ai * 128 + m * 16) * ld + col0;
#pragma unroll
                for (int bj = 0; bj < 2; ++bj) *(u32x4*)(rowp + bj * 128) = pack8(acc[ai][bj][m][0], acc[ai][bj][m][1]); }
    }
};

template <int HD>
DI void rope_store(const AccT& acc, int rowbase, const int* pos, bf16_t* dst, int ld, int c1, int half, int ibase, float scale) {
    int pi[2][4];
#pragma unroll
    for (int ai = 0; ai < 2; ++ai)
#pragma unroll
        for (int m = 0; m < 4; ++m) pi[ai][m] = pos[rowbase + ai * 128 + m * 16];
    float invf[2][4];
#pragma unroll
    for (int n = 0; n < 2; ++n)
#pragma unroll
        for (int j = 0; j < 4; ++j) invf[n][j] = exp2f(-(float)(ibase + 4 * n + j) * (2.0f / HD) * 13.287712379549449f);
#pragma unroll
    for (int ai = 0; ai < 2; ++ai)
#pragma unroll
        for (int m = 0; m < 4; ++m) {
            const int row = rowbase + ai * 128 + m * 16; const float ps = (float)pi[ai][m];
            f32x4 o1[2], o2[2];
#pragma unroll
            for (int n = 0; n < 2; ++n)
#pragma unroll
                for (int j = 0; j < 4; ++j) {
                    const float ang = ps * invf[n][j]; const float rev = __builtin_amdgcn_fractf(ang * 0.15915494309189535f);
                    const float sn = __builtin_amdgcn_sinf(rev), cs = __builtin_amdgcn_cosf(rev);
                    const float t1 = acc[ai][0][m][n][j], t2 = acc[ai][1][m][n][j];
                    o1[n][j] = (t1 * cs - t2 * sn) * scale; o2[n][j] = (t2 * cs + t1 * sn) * scale;
                }
            bf16_t* rowp = dst + (size_t)row * ld + c1;
            *(u32x4*)rowp = pack8(o1[0], o1[1]); *(u32x4*)(rowp + half) = pack8(o2[0], o2[1]);
        }
}

struct EpiInProj {
    bf16_t *rq, *rk, *rv, *aq, *ak, *av; const int* pos;
    DI void operator()(const AccT& acc, const Unit& u, int wr, int wc, int fr, int fq) const {
        const int pn = u.pn, rowbase = u.pm * 256 + wr * 64 + fr;
        if (pn < 16) {
            bf16_t* dst = pn < 8 ? rq : rk; const float scale = pn < 8 ? 1.0f : 0.0625f;
            rope_store<256>(acc, rowbase, pos, dst, 2048, 256 * (pn & 7) + 32 * wc + 8 * fq, 128, 32 * wc + 8 * fq, scale);
        } else if (pn < 32) {
            const int col0 = (pn - 16) * 256 + wc * 32 + 8 * fq;
#pragma unroll
            for (int ai = 0; ai < 2; ++ai)
#pragma unroll
                for (int m = 0; m < 4; ++m) { bf16_t* rowp = rv + (size_t)(rowbase + ai * 128 + m * 16) * 4096 + col0;
#pragma unroll
                    for (int bj = 0; bj < 2; ++bj) *(u32x4*)(rowp + bj * 128) = pack8(acc[ai][bj][m][0], acc[ai][bj][m][1]); }
        } else if (pn < 66) {
            const int q9 = pn - 48; bf16_t* dst = q9 < 9 ? aq : ak; const int t9 = q9 < 9 ? q9 : q9 - 9;
            const int head = 2 * t9 + (wc >> 1), ib = 32 * (wc & 1) + 8 * fq;
            rope_store<128>(acc, rowbase, pos, dst, 2304, head * 128 + ib, 64, ib, 1.0f);
        } else {
            const int col0 = (pn - 66) * 256 + wc * 32 + 8 * fq;
#pragma unroll
            for (int ai = 0; ai < 2; ++ai)
#pragma unroll
                for (int m = 0; m < 4; ++m) { bf16_t* rowp = av + (size_t)(rowbase + ai * 128 + m * 16) * 2304 + col0;
#pragma unroll
                    for (int bj = 0; bj < 2; ++bj) *(u32x4*)(rowp + bj * 128) = pack8(acc[ai][bj][m][0], acc[ai][bj][m][1]); }
        }
    }
};

struct EpiRetGate {
    bf16_t* ret; const float* retss; const float* gain;
    DI void operator()(const AccT& acc, const Unit& u, int wr, int wc, int fr, int fq) const {
        const int rowbase = u.pm * 256 + wr * 64 + fr, head = u.pn >> 1, colb = u.pn * 256 + wc * 32 + 8 * fq;
        f32x4 gn[2][2];
#pragma unroll
        for (int bj = 0; bj < 2; ++bj) { gn[bj][0] = *(const f32x4*)(gain + colb + bj * 128); gn[bj][1] = *(const f32x4*)(gain + colb + bj * 128 + 4); }
#pragma unroll
        for (int ai = 0; ai < 2; ++ai) {
            f32x4 sA[4], sB[4]; u32x4 rr[4][2];
#pragma unroll
            for (int m = 0; m < 4; ++m) { const float* ps = retss + ((size_t)(rowbase + ai * 128 + m * 16) * 8 + head) * 8; sA[m] = *(const f32x4*)ps; sB[m] = *(const f32x4*)(ps + 4); }
#pragma unroll
            for (int m = 0; m < 4; ++m)
#pragma unroll
                for (int bj = 0; bj < 2; ++bj) rr[m][bj] = *(const u32x4*)(ret + (size_t)(rowbase + ai * 128 + m * 16) * 4096 + colb + bj * 128);
#pragma unroll
            for (int m = 0; m < 4; ++m) {
                const f32x4 s0 = sA[m], s1 = sB[m];
                const float rsv = __builtin_amdgcn_rsqf((((s0[0] + s0[1]) + (s0[2] + s0[3])) + ((s1[0] + s1[1]) + (s1[2] + s1[3]))) * (1.0f / 512.0f) + 1e-6f);
#pragma unroll
                for (int bj = 0; bj < 2; ++bj) {
                    const u32x4 r4 = rr[m][bj];
                    const float rf[8] = {bflo(r4.x), bfhi(r4.x), bflo(r4.y), bfhi(r4.y), bflo(r4.z), bfhi(r4.z), bflo(r4.w), bfhi(r4.w)};
                    f32x4 o0, o1;
#pragma unroll
                    for (int j = 0; j < 4; ++j) {
                        const float a0 = acc[ai][bj][m][0][j], a1 = acc[ai][bj][m][1][j];
                        o0[j] = a0 * sigmoidf_(a0) * (rf[j] * rsv * gn[bj][0][j]); o1[j] = a1 * sigmoidf_(a1) * (rf[4 + j] * rsv * gn[bj][1][j]);
                    }
                    *(u32x4*)(ret + (size_t)(rowbase + ai * 128 + m * 16) * 4096 + colb + bj * 128) = pack8(o0, o1);
                }
            }
        }
    }
};

struct EpiGates {
    bf16_t* O; const float* bias;
    DI void operator()(const AccT& acc, const Unit& u, int wr, int wc, int fr, int fq) const {
        const int rowbase = u.pm * 256 + wr * 64 + fr;
#pragma unroll
        for (int bj = 0; bj < 2; ++bj) {
            const int col = u.pn * 256 + bj * 128 + wc * 32 + 8 * fq;
            const f32x4 b0 = *(const f32x4*)(bias + col), b1 = *(const f32x4*)(bias + col + 4);
#pragma unroll
            for (int ai = 0; ai < 2; ++ai)
#pragma unroll
                for (int m = 0; m < 4; ++m) {
                    f32x4 o0, o1;
#pragma unroll
                    for (int j = 0; j < 4; ++j) { o0[j] = sigmoidf_(acc[ai][bj][m][0][j] + b0[j]); o1[j] = sigmoidf_(acc[ai][bj][m][1][j] + b1[j]); }
                    *(u32x4*)(O + (size_t)(rowbase + ai * 128 + m * 16) * 4096 + col) = pack8(o0, o1);
                }
        }
    }
};

struct EpiYMerge {
    const bf16_t* gates; bf16_t* U2;
    DI void mid(AccT& acc, const Unit& u, int wr, int wc, int fr, int fq) const {
        const int rowbase = u.pm * 256 + wr * 64 + fr, colb = u.pn * 256 + wc * 32 + 8 * fq;
#pragma unroll
        for (int ai = 0; ai < 2; ++ai) {
            u32x4 gr[4][2], ga[4][2];
#pragma unroll
            for (int m = 0; m < 4; ++m)
#pragma unroll
                for (int bj = 0; bj < 2; ++bj) { const bf16_t* pg = gates + (size_t)(rowbase + ai * 128 + m * 16) * 4096 + colb + bj * 128; gr[m][bj] = *(const u32x4*)pg; ga[m][bj] = *(const u32x4*)(pg + 2048); }
#pragma unroll
            for (int m = 0; m < 4; ++m)
#pragma unroll
                for (int bj = 0; bj < 2; ++bj) {
                    const u32x4 g1 = gr[m][bj], g2 = ga[m][bj];
                    const float r[8] = {bflo(g1.x), bfhi(g1.x), bflo(g1.y), bfhi(g1.y), bflo(g1.z), bfhi(g1.z), bflo(g1.w), bfhi(g1.w)};
                    const float a[8] = {bflo(g2.x), bfhi(g2.x), bflo(g2.y), bfhi(g2.y), bflo(g2.z), bfhi(g2.z), bflo(g2.w), bfhi(g2.w)};
#pragma unroll
                    for (int j = 0; j < 4; ++j) { acc[ai][bj][m][0][j] *= r[j] * __builtin_amdgcn_rcpf(fmaxf(a[j], 1e-30f)); acc[ai][bj][m][1][j] *= r[4 + j] * __builtin_amdgcn_rcpf(fmaxf(a[4 + j], 1e-30f)); }
                }
        }
    }
    DI void operator()(const AccT& acc, const Unit& u, int wr, int wc, int fr, int fq) const {
        const int rowbase = u.pm * 256 + wr * 64 + fr, colb = u.pn * 256 + wc * 32 + 8 * fq;
        u32x4 gg[2][4][2];
#pragma unroll
        for (int ai = 0; ai < 2; ++ai)
#pragma unroll
            for (int m = 0; m < 4; ++m)
#pragma unroll
                for (int bj = 0; bj < 2; ++bj) gg[ai][m][bj] = *(const u32x4*)(gates + (size_t)(rowbase + ai * 128 + m * 16) * 4096 + 2048 + colb + bj * 128);
#pragma unroll
        for (int ai = 0; ai < 2; ++ai)
#pragma unroll
            for (int m = 0; m < 4; ++m)
#pragma unroll
                for (int bj = 0; bj < 2; ++bj) {
                    const u32x4 g4 = gg[ai][m][bj];
                    f32x4 o0 = acc[ai][bj][m][0], o1 = acc[ai][bj][m][1];
                    o0[0] *= bflo(g4.x); o0[1] *= bfhi(g4.x); o0[2] *= bflo(g4.y); o0[3] *= bfhi(g4.y);
                    o1[0] *= bflo(g4.z); o1[1] *= bfhi(g4.z); o1[2] *= bflo(g4.w); o1[3] *= bfhi(g4.w);
                    *(u32x4*)(U2 + (size_t)(rowbase + ai * 128 + m * 16) * 2048 + colb + bj * 128) = pack8(o0, o1);
                }
    }
};

DI float gelu_tanh(float v) {
    const float uu = 0.7978845608028654f * (v + 0.044715f * v * v * v);
    const float e = __builtin_amdgcn_exp2f(2.8853900817779268f * uu);
    return v - v * __builtin_amdgcn_rcpf(e + 1.0f);
}
struct EpiConvAct {
    const bf16_t* A; bf16_t* ACT; const float* conv_w; const float* conv_b;
    DI void operator()(const AccT& acc, const Unit& u, int wr, int wc, int fr, int fq) const {
        const int rowbase = u.pm * 256 + wr * 64 + fr;
#pragma unroll
        for (int bj = 0; bj < 2; ++bj) {
            const int col = u.pn * 256 + bj * 128 + wc * 32 + 8 * fq;
            f32x4 w0[2], w1[2], w2[2], cb[2];
#pragma unroll
            for (int hh = 0; hh < 2; ++hh) { w0[hh] = *(const f32x4*)(conv_w + col + 4 * hh); w1[hh] = *(const f32x4*)(conv_w + FF + col + 4 * hh); w2[hh] = *(const f32x4*)(conv_w + 2 * FF + col + 4 * hh); cb[hh] = *(const f32x4*)(conv_b + col + 4 * hh); }
#pragma unroll
            for (int aim = 0; aim < 4; ++aim) { const int ai = aim >> 1, mb = (aim & 1) * 2;
                u32x4 a0[4], a1[4], a2[4];
#pragma unroll
                for (int m = mb; m < mb + 2; ++m) {
                    const int row = rowbase + ai * 128 + m * 16; const int sq = row & (SEQ - 1);
                    const bf16_t* pa = A + (size_t)row * FF + col;
                    a0[m] = *(const u32x4*)pa;
                    a1[m] = *(const u32x4*)(pa - (sq >= 1 ? FF : 0));
                    a2[m] = *(const u32x4*)(pa - (sq >= 2 ? 2 * FF : 0));
                }
#pragma unroll
                for (int m = mb; m < mb + 2; ++m) {
                    const int row = rowbase + ai * 128 + m * 16; const int sq = row & (SEQ - 1);
                    const float k1 = sq >= 1 ? 1.0f : 0.0f, k2 = sq >= 2 ? 1.0f : 0.0f;
                    const u32x4 x0 = a0[m], x1 = a1[m], x2 = a2[m];
                    const float f0[8] = {bflo(x0.x), bfhi(x0.x), bflo(x0.y), bfhi(x0.y), bflo(x0.z), bfhi(x0.z), bflo(x0.w), bfhi(x0.w)};
                    const float f1[8] = {bflo(x1.x), bfhi(x1.x), bflo(x1.y), bfhi(x1.y), bflo(x1.z), bfhi(x1.z), bflo(x1.w), bfhi(x1.w)};
                    const float f2[8] = {bflo(x2.x), bfhi(x2.x), bflo(x2.y), bfhi(x2.y), bflo(x2.z), bfhi(x2.z), bflo(x2.w), bfhi(x2.w)};
                    f32x4 o0, o1;
#pragma unroll
                    for (int j = 0; j < 4; ++j) {
                        const float c0 = cb[0][j] + w0[0][j] * f0[j] + k1 * (w1[0][j] * f1[j]) + k2 * (w2[0][j] * f2[j]);
                        const float c1 = cb[1][j] + w0[1][j] * f0[4 + j] + k1 * (w1[1][j] * f1[4 + j]) + k2 * (w2[1][j] * f2[4 + j]);
                        o0[j] = gelu_tanh(c0) * acc[ai][bj][m][0][j]; o1[j] = gelu_tanh(c1) * acc[ai][bj][m][1][j];
                    }
                    *(u32x4*)(ACT + (size_t)row * FF + col) = pack8(o0, o1);
                }
            }
        }
    }
};

DI int invperm32(int c) { return 16 * ((c >> 2) & 1) + 4 * (c >> 3) + (c & 3); }
DI int slot_std(int c) { return (c & ~31) | invperm32(c & 31); }
DI int slot_win(int c) {
    if (c >= 12288 && c < 16896) { const int tc = c & 255, hh = tc >> 7, bj = (tc >> 6) & 1, i64 = tc & 63, x = 64 * hh + i64; return (c & ~255) + 128 * bj + (x & ~31) + invperm32(x & 31); }
    return slot_std(c);
}
DI void transpose_item(const float* W, int K, int N, bf16_t* WT, int mode, LAS float* scr, int item, int lane) {
    const int nblk = N / 32, kb = item / nblk, nb = item % nblk, k0 = 64 * kb, n0 = 32 * nb;
#pragma unroll 8
    for (int i = 0; i < 32; ++i) { const int kk = 2 * i + (lane >> 5); scr[kk * 33 + (lane & 31)] = W[(size_t)(k0 + kk) * N + n0 + (lane & 31)]; }
    asm volatile("s_waitcnt lgkmcnt(0)" ::: "memory");
    const int c = lane & 7;
#pragma unroll
    for (int j = 0; j < 4; ++j) { const int n = (lane >> 3) + 8 * j; const LAS float* s = scr + (8 * c) * 33 + n;
        u32x4 o; o.x = cvt_pk_bf16(s[0 * 33], s[1 * 33]); o.y = cvt_pk_bf16(s[2 * 33], s[3 * 33]); o.z = cvt_pk_bf16(s[4 * 33], s[5 * 33]); o.w = cvt_pk_bf16(s[6 * 33], s[7 * 33]);
        const int drow = mode ? slot_win(n0 + n) : slot_std(n0 + n);
        *(u32x4*)(WT + (size_t)drow * K + k0 + 8 * c) = o; }
    asm volatile("s_waitcnt lgkmcnt(0)" ::: "memory");
}

DI void phase0(const Params& p, LAS unsigned char* lds) {
    const int tid = threadIdx.x, lane = tid & 63, wave = tid >> 6;
    LAS float* sc = (LAS float*)lds;
    LAS float* red = sc + 8192;
    float* ada = (float*)(p.ws + WS_ADA);
    for (int i = tid; i < 8192; i += 512) { const float v = p.c[i]; sc[i] = v / (1.0f + __expf(-v)); }
    __syncthreads();
    for (int cb = blockIdx.x; cb < 256; cb += gridDim.x) {
        {
            const int rg = lane / 12, cq = lane - 12 * rg;
            f32x4 a0 = {0.f, 0.f, 0.f, 0.f}, a1 = a0, a2 = a0, a3 = a0;
            if (rg < 5) {
                const float* wp = p.w_ada + 48 * cb + 4 * cq;
#pragma unroll 13
                for (int i = 0; i < 52; ++i) { const int kl = 5 * i + rg; if (kl < 256) { const int kk = 256 * wave + kl; const f32x4 wv = *(const f32x4*)(wp + (size_t)kk * 12288);
                    a0 += sc[kk] * wv; a1 += sc[2048 + kk] * wv; a2 += sc[4096 + kk] * wv; a3 += sc[6144 + kk] * wv; } }
                LAS float* rp = red + ((wave * 5 + rg) * 4) * 48 + 4 * cq;
                *(LAS f32x4*)(rp) = a0; *(LAS f32x4*)(rp + 48) = a1; *(LAS f32x4*)(rp + 96) = a2; *(LAS f32x4*)(rp + 144) = a3;
            }
        }
        __syncthreads();
        if (tid < 192) { const int b = tid / 48, l = tid % 48; float sacc = 0.f;
#pragma unroll 8
            for (int wg = 0; wg < 40; ++wg) sacc += red[(wg * 4 + b) * 48 + l];
            ada[b * 12288 + 48 * cb + l] = sacc + p.b_ada[48 * cb + l]; }
        __syncthreads();
    }
    LAS float* scr = (LAS float*)(lds + 40960 + wave * 8448);
    const int gw = blockIdx.x * 8 + wave, NGW = gridDim.x * 8;
    constexpr int I_IN = (2048 / 64) * (19200 / 32), I_GATE = (2048 / 64) * (4096 / 32), I_RET = (4096 / 64) * (2048 / 32), I_ATT = (2304 / 64) * (2048 / 32),
                  I_MIX = (2048 / 64) * (2048 / 32), I_UP = (2048 / 64) * (11264 / 32), I_DOWN = (5632 / 64) * (2048 / 32);
    constexpr int NITEMS = I_IN + I_GATE + I_RET + I_ATT + I_MIX + I_UP + I_DOWN;
    for (int it = gw; it < NITEMS - I_UP; it += NGW) {
        int r = it;
        if (r < I_IN) { transpose_item(p.w_in, 2048, 19200, (bf16_t*)(p.ws + WS_WIN), 1, scr, r, lane); continue; } r -= I_IN;
        if (r < I_GATE) { transpose_item(p.w_gate, 2048, 4096, (bf16_t*)(p.ws + WS_WGATE), 0, scr, r, lane); continue; } r -= I_GATE;
        if (r < I_RET) { transpose_item(p.w_ret_out, 4096, 2048, (bf16_t*)(p.ws + WS_WRET), 0, scr, r, lane); continue; } r -= I_RET;
        if (r < I_ATT) { transpose_item(p.w_att_out, 2304, 2048, (bf16_t*)(p.ws + WS_WATT), 0, scr, r, lane); continue; } r -= I_ATT;
        if (r < I_MIX) { transpose_item(p.w_mix, 2048, 2048, (bf16_t*)(p.ws + WS_WMIX), 0, scr, r, lane); continue; } r -= I_MIX;
        transpose_item(p.w_down, 5632, 2048, (bf16_t*)(p.ws + WS_WDOWN), 0, scr, r, lane);
    }
}
DI void convert_ffn_weights(const Params& p, LAS unsigned char* lds, int idx, int nshare) {
    const int lane = threadIdx.x & 63, wave = threadIdx.x >> 6;
    LAS float* scr = (LAS float*)(lds + wave * 8448);
    constexpr int I_UP = (2048 / 64) * (11264 / 32), I_DOWN = (5632 / 64) * (2048 / 32);
    for (int it = idx * 8 + wave; it < I_UP; it += nshare * 8) transpose_item(p.w_up, 2048, 11264, (bf16_t*)(p.ws + WS_WUP), 0, scr, it, lane);
}

constexpr int NR = 2;
DI void phase_h(const Params& p) {
    const int lane = threadIdx.x & 63, wave = threadIdx.x >> 6;
    const float* ada = (const float*)(p.ws + WS_ADA); bf16_t* H = (bf16_t*)(p.ws + WS_H);
    const int nw = gridDim.x * 8;
    for (int row0 = blockIdx.x * 8 + wave; row0 < T_TOK; row0 += nw * NR) {
        f32x4 v[NR][4][2]; float ss[NR];
#pragma unroll
        for (int q = 0; q < NR; ++q) { const float* xr = p.x + (size_t)(row0 + q * nw) * DM; ss[q] = 0.f;
#pragma unroll
            for (int it = 0; it < 4; ++it) { const int col = (it * 64 + lane) * 8; v[q][it][0] = *(const f32x4*)(xr + col); v[q][it][1] = *(const f32x4*)(xr + col + 4); } }
#pragma unroll
        for (int q = 0; q < NR; ++q) {
#pragma unroll
            for (int it = 0; it < 4; ++it)
#pragma unroll
                for (int j = 0; j < 4; ++j) ss[q] += v[q][it][0][j] * v[q][it][0][j] + v[q][it][1][j] * v[q][it][1][j];
            ss[q] = __builtin_amdgcn_rsqf(wave_sum(ss[q]) * (1.0f / DM) + 1e-6f); }
#pragma unroll
        for (int it = 0; it < 4; ++it) { const int col = (it * 64 + lane) * 8;
            f32x4 g[2], sh[NR][2], scl[NR][2];
#pragma unroll
            for (int hh = 0; hh < 2; ++hh) { g[hh] = *(const f32x4*)(p.g_pre_mix + col + 4 * hh);
#pragma unroll
                for (int q = 0; q < NR; ++q) { const int b = (row0 + q * nw) / SEQ; sh[q][hh] = *(const f32x4*)(ada + b * 12288 + col + 4 * hh); scl[q][hh] = *(const f32x4*)(ada + b * 12288 + 2048 + col + 4 * hh); } }
#pragma unroll
            for (int q = 0; q < NR; ++q) { f32x4 o[2];
#pragma unroll
                for (int hh = 0; hh < 2; ++hh)
#pragma unroll
                    for (int j = 0; j < 4; ++j) o[hh][j] = v[q][it][hh][j] * ss[q] * g[hh][j] * (1.0f + scl[q][hh][j]) + sh[q][hh][j];
                *(u32x4*)(H + (size_t)(row0 + q * nw) * DM + col) = pack8(o[0], o[1]); } }
    }
}

DI void phase_postmix(const Params& p) {
    const int lane = threadIdx.x & 63, wave = threadIdx.x >> 6;
    const float* ada = (const float*)(p.ws + WS_ADA); const bf16_t* Y = (const bf16_t*)(p.ws + WS_Y); bf16_t* H2 = (bf16_t*)(p.ws + WS_H2);
    const int nw = gridDim.x * 8;
    for (int row0 = blockIdx.x * 8 + wave; row0 < T_TOK; row0 += nw * NR) {
        f32x4 y[NR][4][2], xv[NR][4][2]; float ry[NR], r1[NR];
#pragma unroll
        for (int q = 0; q < NR; ++q) { const size_t ro = (size_t)(row0 + q * nw) * DM;
#pragma unroll
            for (int it = 0; it < 4; ++it) { const int col = (it * 64 + lane) * 8; const u32x4 w = *(const u32x4*)(Y + ro + col);
                y[q][it][0] = (f32x4){bflo(w.x), bfhi(w.x), bflo(w.y), bfhi(w.y)}; y[q][it][1] = (f32x4){bflo(w.z), bfhi(w.z), bflo(w.w), bfhi(w.w)};
                xv[q][it][0] = *(const f32x4*)(p.x + ro + col); xv[q][it][1] = *(const f32x4*)(p.x + ro + col + 4); } }
#pragma unroll
        for (int q = 0; q < NR; ++q) { float ss = 0.f;
#pragma unroll
            for (int it = 0; it < 4; ++it)
#pragma unroll
                for (int j = 0; j < 4; ++j) ss += y[q][it][0][j] * y[q][it][0][j] + y[q][it][1][j] * y[q][it][1][j];
            ry[q] = __builtin_amdgcn_rsqf(wave_sum(ss) * (1.0f / DM) + 1e-6f); }
#pragma unroll
        for (int q = 0; q < NR; ++q) { const int row = row0 + q * nw; const float* ab = ada + (row / SEQ) * 12288; float s1 = 0.f;
#pragma unroll
            for (int it = 0; it < 4; ++it) { const int col = (it * 64 + lane) * 8;
#pragma unroll
                for (int hh = 0; hh < 2; ++hh) { const f32x4 g = *(const f32x4*)(p.g_post_mix + col + 4 * hh), gt = *(const f32x4*)(ab + 4096 + col + 4 * hh);
                    f32x4 o;
#pragma unroll
                    for (int j = 0; j < 4; ++j) { o[j] = xv[q][it][hh][j] + gt[j] * (y[q][it][hh][j] * ry[q] * g[j]); s1 += o[j] * o[j]; }
                    y[q][it][hh] = o; }
                *(u32x4*)((bf16_t*)(p.out + (size_t)row * DM + DM / 2) + col) = pack8(y[q][it][0], y[q][it][1]); }
            r1[q] = __builtin_amdgcn_rsqf(wave_sum(s1) * (1.0f / DM) + 1e-6f); }
#pragma unroll
        for (int q = 0; q < NR; ++q) { const int row = row0 + q * nw; const float* ab = ada + (row / SEQ) * 12288;
#pragma unroll
            for (int it = 0; it < 4; ++it) { const int col = (it * 64 + lane) * 8; f32x4 o[2];
#pragma unroll
                for (int hh = 0; hh < 2; ++hh) { const f32x4 g = *(const f32x4*)(p.g_pre_ffn + col + 4 * hh), sh = *(const f32x4*)(ab + 6144 + col + 4 * hh), scl = *(const f32x4*)(ab + 8192 + col + 4 * hh);
#pragma unroll
                    for (int j = 0; j < 4; ++j) o[hh][j] = y[q][it][hh][j] * r1[q] * g[j] * (1.0f + scl[j]) + sh[j]; }
                *(u32x4*)(H2 + (size_t)row * DM + col) = pack8(o[0], o[1]); } }
    }
}

DI void phase_final(const Params& p) {
    const int lane = threadIdx.x & 63, wave = threadIdx.x >> 6;
    const float* ada = (const float*)(p.ws + WS_ADA); const bf16_t* Y = (const bf16_t*)(p.ws + WS_Y2);
    const int nw = gridDim.x * 8;
    for (int row0 = blockIdx.x * 8 + wave; row0 < T_TOK; row0 += nw * NR) {
        f32x4 y[NR][4][2], xv[NR][4][2]; float ry[NR];
#pragma unroll
        for (int q = 0; q < NR; ++q) { const size_t ro = (size_t)(row0 + q * nw) * DM;
#pragma unroll
            for (int it = 0; it < 4; ++it) { const int col = (it * 64 + lane) * 8; const u32x4 w = *(const u32x4*)(Y + ro + col);
                y[q][it][0] = (f32x4){bflo(w.x), bfhi(w.x), bflo(w.y), bfhi(w.y)}; y[q][it][1] = (f32x4){bflo(w.z), bfhi(w.z), bflo(w.w), bfhi(w.w)};
                const u32x4 xw = *(const u32x4*)((const bf16_t*)(p.out + ro + DM / 2) + col);
                xv[q][it][0] = (f32x4){bflo(xw.x), bfhi(xw.x), bflo(xw.y), bfhi(xw.y)}; xv[q][it][1] = (f32x4){bflo(xw.z), bfhi(xw.z), bflo(xw.w), bfhi(xw.w)}; } }
#pragma unroll
        for (int q = 0; q < NR; ++q) { float ss = 0.f;
#pragma unroll
            for (int it = 0; it < 4; ++it)
#pragma unroll
                for (int j = 0; j < 4; ++j) ss += y[q][it][0][j] * y[q][it][0][j] + y[q][it][1][j] * y[q][it][1][j];
            ry[q] = __builtin_amdgcn_rsqf(wave_sum(ss) * (1.0f / DM) + 1e-6f); }
#pragma unroll
        for (int q = 0; q < NR; ++q) { const int row = row0 + q * nw; const float* ab = ada + (row / SEQ) * 12288;
#pragma unroll
            for (int it = 0; it < 4; ++it) { const int col = (it * 64 + lane) * 8;
#pragma unroll
                for (int hh = 0; hh < 2; ++hh) { const f32x4 g = *(const f32x4*)(p.g_post_ffn + col + 4 * hh), gt = *(const f32x4*)(ab + 10240 + col + 4 * hh);
                    f32x4 o;
#pragma unroll
                    for (int j = 0; j < 4; ++j) o[j] = xv[q][it][hh][j] + gt[j] * (y[q][it][hh][j] * ry[q] * g[j]);
                    *(f32x4*)(p.out + (size_t)row * DM + col + 4 * hh) = o; } } }
    }
}

DI void phase_alpha(const Params& p) {
    bf16_t* att = (bf16_t*)(p.ws + WS_AQ); const float* lse = (const float*)(p.ws + WS_LSE);
    const int lane = threadIdx.x & 63, wave = threadIdx.x >> 6;
    for (int t = blockIdx.x * 8 + wave; t < T_TOK; t += gridDim.x * 8) {
        const float l = lse[(size_t)t * 18 + (lane < 18 ? lane : 0)];
        const int j = lane % 6;
        const float l0 = __shfl(l, j), l1 = __shfl(l, 6 + j), l2 = __shfl(l, 12 + j);
        const float mm = fmaxf(l0, fmaxf(l1, l2)); const float e0 = __expf(l0 - mm), e1 = __expf(l1 - mm), e2 = __expf(l2 - mm);
        const float al_lane = __expf(l - mm) / (e0 + e1 + e2);
        u32x4* row = (u32x4*)(att + (size_t)t * 2304);
        u32x4 w[5];
#pragma unroll
        for (int k = 0; k < 5; ++k) { const int ch = lane + 64 * k; if (ch < 288) w[k] = row[ch]; }
#pragma unroll
        for (int k = 0; k < 5; ++k) { const int ch = lane + 64 * k; const float al = __shfl(al_lane, (ch < 288 ? ch : 0) >> 4);
            if (ch < 288) { u32x4 o;
                o.x = cvt_pk_bf16(bflo(w[k].x) * al, bfhi(w[k].x) * al); o.y = cvt_pk_bf16(bflo(w[k].y) * al, bfhi(w[k].y) * al);
                o.z = cvt_pk_bf16(bflo(w[k].z) * al, bfhi(w[k].z) * al); o.w = cvt_pk_bf16(bflo(w[k].w) * al, bfhi(w[k].w) * al);
                row[ch] = o; } }
    }
}

DI void phase_retention(const Params& p, LAS unsigned char* lds, int cblk) {
    const int tid = threadIdx.x, lane = tid & 63, w = tid >> 6, fr = lane & 15, fq = lane >> 4;
    LAS unsigned char* Qs = lds; LAS unsigned char* Ks = lds + 33792; LAS unsigned char* Vs = lds + 67584; LAS unsigned char* St = lds + 76800; LAS unsigned char* Ps = lds + 110592;
    LAS float* red = (LAS float*)(lds + 119808);
    const bf16_t* rq = (const bf16_t*)(p.ws + WS_RQ); const bf16_t* rk = (const bf16_t*)(p.ws + WS_RK); bf16_t* rv = (bf16_t*)p.out; float* retss = (float*)(p.ws + WS_RETSS);
    for (int item = cblk; item < 256; item += gridDim.x) {
        const int q5 = item >> 3, bh = (item & 7) * 4 + (q5 & 3), slice = q5 >> 2, b = bh >> 3, h = bh & 7;
        const float lg = log1pf(-exp2f(-5.0f - (float)h));
        const float gamma_c = expf(64.0f * lg);
        const float xv = expf(-lg * (float)((tid >> 3) + 1));
        const float xo0 = expf(lg * (float)(32 * (w & 1) + fr + 1)), xo1 = expf(lg * (float)(32 * (w & 1) + 16 + fr + 1));
        const size_t tok0 = (size_t)b * SEQ;
        const bf16_t* qbase = rq + tok0 * 2048 + h * 256 + (tid & 31) * 8; const bf16_t* kbase = rk + tok0 * 2048 + h * 256 + (tid & 31) * 8;
        bf16_t* vbase = rv + tok0 * 4096 + h * 512 + slice * 64;
        u32x4 pq[4], pk[4], pv;
        f32x4 Sreg[2][4];
#pragma unroll
        for (int a = 0; a < 2; ++a)
#pragma unroll
            for (int bb = 0; bb < 4; ++bb) Sreg[a][bb] = (f32x4){0.f, 0.f, 0.f, 0.f};
        for (int i = tid; i < 33792 / 16; i += 512) ((LAS u32x4*)St)[i] = (u32x4){0u, 0u, 0u, 0u};
#define RET_LOAD(c) do { _Pragma("unroll") for (int i = 0; i < 4; ++i) { const int row = (tid + 512 * i) >> 5; \
            pq[i] = *(const u32x4*)(qbase + (size_t)(64 * (c) + row) * 2048); pk[i] = *(const u32x4*)(kbase + (size_t)(64 * (c) + row) * 2048); } \
            pv = *(const u32x4*)(vbase + (size_t)(64 * (c) + (tid >> 3)) * 4096 + (tid & 7) * 8); } while (0)
#define RET_STORE() do { _Pragma("unroll") for (int i = 0; i < 4; ++i) { const int e = tid + 512 * i, row = e >> 5, pc = e & 31; \
            *(LAS u32x4*)(Qs + row * 528 + pc * 16) = pq[i]; *(LAS u32x4*)(Ks + row * 528 + pc * 16) = pk[i]; } \
            { u32x4 o; o.x = cvt_pk_bf16(bflo(pv.x) * xv, bfhi(pv.x) * xv); o.y = cvt_pk_bf16(bflo(pv.y) * xv, bfhi(pv.y) * xv); \
              o.z = cvt_pk_bf16(bflo(pv.z) * xv, bfhi(pv.z) * xv); o.w = cvt_pk_bf16(bflo(pv.w) * xv, bfhi(pv.w) * xv); \
              *(LAS u32x4*)(Vs + (tid >> 3) * 144 + (tid & 7) * 16) = o; } } while (0)
        RET_LOAD(0); RET_STORE();
        __syncthreads();
        for (int c = 0; c < 128; ++c) {
            if (c + 1 < 128) RET_LOAD(c + 1);
            bf16x8 qfr[8][2];
            {
                const int jt = w >> 1, it0 = (w & 1) * 2;
                f32x4 sa[2] = {(f32x4){0.f, 0.f, 0.f, 0.f}, (f32x4){0.f, 0.f, 0.f, 0.f}};
#pragma unroll
                for (int ks = 0; ks < 8; ++ks) {
                    const bf16x8 kf = *(const LAS bf16x8*)(Ks + (16 * jt + fr) * 528 + (32 * ks + 8 * fq) * 2);
#pragma unroll
                    for (int t = 0; t < 2; ++t) { qfr[ks][t] = *(const LAS bf16x8*)(Qs + (16 * (it0 + t) + fr) * 528 + (32 * ks + 8 * fq) * 2); sa[t] = mfma16(kf, qfr[ks][t], sa[t]); }
                }
#pragma unroll
                for (int t = 0; t < 2; ++t) { const int iq = 16 * (it0 + t) + fr, jk0 = 16 * jt + 4 * fq;
                    u32x2 o; o.x = cvt_pk_bf16(jk0 + 0 <= iq ? sa[t][0] : 0.f, jk0 + 1 <= iq ? sa[t][1] : 0.f); o.y = cvt_pk_bf16(jk0 + 2 <= iq ? sa[t][2] : 0.f, jk0 + 3 <= iq ? sa[t][3] : 0.f);
                    *(LAS u32x2*)(Ps + iq * 144 + jk0 * 2) = o; }
            }
            {
#pragma unroll
                for (int ks = 0; ks < 2; ++ks) {
                    const int j0 = 32 * ks + 8 * fq + (fr >> 2);
                    bf16x8 kt[2], vf[4];
#pragma unroll
                    for (int dd = 0; dd < 2; ++dd) { LAS unsigned char* a0 = Ks + j0 * 528 + (16 * (2 * w + dd) + 4 * (fr & 3)) * 2; kt[dd] = tr_read2(a0, a0 + 4 * 528); }
#pragma unroll
                    for (int vt = 0; vt < 4; ++vt) { LAS unsigned char* a0 = Vs + j0 * 144 + (16 * vt + 4 * (fr & 3)) * 2; vf[vt] = tr_read2(a0, a0 + 4 * 144); }
#pragma unroll
                    for (int dd = 0; dd < 2; ++dd)
#pragma unroll
                        for (int vt = 0; vt < 4; ++vt) Sreg[dd][vt] = mfma16(kt[dd], vf[vt], Sreg[dd][vt]);
                }
#pragma unroll
                for (int dd = 0; dd < 2; ++dd)
#pragma unroll
                    for (int vt = 0; vt < 4; ++vt) Sreg[dd][vt] *= gamma_c;
            }
            __syncthreads();
            {
                const int vt = w >> 1, it0 = (w & 1) * 2;
                f32x4 oa[2] = {(f32x4){0.f, 0.f, 0.f, 0.f}, (f32x4){0.f, 0.f, 0.f, 0.f}};
#pragma unroll
                for (int ks = 0; ks < 8; ++ks) {
                    const bf16x8 sf = *(const LAS bf16x8*)(St + (16 * vt + fr) * 528 + (32 * ks + 8 * fq) * 2);
#pragma unroll
                    for (int t = 0; t < 2; ++t) oa[t] = mfma16(sf, qfr[ks][t], oa[t]);
                }
#pragma unroll
                for (int ks = 0; ks < 2; ++ks) {
                    const int j0 = 32 * ks + 8 * fq + (fr >> 2);
                    LAS unsigned char* a0 = Vs + j0 * 144 + (16 * vt + 4 * (fr & 3)) * 2; const bf16x8 vf = tr_read2(a0, a0 + 4 * 144);
#pragma unroll
                    for (int t = 0; t < 2; ++t) { const bf16x8 pf = *(const LAS bf16x8*)(Ps + (16 * (it0 + t) + fr) * 144 + (32 * ks + 8 * fq) * 2); oa[t] = mfma16(vf, pf, oa[t]); }
                }
#pragma unroll
                for (int t = 0; t < 2; ++t) { const int iq = 16 * (it0 + t) + fr; oa[t] *= (t == 0 ? xo0 : xo1);
                    u32x2 o; o.x = cvt_pk_bf16(oa[t][0], oa[t][1]); o.y = cvt_pk_bf16(oa[t][2], oa[t][3]);
                    *(u32x2*)(vbase + (size_t)(64 * c + iq) * 4096 + 16 * vt + 4 * fq) = o;
                    float ss = (oa[t][0] * oa[t][0] + oa[t][1] * oa[t][1]) + (oa[t][2] * oa[t][2] + oa[t][3] * oa[t][3]);
                    ss += __shfl_xor(ss, 16); ss += __shfl_xor(ss, 32);
                    if (fq == 0) red[iq * 4 + vt] = ss; }
            }
            __syncthreads();
#pragma unroll
            for (int dd = 0; dd < 2; ++dd)
#pragma unroll
                for (int vt = 0; vt < 4; ++vt) { u32x2 o; o.x = cvt_pk_bf16(Sreg[dd][vt][0], Sreg[dd][vt][1]); o.y = cvt_pk_bf16(Sreg[dd][vt][2], Sreg[dd][vt][3]);
                    *(LAS u32x2*)(St + (16 * vt + fr) * 528 + (16 * (2 * w + dd) + 4 * fq) * 2) = o; }
            if (c + 1 < 128) RET_STORE();
            if (tid < 64) retss[((tok0 + 64 * c + tid) * 8 + h) * 8 + slice] = (red[tid * 4 + 0] + red[tid * 4 + 1]) + (red[tid * 4 + 2] + red[tid * 4 + 3]);
            __syncthreads();
        }
#undef RET_LOAD
#undef RET_STORE
    }
}

DI void phase_attention(const Params& p, LAS unsigned char* lds) {
    const int tid = threadIdx.x, lane = tid & 63, w = tid >> 6, fr = lane & 15, fq = lane >> 4;
    LAS unsigned char* Ks = lds; LAS unsigned char* Vs = lds + 69632;
    bf16_t* aq = (bf16_t*)(p.ws + WS_AQ); const bf16_t* ak = (const bf16_t*)(p.ws + WS_AK); const bf16_t* av = (const bf16_t*)(p.ws + WS_AV); float* lse = (float*)(p.ws + WS_LSE);
    const int per = (4608 + (int)gridDim.x - 1) / (int)gridDim.x, it_lo = (int)blockIdx.x * per, it_hi = (it_lo + per < 4608) ? it_lo + per : 4608;
    int prev_key = -1;
    u32x4 kcur[4], vcur[4];
#define ATT_LOAD_CUR(item_) do { const int bh_ = (item_) >> 6, e64_ = (item_) & 63, head_ = bh_ % 18, b_ = bh_ / 18; \
        const int rsh_ = 2 * (head_ / 6), r_ = 1 << rsh_, nbc_ = 64 >> rsh_, cls_ = e64_ / nbc_, nb_ = e64_ - cls_ * nbc_; \
        _Pragma("unroll") for (int i = 0; i < 4; ++i) { const int e = tid + 512 * i, row = e >> 4, pc = e & 15; \
            const size_t off = ((size_t)b_ * SEQ + (size_t)(nb_ * 128 + row) * r_ + cls_) * 2304 + head_ * 128 + pc * 8; \
            kcur[i] = *(const u32x4*)(ak + off); vcur[i] = *(const u32x4*)(av + off); } } while (0)
    if (it_lo < it_hi) ATT_LOAD_CUR(it_lo);
    for (int item = it_lo, cnt = 0; item < it_hi; ++item, ++cnt) {
        const int bh = item >> 6, e64 = item & 63, head = bh % 18, b = bh / 18;
        const int g = head / 6, rsh = 2 * g, r = 1 << rsh, nbc = 64 >> rsh, cls = e64 / nbc, nb = e64 - cls * nbc;
        const int pq0 = nb * 128, pk0 = pq0 - 128;
        const size_t tokb = (size_t)b * SEQ;
        const int scur = cnt & 1, sprev = scur ^ 1;
        const bool reuse = (nb > 0) && (prev_key == item - 1);
#pragma unroll
        for (int i = 0; i < 4; ++i) { const int e = tid + 512 * i, row = e >> 4, pc = e & 15;
            *(LAS u32x4*)(Ks + (scur * 128 + row) * 272 + pc * 16) = kcur[i]; *(LAS u32x4*)(Vs + (scur * 128 + row) * 288 + pc * 16) = vcur[i]; }
        if (!reuse) {
#pragma unroll
            for (int i = 0; i < 4; ++i) { const int e = tid + 512 * i, row = e >> 4, pc = e & 15;
                u32x4 kv = {0u, 0u, 0u, 0u}, vv = kv;
                if (nb > 0) { const size_t off = (tokb + (size_t)(pk0 + row) * r + cls) * 2304 + head * 128 + pc * 8; kv = *(const u32x4*)(ak + off); vv = *(const u32x4*)(av + off); }
                *(LAS u32x4*)(Ks + (sprev * 128 + row) * 272 + pc * 16) = kv; *(LAS u32x4*)(Vs + (sprev * 128 + row) * 288 + pc * 16) = vv; }
        }
        if (item + 1 < it_hi) ATT_LOAD_CUR(item + 1);
        prev_key = item;
        const int qq = 16 * w + fr;
        const size_t tokq = tokb + (size_t)(pq0 + qq) * r + cls;
        bf16x8 qf[4];
        { const bf16_t* qp = aq + tokq * 2304 + head * 128 + 8 * fq;
#pragma unroll
          for (int ks = 0; ks < 4; ++ks) qf[ks] = *(const bf16x8*)(qp + 32 * ks); }
        __syncthreads();
        f32x4 sa[10];
#pragma unroll
        for (int kt = 0; kt < 10; ++kt) { sa[kt] = (f32x4){0.f, 0.f, 0.f, 0.f};
            const int T = (w + kt < 16) ? w + kt : 15;
            const int krow = ((T < 8) ? sprev : scur) * 128 + 16 * (T & 7) + fr;
#pragma unroll
            for (int ks = 0; ks < 4; ++ks) { const bf16x8 kf = *(const LAS bf16x8*)(Ks + krow * 272 + (32 * ks + 8 * fq) * 2); sa[kt] = mfma16(kf, qf[ks], sa[kt]); } }
        const float sc2 = 0.08838834764831845f * 1.4426950408889634f;
        float mrow = -INFINITY;
#pragma unroll
        for (int kt = 0; kt < 10; ++kt)
#pragma unroll
            for (int j = 0; j < 4; ++j) { const int kk = 16 * (w + kt) + 4 * fq + j; const bool valid = (kk >= qq) && (kk <= qq + 128) && (pk0 + kk >= 0);
                const float sv = valid ? sa[kt][j] * sc2 : -INFINITY; sa[kt][j] = sv; mrow = fmaxf(mrow, sv); }
        mrow = fmaxf(mrow, __shfl_xor(mrow, 16)); mrow = fmaxf(mrow, __shfl_xor(mrow, 32));
        float lsum = 0.f;
        bf16x8 pf[5];
#pragma unroll
        for (int t = 0; t < 5; ++t) { f32x4 p0, p1;
#pragma unroll
            for (int j = 0; j < 4; ++j) { p0[j] = __builtin_amdgcn_exp2f(sa[2 * t][j] - mrow); p1[j] = __builtin_amdgcn_exp2f(sa[2 * t + 1][j] - mrow); lsum += p0[j] + p1[j]; }
            const u32x4 pk4 = pack8(p0, p1); pf[t] = __builtin_bit_cast(bf16x8, pk4); }
        lsum += __shfl_xor(lsum, 16); lsum += __shfl_xor(lsum, 32);
        __builtin_amdgcn_sched_barrier(0);
        f32x4 oa[8];
#pragma unroll
        for (int dt = 0; dt < 8; ++dt) oa[dt] = (f32x4){0.f, 0.f, 0.f, 0.f};
#pragma unroll
        for (int t = 0; t < 5; ++t) {
            const int T0 = w + 2 * t, T1 = (T0 + 1 < 16) ? T0 + 1 : T0;
            const int r0 = ((T0 < 8) ? sprev : scur) * 128 + 16 * (T0 & 7) + 4 * fq + (fr >> 2), r1 = ((T1 < 8) ? sprev : scur) * 128 + 16 * (T1 & 7) + 4 * fq + (fr >> 2);
            LAS unsigned char* a0 = Vs + r0 * 288 + (4 * (fr & 3)) * 2; LAS unsigned char* a1 = Vs + r1 * 288 + (4 * (fr & 3)) * 2;
#pragma unroll
            for (int dt = 0; dt < 8; ++dt) { const bf16x8 vf = tr_read2(a0 + 32 * dt, a1 + 32 * dt); oa[dt] = mfma16(vf, pf[t], oa[dt]); }
        }
        const float inv = __builtin_amdgcn_rcpf(lsum);
        bf16_t* po = aq + tokq * 2304 + head * 128 + 4 * fq;
#pragma unroll
        for (int dt = 0; dt < 8; ++dt) { u32x2 o; o.x = cvt_pk_bf16(oa[dt][0] * inv, oa[dt][1] * inv); o.y = cvt_pk_bf16(oa[dt][2] * inv, oa[dt][3] * inv); *(u32x2*)(po + 16 * dt) = o; }
        if (fq == 0) lse[tokq * 18 + head] = mrow * 0.6931471805599453f + __logf(lsum);
        __syncthreads();
    }
#undef ATT_LOAD_CUR
}

constexpr size_t WS_BAR = 700000;
DI void grid_barrier(unsigned* bar, unsigned& nbar, const bool hier, const unsigned xcd, const unsigned per_xcd) {
    asm volatile("s_waitcnt vmcnt(0)" ::: "memory");
    __syncthreads();
    if (threadIdx.x == 0) {
        __builtin_amdgcn_fence(__ATOMIC_RELEASE, "agent");
        asm volatile("s_waitcnt vmcnt(0)" ::: "memory");
        const unsigned gen = nbar + 1u;
        if (hier) {
            unsigned* xc = bar + 256 + 64 * xcd; unsigned* top = bar + 1024;
            const unsigned old = __hip_atomic_fetch_add(xc, 1u, __ATOMIC_RELAXED, __HIP_MEMORY_SCOPE_AGENT);
            if (old + 1u == gen * per_xcd) __hip_atomic_fetch_add(top, 1u, __ATOMIC_RELAXED, __HIP_MEMORY_SCOPE_AGENT);
            while (__hip_atomic_load(top, __ATOMIC_RELAXED, __HIP_MEMORY_SCOPE_AGENT) < gen * 8u) __builtin_amdgcn_s_sleep(1);
        } else {
            const unsigned target = gen * gridDim.x;
            __hip_atomic_fetch_add(bar, 1u, __ATOMIC_RELAXED, __HIP_MEMORY_SCOPE_AGENT);
            while (__hip_atomic_load(bar, __ATOMIC_RELAXED, __HIP_MEMORY_SCOPE_AGENT) < target) __builtin_amdgcn_s_sleep(1);
        }
        __builtin_amdgcn_fence(__ATOMIC_ACQUIRE, "agent");
        asm volatile("s_waitcnt vmcnt(0)" ::: "memory");
    }
    __syncthreads();
    ++nbar;
}

constexpr int N_PHASES = 13;
__global__ void __launch_bounds__(512, 2) mega(Params p) {
    extern __shared__ __attribute__((aligned(16))) unsigned char shm[];
    LAS unsigned char* lds = (LAS unsigned char*)shm;
    unsigned char* ws = p.ws;
    const int G = gridDim.x, c = blockIdx.x;
    unsigned* bar = (unsigned*)(ws + WS_BAR); unsigned nbar = 0;
    int c_eff = c; unsigned my_xcd = 0, my_idx = 0; bool hier = false;
    if (p.ph_hi - p.ph_lo > 1) {
        my_xcd = (unsigned)__builtin_amdgcn_s_getreg((3 << 11) | 20) & 0xFu;
        if (threadIdx.x == 0) my_idx = __hip_atomic_fetch_add(bar + 64 + 16 * (my_xcd & 7u), 1u, __ATOMIC_RELAXED, __HIP_MEMORY_SCOPE_AGENT);
        my_idx = (unsigned)__builtin_amdgcn_readfirstlane((int)my_idx);
    }
    if (p.ph_lo <= 0 && 0 < p.ph_hi) {
        if (0 > p.ph_lo) grid_barrier(bar, nbar, hier, my_xcd, (unsigned)G / 8u);

#if (PHMASK >> 0) & 1
            phase0(p, lds);
#endif
    }
    if (p.ph_lo <= 1 && 1 < p.ph_hi) {
        if (1 > p.ph_lo) cg::this_grid().sync();
        if (p.ph_hi - p.ph_lo > 1) {
            LAS unsigned* cw = (LAS unsigned*)lds;
            if (threadIdx.x == 0) {
                bool ok = (G % 8) == 0 && my_xcd < 8u;
                for (int x = 0; x < 8; ++x) ok = ok && (__hip_atomic_load(bar + 64 + 16 * x, __ATOMIC_RELAXED, __HIP_MEMORY_SCOPE_AGENT) == (unsigned)(G / 8));
                cw[0] = ok ? (my_idx * 8u + my_xcd) : (unsigned)c; cw[1] = ok ? 1u : 0u;
            }
            __syncthreads();
            c_eff = __builtin_amdgcn_readfirstlane((int)cw[0]);
            hier = (cw[1] != 0u);
            __syncthreads();
        }

#if (PHMASK >> 1) & 1
            phase_h(p);
#endif
    }
    if (p.ph_lo <= 2 && 2 < p.ph_hi) {
        if (2 > p.ph_lo) grid_barrier(bar, nbar, hier, my_xcd, (unsigned)G / 8u);

#if (PHMASK >> 2) & 1
            pg8::Gemm g{(const bf16_t*)(ws + WS_H), (const bf16_t*)(ws + WS_WIN), T_TOK, 59 * 256, 2048, nullptr, nullptr, 0}; pg8::StaticOrder S; S.init(T_TOK, 59 * 256, G, c_eff, 32, 16);
            EpiInProj E{(bf16_t*)(ws + WS_RQ), (bf16_t*)(ws + WS_RK), (bf16_t*)p.out, (bf16_t*)(ws + WS_AQ), (bf16_t*)(ws + WS_AK), (bf16_t*)(ws + WS_AV), p.pos};
            pg8::gemm_phase<1>(lds, g, S, E);
            { const int nwg2 = 128 * 59, rem = nwg2 % G;
              if (rem == 0) convert_ffn_weights(p, lds, c_eff, G); else if (c_eff >= rem) convert_ffn_weights(p, lds, c_eff - rem, G - rem); }
#endif
    }
    if (p.ph_lo <= 3 && 3 < p.ph_hi) {
        if (3 > p.ph_lo) grid_barrier(bar, nbar, hier, my_xcd, (unsigned)G / 8u);

#if (PHMASK >> 3) & 1
            phase_retention(p, lds, c_eff); __syncthreads();
#endif
#if (PHMASK >> 13) & 1
            phase_attention(p, lds);
#endif
    }
    if (p.ph_lo <= 4 && 4 < p.ph_hi) {
        if (4 > p.ph_lo) grid_barrier(bar, nbar, hier, my_xcd, (unsigned)G / 8u);

#if (PHMASK >> 4) & 1
            { pg8::Gemm g{(const bf16_t*)(ws + WS_H), (const bf16_t*)(ws + WS_WIN) + (size_t)8192 * 2048, T_TOK, 4096, 2048, nullptr, nullptr, 0}; pg8::StaticOrder S; S.init(T_TOK, 4096, G, c_eff);
              EpiRetGate E{(bf16_t*)p.out, (const float*)(ws + WS_RETSS), p.ret_gain}; pg8::gemm_phase<1>(lds, g, S, E); }
#endif
#if (PHMASK >> 14) & 1
            { pg8::Gemm g{(const bf16_t*)(ws + WS_H), (const bf16_t*)(ws + WS_WGATE), T_TOK, 4096, 2048, nullptr, nullptr, 0}; pg8::StaticOrder S; S.init(T_TOK, 4096, G, c_eff);
              EpiGates E{(bf16_t*)(ws + WS_GATES), p.b_gate}; pg8::gemm_phase<1>(lds, g, S, E); }
#endif
#if (PHMASK >> 15) & 1
            phase_alpha(p);
#endif
    }
    if (p.ph_lo <= 5 && 5 < p.ph_hi) {
        if (5 > p.ph_lo) grid_barrier(bar, nbar, hier, my_xcd, (unsigned)G / 8u);

#if (PHMASK >> 5) & 1
            pg8::Gemm g{(const bf16_t*)p.out, (const bf16_t*)(ws + WS_WRET), T_TOK, 2048, 4096, (const bf16_t*)(ws + WS_AQ), (const bf16_t*)(ws + WS_WATT), 2304}; pg8::StaticOrder S; S.init(T_TOK, 2048, G, c_eff);
            EpiYMerge E{(const bf16_t*)(ws + WS_GATES), (bf16_t*)(ws + WS_U2)}; pg8::gemm_phase<2>(lds, g, S, E);
#endif
    }
    if (p.ph_lo <= 7 && 7 < p.ph_hi) {
        if (7 > p.ph_lo) grid_barrier(bar, nbar, hier, my_xcd, (unsigned)G / 8u);

#if (PHMASK >> 7) & 1
            pg8::Gemm g{(const bf16_t*)(ws + WS_U2), (const bf16_t*)(ws + WS_WMIX), T_TOK, 2048, 2048, nullptr, nullptr, 0}; pg8::StaticOrder S; S.init(T_TOK, 2048, G, c_eff);
            EpiStoreBf16 E{(bf16_t*)(ws + WS_Y), 2048}; pg8::gemm_phase<1>(lds, g, S, E);
#endif
    }
    if (p.ph_lo <= 8 && 8 < p.ph_hi) {
        if (8 > p.ph_lo) grid_barrier(bar, nbar, hier, my_xcd, (unsigned)G / 8u);

#if (PHMASK >> 8) & 1
            phase_postmix(p);
#endif
    }
    if (p.ph_lo <= 9 && 9 < p.ph_hi) {
        if (9 > p.ph_lo) grid_barrier(bar, nbar, hier, my_xcd, (unsigned)G / 8u);

#if (PHMASK >> 9) & 1
            pg8::Gemm g{(const bf16_t*)(ws + WS_H2), (const bf16_t*)(ws + WS_WUP), T_TOK, FF, 2048, nullptr, nullptr, 0}; pg8::StaticOrder S; S.init(T_TOK, FF, G, c_eff);
            EpiStoreBf16 E{(bf16_t*)(ws + WS_A), FF}; pg8::gemm_phase<1>(lds, g, S, E);
#endif
    }
    if (p.ph_lo <= 10 && 10 < p.ph_hi) {
        if (10 > p.ph_lo) grid_barrier(bar, nbar, hier, my_xcd, (unsigned)G / 8u);

#if (PHMASK >> 10) & 1
            pg8::Gemm g{(const bf16_t*)(ws + WS_H2), (const bf16_t*)(ws + WS_WUP) + (size_t)FF * 2048, T_TOK, FF, 2048, nullptr, nullptr, 0}; pg8::StaticOrder S; S.init(T_TOK, FF, G, c_eff);
            EpiConvAct E{(const bf16_t*)(ws + WS_A), (bf16_t*)(ws + WS_ACT), p.conv_w, p.conv_b}; pg8::gemm_phase<1>(lds, g, S, E);
#endif
    }
    if (p.ph_lo <= 11 && 11 < p.ph_hi) {
        if (11 > p.ph_lo) grid_barrier(bar, nbar, hier, my_xcd, (unsigned)G / 8u);

#if (PHMASK >> 11) & 1
            pg8::Gemm g{(const bf16_t*)(ws + WS_ACT), (const bf16_t*)(ws + WS_WDOWN), T_TOK, 2048, FF, nullptr, nullptr, 0}; pg8::StaticOrder S; S.init(T_TOK, 2048, G, c_eff);
            EpiStoreBf16 E{(bf16_t*)(ws + WS_Y2), 2048}; pg8::gemm_phase<1>(lds, g, S, E);
#endif
    }
    if (p.ph_lo <= 12 && 12 < p.ph_hi) {
        if (12 > p.ph_lo) grid_barrier(bar, nbar, hier, my_xcd, (unsigned)G / 8u);

#if (PHMASK >> 12) & 1
            phase_final(p);
#endif
    }
}

extern "C" void kernel_launch(void* const* d_in, const int* in_sizes, int n_in, void* d_out, int out_size, void* d_ws, size_t ws_size, hipStream_t stream) {
    static int grid = 0;
    if (grid == 0) {
        if (n_in != 20 || ws_size < WS_END) { fprintf(stderr, "kernel_launch: unexpected n_in %d or ws_size %zu (need %zu)\n", n_in, ws_size, (size_t)WS_END); grid = -1; return; }
        int dev = 0, cus = 0, per_cu = 0;
        hipGetDevice(&dev); hipDeviceGetAttribute(&cus, hipDeviceAttributeMultiprocessorCount, dev);
        if (hipFuncSetAttribute((const void*)mega, hipFuncAttributeMaxDynamicSharedMemorySize, LDS_BYTES) != hipSuccess) { fprintf(stderr, "kernel_launch: hipFuncSetAttribute failed\n"); grid = -1; return; }
        if (hipOccupancyMaxActiveBlocksPerMultiprocessor(&per_cu, (const void*)mega, 512, LDS_BYTES) != hipSuccess || per_cu < 1) { fprintf(stderr, "kernel_launch: occupancy query says %d\n", per_cu); per_cu = 1; }
        (void)hipGetLastError();
        grid = cus * 1;
    }
    if (grid < 0) return;
    Params p{};
    p.x = (const float*)d_in[0]; p.c = (const float*)d_in[1]; p.pos = (const int*)d_in[2]; p.w_ada = (const float*)d_in[3]; p.b_ada = (const float*)d_in[4]; p.g_pre_mix = (const float*)d_in[5];
    p.w_in = (const float*)d_in[6]; p.ret_gain = (const float*)d_in[7]; p.w_ret_out = (const float*)d_in[8]; p.w_att_out = (const float*)d_in[9]; p.w_gate = (const float*)d_in[10]; p.b_gate = (const float*)d_in[11];
    p.w_mix = (const float*)d_in[12]; p.g_post_mix = (const float*)d_in[13]; p.g_pre_ffn = (const float*)d_in[14]; p.w_up = (const float*)d_in[15]; p.conv_w = (const float*)d_in[16]; p.conv_b = (const float*)d_in[17];
    p.w_down = (const float*)d_in[18]; p.g_post_ffn = (const float*)d_in[19];
    p.out = (float*)d_out; p.ws = (unsigned char*)d_ws;
    if (hipMemsetAsync((char*)d_ws + WS_BAR, 0, 8192, stream) != hipSuccess) { fprintf(stderr, "kernel_launch: memset failed\n"); return; }
#if N_LAUNCH_PER_PHASE
    for (int ph = 0; ph < N_PHASES; ++ph) { p.ph_lo = ph; p.ph_hi = ph + 1; hipLaunchKernelGGL(mega, dim3(grid), dim3(512), LDS_BYTES, stream, p); }
#else
    p.ph_lo = 0; p.ph_hi = N_PHASES;
    void* args[] = {&p};
    hipError_t e = hipLaunchCooperativeKernel((const void*)mega, dim3(grid), dim3(512), args, LDS_BYTES, stream);
    if (e != hipSuccess) fprintf(stderr, "cooperative launch failed: %s (grid %d)\n", hipGetErrorString(e), grid);
#endif
}
```

```cpp
#include <hip/hip_runtime.h>
#include <hip/hip_cooperative_groups.h>
#include <cstdio>
#include <cstdint>
namespace cg = cooperative_groups;

#define DI __device__ __forceinline__
#define LAS __attribute__((address_space(3)))
typedef unsigned short bf16_t;
typedef short bf16x8 __attribute__((ext_vector_type(8)));
typedef short s16x4 __attribute__((ext_vector_type(4)));
typedef float f32x4 __attribute__((ext_vector_type(4)));
typedef unsigned u32x4 __attribute__((ext_vector_type(4)));
typedef unsigned u32x2 __attribute__((ext_vector_type(2)));

#ifndef PHMASK
#define PHMASK 0xFFFF
#endif
#ifndef N_LAUNCH_PER_PHASE
#define N_LAUNCH_PER_PHASE 0
#endif

constexpr int T_TOK = 32768, DM = 2048, SEQ = 8192, NB = 4;
constexpr int FF = 5632;
constexpr int LDS_BYTES = 143360;
constexpr size_t MiB = 1u << 20;
constexpr size_t WS_ADA = 0;
constexpr size_t WS_LSE = 1 * MiB;
constexpr size_t WS_RETSS = 4 * MiB;
constexpr size_t WS_WUP = 12 * MiB;
constexpr size_t WS_WDOWN = 56 * MiB;
constexpr size_t WS_WIN = 78 * MiB;
constexpr size_t WS_WGATE = 153 * MiB;
constexpr size_t WS_WRET = 169 * MiB;
constexpr size_t WS_WATT = 185 * MiB;
constexpr size_t WS_WMIX = 194 * MiB;
constexpr size_t WS_H = 206 * MiB;
constexpr size_t WS_RQ = 334 * MiB;
constexpr size_t WS_RK = 462 * MiB;
constexpr size_t WS_AQ = 590 * MiB;
constexpr size_t WS_AK = 734 * MiB;
constexpr size_t WS_AV = 878 * MiB;
constexpr size_t WS_GATES = 334 * MiB;
constexpr size_t WS_U = 734 * MiB;
constexpr size_t WS_U2 = 206 * MiB;
constexpr size_t WS_Y = 334 * MiB;
constexpr size_t WS_H2 = 78 * MiB;
constexpr size_t WS_A = 206 * MiB;
constexpr size_t WS_ACT = 558 * MiB;
constexpr size_t WS_Y2 = 78 * MiB;
constexpr size_t WS_END = 1022 * MiB;

struct Params {
    const float *x, *c; const int* pos;
    const float *w_ada, *b_ada, *g_pre_mix, *w_in, *ret_gain, *w_ret_out, *w_att_out, *w_gate, *b_gate, *w_mix, *g_post_mix, *g_pre_ffn, *w_up, *conv_w, *conv_b, *w_down, *g_post_ffn;
    float* out; unsigned char* ws; int ph_lo, ph_hi;
};

typedef __bf16 bf16x2_t __attribute__((ext_vector_type(2)));
DI unsigned cvt_pk_bf16(float lo, float hi) { bf16x2_t v = {(__bf16)lo, (__bf16)hi}; return __builtin_bit_cast(unsigned, v); }
DI float bflo(unsigned w) { return __uint_as_float(w << 16); }
DI float bfhi(unsigned w) { return __uint_as_float(w & 0xffff0000u); }
DI float wave_sum(float v) {
#pragma unroll
    for (int o = 1; o < 64; o <<= 1) v += __shfl_xor(v, o);
    return v;
}
DI float sigmoidf_(float v) { return __builtin_amdgcn_rcpf(1.0f + __builtin_amdgcn_exp2f(-1.4426950408889634f * v)); }
DI f32x4 mfma16(bf16x8 a, bf16x8 b, f32x4 c) { return __builtin_amdgcn_mfma_f32_16x16x32_bf16(a, b, c, 0, 0, 0); }
DI s16x4 tr_read(LAS unsigned char* p) { return __builtin_amdgcn_ds_read_tr16_b64_v4i16((LAS s16x4*)p); }
DI bf16x8 tr_read2(LAS unsigned char* p0, LAS unsigned char* p1) { s16x4 lo = tr_read(p0), hi = tr_read(p1); return __builtin_shufflevector(lo, hi, 0, 1, 2, 3, 4, 5, 6, 7); }

namespace pg8 {
constexpr int BM = 256, BK = 64, HALF = 128, HTB = HALF * BK * 2, STAGE_BYTES = 8 * HTB, NXCD = 8, WGM = 8;
DI int lds_byte(int r, int c) { const int st = (r >> 4) * 2 + (c >> 5), rr = r & 15, cc = c & 31, ob = rr * 64 + cc * 2; return st * 1024 + (ob ^ (((ob >> 9) & 1) << 5)); }
DI void stage_rc(int b, int& R, int& C) { const int st = b / 1024, sb = b % 1024, swz = sb ^ (((sb >> 9) & 1) << 5); R = (st >> 1) * 16 + swz / 64; C = (st & 1) * 32 + (swz % 64) / 2; }
struct Unit { int pm, pn; };
struct Gemm { const bf16_t* A; const bf16_t* Bt; int M, N, K; const bf16_t* A1; const bf16_t* Bt1; int K1; };
struct StaticOrder {
    int nM, nN, nwg, G, c, skip_lo, skip_n;
    DI void init(int M, int N, int G_, int c_, int slo = 1 << 30, int sn = 0) { nM = M / BM; nN = N / BM; nwg = nM * nN; G = G_; c = c_; skip_lo = slo; skip_n = sn; }
    DI bool next(int i, Unit& u) const {
        const long L = (long)i * G + c; if (L >= nwg) return false;
        int wgid = (int)L; { const int q = nwg / NXCD, r = nwg % NXCD, xcd = wgid % NXCD, off = wgid / NXCD; wgid = (xcd < r ? xcd * (q + 1) : r * (q + 1) + (xcd - r) * q) + off; }
        const int nig = WGM * nN, gid = wgid / nig, fm = gid * WGM, gsz = (nM - fm) < WGM ? (nM - fm) : WGM;
        u.pm = fm + ((wgid % nig) % gsz); u.pn = (wgid % nig) / gsz; if (u.pn >= skip_lo) u.pn += skip_n; return true;
    }
};

#ifndef PG8_ALIGN
#define PG8_ALIGN true
#endif
#ifndef PG8_SP2
#define PG8_SP2 true
#endif
template <int NSEG, class Epi, bool ALIGN_EPI = PG8_ALIGN, bool SP2 = PG8_SP2>
DI void gemm_phase(LAS unsigned char* lds, const Gemm g, const StaticOrder& S, const Epi& E) {
    const int tid = threadIdx.x, wid = __builtin_amdgcn_readfirstlane(tid >> 6), lane = tid & 63, wr = wid >> 2, wc = wid & 3, fr = lane & 15, fq = lane >> 4;
    int Rr[2], Cc[2];
#pragma unroll
    for (int i = 0; i < 2; ++i) stage_rc(tid * 16 + i * 8192, Rr[i], Cc[i]);
    const size_t kstep = (size_t)(BK * 2);
    const unsigned ldsw = (unsigned)wid * 1024u;
    const int aoff = lds_byte(wr * 64 + fr, fq * 8), boff = lds_byte(wc * 32 + fr, fq * 8);
#define PG8_SA(b, h) (((b) * 2 + (h)) * HTB)
#define PG8_SB(b, h) ((4 + (b) * 2 + (h)) * HTB)
#define PG8_STAGE(bufoff, gbase, VO) do { _Pragma("unroll") for (int _i = 0; _i < 2; ++_i) \
        __builtin_amdgcn_global_load_lds((const unsigned*)((const char*)(gbase) + VO[_i]), (LAS unsigned*)(lds + (bufoff) + ldsw + _i * 8192), 16, 0, 0); } while (0)
#define PG8_LDA(dst, b, h) do { _Pragma("unroll") for (int m = 0; m < 4; ++m) _Pragma("unroll") for (int k = 0; k < 2; ++k) dst[m][k] = *(const LAS bf16x8*)(lds + PG8_SA(b, h) + aoff + m * 2048 + k * 1024); } while (0)
#define PG8_LDB(dst, b, h) do { _Pragma("unroll") for (int n = 0; n < 2; ++n) _Pragma("unroll") for (int k = 0; k < 2; ++k) dst[n][k] = *(const LAS bf16x8*)(lds + PG8_SB(b, h) + boff + n * 2048 + k * 1024); } while (0)
#define PG8_MMA(ai, bj, At, Bt) do { __builtin_amdgcn_s_setprio(1); _Pragma("unroll") for (int m = 0; m < 4; ++m) _Pragma("unroll") for (int n = 0; n < 2; ++n) _Pragma("unroll") for (int k = 0; k < 2; ++k) \
        acc[ai][bj][m][n] = __builtin_amdgcn_mfma_f32_16x16x32_bf16(Bt[n][k], At[m][k], acc[ai][bj][m][n], 0, 0, 0); __builtin_amdgcn_s_setprio(0); } while (0)
#define PG8_WAIT_V(n) asm volatile("s_waitcnt vmcnt(" #n ")" ::: "memory")
#define PG8_WAIT_L(n) asm volatile("s_waitcnt lgkmcnt(" #n ")" ::: "memory")
#define PG8_BAR __builtin_amdgcn_s_barrier()
#define PG8_SCHED __builtin_amdgcn_sched_barrier(0)
    Unit cur, nxt; int ti = 0, seg = 0;
    if (!S.next(0, cur)) return;
    f32x4 acc[2][2][4][2];
#pragma unroll
    for (int a = 0; a < 2; ++a)
#pragma unroll
        for (int b = 0; b < 2; ++b)
#pragma unroll
            for (int m = 0; m < 4; ++m)
#pragma unroll
                for (int n = 0; n < 2; ++n) acc[a][b][m][n] = (f32x4){0.f, 0.f, 0.f, 0.f};
    bf16x8 At[4][2], B0[2][2], B1[2][2];
    int Kc = g.K;
    unsigned voffC[2];
#pragma unroll
    for (int i = 0; i < 2; ++i) voffC[i] = (unsigned)(Rr[i] * Kc + Cc[i]) * 2u;
    size_t hstepC = (size_t)HALF * Kc * 2;
    const char* cA = (const char*)g.A + (size_t)cur.pm * 2 * hstepC; const char* cB = (const char*)g.Bt + (size_t)cur.pn * 2 * hstepC;
    if constexpr (SP2) {
        PG8_STAGE(PG8_SB(0, 0), cB, voffC); PG8_STAGE(PG8_SB(0, 1), cB + hstepC, voffC); PG8_STAGE(PG8_SA(0, 0), cA, voffC); PG8_STAGE(PG8_SA(0, 1), cA + hstepC, voffC);
        if (wr == 1) PG8_BAR;
        PG8_WAIT_V(2); PG8_BAR;
        PG8_STAGE(PG8_SB(1, 0), cB + kstep, voffC); PG8_STAGE(PG8_SA(1, 0), cA + kstep, voffC); PG8_STAGE(PG8_SB(1, 1), cB + hstepC + kstep, voffC);
        PG8_WAIT_V(6); PG8_BAR;
    } else {
        PG8_STAGE(PG8_SB(0, 0), cB, voffC); PG8_STAGE(PG8_SA(0, 0), cA, voffC); PG8_STAGE(PG8_SB(0, 1), cB + hstepC, voffC); PG8_STAGE(PG8_SA(0, 1), cA + hstepC, voffC);
        if (wr == 1) PG8_BAR;
        PG8_WAIT_V(4); PG8_BAR;
        PG8_STAGE(PG8_SB(1, 0), cB + kstep, voffC); PG8_STAGE(PG8_SA(1, 0), cA + kstep, voffC); PG8_STAGE(PG8_SB(1, 1), cB + hstepC + kstep, voffC);
        PG8_WAIT_V(6); PG8_BAR;
    }
    for (;;) {
        bool has_next; int nseg = 0;
        if (NSEG > 1 && seg + 1 < NSEG) { has_next = true; nxt = cur; nseg = seg + 1; }
        else has_next = S.next(ti + 1, nxt);
        int Kn = Kc; const char* nA = cA; const char* nB = cB;
        if (has_next) { Kn = (NSEG > 1 && nseg == 1) ? g.K1 : g.K;
            nA = (const char*)((NSEG > 1 && nseg == 1) ? g.A1 : g.A) + (size_t)nxt.pm * 256 * Kn * 2; nB = (const char*)((NSEG > 1 && nseg == 1) ? g.Bt1 : g.Bt) + (size_t)nxt.pn * 256 * Kn * 2; }
        unsigned voffN[2];
#pragma unroll
        for (int i = 0; i < 2; ++i) voffN[i] = (NSEG > 1) ? (unsigned)(Rr[i] * Kn + Cc[i]) * 2u : voffC[i];
        const size_t hstepN = (NSEG > 1) ? (size_t)HALF * Kn * 2 : hstepC;
        const int nt = Kc / BK;
        for (int t = 0; t < nt; t += 2) {
            const bool last = (t == nt - 2);
            const char* a1 = cA + (size_t)(t + 1) * kstep;
            const char* a2 = last ? nA : cA + (size_t)(t + 2) * kstep; const char* b2 = last ? nB : cB + (size_t)(t + 2) * kstep;
            const char* a3 = a2 + kstep; const char* b3 = b2 + kstep;
            unsigned v2[2]; v2[0] = (NSEG > 1 && last) ? voffN[0] : voffC[0]; v2[1] = (NSEG > 1 && last) ? voffN[1] : voffC[1];
            const size_t h2 = (NSEG > 1 && last) ? hstepN : hstepC;
            if constexpr (SP2) {
            PG8_LDB(B0, 0, 0); PG8_LDB(B1, 0, 1); PG8_SCHED; PG8_LDA(At, 0, 0); PG8_STAGE(PG8_SA(1, 1), a1 + hstepC, voffC);
            PG8_WAIT_V(8); PG8_WAIT_L(0); PG8_BAR; PG8_MMA(0, 0, At, B0); PG8_MMA(0, 1, At, B1); PG8_BAR; PG8_SCHED;
            PG8_LDA(At, 0, 1); PG8_STAGE(PG8_SB(0, 0), b2, v2); PG8_STAGE(PG8_SB(0, 1), b2 + h2, v2); PG8_STAGE(PG8_SA(0, 0), a2, v2);
            PG8_WAIT_V(8); PG8_WAIT_L(0); PG8_BAR; PG8_MMA(1, 0, At, B0); PG8_MMA(1, 1, At, B1); PG8_BAR; PG8_SCHED;
            PG8_LDB(B0, 1, 0); PG8_LDB(B1, 1, 1); PG8_SCHED; PG8_LDA(At, 1, 0); PG8_STAGE(PG8_SA(0, 1), a2 + h2, v2);
            PG8_WAIT_V(8); PG8_WAIT_L(0); PG8_BAR; PG8_MMA(0, 0, At, B0); PG8_MMA(0, 1, At, B1); PG8_BAR; PG8_SCHED;
            PG8_LDA(At, 1, 1); PG8_STAGE(PG8_SB(1, 0), b3, v2); PG8_STAGE(PG8_SB(1, 1), b3 + h2, v2); PG8_STAGE(PG8_SA(1, 0), a3, v2);
            PG8_WAIT_V(8); PG8_WAIT_L(0); PG8_BAR; PG8_MMA(1, 0, At, B0); PG8_MMA(1, 1, At, B1); PG8_BAR; PG8_SCHED;
            } else {
            PG8_LDB(B0, 0, 0); PG8_SCHED; PG8_LDA(At, 0, 0); PG8_STAGE(PG8_SA(1, 1), a1 + hstepC, voffC);
            PG8_WAIT_L(8); PG8_BAR; PG8_WAIT_L(0); PG8_MMA(0, 0, At, B0); PG8_BAR; PG8_SCHED;
            PG8_LDB(B1, 0, 1); PG8_STAGE(PG8_SB(0, 0), b2, v2);
            PG8_BAR; PG8_WAIT_L(0); PG8_MMA(0, 1, At, B1); PG8_BAR;
            PG8_LDA(At, 0, 1); PG8_STAGE(PG8_SA(0, 0), a2, v2);
            PG8_BAR; PG8_WAIT_L(0); PG8_MMA(1, 0, At, B0); PG8_BAR; PG8_SCHED;
            PG8_STAGE(PG8_SB(0, 1), b2 + h2, v2);
            PG8_WAIT_V(6); PG8_BAR; PG8_MMA(1, 1, At, B1); PG8_BAR;
            PG8_LDB(B0, 1, 0); PG8_SCHED; PG8_LDA(At, 1, 0); PG8_STAGE(PG8_SA(0, 1), a2 + h2, v2);
            PG8_WAIT_L(8); PG8_BAR; PG8_WAIT_L(0); PG8_MMA(0, 0, At, B0); PG8_BAR; PG8_SCHED;
            PG8_LDB(B1, 1, 1); PG8_STAGE(PG8_SB(1, 0), b3, v2);
            PG8_BAR; PG8_WAIT_L(0); PG8_MMA(0, 1, At, B1); PG8_BAR;
            PG8_LDA(At, 1, 1); PG8_STAGE(PG8_SA(1, 0), a3, v2);
            PG8_BAR; PG8_WAIT_L(0); PG8_MMA(1, 0, At, B0); PG8_BAR; PG8_SCHED;
            PG8_STAGE(PG8_SB(1, 1), b3 + h2, v2);
            PG8_WAIT_V(6); PG8_BAR; PG8_MMA(1, 1, At, B1); PG8_BAR;
            }
        }
        if constexpr (ALIGN_EPI) { if (wr == 0) PG8_BAR; }
        if constexpr (NSEG > 1) { if (seg + 1 < NSEG) E.mid(acc, cur, wr, wc, fr, fq); else E(acc, cur, wr, wc, fr, fq); }
        else E(acc, cur, wr, wc, fr, fq);
        if (!has_next) break;
        if (NSEG == 1 || nseg == 0) {
#pragma unroll
            for (int a = 0; a < 2; ++a)
#pragma unroll
                for (int b = 0; b < 2; ++b)
#pragma unroll
                    for (int m = 0; m < 4; ++m)
#pragma unroll
                        for (int n = 0; n < 2; ++n) acc[a][b][m][n] = (f32x4){0.f, 0.f, 0.f, 0.f};
            ++ti;
        }
        cur = nxt; cA = nA; cB = nB; seg = nseg;
        if (NSEG > 1) { Kc = Kn; voffC[0] = voffN[0]; voffC[1] = voffN[1]; hstepC = hstepN; }
        if constexpr (ALIGN_EPI) { if (wr == 1) PG8_BAR; }
    }
    PG8_WAIT_V(0);
    if constexpr (!ALIGN_EPI) { if (wr == 0) PG8_BAR; }
    PG8_BAR;
#undef PG8_SA
#undef PG8_SB
#undef PG8_STAGE
#undef PG8_LDA
#undef PG8_LDB
#undef PG8_MMA
#undef PG8_WAIT_V
#undef PG8_WAIT_L
#undef PG8_BAR
#undef PG8_SCHED
}
}
using pg8::Unit;
typedef f32x4 AccT[2][2][4][2];

DI u32x4 pack8(const f32x4& v0, const f32x4& v1) { u32x4 w; w.x = cvt_pk_bf16(v0[0], v0[1]); w.y = cvt_pk_bf16(v0[2], v0[3]); w.z = cvt_pk_bf16(v1[0], v1[1]); w.w = cvt_pk_bf16(v1[2], v1[3]); return w; }

struct EpiStoreBf16 {
    bf16_t* O; int ld;
    DI void operator()(const AccT& acc, const Unit& u, int wr, int wc, int fr, int fq) const {
        const int row0 = u.pm * 256 + wr * 64 + fr, col0 = u.pn * 256 + wc * 32 + 8 * fq;
#pragma unroll
        for (int ai = 0; ai < 2; ++ai)
#pragma unroll
            for (int m = 0; m < 4; ++m) { bf16_t* rowp = O + (size_t)(row0 + ai * 128 + m * 16) * ld + col0;
#pragma unroll
                for (int bj = 0; bj < 2; ++bj) *(u32x4*)(rowp + bj * 128) = pack8(acc[ai][bj][m][0], acc[ai][bj][m][1]); }
    }
};

template <int HD>
DI void rope_store(const AccT& acc, int rowbase, const int* pos, bf16_t* dst, int ld, int c1, int half, int ibase, float scale) {
    int pi[2][4];
#pragma unroll
    for (int ai = 0; ai < 2; ++ai)
#pragma unroll
        for (int m = 0; m < 4; ++m) pi[ai][m] = pos[rowbase + ai * 128 + m * 16];
    float invf[2][4];
#pragma unroll
    for (int n = 0; n < 2; ++n)
#pragma unroll
        for (int j = 0; j < 4; ++j) invf[n][j] = exp2f(-(float)(ibase + 4 * n + j) * (2.0f / HD) * 13.287712379549449f);
#pragma unroll
    for (int ai = 0; ai < 2; ++ai)
#pragma unroll
        for (int m = 0; m < 4; ++m) {
            const int row = rowbase + ai * 128 + m * 16; const float ps = (float)pi[ai][m];
            f32x4 o1[2], o2[2];
#pragma unroll
            for (int n = 0; n < 2; ++n)
#pragma unroll
                for (int j = 0; j < 4; ++j) {
                    const float ang = ps * invf[n][j]; const float rev = __builtin_amdgcn_fractf(ang * 0.15915494309189535f);
                    const float sn = __builtin_amdgcn_sinf(rev), cs = __builtin_amdgcn_cosf(rev);
                    const float t1 = acc[ai][0][m][n][j], t2 = acc[ai][1][m][n][j];
                    o1[n][j] = (t1 * cs - t2 * sn) * scale; o2[n][j] = (t2 * cs + t1 * sn) * scale;
                }
            bf16_t* rowp = dst + (size_t)row * ld + c1;
            *(u32x4*)rowp = pack8(o1[0], o1[1]); *(u32x4*)(rowp + half) = pack8(o2[0], o2[1]);
        }
}

struct EpiInProj {
    bf16_t *rq, *rk, *rv, *aq, *ak, *av; const int* pos;
    DI void operator()(const AccT& acc, const Unit& u, int wr, int wc, int fr, int fq) const {
        const int pn = u.pn, rowbase = u.pm * 256 + wr * 64 + fr;
        if (pn < 16) {
            bf16_t* dst = pn < 8 ? rq : rk; const float scale = pn < 8 ? 1.0f : 0.0625f;
            rope_store<256>(acc, rowbase, pos, dst, 2048, 256 * (pn & 7) + 32 * wc + 8 * fq, 128, 32 * wc + 8 * fq, scale);
        } else if (pn < 32) {
            const int col0 = (pn - 16) * 256 + wc * 32 + 8 * fq;
#pragma unroll
            for (int ai = 0; ai < 2; ++ai)
#pragma unroll
                for (int m = 0; m < 4; ++m) { bf16_t* rowp = rv + (size_t)(rowbase + ai * 128 + m * 16) * 4096 + col0;
#pragma unroll
                    for (int bj = 0; bj < 2; ++bj) *(u32x4*)(rowp + bj * 128) = pack8(acc[ai][bj][m][0], acc[ai][bj][m][1]); }
        } else if (pn < 66) {
            const int q9 = pn - 48; bf16_t* dst = q9 < 9 ? aq : ak; const int t9 = q9 < 9 ? q9 : q9 - 9;
            const int head = 2 * t9 + (wc >> 1), ib = 32 * (wc & 1) + 8 * fq;
            rope_store<128>(acc, rowbase, pos, dst, 2304, head * 128 + ib, 64, ib, 1.0f);
        } else {
            const int col0 = (pn - 66) * 256 + wc * 32 + 8 * fq;
#pragma unroll
            for (int ai = 0; ai < 2; ++ai)
#pragma unroll
                for (int m = 0; m < 4; ++m) { bf16_t* rowp = av + (size_t)(rowbase + ai * 128 + m * 16) * 2304 + col0;
#pragma unroll
                    for (int bj = 0; bj < 2; ++bj) *(u32x4*)(rowp + bj * 128) = pack8(acc[ai][bj][m][0], acc[ai][bj][m][1]); }
        }
    }
};

struct EpiRetGate {
    bf16_t* ret; const float* retss; const float* gain;
    DI void operator()(const AccT& acc, const Unit& u, int wr, int wc, int fr, int fq) const {
        const int rowbase = u.pm * 256 + wr * 64 + fr, head = u.pn >> 1, colb = u.pn * 256 + wc * 32 + 8 * fq;
        f32x4 gn[2][2];
#pragma unroll
        for (int bj = 0; bj < 2; ++bj) { gn[bj][0] = *(const f32x4*)(gain + colb + bj * 128); gn[bj][1] = *(const f32x4*)(gain + colb + bj * 128 + 4); }
#pragma unroll
        for (int ai = 0; ai < 2; ++ai) {
            f32x4 sA[4], sB[4]; u32x4 rr[4][2];
#pragma unroll
            for (int m = 0; m < 4; ++m) { const float* ps = retss + ((size_t)(rowbase + ai * 128 + m * 16) * 8 + head) * 8; sA[m] = *(const f32x4*)ps; sB[m] = *(const f32x4*)(ps + 4); }
#pragma unroll
            for (int m = 0; m < 4; ++m)
#pragma unroll
                for (int bj = 0; bj < 2; ++bj) rr[m][bj] = *(const u32x4*)(ret + (size_t)(rowbase + ai * 128 + m * 16) * 4096 + colb + bj * 128);
#pragma unroll
            for (int m = 0; m < 4; ++m) {
                const f32x4 s0 = sA[m], s1 = sB[m];
                const float rsv = __builtin_amdgcn_rsqf((((s0[0] + s0[1]) + (s0[2] + s0[3])) + ((s1[0] + s1[1]) + (s1[2] + s1[3]))) * (1.0f / 512.0f) + 1e-6f);
#pragma unroll
                for (int bj = 0; bj < 2; ++bj) {
                    const u32x4 r4 = rr[m][bj];
                    const float rf[8] = {bflo(r4.x), bfhi(r4.x), bflo(r4.y), bfhi(r4.y), bflo(r4.z), bfhi(r4.z), bflo(r4.w), bfhi(r4.w)};
                    f32x4 o0, o1;
#pragma unroll
                    for (int j = 0; j < 4; ++j) {
                        const float a0 = acc[ai][bj][m][0][j], a1 = acc[ai][bj][m][1][j];
                        o0[j] = a0 * sigmoidf_(a0) * (rf[j] * rsv * gn[bj][0][j]); o1[j] = a1 * sigmoidf_(a1) * (rf[4 + j] * rsv * gn[bj][1][j]);
                    }
                    *(u32x4*)(ret + (size_t)(rowbase + ai * 128 + m * 16) * 4096 + colb + bj * 128) = pack8(o0, o1);
                }
            }
        }
    }
};

struct EpiGates {
    bf16_t* O; const float* bias;
    DI void operator()(const AccT& acc, const Unit& u, int wr, int wc, int fr, int fq) const {
        const int rowbase = u.pm * 256 + wr * 64 + fr;
#pragma unroll
        for (int bj = 0; bj < 2; ++bj) {
            const int col = u.pn * 256 + bj * 128 + wc * 32 + 8 * fq;
            const f32x4 b0 = *(const f32x4*)(bias + col), b1 = *(const f32x4*)(bias + col + 4);
#pragma unroll
            for (int ai = 0; ai < 2; ++ai)
#pragma unroll
                for (int m = 0; m < 4; ++m) {
                    f32x4 o0, o1;
#pragma unroll
                    for (int j = 0; j < 4; ++j) { o0[j] = sigmoidf_(acc[ai][bj][m][0][j] + b0[j]); o1[j] = sigmoidf_(acc[ai][bj][m][1][j] + b1[j]); }
                    *(u32x4*)(O + (size_t)(rowbase + ai * 128 + m * 16) * 4096 + col) = pack8(o0, o1);
                }
        }
    }
};

struct EpiYMerge {
    const bf16_t* gates; bf16_t* U2;
    DI void mid(AccT& acc, const Unit& u, int wr, int wc, int fr, int fq) const {
        const int rowbase = u.pm * 256 + wr * 64 + fr, colb = u.pn * 256 + wc * 32 + 8 * fq;
#pragma unroll
        for (int ai = 0; ai < 2; ++ai) {
            u32x4 gr[4][2], ga[4][2];
#pragma unroll
            for (int m = 0; m < 4; ++m)
#pragma unroll
                for (int bj = 0; bj < 2; ++bj) { const bf16_t* pg = gates + (size_t)(rowbase + ai * 128 + m * 16) * 4096 + colb + bj * 128; gr[m][bj] = *(const u32x4*)pg; ga[m][bj] = *(const u32x4*)(pg + 2048); }
#pragma unroll
            for (int m = 0; m < 4; ++m)
#pragma unroll
                for (int bj = 0; bj < 2; ++bj) {
                    const u32x4 g1 = gr[m][bj], g2 = ga[m][bj];
                    const float r[8] = {bflo(g1.x), bfhi(g1.x), bflo(g1.y), bfhi(g1.y), bflo(g1.z), bfhi(g1.z), bflo(g1.w), bfhi(g1.w)};
                    const float a[8] = {bflo(g2.x), bfhi(g2.x), bflo(g2.y), bfhi(g2.y), bflo(g2.z), bfhi(g2.z), bflo(g2.w), bfhi(g2.w)};
#pragma unroll
                    for (int j = 0; j < 4; ++j) { acc[ai][bj][m][0][j] *= r[j] * __builtin_amdgcn_rcpf(fmaxf(a[j], 1e-30f)); acc[ai][bj][m][1][j] *= r[4 + j] * __builtin_amdgcn_rcpf(fmaxf(a[4 + j], 1e-30f)); }
                }
        }
    }
    DI void operator()(const AccT& acc, const Unit& u, int wr, int wc, int fr, int fq) const {
        const int rowbase = u.pm * 256 + wr * 64 + fr, colb = u.pn * 256 + wc * 32 + 8 * fq;
        u32x4 gg[2][4][2];
#pragma unroll
        for (int ai = 0; ai < 2; ++ai)
#pragma unroll
            for (int m = 0; m < 4; ++m)
#pragma unroll
                for (int bj = 0; bj < 2; ++bj) gg[ai][m][bj] = *(const u32x4*)(gates + (size_t)(rowbase + ai * 128 + m * 16) * 4096 + 2048 + colb + bj * 128);
#pragma unroll
        for (int ai = 0; ai < 2; ++ai)
#pragma unroll
            for (int m = 0; m < 4; ++m)
#pragma unroll
                for (int bj = 0; bj < 2; ++bj) {
                    const u32x4 g4 = gg[ai][m][bj];
                    f32x4 o0 = acc[ai][bj][m][0], o1 = acc[ai][bj][m][1];
                    o0[0] *= bflo(g4.x); o0[1] *= bfhi(g4.x); o0[2] *= bflo(g4.y); o0[3] *= bfhi(g4.y);
                    o1[0] *= bflo(g4.z); o1[1] *= bfhi(g4.z); o1[2] *= bflo(g4.w); o1[3] *= bfhi(g4.w);
                    *(u32x4*)(U2 + (size_t)(rowbase + ai * 128 + m * 16) * 2048 + colb + bj * 128) = pack8(o0, o1);
                }
    }
};

DI float gelu_tanh(float v) {
    const float uu = 0.7978845608028654f * (v + 0.044715f * v * v * v);
    const float e = __builtin_amdgcn_exp2f(2.8853900817779268f * uu);
    return v - v * __builtin_amdgcn_rcpf(e + 1.0f);
}
struct EpiConvAct {
    const bf16_t* A; bf16_t* ACT; const float* conv_w; const float* conv_b;
    DI void operator()(const AccT& acc, const Unit& u, int wr, int wc, int fr, int fq) const {
        const int rowbase = u.pm * 256 + wr * 64 + fr;
#pragma unroll
        for (int bj = 0; bj < 2; ++bj) {
            const int col = u.pn * 256 + bj * 128 + wc * 32 + 8 * fq;
            f32x4 w0[2], w1[2], w2[2], cb[2];
#pragma unroll
            for (int hh = 0; hh < 2; ++hh) { w0[hh] = *(const f32x4*)(conv_w + col + 4 * hh); w1[hh] = *(const f32x4*)(conv_w + FF + col + 4 * hh); w2[hh] = *(const f32x4*)(conv_w + 2 * FF + col + 4 * hh); cb[hh] = *(const f32x4*)(conv_b + col + 4 * hh); }
#pragma unroll
            for (int aim = 0; aim < 4; ++aim) { const int ai = aim >> 1, mb = (aim & 1) * 2;
                u32x4 a0[4], a1[4], a2[4];
#pragma unroll
                for (int m = mb; m < mb + 2; ++m) {
                    const int row = rowbase + ai * 128 + m * 16; const int sq = row & (SEQ - 1);
                    const bf16_t* pa = A + (size_t)row * FF + col;
                    a0[m] = *(const u32x4*)pa;
                    a1[m] = *(const u32x4*)(pa - (sq >= 1 ? FF : 0));
                    a2[m] = *(const u32x4*)(pa - (sq >= 2 ? 2 * FF : 0));
                }
#pragma unroll
                for (int m = mb; m < mb + 2; ++m) {
                    const int row = rowbase + ai * 128 + m * 16; const int sq = row & (SEQ - 1);
                    const float k1 = sq >= 1 ? 1.0f : 0.0f, k2 = sq >= 2 ? 1.0f : 0.0f;
                    const u32x4 x0 = a0[m], x1 = a1[m], x2 = a2[m];
                    const float f0[8] = {bflo(x0.x), bfhi(x0.x), bflo(x0.y), bfhi(x0.y), bflo(x0.z), bfhi(x0.z), bflo(x0.w), bfhi(x0.w)};
                    const float f1[8] = {bflo(x1.x), bfhi(x1.x), bflo(x1.y), bfhi(x1.y), bflo(x1.z), bfhi(x1.z), bflo(x1.w), bfhi(x1.w)};
                    const float f2[8] = {bflo(x2.x), bfhi(x2.x), bflo(x2.y), bfhi(x2.y), bflo(x2.z), bfhi(x2.z), bflo(x2.w), bfhi(x2.w)};
                    f32x4 o0, o1;
#pragma unroll
                    for (int j = 0; j < 4; ++j) {
                        const float c0 = cb[0][j] + w0[0][j] * f0[j] + k1 * (w1[0][j] * f1[j]) + k2 * (w2[0][j] * f2[j]);
                        const float c1 = cb[1][j] + w0[1][j] * f0[4 + j] + k1 * (w1[1][j] * f1[4 + j]) + k2 * (w2[1][j] * f2[4 + j]);
                        o0[j] = gelu_tanh(c0) * acc[ai][bj][m][0][j]; o1[j] = gelu_tanh(c1) * acc[ai][bj][m][1][j];
                    }
                    *(u32x4*)(ACT + (size_t)row * FF + col) = pack8(o0, o1);
                }
            }
        }
    }
};

DI int invperm32(int c) { return 16 * ((c >> 2) & 1) + 4 * (c >> 3) + (c & 3); }
DI int slot_std(int c) { return (c & ~31) | invperm32(c & 31); }
DI int slot_win(int c) {
    if (c >= 12288 && c < 16896) { const int tc = c & 255, hh = tc >> 7, bj = (tc >> 6) & 1, i64 = tc & 63, x = 64 * hh + i64; return (c & ~255) + 128 * bj + (x & ~31) + invperm32(x & 31); }
    return slot_std(c);
}
DI void transpose_item(const float* W, int K, int N, bf16_t* WT, int mode, LAS float* scr, int item, int lane) {
    const int nblk = N / 32, kb = item / nblk, nb = item % nblk, k0 = 64 * kb, n0 = 32 * nb;
#pragma unroll 8
    for (int i = 0; i < 32; ++i) { const int kk = 2 * i + (lane >> 5); scr[kk * 33 + (lane & 31)] = W[(size_t)(k0 + kk) * N + n0 + (lane & 31)]; }
    asm volatile("s_waitcnt lgkmcnt(0)" ::: "memory");
    const int c = lane & 7;
#pragma unroll
    for (int j = 0; j < 4; ++j) { const int n = (lane >> 3) + 8 * j; const LAS float* s = scr + (8 * c) * 33 + n;
        u32x4 o; o.x = cvt_pk_bf16(s[0 * 33], s[1 * 33]); o.y = cvt_pk_bf16(s[2 * 33], s[3 * 33]); o.z = cvt_pk_bf16(s[4 * 33], s[5 * 33]); o.w = cvt_pk_bf16(s[6 * 33], s[7 * 33]);
        const int drow = mode ? slot_win(n0 + n) : slot_std(n0 + n);
        *(u32x4*)(WT + (size_t)drow * K + k0 + 8 * c) = o; }
    asm volatile("s_waitcnt lgkmcnt(0)" ::: "memory");
}

DI void phase0(const Params& p, LAS unsigned char* lds) {
    const int tid = threadIdx.x, lane = tid & 63, wave = tid >> 6;
    LAS float* sc = (LAS float*)lds;
    LAS float* red = sc + 8192;
    float* ada = (float*)(p.ws + WS_ADA);
    for (int i = tid; i < 8192; i += 512) { const float v = p.c[i]; sc[i] = v / (1.0f + __expf(-v)); }
    __syncthreads();
    for (int cb = blockIdx.x; cb < 256; cb += gridDim.x) {
        {
            const int rg = lane / 12, cq = lane - 12 * rg;
            f32x4 a0 = {0.f, 0.f, 0.f, 0.f}, a1 = a0, a2 = a0, a3 = a0;
            if (rg < 5) {
                const float* wp = p.w_ada + 48 * cb + 4 * cq;
#pragma unroll 13
                for (int i = 0; i < 52; ++i) { const int kl = 5 * i + rg; if (kl < 256) { const int kk = 256 * wave + kl; const f32x4 wv = *(const f32x4*)(wp + (size_t)kk * 12288);
                    a0 += sc[kk] * wv; a1 += sc[2048 + kk] * wv; a2 += sc[4096 + kk] * wv; a3 += sc[6144 + kk] * wv; } }
                LAS float* rp = red + ((wave * 5 + rg) * 4) * 48 + 4 * cq;
                *(LAS f32x4*)(rp) = a0; *(LAS f32x4*)(rp + 48) = a1; *(LAS f32x4*)(rp + 96) = a2; *(LAS f32x4*)(rp + 144) = a3;
            }
        }
        __syncthreads();
        if (tid < 192) { const int b = tid / 48, l = tid % 48; float sacc = 0.f;
#pragma unroll 8
            for (int wg = 0; wg < 40; ++wg) sacc += red[(wg * 4 + b) * 48 + l];
            ada[b * 12288 + 48 * cb + l] = sacc + p.b_ada[48 * cb + l]; }
        __syncthreads();
    }
    asm volatile("s_waitcnt vmcnt(0)" ::: "memory");
    __syncthreads();
    if (tid == 0) { __builtin_amdgcn_fence(__ATOMIC_RELEASE, "agent"); asm volatile("s_waitcnt vmcnt(0)" ::: "memory");
        __hip_atomic_fetch_add((unsigned*)(p.ws + 700000) + 1536, 1u, __ATOMIC_RELAXED, __HIP_MEMORY_SCOPE_AGENT); }
    LAS float* scr = (LAS float*)(lds + 40960 + wave * 8448);
    const int gw = blockIdx.x * 8 + wave, NGW = gridDim.x * 8;
    constexpr int I_IN = (2048 / 64) * (19200 / 32), I_GATE = (2048 / 64) * (4096 / 32), I_RET = (4096 / 64) * (2048 / 32), I_ATT = (2304 / 64) * (2048 / 32),
                  I_MIX = (2048 / 64) * (2048 / 32), I_UP = (2048 / 64) * (11264 / 32), I_DOWN = (5632 / 64) * (2048 / 32);
    constexpr int NITEMS = I_IN + I_GATE + I_RET + I_ATT + I_MIX + I_UP + I_DOWN;
    for (int it = gw; it < NITEMS - I_UP; it += NGW) {
        int r = it;
        if (r < I_IN) { transpose_item(p.w_in, 2048, 19200, (bf16_t*)(p.ws + WS_WIN), 1, scr, r, lane); continue; } r -= I_IN;
        if (r < I_GATE) { transpose_item(p.w_gate, 2048, 4096, (bf16_t*)(p.ws + WS_WGATE), 0, scr, r, lane); continue; } r -= I_GATE;
        if (r < I_RET) { transpose_item(p.w_ret_out, 4096, 2048, (bf16_t*)(p.ws + WS_WRET), 0, scr, r, lane); continue; } r -= I_RET;
        if (r < I_ATT) { transpose_item(p.w_att_out, 2304, 2048, (bf16_t*)(p.ws + WS_WATT), 0, scr, r, lane); continue; } r -= I_ATT;
        if (r < I_MIX) { transpose_item(p.w_mix, 2048, 2048, (bf16_t*)(p.ws + WS_WMIX), 0, scr, r, lane); continue; } r -= I_MIX;
        transpose_item(p.w_down, 5632, 2048, (bf16_t*)(p.ws + WS_WDOWN), 0, scr, r, lane);
    }
}
DI void convert_ffn_weights(const Params& p, LAS unsigned char* lds, int idx, int nshare) {
    const int lane = threadIdx.x & 63, wave = threadIdx.x >> 6;
    LAS float* scr = (LAS float*)(lds + wave * 8448);
    constexpr int I_UP = (2048 / 64) * (11264 / 32), I_DOWN = (5632 / 64) * (2048 / 32);
    for (int it = idx * 8 + wave; it < I_UP; it += nshare * 8) transpose_item(p.w_up, 2048, 11264, (bf16_t*)(p.ws + WS_WUP), 0, scr, it, lane);
}

constexpr int NR = 2;
DI void phase_h(const Params& p) {
    const int lane = threadIdx.x & 63, wave = threadIdx.x >> 6;
    const float* ada = (const float*)(p.ws + WS_ADA); bf16_t* H = (bf16_t*)(p.ws + WS_H);
    const int nw = gridDim.x * 8;
    for (int row0 = blockIdx.x * 8 + wave; row0 < T_TOK; row0 += nw * NR) {
        f32x4 v[NR][4][2]; float ss[NR];
#pragma unroll
        for (int q = 0; q < NR; ++q) { const float* xr = p.x + (size_t)(row0 + q * nw) * DM; ss[q] = 0.f;
#pragma unroll
            for (int it = 0; it < 4; ++it) { const int col = (it * 64 + lane) * 8; v[q][it][0] = *(const f32x4*)(xr + col); v[q][it][1] = *(const f32x4*)(xr + col + 4); } }
#pragma unroll
        for (int q = 0; q < NR; ++q) {
#pragma unroll
            for (int it = 0; it < 4; ++it)
#pragma unroll
                for (int j = 0; j < 4; ++j) ss[q] += v[q][it][0][j] * v[q][it][0][j] + v[q][it][1][j] * v[q][it][1][j];
            ss[q] = __builtin_amdgcn_rsqf(wave_sum(ss[q]) * (1.0f / DM) + 1e-6f); }
#pragma unroll
        for (int it = 0; it < 4; ++it) { const int col = (it * 64 + lane) * 8;
            f32x4 g[2], sh[NR][2], scl[NR][2];
#pragma unroll
            for (int hh = 0; hh < 2; ++hh) { g[hh] = *(const f32x4*)(p.g_pre_mix + col + 4 * hh);
#pragma unroll
                for (int q = 0; q < NR; ++q) { const int b = (row0 + q * nw) / SEQ; sh[q][hh] = *(const f32x4*)(ada + b * 12288 + col + 4 * hh); scl[q][hh] = *(const f32x4*)(ada + b * 12288 + 2048 + col + 4 * hh); } }
#pragma unroll
            for (int q = 0; q < NR; ++q) { f32x4 o[2];
#pragma unroll
                for (int hh = 0; hh < 2; ++hh)
#pragma unroll
                    for (int j = 0; j < 4; ++j) o[hh][j] = v[q][it][hh][j] * ss[q] * g[hh][j] * (1.0f + scl[q][hh][j]) + sh[q][hh][j];
                *(u32x4*)(H + (size_t)(row0 + q * nw) * DM + col) = pack8(o[0], o[1]); } }
    }
}

DI void phase_postmix(const Params& p) {
    const int lane = threadIdx.x & 63, wave = threadIdx.x >> 6;
    const float* ada = (const float*)(p.ws + WS_ADA); const bf16_t* Y = (const bf16_t*)(p.ws + WS_Y); bf16_t* H2 = (bf16_t*)(p.ws + WS_H2);
    const int nw = gridDim.x * 8;
    for (int row0 = blockIdx.x * 8 + wave; row0 < T_TOK; row0 += nw * NR) {
        f32x4 y[NR][4][2], xv[NR][4][2]; float ry[NR], r1[NR];
#pragma unroll
        for (int q = 0; q < NR; ++q) { const size_t ro = (size_t)(row0 + q * nw) * DM;
#pragma unroll
            for (int it = 0; it < 4; ++it) { const int col = (it * 64 + lane) * 8; const u32x4 w = *(const u32x4*)(Y + ro + col);
                y[q][it][0] = (f32x4){bflo(w.x), bfhi(w.x), bflo(w.y), bfhi(w.y)}; y[q][it][1] = (f32x4){bflo(w.z), bfhi(w.z), bflo(w.w), bfhi(w.w)};
                xv[q][it][0] = *(const f32x4*)(p.x + ro + col); xv[q][it][1] = *(const f32x4*)(p.x + ro + col + 4); } }
#pragma unroll
        for (int q = 0; q < NR; ++q) { float ss = 0.f;
#pragma unroll
            for (int it = 0; it < 4; ++it)
#pragma unroll
                for (int j = 0; j < 4; ++j) ss += y[q][it][0][j] * y[q][it][0][j] + y[q][it][1][j] * y[q][it][1][j];
            ry[q] = __builtin_amdgcn_rsqf(wave_sum(ss) * (1.0f / DM) + 1e-6f); }
#pragma unroll
        for (int q = 0; q < NR; ++q) { const int row = row0 + q * nw; const float* ab = ada + (row / SEQ) * 12288; float s1 = 0.f;
#pragma unroll
            for (int it = 0; it < 4; ++it) { const int col = (it * 64 + lane) * 8;
#pragma unroll
                for (int hh = 0; hh < 2; ++hh) { const f32x4 g = *(const f32x4*)(p.g_post_mix + col + 4 * hh), gt = *(const f32x4*)(ab + 4096 + col + 4 * hh);
                    f32x4 o;
#pragma unroll
                    for (int j = 0; j < 4; ++j) { o[j] = xv[q][it][hh][j] + gt[j] * (y[q][it][hh][j] * ry[q] * g[j]); s1 += o[j] * o[j]; }
                    y[q][it][hh] = o; }
                *(u32x4*)((bf16_t*)(p.out + (size_t)row * DM + DM / 2) + col) = pack8(y[q][it][0], y[q][it][1]); }
            r1[q] = __builtin_amdgcn_rsqf(wave_sum(s1) * (1.0f / DM) + 1e-6f); }
#pragma unroll
        for (int q = 0; q < NR; ++q) { const int row = row0 + q * nw; const float* ab = ada + (row / SEQ) * 12288;
#pragma unroll
            for (int it = 0; it < 4; ++it) { const int col = (it * 64 + lane) * 8; f32x4 o[2];
#pragma unroll
                for (int hh = 0; hh < 2; ++hh) { const f32x4 g = *(const f32x4*)(p.g_pre_ffn + col + 4 * hh), sh = *(const f32x4*)(ab + 6144 + col + 4 * hh), scl = *(const f32x4*)(ab + 8192 + col + 4 * hh);
#pragma unroll
                    for (int j = 0; j < 4; ++j) o[hh][j] = y[q][it][hh][j] * r1[q] * g[j] * (1.0f + scl[j]) + sh[j]; }
                *(u32x4*)(H2 + (size_t)row * DM + col) = pack8(o[0], o[1]); } }
    }
}

DI void phase_final(const Params& p) {
    const int lane = threadIdx.x & 63, wave = threadIdx.x >> 6;
    const float* ada = (const float*)(p.ws + WS_ADA); const bf16_t* Y = (const bf16_t*)(p.ws + WS_Y2);
    const int nw = gridDim.x * 8;
    for (int row0 = blockIdx.x * 8 + wave; row0 < T_TOK; row0 += nw * NR) {
        f32x4 y[NR][4][2], xv[NR][4][2]; float ry[NR];
#pragma unroll
        for (int q = 0; q < NR; ++q) { const size_t ro = (size_t)(row0 + q * nw) * DM;
#pragma unroll
            for (int it = 0; it < 4; ++it) { const int col = (it * 64 + lane) * 8; const u32x4 w = *(const u32x4*)(Y + ro + col);
                y[q][it][0] = (f32x4){bflo(w.x), bfhi(w.x), bflo(w.y), bfhi(w.y)}; y[q][it][1] = (f32x4){bflo(w.z), bfhi(w.z), bflo(w.w), bfhi(w.w)};
                const u32x4 xw = *(const u32x4*)((const bf16_t*)(p.out + ro + DM / 2) + col);
                xv[q][it][0] = (f32x4){bflo(xw.x), bfhi(xw.x), bflo(xw.y), bfhi(xw.y)}; xv[q][it][1] = (f32x4){bflo(xw.z), bfhi(xw.z), bflo(xw.w), bfhi(xw.w)}; } }
#pragma unroll
        for (int q = 0; q < NR; ++q) { float ss = 0.f;
#pragma unroll
            for (int it = 0; it < 4; ++it)
#pragma unroll
                for (int j = 0; j < 4; ++j) ss += y[q][it][0][j] * y[q][it][0][j] + y[q][it][1][j] * y[q][it][1][j];
            ry[q] = __builtin_amdgcn_rsqf(wave_sum(ss) * (1.0f / DM) + 1e-6f); }
#pragma unroll
        for (int q = 0; q < NR; ++q) { const int row = row0 + q * nw; const float* ab = ada + (row / SEQ) * 12288;
#pragma unroll
            for (int it = 0; it < 4; ++it) { const int col = (it * 64 + lane) * 8;
#pragma unroll
                for (int hh = 0; hh < 2; ++hh) { const f32x4 g = *(const f32x4*)(p.g_post_ffn + col + 4 * hh), gt = *(const f32x4*)(ab + 10240 + col + 4 * hh);
                    f32x4 o;
#pragma unroll
                    for (int j = 0; j < 4; ++j) o[j] = xv[q][it][hh][j] + gt[j] * (y[q][it][hh][j] * ry[q] * g[j]);
                    *(f32x4*)(p.out + (size_t)row * DM + col + 4 * hh) = o; } } }
    }
}

DI void phase_alpha(const Params& p) {
    bf16_t* att = (bf16_t*)(p.ws + WS_AQ); const float* lse = (const float*)(p.ws + WS_LSE);
    const int lane = threadIdx.x & 63, wave = threadIdx.x >> 6;
    for (int t = blockIdx.x * 8 + wave; t < T_TOK; t += gridDim.x * 8) {
        const float l = lse[(size_t)t * 18 + (lane < 18 ? lane : 0)];
        const int j = lane % 6;
        const float l0 = __shfl(l, j), l1 = __shfl(l, 6 + j), l2 = __shfl(l, 12 + j);
        const float mm = fmaxf(l0, fmaxf(l1, l2)); const float e0 = __expf(l0 - mm), e1 = __expf(l1 - mm), e2 = __expf(l2 - mm);
        const float al_lane = __expf(l - mm) / (e0 + e1 + e2);
        u32x4* row = (u32x4*)(att + (size_t)t * 2304);
        u32x4 w[5];
#pragma unroll
        for (int k = 0; k < 5; ++k) { const int ch = lane + 64 * k; if (ch < 288) w[k] = row[ch]; }
#pragma unroll
        for (int k = 0; k < 5; ++k) { const int ch = lane + 64 * k; const float al = __shfl(al_lane, (ch < 288 ? ch : 0) >> 4);
            if (ch < 288) { u32x4 o;
                o.x = cvt_pk_bf16(bflo(w[k].x) * al, bfhi(w[k].x) * al); o.y = cvt_pk_bf16(bflo(w[k].y) * al, bfhi(w[k].y) * al);
                o.z = cvt_pk_bf16(bflo(w[k].z) * al, bfhi(w[k].z) * al); o.w = cvt_pk_bf16(bflo(w[k].w) * al, bfhi(w[k].w) * al);
                row[ch] = o; } }
    }
}

DI void phase_retention(const Params& p, LAS unsigned char* lds, int cblk) {
    const int tid = threadIdx.x, lane = tid & 63, w = tid >> 6, fr = lane & 15, fq = lane >> 4;
    LAS unsigned char* Qs = lds; LAS unsigned char* Ks = lds + 33792; LAS unsigned char* Vs = lds + 67584; LAS unsigned char* St = lds + 76800; LAS unsigned char* Ps = lds + 110592;
    LAS float* red = (LAS float*)(lds + 119808);
    const bf16_t* rq = (const bf16_t*)(p.ws + WS_RQ); const bf16_t* rk = (const bf16_t*)(p.ws + WS_RK); bf16_t* rv = (bf16_t*)p.out; float* retss = (float*)(p.ws + WS_RETSS);
    for (int item = cblk; item < 256; item += gridDim.x) {
        const int q5 = item >> 3, bh = (item & 7) * 4 + (q5 & 3), slice = q5 >> 2, b = bh >> 3, h = bh & 7;
        const float lg = log1pf(-exp2f(-5.0f - (float)h));
        const float gamma_c = expf(64.0f * lg);
        const float xv = expf(-lg * (float)((tid >> 3) + 1));
        const float xo0 = expf(lg * (float)(32 * (w & 1) + fr + 1)), xo1 = expf(lg * (float)(32 * (w & 1) + 16 + fr + 1));
        const size_t tok0 = (size_t)b * SEQ;
        const bf16_t* qbase = rq + tok0 * 2048 + h * 256 + (tid & 31) * 8; const bf16_t* kbase = rk + tok0 * 2048 + h * 256 + (tid & 31) * 8;
        bf16_t* vbase = rv + tok0 * 4096 + h * 512 + slice * 64;
        u32x4 pq[4], pk[4], pv;
        f32x4 Sreg[2][4];
#pragma unroll
        for (int a = 0; a < 2; ++a)
#pragma unroll
            for (int bb = 0; bb < 4; ++bb) Sreg[a][bb] = (f32x4){0.f, 0.f, 0.f, 0.f};
        for (int i = tid; i < 33792 / 16; i += 512) ((LAS u32x4*)St)[i] = (u32x4){0u, 0u, 0u, 0u};
#define RET_LOAD(c) do { _Pragma("unroll") for (int i = 0; i < 4; ++i) { const int row = (tid + 512 * i) >> 5; \
            pq[i] = *(const u32x4*)(qbase + (size_t)(64 * (c) + row) * 2048); pk[i] = *(const u32x4*)(kbase + (size_t)(64 * (c) + row) * 2048); } \
            pv = *(const u32x4*)(vbase + (size_t)(64 * (c) + (tid >> 3)) * 4096 + (tid & 7) * 8); } while (0)
#define RET_STORE() do { _Pragma("unroll") for (int i = 0; i < 4; ++i) { const int e = tid + 512 * i, row = e >> 5, pc = e & 31; \
            *(LAS u32x4*)(Qs + row * 528 + pc * 16) = pq[i]; *(LAS u32x4*)(Ks + row * 528 + pc * 16) = pk[i]; } \
            { u32x4 o; o.x = cvt_pk_bf16(bflo(pv.x) * xv, bfhi(pv.x) * xv); o.y = cvt_pk_bf16(bflo(pv.y) * xv, bfhi(pv.y) * xv); \
              o.z = cvt_pk_bf16(bflo(pv.z) * xv, bfhi(pv.z) * xv); o.w = cvt_pk_bf16(bflo(pv.w) * xv, bfhi(pv.w) * xv); \
              *(LAS u32x4*)(Vs + (tid >> 3) * 144 + (tid & 7) * 16) = o; } } while (0)
        RET_LOAD(0); RET_STORE();
        __syncthreads();
        for (int c = 0; c < 128; ++c) {
            if (c + 1 < 128) RET_LOAD(c + 1);
            bf16x8 qfr[8][2];
            {
                const int jt = w >> 1, it0 = (w & 1) * 2;
                f32x4 sa[2] = {(f32x4){0.f, 0.f, 0.f, 0.f}, (f32x4){0.f, 0.f, 0.f, 0.f}};
#pragma unroll
                for (int ks = 0; ks < 8; ++ks) {
                    const bf16x8 kf = *(const LAS bf16x8*)(Ks + (16 * jt + fr) * 528 + (32 * ks + 8 * fq) * 2);
#pragma unroll
                    for (int t = 0; t < 2; ++t) { qfr[ks][t] = *(const LAS bf16x8*)(Qs + (16 * (it0 + t) + fr) * 528 + (32 * ks + 8 * fq) * 2); sa[t] = mfma16(kf, qfr[ks][t], sa[t]); }
                }
#pragma unroll
                for (int t = 0; t < 2; ++t) { const int iq = 16 * (it0 + t) + fr, jk0 = 16 * jt + 4 * fq;
                    u32x2 o; o.x = cvt_pk_bf16(jk0 + 0 <= iq ? sa[t][0] : 0.f, jk0 + 1 <= iq ? sa[t][1] : 0.f); o.y = cvt_pk_bf16(jk0 + 2 <= iq ? sa[t][2] : 0.f, jk0 + 3 <= iq ? sa[t][3] : 0.f);
                    *(LAS u32x2*)(Ps + iq * 144 + jk0 * 2) = o; }
            }
            {
#pragma unroll
                for (int ks = 0; ks < 2; ++ks) {
                    const int j0 = 32 * ks + 8 * fq + (fr >> 2);
                    bf16x8 kt[2], vf[4];
#pragma unroll
                    for (int dd = 0; dd < 2; ++dd) { LAS unsigned char* a0 = Ks + j0 * 528 + (16 * (2 * w + dd) + 4 * (fr & 3)) * 2; kt[dd] = tr_read2(a0, a0 + 4 * 528); }
#pragma unroll
                    for (int vt = 0; vt < 4; ++vt) { LAS unsigned char* a0 = Vs + j0 * 144 + (16 * vt + 4 * (fr & 3)) * 2; vf[vt] = tr_read2(a0, a0 + 4 * 144); }
#pragma unroll
                    for (int dd = 0; dd < 2; ++dd)
#pragma unroll
                        for (int vt = 0; vt < 4; ++vt) Sreg[dd][vt] = mfma16(kt[dd], vf[vt], Sreg[dd][vt]);
                }
#pragma unroll
                for (int dd = 0; dd < 2; ++dd)
#pragma unroll
                    for (int vt = 0; vt < 4; ++vt) Sreg[dd][vt] *= gamma_c;
            }
            __syncthreads();
            {
                const int vt = w >> 1, it0 = (w & 1) * 2;
                f32x4 oa[2] = {(f32x4){0.f, 0.f, 0.f, 0.f}, (f32x4){0.f, 0.f, 0.f, 0.f}};
#pragma unroll
                for (int ks = 0; ks < 8; ++ks) {
                    const bf16x8 sf = *(const LAS bf16x8*)(St + (16 * vt + fr) * 528 + (32 * ks + 8 * fq) * 2);
#pragma unroll
                    for (int t = 0; t < 2; ++t) oa[t] = mfma16(sf, qfr[ks][t], oa[t]);
                }
#pragma unroll
                for (int ks = 0; ks < 2; ++ks) {
                    const int j0 = 32 * ks + 8 * fq + (fr >> 2);
                    LAS unsigned char* a0 = Vs + j0 * 144 + (16 * vt + 4 * (fr & 3)) * 2; const bf16x8 vf = tr_read2(a0, a0 + 4 * 144);
#pragma unroll
                    for (int t = 0; t < 2; ++t) { const bf16x8 pf = *(const LAS bf16x8*)(Ps + (16 * (it0 + t) + fr) * 144 + (32 * ks + 8 * fq) * 2); oa[t] = mfma16(vf, pf, oa[t]); }
                }
#pragma unroll
                for (int t = 0; t < 2; ++t) { const int iq = 16 * (it0 + t) + fr; oa[t] *= (t == 0 ? xo0 : xo1);
                    u32x2 o; o.x = cvt_pk_bf16(oa[t][0], oa[t][1]); o.y = cvt_pk_bf16(oa[t][2], oa[t][3]);
                    *(u32x2*)(vbase + (size_t)(64 * c + iq) * 4096 + 16 * vt + 4 * fq) = o;
                    float ss = (oa[t][0] * oa[t][0] + oa[t][1] * oa[t][1]) + (oa[t][2] * oa[t][2] + oa[t][3] * oa[t][3]);
                    ss += __shfl_xor(ss, 16); ss += __shfl_xor(ss, 32);
                    if (fq == 0) red[iq * 4 + vt] = ss; }
            }
            __syncthreads();
#pragma unroll
            for (int dd = 0; dd < 2; ++dd)
#pragma unroll
                for (int vt = 0; vt < 4; ++vt) { u32x2 o; o.x = cvt_pk_bf16(Sreg[dd][vt][0], Sreg[dd][vt][1]); o.y = cvt_pk_bf16(Sreg[dd][vt][2], Sreg[dd][vt][3]);
                    *(LAS u32x2*)(St + (16 * vt + fr) * 528 + (16 * (2 * w + dd) + 4 * fq) * 2) = o; }
            if (c + 1 < 128) RET_STORE();
            if (tid < 64) retss[((tok0 + 64 * c + tid) * 8 + h) * 8 + slice] = (red[tid * 4 + 0] + red[tid * 4 + 1]) + (red[tid * 4 + 2] + red[tid * 4 + 3]);
            __syncthreads();
        }
#undef RET_LOAD
#undef RET_STORE
    }
}

DI void phase_attention(const Params& p, LAS unsigned char* lds) {
    const int tid = threadIdx.x, lane = tid & 63, w = tid >> 6, fr = lane & 15, fq = lane >> 4;
    LAS unsigned char* Ks = lds; LAS unsigned char* Vs = lds + 69632;
    bf16_t* aq = (bf16_t*)(p.ws + WS_AQ); const bf16_t* ak = (const bf16_t*)(p.ws + WS_AK); const bf16_t* av = (const bf16_t*)(p.ws + WS_AV); float* lse = (float*)(p.ws + WS_LSE);
    const int per = (4608 + (int)gridDim.x - 1) / (int)gridDim.x, it_lo = (int)blockIdx.x * per, it_hi = (it_lo + per < 4608) ? it_lo + per : 4608;
    int prev_key = -1;
    u32x4 kcur[4], vcur[4];
#define ATT_LOAD_CUR(item_) do { const int bh_ = (item_) >> 6, e64_ = (item_) & 63, head_ = bh_ % 18, b_ = bh_ / 18; \
        const int rsh_ = 2 * (head_ / 6), r_ = 1 << rsh_, nbc_ = 64 >> rsh_, cls_ = e64_ / nbc_, nb_ = e64_ - cls_ * nbc_; \
        _Pragma("unroll") for (int i = 0; i < 4; ++i) { const int e = tid + 512 * i, row = e >> 4, pc = e & 15; \
            const size_t off = ((size_t)b_ * SEQ + (size_t)(nb_ * 128 + row) * r_ + cls_) * 2304 + head_ * 128 + pc * 8; \
            kcur[i] = *(const u32x4*)(ak + off); vcur[i] = *(const u32x4*)(av + off); } } while (0)
    if (it_lo < it_hi) ATT_LOAD_CUR(it_lo);
    for (int item = it_lo, cnt = 0; item < it_hi; ++item, ++cnt) {
        const int bh = item >> 6, e64 = item & 63, head = bh % 18, b = bh / 18;
        const int g = head / 6, rsh = 2 * g, r = 1 << rsh, nbc = 64 >> rsh, cls = e64 / nbc, nb = e64 - cls * nbc;
        const int pq0 = nb * 128, pk0 = pq0 - 128;
        const size_t tokb = (size_t)b * SEQ;
        const int scur = cnt & 1, sprev = scur ^ 1;
        const bool reuse = (nb > 0) && (prev_key == item - 1);
#pragma unroll
        for (int i = 0; i < 4; ++i) { const int e = tid + 512 * i, row = e >> 4, pc = e & 15;
            *(LAS u32x4*)(Ks + (scur * 128 + row) * 272 + pc * 16) = kcur[i]; *(LAS u32x4*)(Vs + (scur * 128 + row) * 288 + pc * 16) = vcur[i]; }
        if (!reuse) {
#pragma unroll
            for (int i = 0; i < 4; ++i) { const int e = tid + 512 * i, row = e >> 4, pc = e & 15;
                u32x4 kv = {0u, 0u, 0u, 0u}, vv = kv;
                if (nb > 0) { const size_t off = (tokb + (size_t)(pk0 + row) * r + cls) * 2304 + head * 128 + pc * 8; kv = *(const u32x4*)(ak + off); vv = *(const u32x4*)(av + off); }
                *(LAS u32x4*)(Ks + (sprev * 128 + row) * 272 + pc * 16) = kv; *(LAS u32x4*)(Vs + (sprev * 128 + row) * 288 + pc * 16) = vv; }
        }
        if (item + 1 < it_hi) ATT_LOAD_CUR(item + 1);
        prev_key = item;
        const int qq = 16 * w + fr;
        const size_t tokq = tokb + (size_t)(pq0 + qq) * r + cls;
        bf16x8 qf[4];
        { const bf16_t* qp = aq + tokq * 2304 + head * 128 + 8 * fq;
#pragma unroll
          for (int ks = 0; ks < 4; ++ks) qf[ks] = *(const bf16x8*)(qp + 32 * ks); }
        __syncthreads();
        f32x4 sa[10];
#pragma unroll
        for (int kt = 0; kt < 10; ++kt) { sa[kt] = (f32x4){0.f, 0.f, 0.f, 0.f};
            const int T = (w + kt < 16) ? w + kt : 15;
            const int krow = ((T < 8) ? sprev : scur) * 128 + 16 * (T & 7) + fr;
#pragma unroll
            for (int ks = 0; ks < 4; ++ks) { const bf16x8 kf = *(const LAS bf16x8*)(Ks + krow * 272 + (32 * ks + 8 * fq) * 2); sa[kt] = mfma16(kf, qf[ks], sa[kt]); } }
        const float sc2 = 0.08838834764831845f * 1.4426950408889634f;
        float mrow = -INFINITY;
#pragma unroll
        for (int kt = 0; kt < 10; ++kt)
#pragma unroll
            for (int j = 0; j < 4; ++j) { const int kk = 16 * (w + kt) + 4 * fq + j; const bool valid = (kk >= qq) && (kk <= qq + 128) && (pk0 + kk >= 0);
                const float sv = valid ? sa[kt][j] * sc2 : -INFINITY; sa[kt][j] = sv; mrow = fmaxf(mrow, sv); }
        mrow = fmaxf(mrow, __shfl_xor(mrow, 16)); mrow = fmaxf(mrow, __shfl_xor(mrow, 32));
        float lsum = 0.f;
        bf16x8 pf[5];
#pragma unroll
        for (int t = 0; t < 5; ++t) { f32x4 p0, p1;
#pragma unroll
            for (int j = 0; j < 4; ++j) { p0[j] = __builtin_amdgcn_exp2f(sa[2 * t][j] - mrow); p1[j] = __builtin_amdgcn_exp2f(sa[2 * t + 1][j] - mrow); lsum += p0[j] + p1[j]; }
            const u32x4 pk4 = pack8(p0, p1); pf[t] = __builtin_bit_cast(bf16x8, pk4); }
        lsum += __shfl_xor(lsum, 16); lsum += __shfl_xor(lsum, 32);
        __builtin_amdgcn_sched_barrier(0);
        f32x4 oa[8];
#pragma unroll
        for (int dt = 0; dt < 8; ++dt) oa[dt] = (f32x4){0.f, 0.f, 0.f, 0.f};
#pragma unroll
        for (int t = 0; t < 5; ++t) {
            const int T0 = w + 2 * t, T1 = (T0 + 1 < 16) ? T0 + 1 : T0;
            const int r0 = ((T0 < 8) ? sprev : scur) * 128 + 16 * (T0 & 7) + 4 * fq + (fr >> 2), r1 = ((T1 < 8) ? sprev : scur) * 128 + 16 * (T1 & 7) + 4 * fq + (fr >> 2);
            LAS unsigned char* a0 = Vs + r0 * 288 + (4 * (fr & 3)) * 2; LAS unsigned char* a1 = Vs + r1 * 288 + (4 * (fr & 3)) * 2;
#pragma unroll
            for (int dt = 0; dt < 8; ++dt) { const bf16x8 vf = tr_read2(a0 + 32 * dt, a1 + 32 * dt); oa[dt] = mfma16(vf, pf[t], oa[dt]); }
        }
        const float inv = __builtin_amdgcn_rcpf(lsum);
        bf16_t* po = aq + tokq * 2304 + head * 128 + 4 * fq;
#pragma unroll
        for (int dt = 0; dt < 8; ++dt) { u32x2 o; o.x = cvt_pk_bf16(oa[dt][0] * inv, oa[dt][1] * inv); o.y = cvt_pk_bf16(oa[dt][2] * inv, oa[dt][3] * inv); *(u32x2*)(po + 16 * dt) = o; }
        if (fq == 0) lse[tokq * 18 + head] = mrow * 0.6931471805599453f + __logf(lsum);
        __syncthreads();
    }
#undef ATT_LOAD_CUR
}

constexpr size_t WS_BAR = 700000;
DI void grid_barrier(unsigned* bar, unsigned& nbar, const bool hier, const unsigned xcd, const unsigned per_xcd) {
    asm volatile("s_waitcnt vmcnt(0)" ::: "memory");
    __syncthreads();
    if (threadIdx.x == 0) {
        __builtin_amdgcn_fence(__ATOMIC_RELEASE, "agent");
        asm volatile("s_waitcnt vmcnt(0)" ::: "memory");
        const unsigned gen = nbar + 1u;
        if (hier) {
            unsigned* xc = bar + 256 + 64 * xcd; unsigned* top = bar + 1024;
            const unsigned old = __hip_atomic_fetch_add(xc, 1u, __ATOMIC_RELAXED, __HIP_MEMORY_SCOPE_AGENT);
            if (old + 1u == gen * per_xcd) __hip_atomic_fetch_add(top, 1u, __ATOMIC_RELAXED, __HIP_MEMORY_SCOPE_AGENT);
            while (__hip_atomic_load(top, __ATOMIC_RELAXED, __HIP_MEMORY_SCOPE_AGENT) < gen * 8u) __builtin_amdgcn_s_sleep(1);
        } else {
            const unsigned target = gen * gridDim.x;
            __hip_atomic_fetch_add(bar, 1u, __ATOMIC_RELAXED, __HIP_MEMORY_SCOPE_AGENT);
            while (__hip_atomic_load(bar, __ATOMIC_RELAXED, __HIP_MEMORY_SCOPE_AGENT) < target) __builtin_amdgcn_s_sleep(1);
        }
        __builtin_amdgcn_fence(__ATOMIC_ACQUIRE, "agent");
        asm volatile("s_waitcnt vmcnt(0)" ::: "memory");
    }
    __syncthreads();
    ++nbar;
}

constexpr int N_PHASES = 13;
__global__ void __launch_bounds__(512, 2) mega(Params p) {
    extern __shared__ __attribute__((aligned(16))) unsigned char shm[];
    LAS unsigned char* lds = (LAS unsigned char*)shm;
    unsigned char* ws = p.ws;
    const int G = gridDim.x, c = blockIdx.x;
    unsigned* bar = (unsigned*)(ws + WS_BAR); unsigned nbar = 0;
    int c_eff = c; unsigned my_xcd = 0, my_idx = 0; bool hier = false;
    if (p.ph_hi - p.ph_lo > 1) {
        my_xcd = (unsigned)__builtin_amdgcn_s_getreg((3 << 11) | 20) & 0xFu;
        if (threadIdx.x == 0) my_idx = __hip_atomic_fetch_add(bar + 64 + 16 * (my_xcd & 7u), 1u, __ATOMIC_RELAXED, __HIP_MEMORY_SCOPE_AGENT);
        my_idx = (unsigned)__builtin_amdgcn_readfirstlane((int)my_idx);
    }
    if (p.ph_lo <= 0 && 0 < p.ph_hi) {
        if (0 > p.ph_lo) grid_barrier(bar, nbar, hier, my_xcd, (unsigned)G / 8u);

#if (PHMASK >> 0) & 1
            phase0(p, lds);
#endif
    }
    if (p.ph_lo <= 1 && 1 < p.ph_hi) {
        if (1 > p.ph_lo) {
            if (threadIdx.x == 0) { while (__hip_atomic_load(bar + 1536, __ATOMIC_RELAXED, __HIP_MEMORY_SCOPE_AGENT) < (unsigned)G) __builtin_amdgcn_s_sleep(1);
                __builtin_amdgcn_fence(__ATOMIC_ACQUIRE, "agent"); asm volatile("s_waitcnt vmcnt(0)" ::: "memory"); }
            __syncthreads();
        }
        if (p.ph_hi - p.ph_lo > 1) {
            LAS unsigned* cw = (LAS unsigned*)lds;
            if (threadIdx.x == 0) {
                bool ok = (G % 8) == 0 && my_xcd < 8u;
                for (int x = 0; x < 8; ++x) ok = ok && (__hip_atomic_load(bar + 64 + 16 * x, __ATOMIC_RELAXED, __HIP_MEMORY_SCOPE_AGENT) == (unsigned)(G / 8));
                cw[0] = ok ? (my_idx * 8u + my_xcd) : (unsigned)c; cw[1] = ok ? 1u : 0u;
            }
            __syncthreads();
            c_eff = __builtin_amdgcn_readfirstlane((int)cw[0]);
            hier = (cw[1] != 0u);
            __syncthreads();
        }

#if (PHMASK >> 1) & 1
            phase_h(p);
#endif
    }
    if (p.ph_lo <= 2 && 2 < p.ph_hi) {
        if (2 > p.ph_lo) cg::this_grid().sync();

#if (PHMASK >> 2) & 1
            pg8::Gemm g{(const bf16_t*)(ws + WS_H), (const bf16_t*)(ws + WS_WIN), T_TOK, 59 * 256, 2048, nullptr, nullptr, 0}; pg8::StaticOrder S; S.init(T_TOK, 59 * 256, G, c_eff, 32, 16);
            EpiInProj E{(bf16_t*)(ws + WS_RQ), (bf16_t*)(ws + WS_RK), (bf16_t*)p.out, (bf16_t*)(ws + WS_AQ), (bf16_t*)(ws + WS_AK), (bf16_t*)(ws + WS_AV), p.pos};
            pg8::gemm_phase<1>(lds, g, S, E);
            { const int nwg2 = 128 * 59, rem = nwg2 % G;
              if (rem == 0) convert_ffn_weights(p, lds, c_eff, G); else if (c_eff >= rem) convert_ffn_weights(p, lds, c_eff - rem, G - rem); }
#endif
    }
    if (p.ph_lo <= 3 && 3 < p.ph_hi) {
        if (3 > p.ph_lo) grid_barrier(bar, nbar, hier, my_xcd, (unsigned)G / 8u);

#if (PHMASK >> 3) & 1
            phase_retention(p, lds, c_eff); __syncthreads();
#endif
#if (PHMASK >> 13) & 1
            phase_attention(p, lds);
#endif
    }
    if (p.ph_lo <= 4 && 4 < p.ph_hi) {
        if (4 > p.ph_lo) grid_barrier(bar, nbar, hier, my_xcd, (unsigned)G / 8u);

#if (PHMASK >> 4) & 1
            { pg8::Gemm g{(const bf16_t*)(ws + WS_H), (const bf16_t*)(ws + WS_WIN) + (size_t)8192 * 2048, T_TOK, 4096, 2048, nullptr, nullptr, 0}; pg8::StaticOrder S; S.init(T_TOK, 4096, G, c_eff);
              EpiRetGate E{(bf16_t*)p.out, (const float*)(ws + WS_RETSS), p.ret_gain}; pg8::gemm_phase<1>(lds, g, S, E); }
#endif
#if (PHMASK >> 14) & 1
            { pg8::Gemm g{(const bf16_t*)(ws + WS_H), (const bf16_t*)(ws + WS_WGATE), T_TOK, 4096, 2048, nullptr, nullptr, 0}; pg8::StaticOrder S; S.init(T_TOK, 4096, G, c_eff);
              EpiGates E{(bf16_t*)(ws + WS_GATES), p.b_gate}; pg8::gemm_phase<1>(lds, g, S, E); }
#endif
#if (PHMASK >> 15) & 1
            phase_alpha(p);
#endif
    }
    if (p.ph_lo <= 5 && 5 < p.ph_hi) {
        if (5 > p.ph_lo) grid_barrier(bar, nbar, hier, my_xcd, (unsigned)G / 8u);

#if (PHMASK >> 5) & 1
            pg8::Gemm g{(const bf16_t*)p.out, (const bf16_t*)(ws + WS_WRET), T_TOK, 2048, 4096, (const bf16_t*)(ws + WS_AQ), (const bf16_t*)(ws + WS_WATT), 2304}; pg8::StaticOrder S; S.init(T_TOK, 2048, G, c_eff);
            EpiYMerge E{(const bf16_t*)(ws + WS_GATES), (bf16_t*)(ws + WS_U2)}; pg8::gemm_phase<2>(lds, g, S, E);
#endif
    }
    if (p.ph_lo <= 7 && 7 < p.ph_hi) {
        if (7 > p.ph_lo) grid_barrier(bar, nbar, hier, my_xcd, (unsigned)G / 8u);

#if (PHMASK >> 7) & 1
            pg8::Gemm g{(const bf16_t*)(ws + WS_U2), (const bf16_t*)(ws + WS_WMIX), T_TOK, 2048, 2048, nullptr, nullptr, 0}; pg8::StaticOrder S; S.init(T_TOK, 2048, G, c_eff);
            EpiStoreBf16 E{(bf16_t*)(ws + WS_Y), 2048}; pg8::gemm_phase<1>(lds, g, S, E);
#endif
    }
    if (p.ph_lo <= 8 && 8 < p.ph_hi) {
        if (8 > p.ph_lo) grid_barrier(bar, nbar, hier, my_xcd, (unsigned)G / 8u);

#if (PHMASK >> 8) & 1
            phase_postmix(p);
#endif
    }
    if (p.ph_lo <= 9 && 9 < p.ph_hi) {
        if (9 > p.ph_lo) grid_barrier(bar, nbar, hier, my_xcd, (unsigned)G / 8u);

#if (PHMASK >> 9) & 1
            pg8::Gemm g{(const bf16_t*)(ws + WS_H2), (const bf16_t*)(ws + WS_WUP), T_TOK, FF, 2048, nullptr, nullptr, 0}; pg8::StaticOrder S; S.init(T_TOK, FF, G, c_eff);
            EpiStoreBf16 E{(bf16_t*)(ws + WS_A), FF}; pg8::gemm_phase<1>(lds, g, S, E);
#endif
    }
    if (p.ph_lo <= 10 && 10 < p.ph_hi) {
        if (10 > p.ph_lo) grid_barrier(bar, nbar, hier, my_xcd, (unsigned)G / 8u);

#if (PHMASK >> 10) & 1
            pg8::Gemm g{(const bf16_t*)(ws + WS_H2), (const bf16_t*)(ws + WS_WUP) + (size_t)FF * 2048, T_TOK, FF, 2048, nullptr, nullptr, 0}; pg8::StaticOrder S; S.init(T_TOK, FF, G, c_eff);
            EpiConvAct E{(const bf16_t*)(ws + WS_A), (bf16_t*)(ws + WS_ACT), p.conv_w, p.conv_b}; pg8::gemm_phase<1>(lds, g, S, E);
#endif
    }
    if (p.ph_lo <= 11 && 11 < p.ph_hi) {
        if (11 > p.ph_lo) grid_barrier(bar, nbar, hier, my_xcd, (unsigned)G / 8u);

#if (PHMASK >> 11) & 1
            pg8::Gemm g{(const bf16_t*)(ws + WS_ACT), (const bf16_t*)(ws + WS_WDOWN), T_TOK, 2048, FF, nullptr, nullptr, 0}; pg8::StaticOrder S; S.init(T_TOK, 2048, G, c_eff);
            EpiStoreBf16 E{(bf16_t*)(ws + WS_Y2), 2048}; pg8::gemm_phase<1>(lds, g, S, E);
#endif
    }
    if (p.ph_lo <= 12 && 12 < p.ph_hi) {
        if (12 > p.ph_lo) grid_barrier(bar, nbar, hier, my_xcd, (unsigned)G / 8u);

#if (PHMASK >> 12) & 1
            phase_final(p);
#endif
    }
}

extern "C" void kernel_launch(void* const* d_in, const int* in_sizes, int n_in, void* d_out, int out_size, void* d_ws, size_t ws_size, hipStream_t stream) {
    static int grid = 0;
    if (grid == 0) {
        if (n_in != 20 || ws_size < WS_END) { fprintf(stderr, "kernel_launch: unexpected n_in %d or ws_size %zu (need %zu)\n", n_in, ws_size, (size_t)WS_END); grid = -1; return; }
        int dev = 0, cus = 0, per_cu = 0;
        hipGetDevice(&dev); hipDeviceGetAttribute(&cus, hipDeviceAttributeMultiprocessorCount, dev);
        if (hipFuncSetAttribute((const void*)mega, hipFuncAttributeMaxDynamicSharedMemorySize, LDS_BYTES) != hipSuccess) { fprintf(stderr, "kernel_launch: hipFuncSetAttribute failed\n"); grid = -1; return; }
        if (hipOccupancyMaxActiveBlocksPerMultiprocessor(&per_cu, (const void*)mega, 512, LDS_BYTES) != hipSuccess || per_cu < 1) { fprintf(stderr, "kernel_launch: occupancy query says %d\n", per_cu); per_cu = 1; }
        (void)hipGetLastError();
        grid = cus * 1;
    }
    if (grid < 0) return;
    Params p{};
    p.x = (const float*)d_in[0]; p.c = (const float*)d_in[1]; p.pos = (const int*)d_in[2]; p.w_ada = (const float*)d_in[3]; p.b_ada = (const float*)d_in[4]; p.g_pre_mix = (const float*)d_in[5];
    p.w_in = (const float*)d_in[6]; p.ret_gain = (const float*)d_in[7]; p.w_ret_out = (const float*)d_in[8]; p.w_att_out = (const float*)d_in[9]; p.w_gate = (const float*)d_in[10]; p.b_gate = (const float*)d_in[11];
    p.w_mix = (const float*)d_in[12]; p.g_post_mix = (const float*)d_in[13]; p.g_pre_ffn = (const float*)d_in[14]; p.w_up = (const float*)d_in[15]; p.conv_w = (const float*)d_in[16]; p.conv_b = (const float*)d_in[17];
    p.w_down = (const float*)d_in[18]; p.g_post_ffn = (const float*)d_in[19];
    p.out = (float*)d_out; p.ws = (unsigned char*)d_ws;
    if (hipMemsetAsync((char*)d_ws + WS_BAR, 0, 8192, stream) != hipSuccess) { fprintf(stderr, "kernel_launch: memset failed\n"); return; }
#if N_LAUNCH_PER_PHASE
    for (int ph = 0; ph < N_PHASES; ++ph) { p.ph_lo = ph; p.ph_hi = ph + 1; hipLaunchKernelGGL(mega, dim3(grid), dim3(512), LDS_BYTES, stream, p); }
#else
    p.ph_lo = 0; p.ph_hi = N_PHASES;
    void* args[] = {&p};
    hipError_t e = hipLaunchCooperativeKernel((const void*)mega, dim3(grid), dim3(512), args, LDS_BYTES, stream);
    if (e != hipSuccess) fprintf(stderr, "cooperative launch failed: %s (grid %d)\n", hipGetErrorString(e), grid);
#endif
}
```

```cpp
#include <hip/hip_runtime.h>
#include <hip/hip_cooperative_groups.h>
#include <cstdio>
#include <cstdint>
namespace cg = cooperative_groups;

#define DI __device__ __forceinline__
#define LAS __attribute__((address_space(3)))
typedef unsigned short bf16_t;
typedef short bf16x8 __attribute__((ext_vector_type(8)));
typedef short s16x4 __attribute__((ext_vector_type(4)));
typedef float f32x4 __attribute__((ext_vector_type(4)));
typedef unsigned u32x4 __attribute__((ext_vector_type(4)));
typedef unsigned u32x2 __attribute__((ext_vector_type(2)));

#ifndef PHMASK
#define PHMASK 0xFFFF
#endif
#ifndef N_LAUNCH_PER_PHASE
#define N_LAUNCH_PER_PHASE 0
#endif

constexpr int T_TOK = 32768, DM = 2048, SEQ = 8192, NB = 4;
constexpr int FF = 5632;
constexpr int LDS_BYTES = 143360;
constexpr size_t MiB = 1u << 20;
constexpr size_t WS_ADA = 0;
constexpr size_t WS_LSE = 1 * MiB;
constexpr size_t WS_RETSS = 4 * MiB;
constexpr size_t WS_WUP = 12 * MiB;
constexpr size_t WS_WDOWN = 56 * MiB;
constexpr size_t WS_WIN = 78 * MiB;
constexpr size_t WS_WGATE = 153 * MiB;
constexpr size_t WS_WRET = 169 * MiB;
constexpr size_t WS_WATT = 185 * MiB;
constexpr size_t WS_WMIX = 194 * MiB;
constexpr size_t WS_H = 206 * MiB;
constexpr size_t WS_RQ = 334 * MiB;
constexpr size_t WS_RK = 462 * MiB;
constexpr size_t WS_AQ = 590 * MiB;
constexpr size_t WS_AK = 734 * MiB;
constexpr size_t WS_AV = 878 * MiB;
constexpr size_t WS_GATES = 334 * MiB;
constexpr size_t WS_U = 734 * MiB;
constexpr size_t WS_U2 = 206 * MiB;
constexpr size_t WS_Y = 334 * MiB;
constexpr size_t WS_H2 = 78 * MiB;
constexpr size_t WS_A = 206 * MiB;
constexpr size_t WS_ACT = 558 * MiB;
constexpr size_t WS_Y2 = 78 * MiB;
constexpr size_t WS_END = 1022 * MiB;

struct Params {
    const float *x, *c; const int* pos;
    const float *w_ada, *b_ada, *g_pre_mix, *w_in, *ret_gain, *w_ret_out, *w_att_out, *w_gate, *b_gate, *w_mix, *g_post_mix, *g_pre_ffn, *w_up, *conv_w, *conv_b, *w_down, *g_post_ffn;
    float* out; unsigned char* ws; int ph_lo, ph_hi;
};

typedef __bf16 bf16x2_t __attribute__((ext_vector_type(2)));
DI unsigned cvt_pk_bf16(float lo, float hi) { bf16x2_t v = {(__bf16)lo, (__bf16)hi}; return __builtin_bit_cast(unsigned, v); }
DI float bflo(unsigned w) { return __uint_as_float(w << 16); }
DI float bfhi(unsigned w) { return __uint_as_float(w & 0xffff0000u); }
DI float wave_sum(float v) {
#pragma unroll
    for (int o = 1; o < 64; o <<= 1) v += __shfl_xor(v, o);
    return v;
}
DI float sigmoidf_(float v) { return __builtin_amdgcn_rcpf(1.0f + __builtin_amdgcn_exp2f(-1.4426950408889634f * v)); }
DI f32x4 mfma16(bf16x8 a, bf16x8 b, f32x4 c) { return __builtin_amdgcn_mfma_f32_16x16x32_bf16(a, b, c, 0, 0, 0); }
DI s16x4 tr_read(LAS unsigned char* p) { return __builtin_amdgcn_ds_read_tr16_b64_v4i16((LAS s16x4*)p); }
DI bf16x8 tr_read2(LAS unsigned char* p0, LAS unsigned char* p1) { s16x4 lo = tr_read(p0), hi = tr_read(p1); return __builtin_shufflevector(lo, hi, 0, 1, 2, 3, 4, 5, 6, 7); }

namespace pg8 {
constexpr int BM = 256, BK = 64, HALF = 128, HTB = HALF * BK * 2, STAGE_BYTES = 8 * HTB, NXCD = 8, WGM = 4;
DI int lds_byte(int r, int c) { const int st = (r >> 4) * 2 + (c >> 5), rr = r & 15, cc = c & 31, ob = rr * 64 + cc * 2; return st * 1024 + (ob ^ (((ob >> 9) & 1) << 5)); }
DI void stage_rc(int b, int& R, int& C) { const int st = b / 1024, sb = b % 1024, swz = sb ^ (((sb >> 9) & 1) << 5); R = (st >> 1) * 16 + swz / 64; C = (st & 1) * 32 + (swz % 64) / 2; }
struct Unit { int pm, pn; };
struct Gemm { const bf16_t* A; const bf16_t* Bt; int M, N, K; const bf16_t* A1; const bf16_t* Bt1; int K1; };
struct StaticOrder {
    int nM, nN, nwg, G, c, skip_lo, skip_n;
    DI void init(int M, int N, int G_, int c_, int slo = 1 << 30, int sn = 0) { nM = M / BM; nN = N / BM; nwg = nM * nN; G = G_; c = c_; skip_lo = slo; skip_n = sn; }
    DI bool next(int i, Unit& u) const {
        const long L = (long)i * G + c; if (L >= nwg) return false;
        int wgid = (int)L; { const int q = nwg / NXCD, r = nwg % NXCD, xcd = wgid % NXCD, off = wgid / NXCD; wgid = (xcd < r ? xcd * (q + 1) : r * (q + 1) + (xcd - r) * q) + off; }
        const int nig = WGM * nN, gid = wgid / nig, fm = gid * WGM, gsz = (nM - fm) < WGM ? (nM - fm) : WGM;
        u.pm = fm + ((wgid % nig) % gsz); u.pn = (wgid % nig) / gsz; if (u.pn >= skip_lo) u.pn += skip_n; return true;
    }
};

#ifndef PG8_ALIGN
#define PG8_ALIGN true
#endif
#ifndef PG8_SP2
#define PG8_SP2 true
#endif
template <int NSEG, class Epi, bool ALIGN_EPI = PG8_ALIGN, bool SP2 = PG8_SP2>
DI void gemm_phase(LAS unsigned char* lds, const Gemm g, const StaticOrder& S, const Epi& E) {
    const int tid = threadIdx.x, wid = __builtin_amdgcn_readfirstlane(tid >> 6), lane = tid & 63, wr = wid >> 2, wc = wid & 3, fr = lane & 15, fq = lane >> 4;
    int Rr[2], Cc[2];
#pragma unroll
    for (int i = 0; i < 2; ++i) stage_rc(tid * 16 + i * 8192, Rr[i], Cc[i]);
    const size_t kstep = (size_t)(BK * 2);
    const unsigned ldsw = (unsigned)wid * 1024u;
    const int aoff = lds_byte(wr * 64 + fr, fq * 8), boff = lds_byte(wc * 32 + fr, fq * 8);
#define PG8_SA(b, h) (((b) * 2 + (h)) * HTB)
#define PG8_SB(b, h) ((4 + (b) * 2 + (h)) * HTB)
#define PG8_STAGE(bufoff, gbase, VO) do { _Pragma("unroll") for (int _i = 0; _i < 2; ++_i) \
        __builtin_amdgcn_global_load_lds((const unsigned*)((const char*)(gbase) + VO[_i]), (LAS unsigned*)(lds + (bufoff) + ldsw + _i * 8192), 16, 0, 0); } while (0)
#define PG8_LDA(dst, b, h) do { _Pragma("unroll") for (int m = 0; m < 4; ++m) _Pragma("unroll") for (int k = 0; k < 2; ++k) dst[m][k] = *(const LAS bf16x8*)(lds + PG8_SA(b, h) + aoff + m * 2048 + k * 1024); } while (0)
#define PG8_LDB(dst, b, h) do { _Pragma("unroll") for (int n = 0; n < 2; ++n) _Pragma("unroll") for (int k = 0; k < 2; ++k) dst[n][k] = *(const LAS bf16x8*)(lds + PG8_SB(b, h) + boff + n * 2048 + k * 1024); } while (0)
#define PG8_MMA(ai, bj, At, Bt) do { __builtin_amdgcn_s_setprio(1); _Pragma("unroll") for (int m = 0; m < 4; ++m) _Pragma("unroll") for (int n = 0; n < 2; ++n) _Pragma("unroll") for (int k = 0; k < 2; ++k) \
        acc[ai][bj][m][n] = __builtin_amdgcn_mfma_f32_16x16x32_bf16(Bt[n][k], At[m][k], acc[ai][bj][m][n], 0, 0, 0); __builtin_amdgcn_s_setprio(0); } while (0)
#define PG8_WAIT_V(n) asm volatile("s_waitcnt vmcnt(" #n ")" ::: "memory")
#define PG8_WAIT_L(n) asm volatile("s_waitcnt lgkmcnt(" #n ")" ::: "memory")
#define PG8_BAR __builtin_amdgcn_s_barrier()
#define PG8_SCHED __builtin_amdgcn_sched_barrier(0)
    Unit cur, nxt; int ti = 0, seg = 0;
    if (!S.next(0, cur)) return;
    f32x4 acc[2][2][4][2];
#pragma unroll
    for (int a = 0; a < 2; ++a)
#pragma unroll
        for (int b = 0; b < 2; ++b)
#pragma unroll
            for (int m = 0; m < 4; ++m)
#pragma unroll
                for (int n = 0; n < 2; ++n) acc[a][b][m][n] = (f32x4){0.f, 0.f, 0.f, 0.f};
    bf16x8 At[4][2], B0[2][2], B1[2][2];
    int Kc = g.K;
    unsigned voffC[2];
#pragma unroll
    for (int i = 0; i < 2; ++i) voffC[i] = (unsigned)(Rr[i] * Kc + Cc[i]) * 2u;
    size_t hstepC = (size_t)HALF * Kc * 2;
    const char* cA = (const char*)g.A + (size_t)cur.pm * 2 * hstepC; const char* cB = (const char*)g.Bt + (size_t)cur.pn * 2 * hstepC;
    if constexpr (SP2) {
        PG8_STAGE(PG8_SB(0, 0), cB, voffC); PG8_STAGE(PG8_SB(0, 1), cB + hstepC, voffC); PG8_STAGE(PG8_SA(0, 0), cA, voffC); PG8_STAGE(PG8_SA(0, 1), cA + hstepC, voffC);
        if (wr == 1) PG8_BAR;
        PG8_WAIT_V(2); PG8_BAR;
        PG8_STAGE(PG8_SB(1, 0), cB + kstep, voffC); PG8_STAGE(PG8_SA(1, 0), cA + kstep, voffC); PG8_STAGE(PG8_SB(1, 1), cB + hstepC + kstep, voffC);
        PG8_WAIT_V(6); PG8_BAR;
    } else {
        PG8_STAGE(PG8_SB(0, 0), cB, voffC); PG8_STAGE(PG8_SA(0, 0), cA, voffC); PG8_STAGE(PG8_SB(0, 1), cB + hstepC, voffC); PG8_STAGE(PG8_SA(0, 1), cA + hstepC, voffC);
        if (wr == 1) PG8_BAR;
        PG8_WAIT_V(4); PG8_BAR;
        PG8_STAGE(PG8_SB(1, 0), cB + kstep, voffC); PG8_STAGE(PG8_SA(1, 0), cA + kstep, voffC); PG8_STAGE(PG8_SB(1, 1), cB + hstepC + kstep, voffC);
        PG8_WAIT_V(6); PG8_BAR;
    }
    for (;;) {
        bool has_next; int nseg = 0;
        if (NSEG > 1 && seg + 1 < NSEG) { has_next = true; nxt = cur; nseg = seg + 1; }
        else has_next = S.next(ti + 1, nxt);
        int Kn = Kc; const char* nA = cA; const char* nB = cB;
        if (has_next) { Kn = (NSEG > 1 && nseg == 1) ? g.K1 : g.K;
            nA = (const char*)((NSEG > 1 && nseg == 1) ? g.A1 : g.A) + (size_t)nxt.pm * 256 * Kn * 2; nB = (const char*)((NSEG > 1 && nseg == 1) ? g.Bt1 : g.Bt) + (size_t)nxt.pn * 256 * Kn * 2; }
        unsigned voffN[2];
#pragma unroll
        for (int i = 0; i < 2; ++i) voffN[i] = (NSEG > 1) ? (unsigned)(Rr[i] * Kn + Cc[i]) * 2u : voffC[i];
        const size_t hstepN = (NSEG > 1) ? (size_t)HALF * Kn * 2 : hstepC;
        const int nt = Kc / BK;
        for (int t = 0; t < nt; t += 2) {
            const bool last = (t == nt - 2);
            const char* a1 = cA + (size_t)(t + 1) * kstep;
            const char* a2 = last ? nA : cA + (size_t)(t + 2) * kstep; const char* b2 = last ? nB : cB + (size_t)(t + 2) * kstep;
            const char* a3 = a2 + kstep; const char* b3 = b2 + kstep;
            unsigned v2[2]; v2[0] = (NSEG > 1 && last) ? voffN[0] : voffC[0]; v2[1] = (NSEG > 1 && last) ? voffN[1] : voffC[1];
            const size_t h2 = (NSEG > 1 && last) ? hstepN : hstepC;
            if constexpr (SP2) {
            PG8_LDB(B0, 0, 0); PG8_LDB(B1, 0, 1); PG8_SCHED; PG8_LDA(At, 0, 0); PG8_STAGE(PG8_SA(1, 1), a1 + hstepC, voffC);
            PG8_WAIT_V(8); PG8_WAIT_L(0); PG8_BAR; PG8_MMA(0, 0, At, B0); PG8_MMA(0, 1, At, B1); PG8_BAR; PG8_SCHED;
            PG8_LDA(At, 0, 1); PG8_STAGE(PG8_SB(0, 0), b2, v2); PG8_STAGE(PG8_SB(0, 1), b2 + h2, v2); PG8_STAGE(PG8_SA(0, 0), a2, v2);
            PG8_WAIT_V(8); PG8_WAIT_L(0); PG8_BAR; PG8_MMA(1, 0, At, B0); PG8_MMA(1, 1, At, B1); PG8_BAR; PG8_SCHED;
            PG8_LDB(B0, 1, 0); PG8_LDB(B1, 1, 1); PG8_SCHED; PG8_LDA(At, 1, 0); PG8_STAGE(PG8_SA(0, 1), a2 + h2, v2);
            PG8_WAIT_V(8); PG8_WAIT_L(0); PG8_BAR; PG8_MMA(0, 0, At, B0); PG8_MMA(0, 1, At, B1); PG8_BAR; PG8_SCHED;
            PG8_LDA(At, 1, 1); PG8_STAGE(PG8_SB(1, 0), b3, v2); PG8_STAGE(PG8_SB(1, 1), b3 + h2, v2); PG8_STAGE(PG8_SA(1, 0), a3, v2);
            PG8_WAIT_V(8); PG8_WAIT_L(0); PG8_BAR; PG8_MMA(1, 0, At, B0); PG8_MMA(1, 1, At, B1); PG8_BAR; PG8_SCHED;
            } else {
            PG8_LDB(B0, 0, 0); PG8_SCHED; PG8_LDA(At, 0, 0); PG8_STAGE(PG8_SA(1, 1), a1 + hstepC, voffC);
            PG8_WAIT_L(8); PG8_BAR; PG8_WAIT_L(0); PG8_MMA(0, 0, At, B0); PG8_BAR; PG8_SCHED;
            PG8_LDB(B1, 0, 1); PG8_STAGE(PG8_SB(0, 0), b2, v2);
            PG8_BAR; PG8_WAIT_L(0); PG8_MMA(0, 1, At, B1); PG8_BAR;
            PG8_LDA(At, 0, 1); PG8_STAGE(PG8_SA(0, 0), a2, v2);
            PG8_BAR; PG8_WAIT_L(0); PG8_MMA(1, 0, At, B0); PG8_BAR; PG8_SCHED;
            PG8_STAGE(PG8_SB(0, 1), b2 + h2, v2);
            PG8_WAIT_V(6); PG8_BAR; PG8_MMA(1, 1, At, B1); PG8_BAR;
            PG8_LDB(B0, 1, 0); PG8_SCHED; PG8_LDA(At, 1, 0); PG8_STAGE(PG8_SA(0, 1), a2 + h2, v2);
            PG8_WAIT_L(8); PG8_BAR; PG8_WAIT_L(0); PG8_MMA(0, 0, At, B0); PG8_BAR; PG8_SCHED;
            PG8_LDB(B1, 1, 1); PG8_STAGE(PG8_SB(1, 0), b3, v2);
            PG8_BAR; PG8_WAIT_L(0); PG8_MMA(0, 1, At, B1); PG8_BAR;
            PG8_LDA(At, 1, 1); PG8_STAGE(PG8_SA(1, 0), a3, v2);
            PG8_BAR; PG8_WAIT_L(0); PG8_MMA(1, 0, At, B0); PG8_BAR; PG8_SCHED;
            PG8_STAGE(PG8_SB(1, 1), b3 + h2, v2);
            PG8_WAIT_V(6); PG8_BAR; PG8_MMA(1, 1, At, B1); PG8_BAR;
            }
        }
        if constexpr (ALIGN_EPI) { if (wr == 0) PG8_BAR; }
        if constexpr (NSEG > 1) { if (seg + 1 < NSEG) E.mid(acc, cur, wr, wc, fr, fq); else E(acc, cur, wr, wc, fr, fq); }
        else E(acc, cur, wr, wc, fr, fq);
        if (!has_next) break;
        if (NSEG == 1 || nseg == 0) {
#pragma unroll
            for (int a = 0; a < 2; ++a)
#pragma unroll
                for (int b = 0; b < 2; ++b)
#pragma unroll
                    for (int m = 0; m < 4; ++m)
#pragma unroll
                        for (int n = 0; n < 2; ++n) acc[a][b][m][n] = (f32x4){0.f, 0.f, 0.f, 0.f};
            ++ti;
        }
        cur = nxt; cA = nA; cB = nB; seg = nseg;
        if (NSEG > 1) { Kc = Kn; voffC[0] = voffN[0]; voffC[1] = voffN[1]; hstepC = hstepN; }
        if constexpr (ALIGN_EPI) { if (wr == 1) PG8_BAR; }
    }
    PG8_WAIT_V(0);
    if constexpr (!ALIGN_EPI) { if (wr == 0) PG8_BAR; }
    PG8_BAR;
#undef PG8_SA
#undef PG8_SB
#undef PG8_STAGE
#undef PG8_LDA
#undef PG8_LDB
#undef PG8_MMA
#undef PG8_WAIT_V
#undef PG8_WAIT_L
#undef PG8_BAR
#undef PG8_SCHED
}
}
using pg8::Unit;
typedef f32x4 AccT[2][2][4][2];

DI u32x4 pack8(const f32x4& v0, const f32x4& v1) { u32x4 w; w.x = cvt_pk_bf16(v0[0], v0[1]); w.y = cvt_pk_bf16(v0[2], v0[3]); w.z = cvt_pk_bf16(v1[0], v1[1]); w.w = cvt_pk_bf16(v1[2], v1[3]); return w; }

struct EpiStoreBf16 {
    bf16_t* O; int ld;
    DI void operator()(const AccT& acc, const Unit& u, int wr, int wc, int fr, int fq) const {
        const int row0 = u.pm * 256 + wr * 64 + fr, col0 = u.pn * 256 + wc * 32 + 8 * fq;
#pragma unroll
        for (int ai = 0; ai < 2; ++ai)
#pragma unroll
            for (int m = 0; m < 4; ++m) { bf16_t* rowp = O + (size_t)(row0 + ai * 128 + m * 16) * ld + col0;
#pragma unroll
                for (int bj = 0; bj < 2; ++bj) *(u32x4*)(rowp + bj * 128) = pack8(acc[ai][bj][m][0], acc[ai][bj][m][1]); }
    }
};

template <int HD>
DI void rope_store(const AccT& acc, int rowbase, const int* pos, bf16_t* dst, int ld, int c1, int half, int ibase, float scale) {
    int pi[2][4];
#pragma unroll
    for (int ai = 0; ai < 2; ++ai)
#pragma unroll
        for (int m = 0; m < 4; ++m) pi[ai][m] = pos[rowbase + ai * 128 + m * 16];
    float invf[2][4];
#pragma unroll
    for (int n = 0; n < 2; ++n)
#pragma unroll
        for (int j = 0; j < 4; ++j) invf[n][j] = exp2f(-(float)(ibase + 4 * n + j) * (2.0f / HD) * 13.287712379549449f);
#pragma unroll
    for (int ai = 0; ai < 2; ++ai)
#pragma unroll
        for (int m = 0; m < 4; ++m) {
            const int row = rowbase + ai * 128 + m * 16; const float ps = (float)pi[ai][m];
            f32x4 o1[2], o2[2];
#pragma unroll
            for (int n = 0; n < 2; ++n)
#pragma unroll
                for (int j = 0; j < 4; ++j) {
                    const float ang = ps * invf[n][j]; const float rev = __builtin_amdgcn_fractf(ang * 0.15915494309189535f);
                    const float sn = __builtin_amdgcn_sinf(rev), cs = __builtin_amdgcn_cosf(rev);
                    const float t1 = acc[ai][0][m][n][j], t2 = acc[ai][1][m][n][j];
                    o1[n][j] = (t1 * cs - t2 * sn) * scale; o2[n][j] = (t2 * cs + t1 * sn) * scale;
                }
            bf16_t* rowp = dst + (size_t)row * ld + c1;
            *(u32x4*)rowp = pack8(o1[0], o1[1]); *(u32x4*)(rowp + half) = pack8(o2[0], o2[1]);
        }
}

struct EpiInProj {
    bf16_t *rq, *rk, *rv, *aq, *ak, *av; const int* pos;
    DI void operator()(const AccT& acc, const Unit& u, int wr, int wc, int fr, int fq) const {
        const int pn = u.pn, rowbase = u.pm * 256 + wr * 64 + fr;
        if (pn < 16) {
            bf16_t* dst = pn < 8 ? rq : rk; const float scale = pn < 8 ? 1.0f : 0.0625f;
            rope_store<256>(acc, rowbase, pos, dst, 2048, 256 * (pn & 7) + 32 * wc + 8 * fq, 128, 32 * wc + 8 * fq, scale);
        } else if (pn < 32) {
            const int col0 = (pn - 16) * 256 + wc * 32 + 8 * fq;
#pragma unroll
            for (int ai = 0; ai < 2; ++ai)
#pragma unroll
                for (int m = 0; m < 4; ++m) { bf16_t* rowp = rv + (size_t)(rowbase + ai * 128 + m * 16) * 4096 + col0;
#pragma unroll
                    for (int bj = 0; bj < 2; ++bj) *(u32x4*)(rowp + bj * 128) = pack8(acc[ai][bj][m][0], acc[ai][bj][m][1]); }
        } else if (pn < 66) {
            const int q9 = pn - 48; bf16_t* dst = q9 < 9 ? aq : ak; const int t9 = q9 < 9 ? q9 : q9 - 9;
            const int head = 2 * t9 + (wc >> 1), ib = 32 * (wc & 1) + 8 * fq;
            rope_store<128>(acc, rowbase, pos, dst, 2304, head * 128 + ib, 64, ib, 1.0f);
        } else {
            const int col0 = (pn - 66) * 256 + wc * 32 + 8 * fq;
#pragma unroll
            for (int ai = 0; ai < 2; ++ai)
#pragma unroll
                for (int m = 0; m < 4; ++m) { bf16_t* rowp = av + (size_t)(rowbase + ai * 128 + m * 16) * 2304 + col0;
#pragma unroll
                    for (int bj = 0; bj < 2; ++bj) *(u32x4*)(rowp + bj * 128) = pack8(acc[ai][bj][m][0], acc[ai][bj][m][1]); }
        }
    }
};

struct EpiRetGate {
    bf16_t* ret; const float* retss; const float* gain;
    DI void operator()(const AccT& acc, const Unit& u, int wr, int wc, int fr, int fq) const {
        const int rowbase = u.pm * 256 + wr * 64 + fr, head = u.pn >> 1, colb = u.pn * 256 + wc * 32 + 8 * fq;
        f32x4 gn[2][2];
#pragma unroll
        for (int bj = 0; bj < 2; ++bj) { gn[bj][0] = *(const f32x4*)(gain + colb + bj * 128); gn[bj][1] = *(const f32x4*)(gain + colb + bj * 128 + 4); }
#pragma unroll
        for (int ai = 0; ai < 2; ++ai) {
            f32x4 sA[4], sB[4]; u32x4 rr[4][2];
#pragma unroll
            for (int m = 0; m < 4; ++m) { const float* ps = retss + ((size_t)(rowbase + ai * 128 + m * 16) * 8 + head) * 8; sA[m] = *(const f32x4*)ps; sB[m] = *(const f32x4*)(ps + 4); }
#pragma unroll
            for (int m = 0; m < 4; ++m)
#pragma unroll
                for (int bj = 0; bj < 2; ++bj) rr[m][bj] = *(const u32x4*)(ret + (size_t)(rowbase + ai * 128 + m * 16) * 4096 + colb + bj * 128);
#pragma unroll
            for (int m = 0; m < 4; ++m) {
                const f32x4 s0 = sA[m], s1 = sB[m];
                const float rsv = __builtin_amdgcn_rsqf((((s0[0] + s0[1]) + (s0[2] + s0[3])) + ((s1[0] + s1[1]) + (s1[2] + s1[3]))) * (1.0f / 512.0f) + 1e-6f);
#pragma unroll
                for (int bj = 0; bj < 2; ++bj) {
                    const u32x4 r4 = rr[m][bj];
                    const float rf[8] = {bflo(r4.x), bfhi(r4.x), bflo(r4.y), bfhi(r4.y), bflo(r4.z), bfhi(r4.z), bflo(r4.w), bfhi(r4.w)};
                    f32x4 o0, o1;
#pragma unroll
                    for (int j = 0; j < 4; ++j) {
                        const float a0 = acc[ai][bj][m][0][j], a1 = acc[ai][bj][m][1][j];
                        o0[j] = a0 * sigmoidf_(a0) * (rf[j] * rsv * gn[bj][0][j]); o1[j] = a1 * sigmoidf_(a1) * (rf[4 + j] * rsv * gn[bj][1][j]);
                    }
                    *(u32x4*)(ret + (size_t)(rowbase + ai * 128 + m * 16) * 4096 + colb + bj * 128) = pack8(o0, o1);
                }
            }
        }
    }
};

struct EpiGates {
    bf16_t* O; const float* bias;
    DI void operator()(const AccT& acc, const Unit& u, int wr, int wc, int fr, int fq) const {
        const int rowbase = u.pm * 256 + wr * 64 + fr;
#pragma unroll
        for (int bj = 0; bj < 2; ++bj) {
            const int col = u.pn * 256 + bj * 128 + wc * 32 + 8 * fq;
            const f32x4 b0 = *(const f32x4*)(bias + col), b1 = *(const f32x4*)(bias + col + 4);
#pragma unroll
            for (int ai = 0; ai < 2; ++ai)
#pragma unroll
                for (int m = 0; m < 4; ++m) {
                    f32x4 o0, o1;
#pragma unroll
                    for (int j = 0; j < 4; ++j) { o0[j] = sigmoidf_(acc[ai][bj][m][0][j] + b0[j]); o1[j] = sigmoidf_(acc[ai][bj][m][1][j] + b1[j]); }
                    *(u32x4*)(O + (size_t)(rowbase + ai * 128 + m * 16) * 4096 + col) = pack8(o0, o1);
                }
        }
    }
};

struct EpiYMerge {
    const bf16_t* gates; bf16_t* U2;
    DI void mid(AccT& acc, const Unit& u, int wr, int wc, int fr, int fq) const {
        const int rowbase = u.pm * 256 + wr * 64 + fr, colb = u.pn * 256 + wc * 32 + 8 * fq;
#pragma unroll
        for (int ai = 0; ai < 2; ++ai) {
            u32x4 gr[4][2], ga[4][2];
#pragma unroll
            for (int m = 0; m < 4; ++m)
#pragma unroll
                for (int bj = 0; bj < 2; ++bj) { const bf16_t* pg = gates + (size_t)(rowbase + ai * 128 + m * 16) * 4096 + colb + bj * 128; gr[m][bj] = *(const u32x4*)pg; ga[m][bj] = *(const u32x4*)(pg + 2048); }
#pragma unroll
            for (int m = 0; m < 4; ++m)
#pragma unroll
                for (int bj = 0; bj < 2; ++bj) {
                    const u32x4 g1 = gr[m][bj], g2 = ga[m][bj];
                    const float r[8] = {bflo(g1.x), bfhi(g1.x), bflo(g1.y), bfhi(g1.y), bflo(g1.z), bfhi(g1.z), bflo(g1.w), bfhi(g1.w)};
                    const float a[8] = {bflo(g2.x), bfhi(g2.x), bflo(g2.y), bfhi(g2.y), bflo(g2.z), bfhi(g2.z), bflo(g2.w), bfhi(g2.w)};
#pragma unroll
                    for (int j = 0; j < 4; ++j) { acc[ai][bj][m][0][j] *= r[j] * __builtin_amdgcn_rcpf(fmaxf(a[j], 1e-30f)); acc[ai][bj][m][1][j] *= r[4 + j] * __builtin_amdgcn_rcpf(fmaxf(a[4 + j], 1e-30f)); }
                }
        }
    }
    DI void operator()(const AccT& acc, const Unit& u, int wr, int wc, int fr, int fq) const {
        const int rowbase = u.pm * 256 + wr * 64 + fr, colb = u.pn * 256 + wc * 32 + 8 * fq;
        u32x4 gg[2][4][2];
#pragma unroll
        for (int ai = 0; ai < 2; ++ai)
#pragma unroll
            for (int m = 0; m < 4; ++m)
#pragma unroll
                for (int bj = 0; bj < 2; ++bj) gg[ai][m][bj] = *(const u32x4*)(gates + (size_t)(rowbase + ai * 128 + m * 16) * 4096 + 2048 + colb + bj * 128);
#pragma unroll
        for (int ai = 0; ai < 2; ++ai)
#pragma unroll
            for (int m = 0; m < 4; ++m)
#pragma unroll
                for (int bj = 0; bj < 2; ++bj) {
                    const u32x4 g4 = gg[ai][m][bj];
                    f32x4 o0 = acc[ai][bj][m][0], o1 = acc[ai][bj][m][1];
                    o0[0] *= bflo(g4.x); o0[1] *= bfhi(g4.x); o0[2] *= bflo(g4.y); o0[3] *= bfhi(g4.y);
                    o1[0] *= bflo(g4.z); o1[1] *= bfhi(g4.z); o1[2] *= bflo(g4.w); o1[3] *= bfhi(g4.w);
                    *(u32x4*)(U2 + (size_t)(rowbase + ai * 128 + m * 16) * 2048 + colb + bj * 128) = pack8(o0, o1);
                }
    }
};

DI float gelu_tanh(float v) {
    const float uu = 0.7978845608028654f * (v + 0.044715f * v * v * v);
    const float e = __builtin_amdgcn_exp2f(2.8853900817779268f * uu);
    return v - v * __builtin_amdgcn_rcpf(e + 1.0f);
}
struct EpiConvAct {
    const bf16_t* A; bf16_t* ACT; const float* conv_w; const float* conv_b;
    DI void operator()(const AccT& acc, const Unit& u, int wr, int wc, int fr, int fq) const {
        const int rowbase = u.pm * 256 + wr * 64 + fr;
#pragma unroll
        for (int bj = 0; bj < 2; ++bj) {
            const int col = u.pn * 256 + bj * 128 + wc * 32 + 8 * fq;
            f32x4 w0[2], w1[2], w2[2], cb[2];
#pragma unroll
            for (int hh = 0; hh < 2; ++hh) { w0[hh] = *(const f32x4*)(conv_w + col + 4 * hh); w1[hh] = *(const f32x4*)(conv_w + FF + col + 4 * hh); w2[hh] = *(const f32x4*)(conv_w + 2 * FF + col + 4 * hh); cb[hh] = *(const f32x4*)(conv_b + col + 4 * hh); }
#pragma unroll
            for (int aim = 0; aim < 4; ++aim) { const int ai = aim >> 1, mb = (aim & 1) * 2;
                u32x4 a0[4], a1[4], a2[4];
#pragma unroll
                for (int m = mb; m < mb + 2; ++m) {
                    const int row = rowbase + ai * 128 + m * 16; const int sq = row & (SEQ - 1);
                    const bf16_t* pa = A + (size_t)row * FF + col;
                    a0[m] = *(const u32x4*)pa;
                    a1[m] = *(const u32x4*)(pa - (sq >= 1 ? FF : 0));
                    a2[m] = *(const u32x4*)(pa - (sq >= 2 ? 2 * FF : 0));
                }
#pragma unroll
                for (int m = mb; m < mb + 2; ++m) {
                    const int row = rowbase + ai * 128 + m * 16; const int sq = row & (SEQ - 1);
                    const float k1 = sq >= 1 ? 1.0f : 0.0f, k2 = sq >= 2 ? 1.0f : 0.0f;
                    const u32x4 x0 = a0[m], x1 = a1[m], x2 = a2[m];
                    const float f0[8] = {bflo(x0.x), bfhi(x0.x), bflo(x0.y), bfhi(x0.y), bflo(x0.z), bfhi(x0.z), bflo(x0.w), bfhi(x0.w)};
                    const float f1[8] = {bflo(x1.x), bfhi(x1.x), bflo(x1.y), bfhi(x1.y), bflo(x1.z), bfhi(x1.z), bflo(x1.w), bfhi(x1.w)};
                    const float f2[8] = {bflo(x2.x), bfhi(x2.x), bflo(x2.y), bfhi(x2.y), bflo(x2.z), bfhi(x2.z), bflo(x2.w), bfhi(x2.w)};
                    f32x4 o0, o1;
#pragma unroll
                    for (int j = 0; j < 4; ++j) {
                        const float c0 = cb[0][j] + w0[0][j] * f0[j] + k1 * (w1[0][j] * f1[j]) + k2 * (w2[0][j] * f2[j]);
                        const float c1 = cb[1][j] + w0[1][j] * f0[4 + j] + k1 * (w1[1][j] * f1[4 + j]) + k2 * (w2[1][j] * f2[4 + j]);
                        o0[j] = gelu_tanh(c0) * acc[ai][bj][m][0][j]; o1[j] = gelu_tanh(c1) * acc[ai][bj][m][1][j];
                    }
                    *(u32x4*)(ACT + (size_t)row * FF + col) = pack8(o0, o1);
                }
            }
        }
    }
};

DI int invperm32(int c) { return 16 * ((c >> 2) & 1) + 4 * (c >> 3) + (c & 3); }
DI int slot_std(int c) { return (c & ~31) | invperm32(c & 31); }
DI int slot_win(int c) {
    if (c >= 12288 && c < 16896) { const int tc = c & 255, hh = tc >> 7, bj = (tc >> 6) & 1, i64 = tc & 63, x = 64 * hh + i64; return (c & ~255) + 128 * bj + (x & ~31) + invperm32(x & 31); }
    return slot_std(c);
}
DI void transpose_item(const float* W, int K, int N, bf16_t* WT, int mode, LAS float* scr, int item, int lane) {
    const int nblk = N / 32, kb = item / nblk, nb = item % nblk, k0 = 64 * kb, n0 = 32 * nb;
#pragma unroll 8
    for (int i = 0; i < 32; ++i) { const int kk = 2 * i + (lane >> 5); scr[kk * 33 + (lane & 31)] = W[(size_t)(k0 + kk) * N + n0 + (lane & 31)]; }
    asm volatile("s_waitcnt lgkmcnt(0)" ::: "memory");
    const int c = lane & 7;
#pragma unroll
    for (int j = 0; j < 4; ++j) { const int n = (lane >> 3) + 8 * j; const LAS float* s = scr + (8 * c) * 33 + n;
        u32x4 o; o.x = cvt_pk_bf16(s[0 * 33], s[1 * 33]); o.y = cvt_pk_bf16(s[2 * 33], s[3 * 33]); o.z = cvt_pk_bf16(s[4 * 33], s[5 * 33]); o.w = cvt_pk_bf16(s[6 * 33], s[7 * 33]);
        const int drow = mode ? slot_win(n0 + n) : slot_std(n0 + n);
        *(u32x4*)(WT + (size_t)drow * K + k0 + 8 * c) = o; }
    asm volatile("s_waitcnt lgkmcnt(0)" ::: "memory");
}

DI void phase0(const Params& p, LAS unsigned char* lds) {
    const int tid = threadIdx.x, lane = tid & 63, wave = tid >> 6;
    LAS float* sc = (LAS float*)lds;
    LAS float* red = sc + 8192;
    float* ada = (float*)(p.ws + WS_ADA);
    for (int i = tid; i < 8192; i += 512) { const float v = p.c[i]; sc[i] = v / (1.0f + __expf(-v)); }
    __syncthreads();
    for (int cb = blockIdx.x; cb < 256; cb += gridDim.x) {
        {
            const int rg = lane / 12, cq = lane - 12 * rg;
            f32x4 a0 = {0.f, 0.f, 0.f, 0.f}, a1 = a0, a2 = a0, a3 = a0;
            if (rg < 5) {
                const float* wp = p.w_ada + 48 * cb + 4 * cq;
#pragma unroll 13
                for (int i = 0; i < 52; ++i) { const int kl = 5 * i + rg; if (kl < 256) { const int kk = 256 * wave + kl; const f32x4 wv = *(const f32x4*)(wp + (size_t)kk * 12288);
                    a0 += sc[kk] * wv; a1 += sc[2048 + kk] * wv; a2 += sc[4096 + kk] * wv; a3 += sc[6144 + kk] * wv; } }
                LAS float* rp = red + ((wave * 5 + rg) * 4) * 48 + 4 * cq;
                *(LAS f32x4*)(rp) = a0; *(LAS f32x4*)(rp + 48) = a1; *(LAS f32x4*)(rp + 96) = a2; *(LAS f32x4*)(rp + 144) = a3;
            }
        }
        __syncthreads();
        if (tid < 192) { const int b = tid / 48, l = tid % 48; float sacc = 0.f;
#pragma unroll 8
            for (int wg = 0; wg < 40; ++wg) sacc += red[(wg * 4 + b) * 48 + l];
            ada[b * 12288 + 48 * cb + l] = sacc + p.b_ada[48 * cb + l]; }
        __syncthreads();
    }
    asm volatile("s_waitcnt vmcnt(0)" ::: "memory");
    __syncthreads();
    if (tid == 0) { __builtin_amdgcn_fence(__ATOMIC_RELEASE, "agent"); asm volatile("s_waitcnt vmcnt(0)" ::: "memory");
        __hip_atomic_fetch_add((unsigned*)(p.ws + 700000) + 1536, 1u, __ATOMIC_RELAXED, __HIP_MEMORY_SCOPE_AGENT); }
    LAS float* scr = (LAS float*)(lds + 40960 + wave * 8448);
    const int gw = blockIdx.x * 8 + wave, NGW = gridDim.x * 8;
    constexpr int I_IN = (2048 / 64) * (19200 / 32), I_GATE = (2048 / 64) * (4096 / 32), I_RET = (4096 / 64) * (2048 / 32), I_ATT = (2304 / 64) * (2048 / 32),
                  I_MIX = (2048 / 64) * (2048 / 32), I_UP = (2048 / 64) * (11264 / 32), I_DOWN = (5632 / 64) * (2048 / 32);
    constexpr int NITEMS = I_IN + I_GATE + I_RET + I_ATT + I_MIX + I_UP + I_DOWN;
    for (int it = gw; it < NITEMS - I_UP; it += NGW) {
        int r = it;
        if (r < I_IN) { transpose_item(p.w_in, 2048, 19200, (bf16_t*)(p.ws + WS_WIN), 1, scr, r, lane); continue; } r -= I_IN;
        if (r < I_GATE) { transpose_item(p.w_gate, 2048, 4096, (bf16_t*)(p.ws + WS_WGATE), 0, scr, r, lane); continue; } r -= I_GATE;
        if (r < I_RET) { transpose_item(p.w_ret_out, 4096, 2048, (bf16_t*)(p.ws + WS_WRET), 0, scr, r, lane); continue; } r -= I_RET;
        if (r < I_ATT) { transpose_item(p.w_att_out, 2304, 2048, (bf16_t*)(p.ws + WS_WATT), 0, scr, r, lane); continue; } r -= I_ATT;
        if (r < I_MIX) { transpose_item(p.w_mix, 2048, 2048, (bf16_t*)(p.ws + WS_WMIX), 0, scr, r, lane); continue; } r -= I_MIX;
        transpose_item(p.w_down, 5632, 2048, (bf16_t*)(p.ws + WS_WDOWN), 0, scr, r, lane);
    }
}
DI void convert_ffn_weights(const Params& p, LAS unsigned char* lds, int idx, int nshare) {
    const int lane = threadIdx.x & 63, wave = threadIdx.x >> 6;
    LAS float* scr = (LAS float*)(lds + wave * 8448);
    constexpr int I_UP = (2048 / 64) * (11264 / 32), I_DOWN = (5632 / 64) * (2048 / 32);
    for (int it = idx * 8 + wave; it < I_UP; it += nshare * 8) transpose_item(p.w_up, 2048, 11264, (bf16_t*)(p.ws + WS_WUP), 0, scr, it, lane);
}

constexpr int NR = 2;
DI void phase_h(const Params& p) {
    const int lane = threadIdx.x & 63, wave = threadIdx.x >> 6;
    const float* ada = (const float*)(p.ws + WS_ADA); bf16_t* H = (bf16_t*)(p.ws + WS_H);
    const int nw = gridDim.x * 8;
    for (int row0 = blockIdx.x * 8 + wave; row0 < T_TOK; row0 += nw * NR) {
        f32x4 v[NR][4][2]; float ss[NR];
#pragma unroll
        for (int q = 0; q < NR; ++q) { const float* xr = p.x + (size_t)(row0 + q * nw) * DM; ss[q] = 0.f;
#pragma unroll
            for (int it = 0; it < 4; ++it) { const int col = (it * 64 + lane) * 8; v[q][it][0] = *(const f32x4*)(xr + col); v[q][it][1] = *(const f32x4*)(xr + col + 4); } }
#pragma unroll
        for (int q = 0; q < NR; ++q) {
#pragma unroll
            for (int it = 0; it < 4; ++it)
#pragma unroll
                for (int j = 0; j < 4; ++j) ss[q] += v[q][it][0][j] * v[q][it][0][j] + v[q][it][1][j] * v[q][it][1][j];
            ss[q] = __builtin_amdgcn_rsqf(wave_sum(ss[q]) * (1.0f / DM) + 1e-6f); }
#pragma unroll
        for (int it = 0; it < 4; ++it) { const int col = (it * 64 + lane) * 8;
            f32x4 g[2], sh[NR][2], scl[NR][2];
#pragma unroll
            for (int hh = 0; hh < 2; ++hh) { g[hh] = *(const f32x4*)(p.g_pre_mix + col + 4 * hh);
#pragma unroll
                for (int q = 0; q < NR; ++q) { const int b = (row0 + q * nw) / SEQ; sh[q][hh] = *(const f32x4*)(ada + b * 12288 + col + 4 * hh); scl[q][hh] = *(const f32x4*)(ada + b * 12288 + 2048 + col + 4 * hh); } }
#pragma unroll
            for (int q = 0; q < NR; ++q) { f32x4 o[2];
#pragma unroll
                for (int hh = 0; hh < 2; ++hh)
#pragma unroll
                    for (int j = 0; j < 4; ++j) o[hh][j] = v[q][it][hh][j] * ss[q] * g[hh][j] * (1.0f + scl[q][hh][j]) + sh[q][hh][j];
                *(u32x4*)(H + (size_t)(row0 + q * nw) * DM + col) = pack8(o[0], o[1]); } }
    }
}

DI void phase_postmix(const Params& p) {
    const int lane = threadIdx.x & 63, wave = threadIdx.x >> 6;
    const float* ada = (const float*)(p.ws + WS_ADA); const bf16_t* Y = (const bf16_t*)(p.ws + WS_Y); bf16_t* H2 = (bf16_t*)(p.ws + WS_H2);
    const int nw = gridDim.x * 8;
    for (int row0 = blockIdx.x * 8 + wave; row0 < T_TOK; row0 += nw * NR) {
        f32x4 y[NR][4][2], xv[NR][4][2]; float ry[NR], r1[NR];
#pragma unroll
        for (int q = 0; q < NR; ++q) { const size_t ro = (size_t)(row0 + q * nw) * DM;
#pragma unroll
            for (int it = 0; it < 4; ++it) { const int col = (it * 64 + lane) * 8; const u32x4 w = *(const u32x4*)(Y + ro + col);
                y[q][it][0] = (f32x4){bflo(w.x), bfhi(w.x), bflo(w.y), bfhi(w.y)}; y[q][it][1] = (f32x4){bflo(w.z), bfhi(w.z), bflo(w.w), bfhi(w.w)};
                xv[q][it][0] = *(const f32x4*)(p.x + ro + col); xv[q][it][1] = *(const f32x4*)(p.x + ro + col + 4); } }
#pragma unroll
        for (int q = 0; q < NR; ++q) { float ss = 0.f;
#pragma unroll
            for (int it = 0; it < 4; ++it)
#pragma unroll
                for (int j = 0; j < 4; ++j) ss += y[q][it][0][j] * y[q][it][0][j] + y[q][it][1][j] * y[q][it][1][j];
            ry[q] = __builtin_amdgcn_rsqf(wave_sum(ss) * (1.0f / DM) + 1e-6f); }
#pragma unroll
        for (int q = 0; q < NR; ++q) { const int row = row0 + q * nw; const float* ab = ada + (row / SEQ) * 12288; float s1 = 0.f;
#pragma unroll
            for (int it = 0; it < 4; ++it) { const int col = (it * 64 + lane) * 8;
#pragma unroll
                for (int hh = 0; hh < 2; ++hh) { const f32x4 g = *(const f32x4*)(p.g_post_mix + col + 4 * hh), gt = *(const f32x4*)(ab + 4096 + col + 4 * hh);
                    f32x4 o;
#pragma unroll
                    for (int j = 0; j < 4; ++j) { o[j] = xv[q][it][hh][j] + gt[j] * (y[q][it][hh][j] * ry[q] * g[j]); s1 += o[j] * o[j]; }
                    y[q][it][hh] = o; }
                *(u32x4*)((bf16_t*)(p.out + (size_t)row * DM + DM / 2) + col) = pack8(y[q][it][0], y[q][it][1]); }
            r1[q] = __builtin_amdgcn_rsqf(wave_sum(s1) * (1.0f / DM) + 1e-6f); }
#pragma unroll
        for (int q = 0; q < NR; ++q) { const int row = row0 + q * nw; const float* ab = ada + (row / SEQ) * 12288;
#pragma unroll
            for (int it = 0; it < 4; ++it) { const int col = (it * 64 + lane) * 8; f32x4 o[2];
#pragma unroll
                for (int hh = 0; hh < 2; ++hh) { const f32x4 g = *(const f32x4*)(p.g_pre_ffn + col + 4 * hh), sh = *(const f32x4*)(ab + 6144 + col + 4 * hh), scl = *(const f32x4*)(ab + 8192 + col + 4 * hh);
#pragma unroll
                    for (int j = 0; j < 4; ++j) o[hh][j] = y[q][it][hh][j] * r1[q] * g[j] * (1.0f + scl[j]) + sh[j]; }
                *(u32x4*)(H2 + (size_t)row * DM + col) = pack8(o[0], o[1]); } }
    }
}

DI void phase_final(const Params& p) {
    const int lane = threadIdx.x & 63, wave = threadIdx.x >> 6;
    const float* ada = (const float*)(p.ws + WS_ADA); const bf16_t* Y = (const bf16_t*)(p.ws + WS_Y2);
    const int nw = gridDim.x * 8;
    for (int row0 = blockIdx.x * 8 + wave; row0 < T_TOK; row0 += nw * NR) {
        f32x4 y[NR][4][2], xv[NR][4][2]; float ry[NR];
#pragma unroll
        for (int q = 0; q < NR; ++q) { const size_t ro = (size_t)(row0 + q * nw) * DM;
#pragma unroll
            for (int it = 0; it < 4; ++it) { const int col = (it * 64 + lane) * 8; const u32x4 w = *(const u32x4*)(Y + ro + col);
                y[q][it][0] = (f32x4){bflo(w.x), bfhi(w.x), bflo(w.y), bfhi(w.y)}; y[q][it][1] = (f32x4){bflo(w.z), bfhi(w.z), bflo(w.w), bfhi(w.w)};
                const u32x4 xw = *(const u32x4*)((const bf16_t*)(p.out + ro + DM / 2) + col);
                xv[q][it][0] = (f32x4){bflo(xw.x), bfhi(xw.x), bflo(xw.y), bfhi(xw.y)}; xv[q][it][1] = (f32x4){bflo(xw.z), bfhi(xw.z), bflo(xw.w), bfhi(xw.w)}; } }
#pragma unroll
        for (int q = 0; q < NR; ++q) { float ss = 0.f;
#pragma unroll
            for (int it = 0; it < 4; ++it)
#pragma unroll
                for (int j = 0; j < 4; ++j) ss += y[q][it][0][j] * y[q][it][0][j] + y[q][it][1][j] * y[q][it][1][j];
            ry[q] = __builtin_amdgcn_rsqf(wave_sum(ss) * (1.0f / DM) + 1e-6f); }
#pragma unroll
        for (int q = 0; q < NR; ++q) { const int row = row0 + q * nw; const float* ab = ada + (row / SEQ) * 12288;
#pragma unroll
            for (int it = 0; it < 4; ++it) { const int col = (it * 64 + lane) * 8;
#pragma unroll
                for (int hh = 0; hh < 2; ++hh) { const f32x4 g = *(const f32x4*)(p.g_post_ffn + col + 4 * hh), gt = *(const f32x4*)(ab + 10240 + col + 4 * hh);
                    f32x4 o;
#pragma unroll
                    for (int j = 0; j < 4; ++j) o[j] = xv[q][it][hh][j] + gt[j] * (y[q][it][hh][j] * ry[q] * g[j]);
                    *(f32x4*)(p.out + (size_t)row * DM + col + 4 * hh) = o; } } }
    }
}

DI void phase_alpha(const Params& p) {
    bf16_t* att = (bf16_t*)(p.ws + WS_AQ); const float* lse = (const float*)(p.ws + WS_LSE);
    const int lane = threadIdx.x & 63, wave = threadIdx.x >> 6;
    for (int t = blockIdx.x * 8 + wave; t < T_TOK; t += gridDim.x * 8) {
        const float l = lse[(size_t)t * 18 + (lane < 18 ? lane : 0)];
        const int j = lane % 6;
        const float l0 = __shfl(l, j), l1 = __shfl(l, 6 + j), l2 = __shfl(l, 12 + j);
        const float mm = fmaxf(l0, fmaxf(l1, l2)); const float e0 = __expf(l0 - mm), e1 = __expf(l1 - mm), e2 = __expf(l2 - mm);
        const float al_lane = __expf(l - mm) / (e0 + e1 + e2);
        u32x4* row = (u32x4*)(att + (size_t)t * 2304);
        u32x4 w[5];
#pragma unroll
        for (int k = 0; k < 5; ++k) { const int ch = lane + 64 * k; if (ch < 288) w[k] = row[ch]; }
#pragma unroll
        for (int k = 0; k < 5; ++k) { const int ch = lane + 64 * k; const float al = __shfl(al_lane, (ch < 288 ? ch : 0) >> 4);
            if (ch < 288) { u32x4 o;
                o.x = cvt_pk_bf16(bflo(w[k].x) * al, bfhi(w[k].x) * al); o.y = cvt_pk_bf16(bflo(w[k].y) * al, bfhi(w[k].y) * al);
                o.z = cvt_pk_bf16(bflo(w[k].z) * al, bfhi(w[k].z) * al); o.w = cvt_pk_bf16(bflo(w[k].w) * al, bfhi(w[k].w) * al);
                row[ch] = o; } }
    }
}

DI void phase_retention(const Params& p, LAS unsigned char* lds, int cblk) {
    const int tid = threadIdx.x, lane = tid & 63, w = tid >> 6, fr = lane & 15, fq = lane >> 4;
    LAS unsigned char* Qs = lds; LAS unsigned char* Ks = lds + 33792; LAS unsigned char* Vs = lds + 67584; LAS unsigned char* St = lds + 76800; LAS unsigned char* Ps = lds + 110592;
    LAS float* red = (LAS float*)(lds + 119808);
    const bf16_t* rq = (const bf16_t*)(p.ws + WS_RQ); const bf16_t* rk = (const bf16_t*)(p.ws + WS_RK); bf16_t* rv = (bf16_t*)p.out; float* retss = (float*)(p.ws + WS_RETSS);
    for (int item = cblk; item < 256; item += gridDim.x) {
        const int q5 = item >> 3, bh = (item & 7) * 4 + (q5 & 3), slice = q5 >> 2, b = bh >> 3, h = bh & 7;
        const float lg = log1pf(-exp2f(-5.0f - (float)h));
        const float gamma_c = expf(64.0f * lg);
        const float xv = expf(-lg * (float)((tid >> 3) + 1));
        const float xo0 = expf(lg * (float)(32 * (w & 1) + fr + 1)), xo1 = expf(lg * (float)(32 * (w & 1) + 16 + fr + 1));
        const size_t tok0 = (size_t)b * SEQ;
        const bf16_t* qbase = rq + tok0 * 2048 + h * 256 + (tid & 31) * 8; const bf16_t* kbase = rk + tok0 * 2048 + h * 256 + (tid & 31) * 8;
        bf16_t* vbase = rv + tok0 * 4096 + h * 512 + slice * 64;
        u32x4 pq[4], pk[4], pv;
        f32x4 Sreg[2][4];
#pragma unroll
        for (int a = 0; a < 2; ++a)
#pragma unroll
            for (int bb = 0; bb < 4; ++bb) Sreg[a][bb] = (f32x4){0.f, 0.f, 0.f, 0.f};
        for (int i = tid; i < 33792 / 16; i += 512) ((LAS u32x4*)St)[i] = (u32x4){0u, 0u, 0u, 0u};
#define RET_LOAD(c) do { _Pragma("unroll") for (int i = 0; i < 4; ++i) { const int row = (tid + 512 * i) >> 5; \
            pq[i] = *(const u32x4*)(qbase + (size_t)(64 * (c) + row) * 2048); pk[i] = *(const u32x4*)(kbase + (size_t)(64 * (c) + row) * 2048); } \
            pv = *(const u32x4*)(vbase + (size_t)(64 * (c) + (tid >> 3)) * 4096 + (tid & 7) * 8); } while (0)
#define RET_STORE() do { _Pragma("unroll") for (int i = 0; i < 4; ++i) { const int e = tid + 512 * i, row = e >> 5, pc = e & 31; \
            *(LAS u32x4*)(Qs + row * 528 + pc * 16) = pq[i]; *(LAS u32x4*)(Ks + row * 528 + pc * 16) = pk[i]; } \
            { u32x4 o; o.x = cvt_pk_bf16(bflo(pv.x) * xv, bfhi(pv.x) * xv); o.y = cvt_pk_bf16(bflo(pv.y) * xv, bfhi(pv.y) * xv); \
              o.z = cvt_pk_bf16(bflo(pv.z) * xv, bfhi(pv.z) * xv); o.w = cvt_pk_bf16(bflo(pv.w) * xv, bfhi(pv.w) * xv); \
              *(LAS u32x4*)(Vs + (tid >> 3) * 144 + (tid & 7) * 16) = o; } } while (0)
        RET_LOAD(0); RET_STORE();
        __syncthreads();
        for (int c = 0; c < 128; ++c) {
            if (c + 1 < 128) RET_LOAD(c + 1);
            bf16x8 qfr[8][2];
            {
                const int jt = w >> 1, it0 = (w & 1) * 2;
                f32x4 sa[2] = {(f32x4){0.f, 0.f, 0.f, 0.f}, (f32x4){0.f, 0.f, 0.f, 0.f}};
#pragma unroll
                for (int ks = 0; ks < 8; ++ks) {
                    const bf16x8 kf = *(const LAS bf16x8*)(Ks + (16 * jt + fr) * 528 + (32 * ks + 8 * fq) * 2);
#pragma unroll
                    for (int t = 0; t < 2; ++t) { qfr[ks][t] = *(const LAS bf16x8*)(Qs + (16 * (it0 + t) + fr) * 528 + (32 * ks + 8 * fq) * 2); sa[t] = mfma16(kf, qfr[ks][t], sa[t]); }
                }
#pragma unroll
                for (int t = 0; t < 2; ++t) { const int iq = 16 * (it0 + t) + fr, jk0 = 16 * jt + 4 * fq;
                    u32x2 o; o.x = cvt_pk_bf16(jk0 + 0 <= iq ? sa[t][0] : 0.f, jk0 + 1 <= iq ? sa[t][1] : 0.f); o.y = cvt_pk_bf16(jk0 + 2 <= iq ? sa[t][2] : 0.f, jk0 + 3 <= iq ? sa[t][3] : 0.f);
                    *(LAS u32x2*)(Ps + iq * 144 + jk0 * 2) = o; }
            }
            {
#pragma unroll
                for (int ks = 0; ks < 2; ++ks) {
                    const int j0 = 32 * ks + 8 * fq + (fr >> 2);
                    bf16x8 kt[2], vf[4];
#pragma unroll
                    for (int dd = 0; dd < 2; ++dd) { LAS unsigned char* a0 = Ks + j0 * 528 + (16 * (2 * w + dd) + 4 * (fr & 3)) * 2; kt[dd] = tr_read2(a0, a0 + 4 * 528); }
#pragma unroll
                    for (int vt = 0; vt < 4; ++vt) { LAS unsigned char* a0 = Vs + j0 * 144 + (16 * vt + 4 * (fr & 3)) * 2; vf[vt] = tr_read2(a0, a0 + 4 * 144); }
#pragma unroll
                    for (int dd = 0; dd < 2; ++dd)
#pragma unroll
                        for (int vt = 0; vt < 4; ++vt) Sreg[dd][vt] = mfma16(kt[dd], vf[vt], Sreg[dd][vt]);
                }
#pragma unroll
                for (int dd = 0; dd < 2; ++dd)
#pragma unroll
                    for (int vt = 0; vt < 4; ++vt) Sreg[dd][vt] *= gamma_c;
            }
            __syncthreads();
            {
                const int vt = w >> 1, it0 = (w & 1) * 2;
                f32x4 oa[2] = {(f32x4){0.f, 0.f, 0.f, 0.f}, (f32x4){0.f, 0.f, 0.f, 0.f}};
#pragma unroll
                for (int ks = 0; ks < 8; ++ks) {
                    const bf16x8 sf = *(const LAS bf16x8*)(St + (16 * vt + fr) * 528 + (32 * ks + 8 * fq) * 2);
#pragma unroll
                    for (int t = 0; t < 2; ++t) oa[t] = mfma16(sf, qfr[ks][t], oa[t]);
                }
#pragma unroll
                for (int ks = 0; ks < 2; ++ks) {
                    const int j0 = 32 * ks + 8 * fq + (fr >> 2);
                    LAS unsigned char* a0 = Vs + j0 * 144 + (16 * vt + 4 * (fr & 3)) * 2; const bf16x8 vf = tr_read2(a0, a0 + 4 * 144);
#pragma unroll
                    for (int t = 0; t < 2; ++t) { const bf16x8 pf = *(const LAS bf16x8*)(Ps + (16 * (it0 + t) + fr) * 144 + (32 * ks + 8 * fq) * 2); oa[t] = mfma16(vf, pf, oa[t]); }
                }
#pragma unroll
                for (int t = 0; t < 2; ++t) { const int iq = 16 * (it0 + t) + fr; oa[t] *= (t == 0 ? xo0 : xo1);
                    u32x2 o; o.x = cvt_pk_bf16(oa[t][0], oa[t][1]); o.y = cvt_pk_bf16(oa[t][2], oa[t][3]);
                    *(u32x2*)(vbase + (size_t)(64 * c + iq) * 4096 + 16 * vt + 4 * fq) = o;
                    float ss = (oa[t][0] * oa[t][0] + oa[t][1] * oa[t][1]) + (oa[t][2] * oa[t][2] + oa[t][3] * oa[t][3]);
                    ss += __shfl_xor(ss, 16); ss += __shfl_xor(ss, 32);
                    if (fq == 0) red[iq * 4 + vt] = ss; }
            }
            __syncthreads();
#pragma unroll
            for (int dd = 0; dd < 2; ++dd)
#pragma unroll
                for (int vt = 0; vt < 4; ++vt) { u32x2 o; o.x = cvt_pk_bf16(Sreg[dd][vt][0], Sreg[dd][vt][1]); o.y = cvt_pk_bf16(Sreg[dd][vt][2], Sreg[dd][vt][3]);
                    *(LAS u32x2*)(St + (16 * vt + fr) * 528 + (16 * (2 * w + dd) + 4 * fq) * 2) = o; }
            if (c + 1 < 128) RET_STORE();
            if (tid < 64) retss[((tok0 + 64 * c + tid) * 8 + h) * 8 + slice] = (red[tid * 4 + 0] + red[tid * 4 + 1]) + (red[tid * 4 + 2] + red[tid * 4 + 3]);
            __syncthreads();
        }
#undef RET_LOAD
#undef RET_STORE
    }
}

DI void phase_attention(const Params& p, LAS unsigned char* lds) {
    const int tid = threadIdx.x, lane = tid & 63, w = tid >> 6, fr = lane & 15, fq = lane >> 4;
    LAS unsigned char* Ks = lds; LAS unsigned char* Vs = lds + 69632;
    bf16_t* aq = (bf16_t*)(p.ws + WS_AQ); const bf16_t* ak = (const bf16_t*)(p.ws + WS_AK); const bf16_t* av = (const bf16_t*)(p.ws + WS_AV); float* lse = (float*)(p.ws + WS_LSE);
    const int per = (4608 + (int)gridDim.x - 1) / (int)gridDim.x, it_lo = (int)blockIdx.x * per, it_hi = (it_lo + per < 4608) ? it_lo + per : 4608;
    int prev_key = -1;
    u32x4 kcur[4], vcur[4];
#define ATT_LOAD_CUR(item_) do { const int bh_ = (item_) >> 6, e64_ = (item_) & 63, head_ = bh_ % 18, b_ = bh_ / 18; \
        const int rsh_ = 2 * (head_ / 6), r_ = 1 << rsh_, nbc_ = 64 >> rsh_, cls_ = e64_ / nbc_, nb_ = e64_ - cls_ * nbc_; \
        _Pragma("unroll") for (int i = 0; i < 4; ++i) { const int e = tid + 512 * i, row = e >> 4, pc = e & 15; \
            const size_t off = ((size_t)b_ * SEQ + (size_t)(nb_ * 128 + row) * r_ + cls_) * 2304 + head_ * 128 + pc * 8; \
            kcur[i] = *(const u32x4*)(ak + off); vcur[i] = *(const u32x4*)(av + off); } } while (0)
    if (it_lo < it_hi) ATT_LOAD_CUR(it_lo);
    for (int item = it_lo, cnt = 0; item < it_hi; ++item, ++cnt) {
        const int bh = item >> 6, e64 = item & 63, head = bh % 18, b = bh / 18;
        const int g = head / 6, rsh = 2 * g, r = 1 << rsh, nbc = 64 >> rsh, cls = e64 / nbc, nb = e64 - cls * nbc;
        const int pq0 = nb * 128, pk0 = pq0 - 128;
        const size_t tokb = (size_t)b * SEQ;
        const int scur = cnt & 1, sprev = scur ^ 1;
        const bool reuse = (nb > 0) && (prev_key == item - 1);
#pragma unroll
        for (int i = 0; i < 4; ++i) { const int e = tid + 512 * i, row = e >> 4, pc = e & 15;
            *(LAS u32x4*)(Ks + (scur * 128 + row) * 272 + pc * 16) = kcur[i]; *(LAS u32x4*)(Vs + (scur * 128 + row) * 288 + pc * 16) = vcur[i]; }
        if (!reuse) {
#pragma unroll
            for (int i = 0; i < 4; ++i) { const int e = tid + 512 * i, row = e >> 4, pc = e & 15;
                u32x4 kv = {0u, 0u, 0u, 0u}, vv = kv;
                if (nb > 0) { const size_t off = (tokb + (size_t)(pk0 + row) * r + cls) * 2304 + head * 128 + pc * 8; kv = *(const u32x4*)(ak + off); vv = *(const u32x4*)(av + off); }
                *(LAS u32x4*)(Ks + (sprev * 128 + row) * 272 + pc * 16) = kv; *(LAS u32x4*)(Vs + (sprev * 128 + row) * 288 + pc * 16) = vv; }
        }
        if (item + 1 < it_hi) ATT_LOAD_CUR(item + 1);
        prev_key = item;
        const int qq = 16 * w + fr;
        const size_t tokq = tokb + (size_t)(pq0 + qq) * r + cls;
        bf16x8 qf[4];
        { const bf16_t* qp = aq + tokq * 2304 + head * 128 + 8 * fq;
#pragma unroll
          for (int ks = 0; ks < 4; ++ks) qf[ks] = *(const bf16x8*)(qp + 32 * ks); }
        __syncthreads();
        f32x4 sa[10];
#pragma unroll
        for (int kt = 0; kt < 10; ++kt) { sa[kt] = (f32x4){0.f, 0.f, 0.f, 0.f};
            const int T = (w + kt < 16) ? w + kt : 15;
            const int krow = ((T < 8) ? sprev : scur) * 128 + 16 * (T & 7) + fr;
#pragma unroll
            for (int ks = 0; ks < 4; ++ks) { const bf16x8 kf = *(const LAS bf16x8*)(Ks + krow * 272 + (32 * ks + 8 * fq) * 2); sa[kt] = mfma16(kf, qf[ks], sa[kt]); } }
        const float sc2 = 0.08838834764831845f * 1.4426950408889634f;
        float mrow = -INFINITY;
#pragma unroll
        for (int kt = 0; kt < 10; ++kt)
#pragma unroll
            for (int j = 0; j < 4; ++j) { const int kk = 16 * (w + kt) + 4 * fq + j; const bool valid = (kk >= qq) && (kk <= qq + 128) && (pk0 + kk >= 0);
                const float sv = valid ? sa[kt][j] * sc2 : -INFINITY; sa[kt][j] = sv; mrow = fmaxf(mrow, sv); }
        mrow = fmaxf(mrow, __shfl_xor(mrow, 16)); mrow = fmaxf(mrow, __shfl_xor(mrow, 32));
        float lsum = 0.f;
        bf16x8 pf[5];
#pragma unroll
        for (int t = 0; t < 5; ++t) { f32x4 p0, p1;
#pragma unroll
            for (int j = 0; j < 4; ++j) { p0[j] = __builtin_amdgcn_exp2f(sa[2 * t][j] - mrow); p1[j] = __builtin_amdgcn_exp2f(sa[2 * t + 1][j] - mrow); lsum += p0[j] + p1[j]; }
            const u32x4 pk4 = pack8(p0, p1); pf[t] = __builtin_bit_cast(bf16x8, pk4); }
        lsum += __shfl_xor(lsum, 16); lsum += __shfl_xor(lsum, 32);
        __builtin_amdgcn_sched_barrier(0);
        f32x4 oa[8];
#pragma unroll
        for (int dt = 0; dt < 8; ++dt) oa[dt] = (f32x4){0.f, 0.f, 0.f, 0.f};
#pragma unroll
        for (int t = 0; t < 5; ++t) {
            const int T0 = w + 2 * t, T1 = (T0 + 1 < 16) ? T0 + 1 : T0;
            const int r0 = ((T0 < 8) ? sprev : scur) * 128 + 16 * (T0 & 7) + 4 * fq + (fr >> 2), r1 = ((T1 < 8) ? sprev : scur) * 128 + 16 * (T1 & 7) + 4 * fq + (fr >> 2);
            LAS unsigned char* a0 = Vs + r0 * 288 + (4 * (fr & 3)) * 2; LAS unsigned char* a1 = Vs + r1 * 288 + (4 * (fr & 3)) * 2;
#pragma unroll
            for (int dt = 0; dt < 8; ++dt) { const bf16x8 vf = tr_read2(a0 + 32 * dt, a1 + 32 * dt); oa[dt] = mfma16(vf, pf[t], oa[dt]); }
        }
        const float inv = __builtin_amdgcn_rcpf(lsum);
        bf16_t* po = aq + tokq * 2304 + head * 128 + 4 * fq;
#pragma unroll
        for (int dt = 0; dt < 8; ++dt) { u32x2 o; o.x = cvt_pk_bf16(oa[dt][0] * inv, oa[dt][1] * inv); o.y = cvt_pk_bf16(oa[dt][2] * inv, oa[dt][3] * inv); *(u32x2*)(po + 16 * dt) = o; }
        if (fq == 0) lse[tokq * 18 + head] = mrow * 0.6931471805599453f + __logf(lsum);
        __syncthreads();
    }
#undef ATT_LOAD_CUR
}

constexpr size_t WS_BAR = 700000;
DI void grid_barrier(unsigned* bar, unsigned& nbar, const bool hier, const unsigned xcd, const unsigned per_xcd) {
    asm volatile("s_waitcnt vmcnt(0)" ::: "memory");
    __syncthreads();
    if (threadIdx.x == 0) {
        __builtin_amdgcn_fence(__ATOMIC_RELEASE, "agent");
        asm volatile("s_waitcnt vmcnt(0)" ::: "memory");
        const unsigned gen = nbar + 1u;
        if (hier) {
            unsigned* xc = bar + 256 + 64 * xcd; unsigned* top = bar + 1024;
            const unsigned old = __hip_atomic_fetch_add(xc, 1u, __ATOMIC_RELAXED, __HIP_MEMORY_SCOPE_AGENT);
            if (old + 1u == gen * per_xcd) __hip_atomic_fetch_add(top, 1u, __ATOMIC_RELAXED, __HIP_MEMORY_SCOPE_AGENT);
            while (__hip_atomic_load(top, __ATOMIC_RELAXED, __HIP_MEMORY_SCOPE_AGENT) < gen * 8u) __builtin_amdgcn_s_sleep(1);
        } else {
            const unsigned target = gen * gridDim.x;
            __hip_atomic_fetch_add(bar, 1u, __ATOMIC_RELAXED, __HIP_MEMORY_SCOPE_AGENT);
            while (__hip_atomic_load(bar, __ATOMIC_RELAXED, __HIP_MEMORY_SCOPE_AGENT) < target) __builtin_amdgcn_s_sleep(1);
        }
        __builtin_amdgcn_fence(__ATOMIC_ACQUIRE, "agent");
        asm volatile("s_waitcnt vmcnt(0)" ::: "memory");
    }
    __syncthreads();
    ++nbar;
}

constexpr int N_PHASES = 13;
__global__ void __launch_bounds__(512, 2) mega(Params p) {
    extern __shared__ __attribute__((aligned(16))) unsigned char shm[];
    LAS unsigned char* lds = (LAS unsigned char*)shm;
    unsigned char* ws = p.ws;
    const int G = gridDim.x, c = blockIdx.x;
    unsigned* bar = (unsigned*)(ws + WS_BAR); unsigned nbar = 0;
    int c_eff = c; unsigned my_xcd = 0, my_idx = 0; bool hier = false;
    if (p.ph_hi - p.ph_lo > 1) {
        my_xcd = (unsigned)__builtin_amdgcn_s_getreg((3 << 11) | 20) & 0xFu;
        if (threadIdx.x == 0) my_idx = __hip_atomic_fetch_add(bar + 64 + 16 * (my_xcd & 7u), 1u, __ATOMIC_RELAXED, __HIP_MEMORY_SCOPE_AGENT);
        my_idx = (unsigned)__builtin_amdgcn_readfirstlane((int)my_idx);
    }
    if (p.ph_lo <= 0 && 0 < p.ph_hi) {
        if (0 > p.ph_lo) grid_barrier(bar, nbar, hier, my_xcd, (unsigned)G / 8u);

#if (PHMASK >> 0) & 1
            phase0(p, lds);
#endif
    }
    if (p.ph_lo <= 1 && 1 < p.ph_hi) {
        if (1 > p.ph_lo) {
            if (threadIdx.x == 0) { while (__hip_atomic_load(bar + 1536, __ATOMIC_RELAXED, __HIP_MEMORY_SCOPE_AGENT) < (unsigned)G) __builtin_amdgcn_s_sleep(1);
                __builtin_amdgcn_fence(__ATOMIC_ACQUIRE, "agent"); asm volatile("s_waitcnt vmcnt(0)" ::: "memory"); }
            __syncthreads();
        }
        if (p.ph_hi - p.ph_lo > 1) {
            LAS unsigned* cw = (LAS unsigned*)lds;
            if (threadIdx.x == 0) {
                bool ok = (G % 8) == 0 && my_xcd < 8u;
                for (int x = 0; x < 8; ++x) ok = ok && (__hip_atomic_load(bar + 64 + 16 * x, __ATOMIC_RELAXED, __HIP_MEMORY_SCOPE_AGENT) == (unsigned)(G / 8));
                cw[0] = ok ? (my_idx * 8u + my_xcd) : (unsigned)c; cw[1] = ok ? 1u : 0u;
            }
            __syncthreads();
            c_eff = __builtin_amdgcn_readfirstlane((int)cw[0]);
            hier = (cw[1] != 0u);
            __syncthreads();
        }

#if (PHMASK >> 1) & 1
            phase_h(p);
#endif
    }
    if (p.ph_lo <= 2 && 2 < p.ph_hi) {
        if (2 > p.ph_lo) cg::this_grid().sync();

#if (PHMASK >> 2) & 1
            pg8::Gemm g{(const bf16_t*)(ws + WS_H), (const bf16_t*)(ws + WS_WIN), T_TOK, 59 * 256, 2048, nullptr, nullptr, 0}; pg8::StaticOrder S; S.init(T_TOK, 59 * 256, G, c_eff, 32, 16);
            EpiInProj E{(bf16_t*)(ws + WS_RQ), (bf16_t*)(ws + WS_RK), (bf16_t*)p.out, (bf16_t*)(ws + WS_AQ), (bf16_t*)(ws + WS_AK), (bf16_t*)(ws + WS_AV), p.pos};
            pg8::gemm_phase<1>(lds, g, S, E);
            { const int nwg2 = 128 * 59, rem = nwg2 % G;
              if (rem == 0) convert_ffn_weights(p, lds, c_eff, G); else if (c_eff >= rem) convert_ffn_weights(p, lds, c_eff - rem, G - rem); }
#endif
    }
    if (p.ph_lo <= 3 && 3 < p.ph_hi) {
        if (3 > p.ph_lo) grid_barrier(bar, nbar, hier, my_xcd, (unsigned)G / 8u);

#if (PHMASK >> 3) & 1
            phase_retention(p, lds, c_eff); __syncthreads();
#endif
#if (PHMASK >> 13) & 1
            phase_attention(p, lds);
#endif
    }
    if (p.ph_lo <= 4 && 4 < p.ph_hi) {
        if (4 > p.ph_lo) grid_barrier(bar, nbar, hier, my_xcd, (unsigned)G / 8u);

#if (PHMASK >> 4) & 1
            { pg8::Gemm g{(const bf16_t*)(ws + WS_H), (const bf16_t*)(ws + WS_WIN) + (size_t)8192 * 2048, T_TOK, 4096, 2048, nullptr, nullptr, 0}; pg8::StaticOrder S; S.init(T_TOK, 4096, G, c_eff);
              EpiRetGate E{(bf16_t*)p.out, (const float*)(ws + WS_RETSS), p.ret_gain}; pg8::gemm_phase<1>(lds, g, S, E); }
#endif
#if (PHMASK >> 14) & 1
            { pg8::Gemm g{(const bf16_t*)(ws + WS_H), (const bf16_t*)(ws + WS_WGATE), T_TOK, 4096, 2048, nullptr, nullptr, 0}; pg8::StaticOrder S; S.init(T_TOK, 4096, G, c_eff);
              EpiGates E{(bf16_t*)(ws + WS_GATES), p.b_gate}; pg8::gemm_phase<1>(lds, g, S, E); }
#endif
#if (PHMASK >> 15) & 1
            phase_alpha(p);
#endif
    }
    if (p.ph_lo <= 5 && 5 < p.ph_hi) {
        if (5 > p.ph_lo) grid_barrier(bar, nbar, hier, my_xcd, (unsigned)G / 8u);

#if (PHMASK >> 5) & 1
            pg8::Gemm g{(const bf16_t*)p.out, (const bf16_t*)(ws + WS_WRET), T_TOK, 2048, 4096, (const bf16_t*)(ws + WS_AQ), (const bf16_t*)(ws + WS_WATT), 2304}; pg8::StaticOrder S; S.init(T_TOK, 2048, G, c_eff);
            EpiYMerge E{(const bf16_t*)(ws + WS_GATES), (bf16_t*)(ws + WS_U2)}; pg8::gemm_phase<2>(lds, g, S, E);
#endif
    }
    if (p.ph_lo <= 7 && 7 < p.ph_hi) {
        if (7 > p.ph_lo) grid_barrier(bar, nbar, hier, my_xcd, (unsigned)G / 8u);

#if (PHMASK >> 7) & 1
            pg8::Gemm g{(const bf16_t*)(ws + WS_U2), (const bf16_t*)(ws + WS_WMIX), T_TOK, 2048, 2048, nullptr, nullptr, 0}; pg8::StaticOrder S; S.init(T_TOK, 2048, G, c_eff);
            EpiStoreBf16 E{(bf16_t*)(ws + WS_Y), 2048}; pg8::gemm_phase<1>(lds, g, S, E);
#endif
    }
    if (p.ph_lo <= 8 && 8 < p.ph_hi) {
        if (8 > p.ph_lo) grid_barrier(bar, nbar, hier, my_xcd, (unsigned)G / 8u);

#if (PHMASK >> 8) & 1
            phase_postmix(p);
#endif
    }
    if (p.ph_lo <= 9 && 9 < p.ph_hi) {
        if (9 > p.ph_lo) grid_barrier(bar, nbar, hier, my_xcd, (unsigned)G / 8u);

#if (PHMASK >> 9) & 1
            pg8::Gemm g{(const bf16_t*)(ws + WS_H2), (const bf16_t*)(ws + WS_WUP), T_TOK, FF, 2048, nullptr, nullptr, 0}; pg8::StaticOrder S; S.init(T_TOK, FF, G, c_eff);
            EpiStoreBf16 E{(bf16_t*)(ws + WS_A), FF}; pg8::gemm_phase<1>(lds, g, S, E);
#endif
    }
    if (p.ph_lo <= 10 && 10 < p.ph_hi) {
        if (10 > p.ph_lo) grid_barrier(bar, nbar, hier, my_xcd, (unsigned)G / 8u);

#if (PHMASK >> 10) & 1
            pg8::Gemm g{(const bf16_t*)(ws + WS_H2), (const bf16_t*)(ws + WS_WUP) + (size_t)FF * 2048, T_TOK, FF, 2048, nullptr, nullptr, 0}; pg8::StaticOrder S; S.init(T_TOK, FF, G, c_eff);
            EpiConvAct E{(const bf16_t*)(ws + WS_A), (bf16_t*)(ws + WS_ACT), p.conv_w, p.conv_b}; pg8::gemm_phase<1>(lds, g, S, E);
#endif
    }
    if (p.ph_lo <= 11 && 11 < p.ph_hi) {
        if (11 > p.ph_lo) grid_barrier(bar, nbar, hier, my_xcd, (unsigned)G / 8u);

#if (PHMASK >> 11) & 1
            pg8::Gemm g{(const bf16_t*)(ws + WS_ACT), (const bf16_t*)(ws + WS_WDOWN), T_TOK, 2048, FF, nullptr, nullptr, 0}; pg8::StaticOrder S; S.init(T_TOK, 2048, G, c_eff);
            EpiStoreBf16 E{(bf16_t*)(ws + WS_Y2), 2048}; pg8::gemm_phase<1>(lds, g, S, E);
#endif
    }
    if (p.ph_lo <= 12 && 12 < p.ph_hi) {
        if (12 > p.ph_lo) grid_barrier(bar, nbar, hier, my_xcd, (unsigned)G / 8u);

#if (PHMASK >> 12) & 1
            phase_final(p);
#endif
    }
}

extern "C" void kernel_launch(void* const* d_in, const int* in_sizes, int n_in, void* d_out, int out_size, void* d_ws, size_t ws_size, hipStream_t stream) {
    static int grid = 0;
    if (grid == 0) {
        if (n_in != 20 || ws_size < WS_END) { fprintf(stderr, "kernel_launch: unexpected n_in %d or ws_size %zu (need %zu)\n", n_in, ws_size, (size_t)WS_END); grid = -1; return; }
        int dev = 0, cus = 0, per_cu = 0;
        hipGetDevice(&dev); hipDeviceGetAttribute(&cus, hipDeviceAttributeMultiprocessorCount, dev);
        if (hipFuncSetAttribute((const void*)mega, hipFuncAttributeMaxDynamicSharedMemorySize, LDS_BYTES) != hipSuccess) { fprintf(stderr, "kernel_launch: hipFuncSetAttribute failed\n"); grid = -1; return; }
        if (hipOccupancyMaxActiveBlocksPerMultiprocessor(&per_cu, (const void*)mega, 512, LDS_BYTES) != hipSuccess || per_cu < 1) { fprintf(stderr, "kernel_launch: occupancy query says %d\n", per_cu); per_cu = 1; }
        (void)hipGetLastError();
        grid = cus * 1;
    }
    if (grid < 0) return;
    Params p{};
    p.x = (const float*)d_in[0]; p.c = (const float*)d_in[1]; p.pos = (const int*)d_in[2]; p.w_ada = (const float*)d_in[3]; p.b_ada = (const float*)d_in[4]; p.g_pre_mix = (const float*)d_in[5];
    p.w_in = (const float*)d_in[6]; p.ret_gain = (const float*)d_in[7]; p.w_ret_out = (const float*)d_in[8]; p.w_att_out = (const float*)d_in[9]; p.w_gate = (const float*)d_in[10]; p.b_gate = (const float*)d_in[11];
    p.w_mix = (const float*)d_in[12]; p.g_post_mix = (const float*)d_in[13]; p.g_pre_ffn = (const float*)d_in[14]; p.w_up = (const float*)d_in[15]; p.conv_w = (const float*)d_in[16]; p.conv_b = (const float*)d_in[17];
    p.w_down = (const float*)d_in[18]; p.g_post_ffn = (const float*)d_in[19];
    p.out = (float*)d_out; p.ws = (unsigned char*)d_ws;
    if (hipMemsetAsync((char*)d_ws + WS_BAR, 0, 8192, stream) != hipSuccess) { fprintf(stderr, "kernel_launch: memset failed\n"); return; }
#if N_LAUNCH_PER_PHASE
    for (int ph = 0; ph < N_PHASES; ++ph) { p.ph_lo = ph; p.ph_hi = ph + 1; hipLaunchKernelGGL(mega, dim3(grid), dim3(512), LDS_BYTES, stream, p); }
#else
    p.ph_lo = 0; p.ph_hi = N_PHASES;
    void* args[] = {&p};
    hipError_t e = hipLaunchCooperativeKernel((const void*)mega, dim3(grid), dim3(512), args, LDS_BYTES, stream);
    if (e != hipSuccess) fprintf(stderr, "cooperative launch failed: %s (grid %d)\n", hipGetErrorString(e), grid);
#endif
}
```
